# Optimizing an MI355X kernel written in HIP

```python
import math
import jax, jax.numpy as jnp
from jax import lax
import numpy as np


D_MODEL = 2048
BATCH = 4
SEQ = 8192
DEPTH = 1

CHUNK = 64
PLE_DIM = 256
EPS = 1e-6
GLA_HEADS = 8
GLA_DK = 64
GLA_DV = 128
GLA_GATE_RANK = 16
GLA_GATE_TEMP = 16.0
GLA_QK = GLA_HEADS * GLA_DK
GLA_V = GLA_HEADS * GLA_DV
DSA_HEADS = 8
DSA_HD = 128
DSA_W = DSA_HEADS * DSA_HD
IDX_HEADS = 16
IDX_DIM = 64
IDX_Q = IDX_HEADS * IDX_DIM
INDEX_TOPK = 256
Q_BLOCK = 64
REL_BUCKETS = 32
REL_MAX_DIST = 128
N_GROUPS = 8
EXPERTS_PER_GROUP = 8
N_EXPERTS = N_GROUPS * EXPERTS_PER_GROUP
EXPERT_FF = 512
TOP_K_INNER = 2
MOE_BLOCK = 128
SPLITS = (GLA_QK, GLA_QK, GLA_V, GLA_V, GLA_GATE_RANK, DSA_W, DSA_W, DSA_W, IDX_Q, IDX_DIM, IDX_HEADS)
IN_COLS = sum(SPLITS)

kernel_name = 'hybrid_gla_dsa_hmoe_streaming_block'


def rms_norm(t, g):
    tf = t.astype(jnp.float32)
    tf = tf * lax.rsqrt(jnp.mean(tf * tf, axis=-1, keepdims=True) + EPS)
    return (tf * g.astype(jnp.float32)).astype(t.dtype)


def split_cols(z):
    offs, acc = [], 0
    for w in SPLITS[:-1]:
        acc += w
        offs.append(acc)
    return jnp.split(z, offs, axis=-1)


def t5_bucket(rel):
    half = REL_BUCKETS // 2
    exact = half // 2
    sign = jnp.where(rel > 0, half, 0)
    n = jnp.abs(rel)
    nf = jnp.maximum(n, 1).astype(jnp.float32)
    large = exact + (jnp.log(nf / exact) / math.log(REL_MAX_DIST / exact) * (half - exact)).astype(jnp.int32)
    large = jnp.minimum(large, half - 1)
    return sign + jnp.where(n < exact, n, large)


def gla_mixer(q, k, v, g):
    B, S = q.shape[:2]
    n = S // CHUNK

    def to_chunks(t):
        return t.reshape(B, n, CHUNK, *t.shape[2:]).swapaxes(0, 1)

    G = jnp.cumsum(g.reshape(B, n, CHUNK, GLA_HEADS, GLA_DK), axis=2).swapaxes(0, 1)
    causal = jnp.tril(jnp.ones((CHUNK, CHUNK), dtype=bool))

    def step(state, inp):
        qb, kb, vb, Gb = inp
        o_inter = jnp.einsum('bihk,bhkv->bihv', qb * jnp.exp(Gb), state)
        diff = jnp.where(causal[None, :, :, None, None], Gb[:, :, None] - Gb[:, None, :], -jnp.inf)
        scores = jnp.einsum('bihk,bjhk,bijhk->bhij', qb, kb, jnp.exp(diff))
        o_intra = jnp.einsum('bhij,bjhv->bihv', scores, vb)
        G_last = Gb[:, -1]
        k_dec = kb * jnp.exp(G_last[:, None] - Gb)
        state = state * jnp.exp(G_last)[..., None] + jnp.einsum('bjhk,bjhv->bhkv', k_dec, vb)
        return state, o_inter + o_intra

    state0 = jnp.zeros((B, GLA_HEADS, GLA_DK, GLA_DV), q.dtype)
    _, o = lax.scan(step, state0, (to_chunks(q), to_chunks(k), to_chunks(v), G))
    return o.swapaxes(0, 1).reshape(B, S, GLA_HEADS, GLA_DV)


def dsa_mixer(q, k, v, qi, ki, wi, rel_bias):
    B, S = q.shape[:2]
    topk = min(INDEX_TOPK, S // 4)
    nblk = S // Q_BLOCK
    key_chunk = jnp.arange(S) // CHUNK

    def blocks(t):
        return t.reshape(B, nblk, Q_BLOCK, *t.shape[2:]).swapaxes(0, 1)

    def one_block(args):
        blk, qb, qib, wib = args
        qpos = blk * Q_BLOCK + jnp.arange(Q_BLOCK)
        dots = jnp.einsum('bqjd,bsd->bqjs', qib, ki)
        score = jnp.einsum('bqj,bqjs->bqs', wib, jax.nn.relu(dots)).astype(jnp.float32)
        adm = key_chunk[None, :] <= (qpos // CHUNK)[:, None]
        score = jnp.where(adm[None], score, -jnp.inf)
        top_val, top_idx = lax.top_k(score, topk)
        valid = top_val > -jnp.inf
        k_sel = jax.vmap(lambda kk, ii: kk[ii])(k, top_idx)
        v_sel = jax.vmap(lambda vv, ii: vv[ii])(v, top_idx)
        logits = jnp.einsum('bqhd,bqkhd->bhqk', qb, k_sel).astype(jnp.float32) * (DSA_HD ** -0.5)
        bias = rel_bias[t5_bucket(top_idx - qpos[None, :, None])]
        logits = logits + jnp.moveaxis(bias, -1, 1).astype(jnp.float32)
        logits = jnp.where(valid[:, None], logits, -jnp.inf)
        probs = jax.nn.softmax(logits, axis=-1).astype(v.dtype)
        return jnp.einsum('bhqk,bqkhd->bqhd', probs, v_sel)

    out = lax.map(one_block, (jnp.arange(nblk), blocks(q), blocks(qi), blocks(wi)))
    return out.swapaxes(0, 1).reshape(B, S, DSA_W)


def hier_moe(h, w_group_router, b_group_router, w_expert_router, b_expert_router, w_gate, w_up, w_down):
    B, S, D = h.shape
    T = B * S
    hf = h.reshape(T, D)
    grp_logits = (hf @ w_group_router + b_group_router).astype(jnp.float32)
    grp_prob = jax.nn.softmax(grp_logits, axis=-1)
    grp = jnp.argmax(grp_logits, axis=-1)
    grp_w = jnp.take_along_axis(grp_prob, grp[:, None], axis=1)
    exp_logits = (hf @ w_expert_router + b_expert_router).astype(jnp.float32)
    exp_logits = exp_logits.reshape(T, N_GROUPS, EXPERTS_PER_GROUP)
    in_grp = jnp.take_along_axis(exp_logits, grp[:, None, None], axis=1)[:, 0]
    top_val, top_loc = lax.top_k(in_grp, TOP_K_INNER)
    wts = (grp_w * jax.nn.softmax(top_val, axis=-1)).astype(h.dtype)
    eid = grp[:, None] * EXPERTS_PER_GROUP + top_loc

    A = T * TOP_K_INNER
    flat_e = eid.reshape(A)
    flat_tok = jnp.repeat(jnp.arange(T), TOP_K_INNER)
    flat_w = wts.reshape(A)
    order = jnp.argsort(flat_e)
    se, stok, sw = flat_e[order], flat_tok[order], flat_w[order]
    counts = jnp.bincount(flat_e, length=N_EXPERTS)
    padded = ((counts + MOE_BLOCK - 1) // MOE_BLOCK) * MOE_BLOCK
    start = jnp.cumsum(counts) - counts
    pend = jnp.cumsum(padded)
    pstart = pend - padded
    dest = pstart[se] + (jnp.arange(A) - start[se])
    P = A + N_EXPERTS * MOE_BLOCK
    nblk = P // MOE_BLOCK
    row_tok = jnp.zeros((P,), jnp.int32).at[dest].set(stok)
    row_w = jnp.zeros((P,), h.dtype).at[dest].set(sw)
    blk_expert = jnp.clip(jnp.searchsorted(pend, jnp.arange(nblk) * MOE_BLOCK, side='right'), 0, N_EXPERTS - 1)

    def expert_block(args):
        e, tok = args
        xb = hf[tok]
        return (jax.nn.silu(xb @ w_gate[e]) * (xb @ w_up[e])) @ w_down[e]

    y = lax.map(expert_block, (blk_expert, row_tok.reshape(nblk, MOE_BLOCK))).reshape(P, D)
    out = jax.ops.segment_sum(y * row_w[:, None], row_tok, num_segments=T)
    return out.reshape(B, S, D)


def setup_inputs(seed: int = 0) -> dict:
    key = jax.random.key(seed)
    ks = iter(jax.random.split(key, 32))
    L, D = DEPTH, D_MODEL

    def nrm(shape, scale):
        return jax.random.normal(next(ks), shape, jnp.float32) * scale

    return {
        'x': nrm((BATCH, SEQ, D), 1.0),
        'p': nrm((DEPTH, BATCH, SEQ, PLE_DIM), 1.0),
        'norm_mix_g': 1.0 + nrm((L, D), 0.02),
        'w_in': nrm((L, D, IN_COLS), D ** -0.5),
        'gla_w_alpha': nrm((L, GLA_GATE_RANK, GLA_QK), GLA_GATE_RANK ** -0.5),
        'gla_b_alpha': nrm((L, GLA_QK), 0.1),
        'gla_norm_g': 1.0 + nrm((L, GLA_DV), 0.02),
        'w_out_gla': nrm((L, GLA_V, D), GLA_V ** -0.5),
        'q_norm_g': 1.0 + nrm((L, DSA_HD), 0.02),
        'k_norm_g': 1.0 + nrm((L, DSA_HD), 0.02),
        'rel_bias': nrm((REL_BUCKETS, DSA_HEADS), 0.5),
        'w_out_dsa': nrm((L, DSA_W, D), DSA_W ** -0.5),
        'w_branch_gate': nrm((L, D, 2 * D), D ** -0.5),
        'b_branch_gate': nrm((L, 2 * D), 0.01),
        'w_out': nrm((L, D, D), D ** -0.5),
        'norm_ffn_g': 1.0 + nrm((L, D), 0.02),
        'w_group_router': nrm((L, D, N_GROUPS), D ** -0.5),
        'b_group_router': nrm((L, N_GROUPS), 0.01),
        'w_expert_router': nrm((L, D, N_EXPERTS), D ** -0.5),
        'b_expert_router': nrm((L, N_EXPERTS), 0.01),
        'w_exp_gate': nrm((L, N_EXPERTS, D, EXPERT_FF), D ** -0.5),
        'w_exp_up': nrm((L, N_EXPERTS, D, EXPERT_FF), D ** -0.5),
        'w_exp_down': nrm((L, N_EXPERTS, EXPERT_FF, D), EXPERT_FF ** -0.5),
        'norm_ple_g': 1.0 + nrm((L, D), 0.02),
        'w_ple_gate': nrm((L, D, D), D ** -0.5),
        'b_ple_gate': nrm((L, D), 0.01),
        'w_ple_proj': nrm((L, PLE_DIM, D), PLE_DIM ** -0.5),
    }


def reference(x, p, norm_mix_g, w_in, gla_w_alpha, gla_b_alpha, gla_norm_g, w_out_gla, q_norm_g, k_norm_g, rel_bias, w_out_dsa, w_branch_gate, b_branch_gate, w_out, norm_ffn_g, w_group_router, b_group_router, w_expert_router, b_expert_router, w_exp_gate, w_exp_up, w_exp_down, norm_ple_g, w_ple_gate, b_ple_gate, w_ple_proj):
    B, S, D = x.shape
    for i in range(DEPTH):
        h = rms_norm(x, norm_mix_g[i])
        z = h @ w_in[i]
        gq, gk, gv, gr, glr, dq, dk, dv, iq, ik, iw = split_cols(z)
        q_a = gq.reshape(B, S, GLA_HEADS, GLA_DK) * (GLA_DK ** -0.5)
        k_a = gk.reshape(B, S, GLA_HEADS, GLA_DK)
        v_a = gv.reshape(B, S, GLA_HEADS, GLA_DV)
        g_a = (jax.nn.log_sigmoid(glr @ gla_w_alpha[i] + gla_b_alpha[i]) / GLA_GATE_TEMP).reshape(B, S, GLA_HEADS, GLA_DK)
        o_a = gla_mixer(q_a, k_a, v_a, g_a)
        o_a = rms_norm(o_a, gla_norm_g[i]).reshape(B, S, GLA_V) * jax.nn.silu(gr)
        y_a = o_a @ w_out_gla[i]
        q_b = rms_norm(dq.reshape(B, S, DSA_HEADS, DSA_HD), q_norm_g[i])
        k_b = rms_norm(dk.reshape(B, S, DSA_HEADS, DSA_HD), k_norm_g[i])
        v_b = dv.reshape(B, S, DSA_HEADS, DSA_HD)
        q_i = iq.reshape(B, S, IDX_HEADS, IDX_DIM)
        w_i = iw * ((IDX_HEADS ** -0.5) * (IDX_DIM ** -0.5))
        o_b = dsa_mixer(q_b, k_b, v_b, q_i, ik, w_i, rel_bias)
        y_b = o_b @ w_out_dsa[i]
        gates = jax.nn.sigmoid(h @ w_branch_gate[i] + b_branch_gate[i])
        gate_a, gate_b = jnp.split(gates, 2, axis=-1)
        x = x + (gate_a * y_a + gate_b * y_b) @ w_out[i]
        x = x + hier_moe(rms_norm(x, norm_ffn_g[i]), w_group_router[i], b_group_router[i], w_expert_router[i], b_expert_router[i], w_exp_gate[i], w_exp_up[i], w_exp_down[i])
        ple = p[i] @ w_ple_proj[i]
        ple_gate = jax.nn.sigmoid(rms_norm(x, norm_ple_g[i]) @ w_ple_gate[i] + b_ple_gate[i])
        x = x + ple_gate * ple
    return x
```

```cpp
#include <hip/hip_runtime.h>
#include <cstdio>
#include <cstdint>

#ifndef MK_STAGE
#define MK_STAGE 1
#endif

#define GAS __attribute__((address_space(1)))
#define LAS __attribute__((address_space(3)))
typedef unsigned short bf16;
typedef unsigned v4u __attribute__((ext_vector_type(4)));
typedef unsigned v2u __attribute__((ext_vector_type(2)));
typedef float f32x4 __attribute__((ext_vector_type(4)));
typedef float f32x2 __attribute__((ext_vector_type(2)));
typedef float f32x16 __attribute__((ext_vector_type(16)));
typedef short bf16x8 __attribute__((ext_vector_type(8)));
typedef short s16x4 __attribute__((ext_vector_type(4)));
typedef GAS unsigned gu32;
#define RLX_AGENT __ATOMIC_RELAXED, __HIP_MEMORY_SCOPE_AGENT
#define LDS_WAIT() asm volatile("s_waitcnt lgkmcnt(0)" ::: "memory")
#define VM_WAIT() asm volatile("s_waitcnt vmcnt(0)" ::: "memory")

constexpr int NB = 4, SEQ = 8192, T = NB * SEQ, D = 2048, PLE = 256;
constexpr int ZP = 7424;
constexpr int ZC_GQ = 0, ZC_GK = 512, ZC_GV = 1024, ZC_GR = 2048, ZC_GLR = 3072, ZC_IK = 3088, ZC_IW = 3152, ZC_IQ = 3328, ZN_A = 4352  , ZC_DQ = 4352, ZC_DK = 5376, ZC_DV = 6400;
constexpr int NEXP = 64, EFF = 512, ECAP = 32768;
constexpr int ACT_ROWS = 81920;
constexpr float EPS = 1e-6f;
constexpr int NWAVES = 8;

constexpr size_t MiB = 1u << 20;
constexpr size_t al(size_t x) { return (x + 255) & ~(size_t)255; }
constexpr size_t WS_CTL = 0, CTL_ZERO_BYTES = 1 * MiB;
constexpr size_t WS_WIN = WS_CTL + CTL_ZERO_BYTES;
constexpr size_t WS_WBG = WS_WIN + al((size_t)ZP * D * 2);
constexpr size_t WS_WOG = WS_WBG + al((size_t)4096 * D * 2);
constexpr size_t WS_WOD = WS_WOG + al((size_t)D * 1024 * 2);
constexpr size_t WS_WO = WS_WOD + al((size_t)D * 1024 * 2);
constexpr size_t WS_WPG = WS_WO + al((size_t)D * D * 2);
constexpr size_t WS_WPP = WS_WPG + al((size_t)D * D * 2);
constexpr size_t WS_WR = WS_WPP + al((size_t)D * PLE * 2);
constexpr size_t WS_HB = WS_WR + al((size_t)256 * D * 2);
constexpr size_t WS_ZB = WS_HB + al((size_t)T * D * 2);
constexpr size_t ZB_BYTES = (size_t)T * ZP * 2;
constexpr size_t WS_SC = WS_ZB + al(ZB_BYTES);
constexpr size_t SC_PER_BATCH = (size_t)64 * 64 * (128 * 129 / 2);
constexpr size_t SC_BYTES = (size_t)NB * SC_PER_BATCH * 2;
constexpr size_t WS_BM = WS_SC + al(SC_BYTES);
constexpr size_t WS_SLOC = WS_BM + al((size_t)T * 1024);
constexpr size_t WS_STT = WS_SLOC + al((size_t)4096 * 8192 * 4);
constexpr size_t WS_DEC = WS_STT + al((size_t)4096 * 8192 * 2);
constexpr size_t WS_IKC = WS_DEC + al((size_t)4096 * 64 * 4);
constexpr size_t WS_UW = WS_IKC + al((size_t)T * 64 * 2);
constexpr size_t WS_WBG8 = WS_UW + al((size_t)T * 16 * 4);
constexpr size_t WS_WPG8 = WS_WBG8 + al((size_t)4096 * D);
constexpr size_t WS_WOD8 = WS_WPG8 + al((size_t)D * D);
constexpr size_t WS_WO8 = WS_WOD8 + al((size_t)D * 1024);
constexpr size_t WS_END = WS_WO8 + al((size_t)D * D);
constexpr size_t WS_WIN8 = WS_WIN + (size_t)ZN_A * D * 2;
static_assert(WS_WIN8 + (size_t)5120 * D <= WS_WBG, "w_in copies fit their region");
constexpr size_t WS_OA = WS_SC, WS_OB = WS_SC + (size_t)T * 1024 * 2;
constexpr size_t WS_YA = WS_ZB, WS_YB = WS_ZB + (size_t)T * D * 2, WS_U = WS_ZB + 2 * (size_t)T * D * 2;
constexpr size_t WS_WGU = WS_ZB;
constexpr size_t WS_WDN = WS_WGU + (size_t)NEXP * 1024 * D * 2;
constexpr size_t WS_ACT = WS_WDN + (size_t)NEXP * D * EFF * 2;
static_assert(WS_ACT + (size_t)ACT_ROWS * EFF * 2 <= WS_ZB + ZB_BYTES, "MoE overlay fits in Z");
constexpr size_t WS_LOGIT = WS_SC;
constexpr size_t WS_TOKROW = WS_LOGIT + (size_t)T * 256 * 4;
constexpr size_t WS_TOKW = WS_TOKROW + (size_t)NEXP * ECAP * 4;
constexpr size_t WS_PLEB = WS_TOKW + (size_t)NEXP * ECAP * 4;
constexpr size_t WS_PBF = WS_PLEB + (size_t)T * D * 2;
static_assert(WS_PBF + (size_t)T * PLE * 2 <= WS_SC + SC_BYTES, "late overlays fit in SC");
constexpr size_t WS_H8 = WS_STT;
constexpr size_t WS_WGU8 = WS_HB;
constexpr size_t WS_WDN8 = WS_SC + SC_BYTES - (size_t)NEXP * D * EFF;
static_assert(WS_PBF + (size_t)T * PLE * 2 <= WS_WDN8 && WS_OB + (size_t)T * 1024 * 2 <= WS_WDN8 && WS_WDN8 % 256 == 0, "expert down weights behind the SC overlays");
constexpr size_t WS_X2B = WS_ZB;
constexpr size_t WS_H2B = WS_ZB;
constexpr size_t WS_Y0 = WS_SLOC;
static_assert(WS_END <= (size_t)1253000000, "workspace map within the guaranteed minimum");
constexpr int CW_BAR = 4096;
constexpr int CW_CNT = 16384;
constexpr int CW_ATTQ = 20480;

__device__ __forceinline__ unsigned f2bf(float f) { unsigned u = __builtin_bit_cast(unsigned, f); return (u + 0x7fffu + ((u >> 16) & 1u)) >> 16; }
__device__ __forceinline__ unsigned pk2(float lo, float hi) { return f2bf(lo) | (f2bf(hi) << 16); }
__device__ __forceinline__ unsigned pk4_fp8(float a, float b, float c, float d) { int w = 0; w = __builtin_amdgcn_cvt_pk_fp8_f32(a, b, w, false); w = __builtin_amdgcn_cvt_pk_fp8_f32(c, d, w, true); return (unsigned)w; }
__device__ __forceinline__ float bf2f(unsigned short b) { return __builtin_bit_cast(float, (unsigned)b << 16); }
__device__ __forceinline__ float bflo(unsigned w) { return __builtin_bit_cast(float, w << 16); }
__device__ __forceinline__ float bfhi(unsigned w) { return __builtin_bit_cast(float, w & 0xffff0000u); }
__device__ __forceinline__ unsigned cvt_pk_bf16(float lo, float hi) { unsigned r; asm volatile("v_cvt_pk_bf16_f32 %0, %1, %2" : "=v"(r) : "v"(lo), "v"(hi)); return r; }
#define DPP_I(v, ctrl) __builtin_amdgcn_update_dpp((int)(v), (int)(v), (ctrl), 0xF, 0xF, true)
#define DPP_F(v, ctrl) __builtin_bit_cast(float, __builtin_amdgcn_update_dpp(__builtin_bit_cast(int, (float)(v)), __builtin_bit_cast(int, (float)(v)), (ctrl), 0xF, 0xF, true))
constexpr int DPP_X1 = 0xB1, DPP_X2 = 0x4E, DPP_HM = 0x141, DPP_RM = 0x140;
__device__ __forceinline__ float sum8(float v) { v += DPP_F(v, DPP_X1); v += DPP_F(v, DPP_X2); v += DPP_F(v, DPP_HM); return v; }
__device__ __forceinline__ float sum16(float v) { v = sum8(v); v += DPP_F(v, DPP_RM); return v; }
__device__ __forceinline__ float sum32(float v) { v = sum16(v); auto r = __builtin_amdgcn_permlane16_swap(__float_as_uint(v), __float_as_uint(v), false, false); return __uint_as_float(r[0]) + __uint_as_float(r[1]); }
__device__ __forceinline__ float wave_sum(float v) { v = sum32(v); auto r = __builtin_amdgcn_permlane32_swap(__float_as_uint(v), __float_as_uint(v), false, false); return __uint_as_float(r[0]) + __uint_as_float(r[1]); }
__device__ __forceinline__ float wave_max(float v) {
    v = fmaxf(v, DPP_F(v, DPP_X1)); v = fmaxf(v, DPP_F(v, DPP_X2)); v = fmaxf(v, DPP_F(v, DPP_HM)); v = fmaxf(v, DPP_F(v, DPP_RM));
    { auto r = __builtin_amdgcn_permlane16_swap(__float_as_uint(v), __float_as_uint(v), false, false); v = fmaxf(__uint_as_float(r[0]), __uint_as_float(r[1])); }
    { auto r = __builtin_amdgcn_permlane32_swap(__float_as_uint(v), __float_as_uint(v), false, false); v = fmaxf(__uint_as_float(r[0]), __uint_as_float(r[1])); }
    return v;
}
__device__ __forceinline__ int wave_sum_i(int v) {
    v += DPP_I(v, DPP_X1); v += DPP_I(v, DPP_X2); v += DPP_I(v, DPP_HM); v += DPP_I(v, DPP_RM);
    { auto r = __builtin_amdgcn_permlane16_swap((unsigned)v, (unsigned)v, false, false); v = (int)(r[0] + r[1]); }
    { auto r = __builtin_amdgcn_permlane32_swap((unsigned)v, (unsigned)v, false, false); v = (int)(r[0] + r[1]); }
    return v;
}
__device__ __forceinline__ int opaque_tid() { int t = threadIdx.x; asm volatile("" : "+v"(t)); return t; }
__device__ __forceinline__ float sigmoidf_(float x) { return __builtin_amdgcn_rcpf(1.0f + __builtin_amdgcn_exp2f(-1.4426950408889634f * x)); }

#define XB_TMO      128
#define XB_XCNT(j)  (256  + 64 * (j))
#define XB_XSUB(j)  (1280 + 64 * (j))
#define XB_XGEN(j)  (2304 + 64 * (j))
#define XB_TOP      3328
#define XB_TOPGEN   3392
#define XCD_BAR_WORDS 3456
#define XB_SPIN_CAP (1u << 18)
__device__ __forceinline__ unsigned xb_ld(unsigned* p)              { return __hip_atomic_load(p, __ATOMIC_RELAXED, __HIP_MEMORY_SCOPE_AGENT); }
__device__ __forceinline__ unsigned xb_add(unsigned* p, unsigned v) { return __hip_atomic_fetch_add(p, v, __ATOMIC_RELAXED, __HIP_MEMORY_SCOPE_AGENT); }
__device__ __forceinline__ unsigned xb_xcc_id() { return (unsigned)__builtin_amdgcn_s_getreg((3 << 11) | 20) & 0xFu; }
#define XB_SPIN(cond, bar) do { unsigned _sp = 0; while (cond) { __builtin_amdgcn_s_sleep(1); \
    if ((++_sp & 255u) == 0u) { if (xb_ld(&(bar)[XB_TMO])) break; if (_sp > XB_SPIN_CAP) { atomicAdd(&(bar)[XB_TMO], 1u); break; } } } } while (0)
struct XcdBarrier { unsigned* bar; unsigned x; volatile LAS unsigned* st; };
__device__ __forceinline__ XcdBarrier xcd_barrier_post(unsigned* bar, volatile LAS unsigned* st) {
    XcdBarrier b; b.bar = bar; b.x = xb_xcc_id(); b.st = st;
    if (threadIdx.x == 0) (void)xb_add(&bar[XB_XCNT(b.x)], 1u);
    return b;
}
__device__ __forceinline__ void xcd_barrier_complete(unsigned* bar, unsigned x, unsigned& nloc, unsigned& nx) {
    const unsigned G = gridDim.x * gridDim.y * gridDim.z;
    unsigned sum, cnt, mine, sp = 0u;
    for (;;) {
        sum = 0u; cnt = 0u; mine = 0u;
#pragma unroll
        for (unsigned j = 0; j < 16; ++j) { const unsigned c = xb_ld(&bar[XB_XCNT(j)]); sum += c; cnt += (c > 0u) ? 1u : 0u; mine = (j == x) ? c : mine; }
        if (sum == G) break;
        __builtin_amdgcn_s_sleep(1);
        if ((++sp & 255u) == 0u) { if (xb_ld(&bar[XB_TMO])) break; if (sp > XB_SPIN_CAP) { atomicAdd(&bar[XB_TMO], 1u); break; } }
    }
    nloc = mine > 0u ? mine : 1u; nx = cnt > 0u ? cnt : 1u;
}
__device__ __forceinline__ void xcd_barrier(const XcdBarrier& b) {
    asm volatile("s_waitcnt vmcnt(0)" ::: "memory");
    __syncthreads();
    if (threadIdx.x == 0) {
        unsigned* bar = b.bar;
        __builtin_amdgcn_s_waitcnt(0);
        unsigned nloc = b.st[0], nx = b.st[1];
        if (nloc == 0u) { xcd_barrier_complete(bar, b.x, nloc, nx); b.st[0] = nloc; b.st[1] = nx; }
        const unsigned old = xb_add(&bar[XB_XSUB(b.x)], 1u);
        const unsigned gen = old / nloc;
        if (old + 1u == (gen + 1u) * nloc) {
            __builtin_amdgcn_fence(__ATOMIC_RELEASE, "agent");
            asm volatile("s_waitcnt vmcnt(0)" ::: "memory");
            const unsigned og = xb_add(&bar[XB_TOP], 1u);
            const unsigned tg = og / nx;
            if (og + 1u == (tg + 1u) * nx) xb_add(&bar[XB_TOPGEN], 1u);
            else XB_SPIN(xb_ld(&bar[XB_TOPGEN]) == tg, bar);
            __builtin_amdgcn_fence(__ATOMIC_ACQUIRE, "agent");
            xb_add(&bar[XB_XGEN(b.x)], 1u);
            asm volatile("s_waitcnt vmcnt(0)" ::: "memory");
        } else {
            XB_SPIN(xb_ld(&bar[XB_XGEN(b.x)]) == gen, bar);
            __builtin_amdgcn_fence(__ATOMIC_ACQUIRE, "agent");
            asm volatile("s_waitcnt vmcnt(0)" ::: "memory");
        }
    }
    __syncthreads();
}

namespace pg8 {
constexpr int BM = 256, BK = 64, HALF = 128, HTB = HALF * BK * 2, STAGE_BYTES = 8 * HTB, NXCD = 8, WGM = 8;
__host__ __device__ __forceinline__ int lds_byte(int r, int c) { const int st = (r >> 4) * 2 + (c >> 5), rr = r & 15, cc = c & 31, ob = rr * 64 + cc * 2; return st * 1024 + (ob ^ (((ob >> 9) & 1) << 5)); }
__host__ __device__ __forceinline__ void stage_rc(int b, int& R, int& C) { const int st = b / 1024, sb = b % 1024, swz = sb ^ (((sb >> 9) & 1) << 5); R = (st >> 1) * 16 + swz / 64; C = (st & 1) * 32 + (swz % 64) / 2; }
__host__ __device__ __forceinline__ int perm32(int rho) { const int n = rho >> 4, i = rho & 15; return 8 * (i >> 2) + 4 * n + (i & 3); }

struct Unit { int pm, pn; int e, mt; };
struct Gemm { const bf16* A; const bf16* Bt; int K; };

typedef int v8i __attribute__((ext_vector_type(8)));
typedef int v4i __attribute__((ext_vector_type(4)));
struct Gemm8 { const unsigned char* A; const unsigned char* Bt; int K; int sa, sb; };
struct F2x { bf16x8 v[2]; __device__ __forceinline__ bf16x8& operator[](int i) { return v[i]; } __device__ __forceinline__ const bf16x8& operator[](int i) const { return v[i]; } };
__host__ __device__ __forceinline__ int lds_byte8(int r, int g) { const int st = (r >> 4) * 2 + (g >> 1), ob = (r & 15) * 64 + 32 * (g & 1); return st * 1024 + (ob ^ (((ob >> 9) & 1) << 5)); }
struct StaticOrder {
    int nM, nN, nwg, G, c;
    __device__ void init(int M, int N, int G_, int c_) { nM = M / BM; nN = N / BM; nwg = nM * nN; G = G_; c = c_; }
    __device__ __forceinline__ bool next(int i, Unit& u) const {
        const long L = (long)i * G + c; if (L >= nwg) return false;
        int wgid = (int)L; { const int q = nwg / NXCD, r = nwg % NXCD, xcd = wgid % NXCD, off = wgid / NXCD; wgid = (xcd < r ? xcd * (q + 1) : r * (q + 1) + (xcd - r) * q) + off; }
        const int nig = WGM * nN, gid = wgid / nig, fm = gid * WGM, gsz = (nM - fm) < WGM ? (nM - fm) : WGM;
        u.pm = fm + ((wgid % nig) % gsz); u.pn = (wgid % nig) / gsz; u.e = 0; u.mt = 0; return true;
    }
    __device__ __forceinline__ void rows(const Unit&, int, int, unsigned (&)[2][2]) const {}
};

template <class Epi, class Sched, bool GATHER = false>
__device__ __forceinline__ void gemm_phase(LAS unsigned char* lds, const Gemm g, const Sched& S, const Epi& E) {
    int tid_ = threadIdx.x; asm volatile("" : "+v"(tid_));
    const int tid = tid_, wid = __builtin_amdgcn_readfirstlane(tid >> 6), lane = tid & 63, wr = wid >> 2, wc = wid & 3, fr = lane & 15, fq = lane >> 4;
    const int K = g.K, nt = K / BK;
    unsigned voffA[2], voffB[2]; int RA[2], CA[2];
#pragma unroll
    for (int i = 0; i < 2; ++i) { int R, C; stage_rc(tid * 16 + i * 8192, R, C); const int Rb = Epi::PERM ? ((R & ~31) + perm32(R & 31)) : R;
        RA[i] = R; CA[i] = C; voffA[i] = (unsigned)(R * K + C) * 2u; voffB[i] = (unsigned)(Rb * K + C) * 2u; }
    const size_t kstep = (size_t)(BK * 2);
    const size_t hstep = (size_t)HALF * K * 2;
    const size_t tstep = 2 * hstep;
    const unsigned ldsw = (unsigned)wid * 1024u;
    const int aoff = lds_byte(wr * 64 + fr, fq * 8), boff = lds_byte(wc * 32 + fr, fq * 8);
#define PG8_SA(b, h) (((b) * 2 + (h)) * HTB)
#define PG8_SB(b, h) ((4 + (b) * 2 + (h)) * HTB)
#define PG8_STAGE(bufoff, gbase, voff) do { _Pragma("unroll") for (int _i = 0; _i < 2; ++_i) \
        __builtin_amdgcn_global_load_lds((const unsigned*)((const char*)(gbase) + (voff)[_i]), (LAS unsigned*)(lds + (bufoff) + ldsw + _i * 8192), 16, 0, 0); } while (0)
#define PG8_STAGE_A(bufoff, gbase, h, AO) do { if constexpr (GATHER) { PG8_STAGE(bufoff, gbase, AO[h]); } else { PG8_STAGE(bufoff, (gbase) + (h) * hstep, voffA); } } while (0)
#define PG8_LDA(dst, b, h) do { _Pragma("unroll") for (int m = 0; m < 4; ++m) _Pragma("unroll") for (int k = 0; k < 2; ++k) dst[m][k] = *(const LAS bf16x8*)(lds + PG8_SA(b, h) + aoff + m * 2048 + k * 1024); } while (0)
#define PG8_LDB(dst, b, h) do { _Pragma("unroll") for (int n = 0; n < 2; ++n) _Pragma("unroll") for (int k = 0; k < 2; ++k) dst[n][k] = *(const LAS bf16x8*)(lds + PG8_SB(b, h) + boff + n * 2048 + k * 1024); } while (0)
#define PG8_MMA(ai, bj, At, Bt) do { __builtin_amdgcn_s_setprio(1); _Pragma("unroll") for (int m = 0; m < 4; ++m) _Pragma("unroll") for (int n = 0; n < 2; ++n) _Pragma("unroll") for (int k = 0; k < 2; ++k) \
        acc[ai][bj][m][n] = __builtin_amdgcn_mfma_f32_16x16x32_bf16(Bt[n][k], At[m][k], acc[ai][bj][m][n], 0, 0, 0); __builtin_amdgcn_s_setprio(0); } while (0)
#define PG8_WAIT_V(n) asm volatile("s_waitcnt vmcnt(" #n ")" ::: "memory")
#define PG8_WAIT_L(n) asm volatile("s_waitcnt lgkmcnt(" #n ")" ::: "memory")
#define PG8_BAR __builtin_amdgcn_s_barrier()
#define PG8_SCHED __builtin_amdgcn_sched_barrier(0)
    Unit cur, nxt; int ui = 0;
    if (!S.next(0, cur)) return;
    f32x4 acc[2][2][4][2];
#pragma unroll
    for (int a = 0; a < 2; ++a)
#pragma unroll
        for (int b = 0; b < 2; ++b)
#pragma unroll
            for (int m = 0; m < 4; ++m)
#pragma unroll
                for (int n = 0; n < 2; ++n) acc[a][b][m][n] = (f32x4){0.f, 0.f, 0.f, 0.f};
    bf16x8 At[4][2], B0[2][2], B1[2][2];
    unsigned aoc[2][2], aon[2][2];
    const char* cA; const char* cB = (const char*)g.Bt + (size_t)cur.pn * tstep;
    if constexpr (GATHER) { cA = (const char*)g.A; S.rows(cur, RA[0], RA[1], aoc);
#pragma unroll
        for (int h = 0; h < 2; ++h)
#pragma unroll
            for (int i = 0; i < 2; ++i) aoc[h][i] += (unsigned)CA[i] * 2u; }
    else { cA = (const char*)g.A + (size_t)cur.pm * tstep;
#pragma unroll
        for (int i = 0; i < 2; ++i) { aoc[0][i] = 0u; aoc[1][i] = 0u; } }
    PG8_STAGE(PG8_SB(0, 0), cB, voffB); PG8_STAGE(PG8_SB(0, 1), cB + hstep, voffB); PG8_STAGE_A(PG8_SA(0, 0), cA, 0, aoc); PG8_STAGE_A(PG8_SA(0, 1), cA, 1, aoc);
    if (wr == 1) PG8_BAR;
    PG8_WAIT_V(2); PG8_BAR;
    PG8_STAGE(PG8_SB(1, 0), cB + kstep, voffB); PG8_STAGE_A(PG8_SA(1, 0), cA + kstep, 0, aoc); PG8_STAGE(PG8_SB(1, 1), cB + hstep + kstep, voffB);
    PG8_WAIT_V(6); PG8_BAR;
    for (;;) {
        const bool has_next = S.next(ui + 1, nxt);
        const char* nA; const char* nB = has_next ? (const char*)g.Bt + (size_t)nxt.pn * tstep : cB;
        if constexpr (GATHER) { nA = cA;
            if (has_next) { S.rows(nxt, RA[0], RA[1], aon);
#pragma unroll
                for (int h = 0; h < 2; ++h)
#pragma unroll
                    for (int i = 0; i < 2; ++i) aon[h][i] += (unsigned)CA[i] * 2u; }
            else {
#pragma unroll
                for (int h = 0; h < 2; ++h)
#pragma unroll
                    for (int i = 0; i < 2; ++i) aon[h][i] = aoc[h][i]; } }
        else { nA = has_next ? (const char*)g.A + (size_t)nxt.pm * tstep : cA;
#pragma unroll
            for (int h = 0; h < 2; ++h)
#pragma unroll
                for (int i = 0; i < 2; ++i) aon[h][i] = aoc[h][i]; }
#pragma nounroll
        for (int t = 0; t < nt; t += 2) {
            const bool last = (t == nt - 2);
            const char* a1 = cA + (size_t)(t + 1) * kstep;
            const char* a2 = last ? nA : cA + (size_t)(t + 2) * kstep; const char* b2 = last ? nB : cB + (size_t)(t + 2) * kstep;
            const char* a3 = a2 + kstep; const char* b3 = b2 + kstep;
            unsigned ao2[2][2];
#pragma unroll
            for (int h = 0; h < 2; ++h)
#pragma unroll
                for (int i = 0; i < 2; ++i) ao2[h][i] = (GATHER && last) ? aon[h][i] : aoc[h][i];
            PG8_LDB(B0, 0, 0); PG8_LDB(B1, 0, 1); PG8_SCHED; PG8_LDA(At, 0, 0); PG8_STAGE_A(PG8_SA(1, 1), a1, 1, aoc);
            PG8_WAIT_V(8); PG8_WAIT_L(0); PG8_BAR; PG8_MMA(0, 0, At, B0); PG8_MMA(0, 1, At, B1); PG8_BAR; PG8_SCHED;
            PG8_LDA(At, 0, 1); PG8_STAGE(PG8_SB(0, 0), b2, voffB); PG8_STAGE(PG8_SB(0, 1), b2 + hstep, voffB); PG8_STAGE_A(PG8_SA(0, 0), a2, 0, ao2);
            PG8_WAIT_V(8); PG8_WAIT_L(0); PG8_BAR; PG8_MMA(1, 0, At, B0); PG8_MMA(1, 1, At, B1); PG8_BAR; PG8_SCHED;
            PG8_LDB(B0, 1, 0); PG8_LDB(B1, 1, 1); PG8_SCHED; PG8_LDA(At, 1, 0); PG8_STAGE_A(PG8_SA(0, 1), a2, 1, ao2);
            PG8_WAIT_V(8); PG8_WAIT_L(0); PG8_BAR; PG8_MMA(0, 0, At, B0); PG8_MMA(0, 1, At, B1); PG8_BAR; PG8_SCHED;
            PG8_LDA(At, 1, 1); PG8_STAGE(PG8_SB(1, 0), b3, voffB); PG8_STAGE(PG8_SB(1, 1), b3 + hstep, voffB); PG8_STAGE_A(PG8_SA(1, 0), a3, 0, ao2);
            PG8_WAIT_V(8); PG8_WAIT_L(0); PG8_BAR; PG8_MMA(1, 0, At, B0); PG8_MMA(1, 1, At, B1); PG8_BAR; PG8_SCHED;
        }
        if (wr == 0) PG8_BAR;
        asm volatile("s_nop 15\n\ts_nop 7" ::: "memory");
        E(acc, cur, wr, wc, fr, fq);
        if (!has_next) break;
#pragma unroll
        for (int a = 0; a < 2; ++a)
#pragma unroll
            for (int b = 0; b < 2; ++b)
#pragma unroll
                for (int m = 0; m < 4; ++m)
#pragma unroll
                    for (int n = 0; n < 2; ++n) acc[a][b][m][n] = (f32x4){0.f, 0.f, 0.f, 0.f};
        cur = nxt; cA = nA; cB = nB; ++ui;
#pragma unroll
        for (int h = 0; h < 2; ++h)
#pragma unroll
            for (int i = 0; i < 2; ++i) aoc[h][i] = aon[h][i];
        if (wr == 1) PG8_BAR;
    }
    PG8_WAIT_V(0);
    PG8_BAR;
#undef PG8_SA
#undef PG8_SB
#undef PG8_STAGE
#undef PG8_STAGE_A
#undef PG8_LDA
#undef PG8_LDB
#undef PG8_MMA
#undef PG8_WAIT_V
#undef PG8_WAIT_L
#undef PG8_BAR
#undef PG8_SCHED
}

template <class Epi, class Sched, bool GATHER = false>
__device__ __forceinline__ void gemm_phase8(LAS unsigned char* lds, const Gemm8 g, const Sched& S, const Epi& E) {
    int tid_ = threadIdx.x; asm volatile("" : "+v"(tid_));
    const int tid = tid_, wid = __builtin_amdgcn_readfirstlane(tid >> 6), lane = tid & 63, wr = wid >> 2, wc = wid & 3, fr = lane & 15, fq = lane >> 4;
    const int K = g.K, nt = K / BK;
    unsigned voffA[2], voffB[2]; int RA[2], CA[2];
#pragma unroll
    for (int i = 0; i < 2; ++i) { int R, C; stage_rc(tid * 16 + i * 8192, R, C); const int Rb = Epi::PERM ? ((R & ~31) + perm32(R & 31)) : R;
        RA[i] = R; CA[i] = C; voffA[i] = (unsigned)(R * K + C) * 2u; voffB[i] = (unsigned)(Rb * K + C) * 2u; }
    const size_t kstep = (size_t)(BK * 2);
    const size_t hstep = (size_t)HALF * K * 2;
    const size_t tstep = 2 * hstep;
    const unsigned ldsw = (unsigned)wid * 1024u;
    const int aoff = lds_byte8(wr * 64 + fr, fq), boff = lds_byte8(wc * 32 + fr, fq);
#define PG8_SA(b, h) (((b) * 2 + (h)) * HTB)
#define PG8_SB(b, h) ((4 + (b) * 2 + (h)) * HTB)
#define PG8_STAGE(bufoff, gbase, voff) do { _Pragma("unroll") for (int _i = 0; _i < 2; ++_i) \
        __builtin_amdgcn_global_load_lds((const unsigned*)((const char*)(gbase) + (voff)[_i]), (LAS unsigned*)(lds + (bufoff) + ldsw + _i * 8192), 16, 0, 0); } while (0)
#define PG8_STAGE_A(bufoff, gbase, h, AO) do { if constexpr (GATHER) { PG8_STAGE(bufoff, gbase, AO[h]); } else { PG8_STAGE(bufoff, (gbase) + (h) * hstep, voffA); } } while (0)
#define PG8_LD32(p) __builtin_shufflevector(*(const LAS v4i*)(p), *(const LAS v4i*)((p) + 16), 0, 1, 2, 3, 4, 5, 6, 7)
#define PG8_LDA(dst, b, h) do { _Pragma("unroll") for (int m = 0; m < 4; ++m) dst[m] = PG8_LD32(lds + PG8_SA(b, h) + aoff + m * 2048); } while (0)
#define PG8_LDB(dst, b, h) do { _Pragma("unroll") for (int n = 0; n < 2; ++n) dst[n] = PG8_LD32(lds + PG8_SB(b, h) + boff + n * 2048); } while (0)
#define PG8_MMA(ai, bj, At, Bt) do { __builtin_amdgcn_s_setprio(1); _Pragma("unroll") for (int m = 0; m < 4; ++m) _Pragma("unroll") for (int n = 0; n < 2; ++n) \
        asm volatile("v_mfma_scale_f32_16x16x128_f8f6f4 %0, %1, %2, %0, %3, %4 op_sel_hi:[0,0,0]" : "+v"(acc[ai][bj][m][n]) : "v"(Bt[n]), "v"(At[m]), "v"(vsb), "v"(vsa)); __builtin_amdgcn_s_setprio(0); } while (0)
#define PG8_WAIT_V(n) asm volatile("s_waitcnt vmcnt(" #n ")" ::: "memory")
#define PG8_WAIT_L(n) asm volatile("s_waitcnt lgkmcnt(" #n ")" ::: "memory")
#define PG8_BAR __builtin_amdgcn_s_barrier()
#define PG8_SCHED __builtin_amdgcn_sched_barrier(0)
    Unit cur, nxt; int ui = 0;
    if (!S.next(0, cur)) return;
    f32x4 acc[2][2][4][2];
#pragma unroll
    for (int a = 0; a < 2; ++a)
#pragma unroll
        for (int b = 0; b < 2; ++b)
#pragma unroll
            for (int m = 0; m < 4; ++m)
#pragma unroll
                for (int n = 0; n < 2; ++n) acc[a][b][m][n] = (f32x4){0.f, 0.f, 0.f, 0.f};
    v8i At[4], B0[2], B1[2]; const int vsa = g.sa, vsb = g.sb;
    unsigned aoc[2][2], aon[2][2];
    const char* cA; const char* cB = (const char*)g.Bt + (size_t)cur.pn * tstep;
    if constexpr (GATHER) { cA = (const char*)g.A; S.rows(cur, RA[0], RA[1], aoc);
#pragma unroll
        for (int h = 0; h < 2; ++h)
#pragma unroll
            for (int i = 0; i < 2; ++i) aoc[h][i] += (unsigned)CA[i] * 2u; }
    else { cA = (const char*)g.A + (size_t)cur.pm * tstep;
#pragma unroll
        for (int i = 0; i < 2; ++i) { aoc[0][i] = 0u; aoc[1][i] = 0u; } }
    PG8_STAGE(PG8_SB(0, 0), cB, voffB); PG8_STAGE(PG8_SB(0, 1), cB + hstep, voffB); PG8_STAGE_A(PG8_SA(0, 0), cA, 0, aoc); PG8_STAGE_A(PG8_SA(0, 1), cA, 1, aoc);
    if (wr == 1) PG8_BAR;
    PG8_WAIT_V(2); PG8_BAR;
    PG8_STAGE(PG8_SB(1, 0), cB + kstep, voffB); PG8_STAGE_A(PG8_SA(1, 0), cA + kstep, 0, aoc); PG8_STAGE(PG8_SB(1, 1), cB + hstep + kstep, voffB);
    PG8_WAIT_V(6); PG8_BAR;
    for (;;) {
        const bool has_next = S.next(ui + 1, nxt);
        const char* nA; const char* nB = has_next ? (const char*)g.Bt + (size_t)nxt.pn * tstep : cB;
        if constexpr (GATHER) { nA = cA;
            if (has_next) { S.rows(nxt, RA[0], RA[1], aon);
#pragma unroll
                for (int h = 0; h < 2; ++h)
#pragma unroll
                    for (int i = 0; i < 2; ++i) aon[h][i] += (unsigned)CA[i] * 2u; }
            else {
#pragma unroll
                for (int h = 0; h < 2; ++h)
#pragma unroll
                    for (int i = 0; i < 2; ++i) aon[h][i] = aoc[h][i]; } }
        else { nA = has_next ? (const char*)g.A + (size_t)nxt.pm * tstep : cA;
#pragma unroll
            for (int h = 0; h < 2; ++h)
#pragma unroll
                for (int i = 0; i < 2; ++i) aon[h][i] = aoc[h][i]; }
#pragma nounroll
        for (int t = 0; t < nt; t += 2) {
            const bool last = (t == nt - 2);
            const char* a1 = cA + (size_t)(t + 1) * kstep;
            const char* a2 = last ? nA : cA + (size_t)(t + 2) * kstep; const char* b2 = last ? nB : cB + (size_t)(t + 2) * kstep;
            const char* a3 = a2 + kstep; const char* b3 = b2 + kstep;
            unsigned ao2[2][2];
#pragma unroll
            for (int h = 0; h < 2; ++h)
#pragma unroll
                for (int i = 0; i < 2; ++i) ao2[h][i] = (GATHER && last) ? aon[h][i] : aoc[h][i];
            PG8_LDB(B0, 0, 0); PG8_LDB(B1, 0, 1); PG8_SCHED; PG8_LDA(At, 0, 0); PG8_STAGE_A(PG8_SA(1, 1), a1, 1, aoc);
            PG8_WAIT_V(8); PG8_WAIT_L(0); PG8_BAR; PG8_MMA(0, 0, At, B0); PG8_MMA(0, 1, At, B1); PG8_BAR; PG8_SCHED;
            PG8_LDA(At, 0, 1); PG8_STAGE(PG8_SB(0, 0), b2, voffB); PG8_STAGE(PG8_SB(0, 1), b2 + hstep, voffB); PG8_STAGE_A(PG8_SA(0, 0), a2, 0, ao2);
            PG8_WAIT_V(8); PG8_WAIT_L(0); PG8_BAR; PG8_MMA(1, 0, At, B0); PG8_MMA(1, 1, At, B1); PG8_BAR; PG8_SCHED;
            PG8_LDB(B0, 1, 0); PG8_LDB(B1, 1, 1); PG8_SCHED; PG8_LDA(At, 1, 0); PG8_STAGE_A(PG8_SA(0, 1), a2, 1, ao2);
            PG8_WAIT_V(8); PG8_WAIT_L(0); PG8_BAR; PG8_MMA(0, 0, At, B0); PG8_MMA(0, 1, At, B1); PG8_BAR; PG8_SCHED;
            PG8_LDA(At, 1, 1); PG8_STAGE(PG8_SB(1, 0), b3, voffB); PG8_STAGE(PG8_SB(1, 1), b3 + hstep, voffB); PG8_STAGE_A(PG8_SA(1, 0), a3, 0, ao2);
            PG8_WAIT_V(8); PG8_WAIT_L(0); PG8_BAR; PG8_MMA(1, 0, At, B0); PG8_MMA(1, 1, At, B1); PG8_BAR; PG8_SCHED;
        }
        if (wr == 0) PG8_BAR;
        asm volatile("s_nop 15\n\ts_nop 15\n\ts_nop 15" ::: "memory");
        { const int t2 = opaque_tid(), w2 = __builtin_amdgcn_readfirstlane(t2 >> 6), l2 = t2 & 63;
          E(acc, cur, w2 >> 2, w2 & 3, l2 & 15, l2 >> 4); }
        if (!has_next) break;
#pragma unroll
        for (int a = 0; a < 2; ++a)
#pragma unroll
            for (int b = 0; b < 2; ++b)
#pragma unroll
                for (int m = 0; m < 4; ++m)
#pragma unroll
                    for (int n = 0; n < 2; ++n) acc[a][b][m][n] = (f32x4){0.f, 0.f, 0.f, 0.f};
        cur = nxt; cA = nA; cB = nB; ++ui;
#pragma unroll
        for (int h = 0; h < 2; ++h)
#pragma unroll
            for (int i = 0; i < 2; ++i) aoc[h][i] = aon[h][i];
        if (wr == 1) PG8_BAR;
    }
    PG8_WAIT_V(0);
    PG8_BAR;
#undef PG8_SA
#undef PG8_SB
#undef PG8_STAGE
#undef PG8_STAGE_A
#undef PG8_LDA
#undef PG8_LD32
#undef PG8_LDB
#undef PG8_MMA
#undef PG8_WAIT_V
#undef PG8_WAIT_L
#undef PG8_BAR
#undef PG8_SCHED
}

struct EpiBf16Skip {
    static constexpr bool PERM = true;
    bf16* O; int ldc, pn_skip, skip;
    __device__ __forceinline__ void operator()(const f32x4 (&acc)[2][2][4][2], const Unit& u, int wr, int wc, int fr, int fq) const {
        const int row0 = u.pm * BM + wr * 64 + fr, col0 = u.pn * BM + wc * 32 + 8 * fq + (u.pn >= pn_skip ? skip : 0);
#pragma unroll
        for (int ai = 0; ai < 2; ++ai)
#pragma unroll
            for (int m = 0; m < 4; ++m) { bf16* rowp = O + (size_t)(row0 + ai * HALF + m * 16) * ldc + col0;
#pragma unroll
                for (int bj = 0; bj < 2; ++bj) { const f32x4 v0 = acc[ai][bj][m][0], v1 = acc[ai][bj][m][1];
                    v4u w; w.x = cvt_pk_bf16(v0[0], v0[1]); w.y = cvt_pk_bf16(v0[2], v0[3]); w.z = cvt_pk_bf16(v1[0], v1[1]); w.w = cvt_pk_bf16(v1[2], v1[3]);
                    *(v4u*)(rowp + bj * HALF) = w; } }
    }
};
struct EpiFp8 {
    static constexpr bool PERM = true;
    unsigned char* O; int ldc;
    __device__ __forceinline__ void operator()(const f32x4 (&acc)[2][2][4][2], const Unit& u, int wr, int wc, int fr, int fq) const {
        const int row0 = u.pm * BM + wr * 64 + fr, col0 = u.pn * BM + wc * 32 + 8 * fq;
#pragma unroll
        for (int ai = 0; ai < 2; ++ai)
#pragma unroll
            for (int m = 0; m < 4; ++m) { unsigned char* rowp = O + (size_t)(row0 + ai * HALF + m * 16) * ldc + col0;
#pragma unroll
                for (int bj = 0; bj < 2; ++bj) { const f32x4 v0 = acc[ai][bj][m][0] * 8.0f, v1 = acc[ai][bj][m][1] * 8.0f;
                    v2u w; w.x = pk4_fp8(v0[0], v0[1], v0[2], v0[3]); w.y = pk4_fp8(v1[0], v1[1], v1[2], v1[3]);
                    *(v2u*)(rowp + bj * HALF) = w; } }
    }
};
struct EpiBf16 {
    static constexpr bool PERM = true;
    bf16* O; int ldc;
    __device__ __forceinline__ void operator()(const f32x4 (&acc)[2][2][4][2], const Unit& u, int wr, int wc, int fr, int fq) const {
        const int row0 = u.pm * BM + wr * 64 + fr, col0 = u.pn * BM + wc * 32 + 8 * fq;
#pragma unroll
        for (int ai = 0; ai < 2; ++ai)
#pragma unroll
            for (int m = 0; m < 4; ++m) { bf16* rowp = O + (size_t)(row0 + ai * HALF + m * 16) * ldc + col0;
#pragma unroll
                for (int bj = 0; bj < 2; ++bj) { const f32x4 v0 = acc[ai][bj][m][0], v1 = acc[ai][bj][m][1];
                    v4u w; w.x = cvt_pk_bf16(v0[0], v0[1]); w.y = cvt_pk_bf16(v0[2], v0[3]); w.z = cvt_pk_bf16(v1[0], v1[1]); w.w = cvt_pk_bf16(v1[2], v1[3]);
                    *(v4u*)(rowp + bj * HALF) = w; } }
    }
};
struct EpiF32 {
    static constexpr bool PERM = false;
    float* C; int ldc;
    __device__ __forceinline__ void operator()(const f32x4 (&acc)[2][2][4][2], const Unit& u, int wr, int wc, int fr, int fq) const {
        const int row0 = u.pm * BM + wr * 64 + fr, col0 = u.pn * BM + wc * 32 + 4 * fq;
#pragma unroll
        for (int ai = 0; ai < 2; ++ai)
#pragma unroll
            for (int m = 0; m < 4; ++m) { float* rowp = C + (size_t)(row0 + ai * HALF + m * 16) * ldc + col0;
#pragma unroll
                for (int bj = 0; bj < 2; ++bj)
#pragma unroll
                    for (int n = 0; n < 2; ++n) *(f32x4*)(rowp + bj * HALF + n * 16) = acc[ai][bj][m][n]; }
    }
};
struct EpiResF32 {
    static constexpr bool PERM = false;
    const float* base; float* out; int ldc;
    __device__ __forceinline__ void operator()(const f32x4 (&acc)[2][2][4][2], const Unit& u, int wr, int wc, int fr, int fq) const {
        const int row0 = u.pm * BM + wr * 64 + fr, col0 = u.pn * BM + wc * 32 + 4 * fq;
#pragma unroll
        for (int ai = 0; ai < 2; ++ai)
#pragma unroll
            for (int m = 0; m < 4; ++m) { const size_t off = (size_t)(row0 + ai * HALF + m * 16) * ldc + col0;
#pragma unroll
                for (int bj = 0; bj < 2; ++bj)
#pragma unroll
                    for (int n = 0; n < 2; ++n) { const f32x4 b = *(const f32x4*)(base + off + bj * HALF + n * 16); *(f32x4*)(out + off + bj * HALF + n * 16) = b + acc[ai][bj][m][n]; } }
    }
};
struct EpiResBf16P {
    static constexpr bool PERM = true;
    const float* base; bf16* out; int ldc;
    __device__ __forceinline__ void operator()(const f32x4 (&acc)[2][2][4][2], const Unit& u, int wr, int wc, int fr, int fq) const {
        const int row0 = u.pm * BM + wr * 64 + fr, col0 = u.pn * BM + wc * 32 + 8 * fq;
#pragma unroll
        for (int ai = 0; ai < 2; ++ai)
#pragma unroll
            for (int m = 0; m < 4; ++m) { const size_t off = (size_t)(row0 + ai * HALF + m * 16) * ldc + col0;
#pragma unroll
                for (int bj = 0; bj < 2; ++bj) { const f32x4 v0 = *(const f32x4*)(base + off + bj * HALF) + acc[ai][bj][m][0], v1 = *(const f32x4*)(base + off + bj * HALF + 4) + acc[ai][bj][m][1];
                    v4u w; w.x = cvt_pk_bf16(v0[0], v0[1]); w.y = cvt_pk_bf16(v0[2], v0[3]); w.z = cvt_pk_bf16(v1[0], v1[1]); w.w = cvt_pk_bf16(v1[2], v1[3]);
                    *(v4u*)(out + off + bj * HALF) = w; } }
    }
};
struct EpiResF32P {
    static constexpr bool PERM = true;
    const float* base; float* out; int ldc;
    __device__ __forceinline__ void operator()(const f32x4 (&acc)[2][2][4][2], const Unit& u, int wr, int wc, int fr, int fq) const {
        const int row0 = u.pm * BM + wr * 64 + fr, col0 = u.pn * BM + wc * 32 + 8 * fq;
#pragma unroll
        for (int ai = 0; ai < 2; ++ai)
#pragma unroll
            for (int m = 0; m < 4; ++m) { const size_t off = (size_t)(row0 + ai * HALF + m * 16) * ldc + col0;
#pragma unroll
                for (int bj = 0; bj < 2; ++bj)
#pragma unroll
                    for (int n = 0; n < 2; ++n) { const f32x4 b = *(const f32x4*)(base + off + bj * HALF + n * 4); *(f32x4*)(out + off + bj * HALF + n * 4) = b + acc[ai][bj][m][n]; } }
    }
};
struct EpiGateMix {
    static constexpr bool PERM = true;
    const unsigned char* YA; const unsigned char* YB; unsigned char* U; const float* bias;
    __device__ __forceinline__ void operator()(const f32x4 (&acc)[2][2][4][2], const Unit& u, int wr, int wc, int fr, int fq) const {
        const int row0 = u.pm * BM + wr * 64 + fr, col0 = u.pn * HALF + wc * 32 + 8 * fq;
        const f32x4 ba0 = *(const f32x4*)(bias + col0), ba1 = *(const f32x4*)(bias + col0 + 4), bb0 = *(const f32x4*)(bias + D + col0), bb1 = *(const f32x4*)(bias + D + col0 + 4);
#pragma unroll
        for (int ai = 0; ai < 2; ++ai)
#pragma unroll
            for (int m = 0; m < 4; ++m) { const size_t off = (size_t)(row0 + ai * HALF + m * 16) * D + col0;
                const v2u ya = *(const v2u*)(YA + off), yb = *(const v2u*)(YB + off);
                const f32x4 a0 = acc[ai][0][m][0] + ba0, a1 = acc[ai][0][m][1] + ba1, b0 = acc[ai][1][m][0] + bb0, b1 = acc[ai][1][m][1] + bb1;
                float o[8];
                float va[8], vb[8];
                { const auto p0 = __builtin_amdgcn_cvt_pk_f32_fp8((int)ya.x, false), p1 = __builtin_amdgcn_cvt_pk_f32_fp8((int)ya.x, true), p2 = __builtin_amdgcn_cvt_pk_f32_fp8((int)ya.y, false), p3 = __builtin_amdgcn_cvt_pk_f32_fp8((int)ya.y, true);
                  va[0] = p0[0]; va[1] = p0[1]; va[2] = p1[0]; va[3] = p1[1]; va[4] = p2[0]; va[5] = p2[1]; va[6] = p3[0]; va[7] = p3[1]; }
                { const auto p0 = __builtin_amdgcn_cvt_pk_f32_fp8((int)yb.x, false), p1 = __builtin_amdgcn_cvt_pk_f32_fp8((int)yb.x, true), p2 = __builtin_amdgcn_cvt_pk_f32_fp8((int)yb.y, false), p3 = __builtin_amdgcn_cvt_pk_f32_fp8((int)yb.y, true);
                  vb[0] = p0[0]; vb[1] = p0[1]; vb[2] = p1[0]; vb[3] = p1[1]; vb[4] = p2[0]; vb[5] = p2[1]; vb[6] = p3[0]; vb[7] = p3[1]; }
#pragma unroll
                for (int j = 0; j < 8; ++j) { const float ga = sigmoidf_(j < 4 ? a0[j & 3] : a1[j & 3]), gb = sigmoidf_(j < 4 ? b0[j & 3] : b1[j & 3]);
                    o[j] = ga * va[j] + gb * vb[j]; }
                v2u w; w.x = pk4_fp8(o[0], o[1], o[2], o[3]); w.y = pk4_fp8(o[4], o[5], o[6], o[7]);
                *(v2u*)(U + off) = w;
                asm volatile("" ::: "memory"); }
    }
};
struct EpiPleFinal {
    static constexpr bool PERM = true;
    const bf16* x2; const bf16* P; float* out; const float* bias;
    __device__ __forceinline__ void operator()(const f32x4 (&acc)[2][2][4][2], const Unit& u, int wr, int wc, int fr, int fq) const {
        const int row0 = u.pm * BM + wr * 64 + fr, col0 = u.pn * BM + wc * 32 + 8 * fq;
#pragma unroll
        for (int bj = 0; bj < 2; ++bj) { const f32x4 bv0 = *(const f32x4*)(bias + col0 + bj * HALF), bv1 = *(const f32x4*)(bias + col0 + bj * HALF + 4);
#pragma unroll
            for (int ai = 0; ai < 2; ++ai)
#pragma unroll
                for (int m = 0; m < 4; ++m) { const size_t off = (size_t)(row0 + ai * HALF + m * 16) * D + col0 + bj * HALF;
                    const v4u pw = *(const v4u*)(P + off), xw = *(const v4u*)(x2 + off);
                    const f32x4 x0 = {bflo(xw.x), bfhi(xw.x), bflo(xw.y), bfhi(xw.y)}, x1 = {bflo(xw.z), bfhi(xw.z), bflo(xw.w), bfhi(xw.w)};
                    const f32x4 a0 = acc[ai][bj][m][0] + bv0, a1 = acc[ai][bj][m][1] + bv1;
                    f32x4 o0, o1;
                    o0[0] = x0[0] + sigmoidf_(a0[0]) * bflo(pw.x); o0[1] = x0[1] + sigmoidf_(a0[1]) * bfhi(pw.x); o0[2] = x0[2] + sigmoidf_(a0[2]) * bflo(pw.y); o0[3] = x0[3] + sigmoidf_(a0[3]) * bfhi(pw.y);
                    o1[0] = x1[0] + sigmoidf_(a1[0]) * bflo(pw.z); o1[1] = x1[1] + sigmoidf_(a1[1]) * bfhi(pw.z); o1[2] = x1[2] + sigmoidf_(a1[2]) * bflo(pw.w); o1[3] = x1[3] + sigmoidf_(a1[3]) * bfhi(pw.w);
                    *(f32x4*)(out + off) = o0; *(f32x4*)(out + off + 4) = o1; } }
    }
};

struct PleOrder {
    int G, c;
    __device__ __forceinline__ bool next(int i, Unit& u) const {
        int L;
        if (G == 256) { if (c >= 128) { if (i >= 6) return false; L = (c - 128) * 6 + i; } else { if (i >= 2) return false; L = 768 + c * 2 + i; } }
        else { L = i * G + c; if (L >= 1024) return false; }
        u.pm = L >> 3; u.pn = L & 7; u.e = 0; u.mt = 0; return true;
    }
    __device__ __forceinline__ void rows(const Unit&, int, int, unsigned (&)[2][2]) const {}
};
struct MoeOrder {
    const LAS int* pref;
    const LAS int* cntl;
    const int* tokrow; int NT, G, c, K;
    __device__ __forceinline__ bool next(int i, Unit& u) const {
        const int L = i * G + c; if (L >= pref[64] * NT) return false;
        const int tt = L / NT, pnl = L - tt * NT; int lo = 0, hi = 64;
        while (hi - lo > 1) { const int mid = (lo + hi) >> 1; if (pref[mid] <= tt) lo = mid; else hi = mid; }
        u.e = lo; u.mt = tt - pref[lo]; u.pm = tt; u.pn = lo * NT + pnl; return true;
    }
    __device__ __forceinline__ void rows(const Unit& u, int R0, int R1, unsigned (&off)[2][2]) const {
        const int n = cntl[u.e];
#pragma unroll
        for (int h = 0; h < 2; ++h)
#pragma unroll
            for (int i = 0; i < 2; ++i) { const int j = u.mt * 256 + h * 128 + (i ? R1 : R0);
                const int tk = (j < n) ? (tokrow[(size_t)u.e * ECAP + j] >> 1) : 0; off[h][i] = (unsigned)tk * (unsigned)(K * 2); }
    }
};
struct EpiMoe1 {
    static constexpr bool PERM = true;
    unsigned char* ACT;
    __device__ __forceinline__ void operator()(const f32x4 (&acc)[2][2][4][2], const Unit& u, int wr, int wc, int fr, int fq) const {
        const int row0 = u.pm * BM + wr * 64 + fr, col0 = (u.pn & 3) * HALF + wc * 32 + 8 * fq;
#pragma unroll
        for (int ai = 0; ai < 2; ++ai)
#pragma unroll
            for (int m = 0; m < 4; ++m) { float o[8];
#pragma unroll
                for (int j = 0; j < 8; ++j) { const float g = acc[ai][0][m][j >> 2][j & 3], up = acc[ai][1][m][j >> 2][j & 3]; o[j] = 4.0f * g * sigmoidf_(g) * up; }
                v2u w; w.x = pk4_fp8(o[0], o[1], o[2], o[3]); w.y = pk4_fp8(o[4], o[5], o[6], o[7]);
                *(v2u*)(ACT + (size_t)(row0 + ai * HALF + m * 16) * EFF + col0) = w; }
    }
};
struct EpiMoe2 {
    static constexpr bool PERM = true;
    bf16* Y0; long long ydelta; const int* tokrow; const float* tokw; const LAS int* cntl;
    __device__ __forceinline__ void operator()(const f32x4 (&acc)[2][2][4][2], const Unit& u, int wr, int wc, int fr, int fq) const {
        const int n = cntl[u.e], col0 = (u.pn & 7) * BM + wc * 32 + 8 * fq;
#pragma unroll
        for (int ai = 0; ai < 2; ++ai)
#pragma unroll
            for (int m = 0; m < 4; ++m) { const int j = u.mt * 256 + ai * HALF + wr * 64 + m * 16 + fr;
                if (j < n) { const int info = tokrow[(size_t)u.e * ECAP + j]; const float wt = tokw[(size_t)u.e * ECAP + j];
                    bf16* rowp = Y0 + (long long)(info & 1) * ydelta + (size_t)(info >> 1) * D + col0;
#pragma unroll
                    for (int bj = 0; bj < 2; ++bj) { const f32x4 v0 = acc[ai][bj][m][0] * wt, v1 = acc[ai][bj][m][1] * wt;
                        v4u w; w.x = cvt_pk_bf16(v0[0], v0[1]); w.y = cvt_pk_bf16(v0[2], v0[3]); w.z = cvt_pk_bf16(v1[0], v1[1]); w.w = cvt_pk_bf16(v1[2], v1[3]);
                        *(v4u*)(rowp + bj * HALF) = w; } } }
    }
};
}


#define MFMA32(a, b, c) __builtin_amdgcn_mfma_f32_32x32x16_bf16((a), (b), (c), 0, 0, 0)
__device__ __forceinline__ int crow(int r, int hi) { return (r & 3) + 8 * (r >> 2) + 4 * hi; }

constexpr int GLA_Q_OFF = 0, GLA_K_OFF = 65536, GLA_GLR_OFF = 132096;
__device__ __forceinline__ void gla_prep_task(LAS unsigned char* lds, bf16* Z, const float* w_alpha, const float* b_alpha, float* DEC, int task) {
    const int tid = opaque_tid(); const size_t t0 = (size_t)task * 64;
    LAS float* glr = (LAS float*)(lds + GLA_GLR_OFF);
    LAS unsigned short* qt = (LAS unsigned short*)(lds + GLA_Q_OFF); LAS unsigned short* kt = (LAS unsigned short*)(lds + GLA_K_OFF);
    __syncthreads();
#pragma unroll
    for (int i = 0; i < 8; ++i) { const int ch = tid + 512 * i, row = ch >> 6, c8 = (ch & 63) * 8;
        *(LAS v4u*)(qt + row * 512 + c8) = *(const GAS v4u*)(Z + (t0 + row) * ZP + ZC_GQ + c8);
        *(LAS v4u*)(kt + row * 512 + c8) = *(const GAS v4u*)(Z + (t0 + row) * ZP + ZC_GK + c8); }
    for (int i = tid; i < 1024; i += 512) glr[i] = bf2f(Z[(t0 + (i >> 4)) * ZP + ZC_GLR + (i & 15)]);
    float w[16];
#pragma unroll
    for (int i = 0; i < 16; ++i) w[i] = w_alpha[i * 512 + tid];
    const float bb = b_alpha[tid];
    __syncthreads();
    float G = 0.f;
#pragma unroll 4
    for (int r = 0; r < 64; ++r) {
        float pre = bb;
#pragma unroll
        for (int i = 0; i < 16; ++i) pre = fmaf(glr[r * 16 + i], w[i], pre);
        const float ls = fminf(pre, 0.f) - log1pf(__expf(-fabsf(pre)));
        G += ls * (1.0f / 16.0f);
        const float Gc = fmaxf(G, -80.f);
        const float eq = __expf(Gc), ek = __expf(-Gc);
        const float qv = bf2f(qt[r * 512 + tid]), kv = bf2f(kt[r * 512 + tid]);
        qt[r * 512 + tid] = (unsigned short)f2bf(qv * 0.125f * eq);
        kt[r * 512 + tid] = (unsigned short)f2bf(kv * ek);
    }
    DEC[(size_t)task * 512 + tid] = __expf(fmaxf(G, -80.f));
    __syncthreads();
#pragma unroll
    for (int i = 0; i < 8; ++i) { const int ch = tid + 512 * i, row = ch >> 6, c8 = (ch & 63) * 8;
        *(GAS v4u*)(Z + (t0 + row) * ZP + ZC_GQ + c8) = *(const LAS v4u*)(qt + row * 512 + c8);
        *(GAS v4u*)(Z + (t0 + row) * ZP + ZC_GK + c8) = *(const LAS v4u*)(kt + row * 512 + c8); }
    LDS_WAIT(); VM_WAIT(); __syncthreads();
}
__device__ __forceinline__ void dsa_prep_row(int lane, bf16* Z, size_t m, const float* qg, const float* kg, bf16* IKC, float* UW) {
#pragma unroll
    for (int which = 0; which < 2; ++which) {
        bf16* p = Z + m * ZP + (which ? ZC_DK : ZC_DQ) + lane * 16;
        const v4u a = *(const v4u*)p, b = *(const v4u*)(p + 8);
        float v[16]; const unsigned ww[8] = {a.x, a.y, a.z, a.w, b.x, b.y, b.z, b.w};
        float ss = 0.f;
#pragma unroll
        for (int i = 0; i < 8; ++i) { v[2 * i] = bflo(ww[i]); v[2 * i + 1] = bfhi(ww[i]); ss += v[2 * i] * v[2 * i] + v[2 * i + 1] * v[2 * i + 1]; }
        ss = sum8(ss);
        const float rstd = (1.0f / sqrtf(ss * (1.0f / 128.f) + EPS)) * (which ? 1.0f : 0.08838834764831845f * 1.4426950408889634f);
        const float* g = (which ? kg : qg) + (lane & 7) * 16;
        v4u o0, o1;
        o0.x = pk2(v[0] * rstd * g[0], v[1] * rstd * g[1]); o0.y = pk2(v[2] * rstd * g[2], v[3] * rstd * g[3]); o0.z = pk2(v[4] * rstd * g[4], v[5] * rstd * g[5]); o0.w = pk2(v[6] * rstd * g[6], v[7] * rstd * g[7]);
        o1.x = pk2(v[8] * rstd * g[8], v[9] * rstd * g[9]); o1.y = pk2(v[10] * rstd * g[10], v[11] * rstd * g[11]); o1.z = pk2(v[12] * rstd * g[12], v[13] * rstd * g[13]); o1.w = pk2(v[14] * rstd * g[14], v[15] * rstd * g[15]);
        *(v4u*)p = o0; *(v4u*)(p + 8) = o1;
    }
    if (lane < 8) *(v4u*)(IKC + m * 64 + lane * 8) = *(const v4u*)(Z + m * ZP + ZC_IK + lane * 8);
    if (lane < 16) UW[m * 16 + lane] = bf2f(Z[m * ZP + ZC_IW + lane]) * (0.5f / 32.0f);
}
#define FRAG_NAT(dst, tile, s, hg, col) do { _Pragma("unroll") for (int j_ = 0; j_ < 8; ++j_) dst[j_] = (short)(tile)[(16 * (s) + 8 * (hg) + j_) * 64 + (col)]; } while (0)
__device__ __forceinline__ void gla_local_unit(LAS unsigned char* lds, int wave, int lane, const bf16* Z, const float* DEC, float* SLOC, int u) {
    const int h = u & 7; const size_t t0 = (size_t)(u >> 3) * 64; const int r = lane & 31, hg = lane >> 5;
    const LAS unsigned short* kt = (const LAS unsigned short*)(lds + GLA_K_OFF) + h * 64;
    LAS unsigned short* vt = (LAS unsigned short*)(lds + GLA_Q_OFF + wave * 8192);
    const float d0 = DEC[(size_t)u * 64 + r], d1 = DEC[(size_t)u * 64 + 32 + r];
    bf16x8 Bk[2][4];
#pragma unroll
    for (int nt = 0; nt < 2; ++nt)
#pragma unroll
        for (int s = 0; s < 4; ++s) {
#pragma unroll
            for (int j = 0; j < 8; ++j) Bk[nt][s][j] = (short)kt[(16 * s + 8 * hg + j) * 512 + 32 * nt + r]; }
#pragma unroll 1
    for (int half = 0; half < 2; ++half) {
        LDS_WAIT();
#pragma unroll
        for (int i = 0; i < 8; ++i) { const int row = i * 8 + (lane >> 3), ch = lane & 7;
            *(LAS v4u*)(vt + row * 64 + ch * 8) = *(const v4u*)(Z + (t0 + row) * ZP + ZC_GV + h * 128 + half * 64 + ch * 8); }
        LDS_WAIT();
        f32x16 acc[2][2];
#pragma unroll
        for (int a = 0; a < 2; ++a)
#pragma unroll
            for (int b = 0; b < 2; ++b)
#pragma unroll
                for (int i = 0; i < 16; ++i) acc[a][b][i] = 0.f;
#pragma unroll
        for (int mt = 0; mt < 2; ++mt)
#pragma unroll
            for (int s = 0; s < 4; ++s) { bf16x8 Av; FRAG_NAT(Av, vt, s, hg, 32 * mt + r);
                acc[mt][0] = MFMA32(Av, Bk[0][s], acc[mt][0]); acc[mt][1] = MFMA32(Av, Bk[1][s], acc[mt][1]); }
        unsigned short* out = (unsigned short*)SLOC + (size_t)u * 8192;
#pragma unroll
        for (int mt = 0; mt < 2; ++mt)
#pragma unroll
            for (int i = 0; i < 16; ++i) { const int dv = half * 64 + 32 * mt + crow(i, hg);
                out[dv * 64 + r] = (unsigned short)f2bf(acc[mt][0][i] * d0); out[dv * 64 + 32 + r] = (unsigned short)f2bf(acc[mt][1][i] * d1); }
    }
}
__device__ __forceinline__ void gla_scan(const float* SLOC, const float* DEC, bf16* STT, int gt, int ngt) {
    for (int p = gt; p < 32 * 4096; p += ngt) {
        const int bh = p >> 12, ev = (p & 4095) * 2, b = bh >> 3, h = bh & 7, k = ev & 63;
        float s0 = 0.f, s1 = 0.f;
#pragma unroll 8
        for (int c = 0; c < 128; ++c) {
            const size_t u = ((size_t)(b * 128 + c) * 8 + h);
            const unsigned slw = *(const unsigned*)((const unsigned short*)SLOC + u * 8192 + ev); float2 sl; sl.x = bflo(slw); sl.y = bfhi(slw); const float2 dc = *(const float2*)(DEC + u * 64 + k);
            *(unsigned*)(STT + u * 8192 + ev) = pk2(s0, s1);
            s0 = fmaf(s0, dc.x, sl.x); s1 = fmaf(s1, dc.y, sl.y);
        }
    }
}
__device__ __forceinline__ void gla_out_unit(LAS unsigned char* wl, int lane, const bf16* Z, const bf16* STT, const float* gn, bf16* OA, int u) {
    const int h = u & 7; const size_t t0 = (size_t)(u >> 3) * 64; const int r = lane & 31, hg = lane >> 5;
    LAS unsigned short* vt = (LAS unsigned short*)wl;
    LDS_WAIT();
#pragma unroll
    for (int i = 0; i < 16; ++i) { const int row = i * 4 + (lane >> 4), ch = lane & 15;
        *(LAS v4u*)(vt + row * 128 + ch * 8) = *(const v4u*)(Z + (t0 + row) * ZP + ZC_GV + h * 128 + ch * 8); }
    bf16x8 Fq[2][4], Fk[2][4];
#pragma unroll
    for (int t = 0; t < 2; ++t)
#pragma unroll
        for (int s = 0; s < 4; ++s) {
            Fq[t][s] = *(const bf16x8*)(Z + (t0 + 32 * t + r) * ZP + ZC_GQ + h * 64 + 16 * s + 8 * hg);
            Fk[t][s] = *(const bf16x8*)(Z + (t0 + 32 * t + r) * ZP + ZC_GK + h * 64 + 16 * s + 8 * hg); }
    const bf16* st = STT + (size_t)u * 8192;
    LDS_WAIT();
#pragma unroll 1
    for (int it = 0; it < 2; ++it) {
        f32x16 o[4];
#pragma unroll
        for (int d = 0; d < 4; ++d)
#pragma unroll
            for (int i = 0; i < 16; ++i) o[d][i] = 0.f;
#pragma unroll
        for (int d = 0; d < 4; ++d)
#pragma unroll
            for (int s = 0; s < 4; ++s) { const bf16x8 Bs = *(const bf16x8*)(st + (32 * d + r) * 64 + 16 * s + 8 * hg); o[d] = MFMA32(Fq[it][s], Bs, o[d]); }
#pragma unroll
        for (int jt = 0; jt < 2; ++jt) {
            if (jt <= it) {
                f32x16 X;
#pragma unroll
                for (int i = 0; i < 16; ++i) X[i] = 0.f;
#pragma unroll
                for (int s = 0; s < 4; ++s) X = MFMA32(Fk[jt][s], Fq[it][s], X);
                asm volatile("s_nop 15\n\ts_nop 7" : "+v"(X));
                if (jt == it) {
#pragma unroll
                    for (int i = 0; i < 16; ++i) if (crow(i, hg) > r) X[i] = 0.f;
                }
#pragma unroll
                for (int s2 = 0; s2 < 2; ++s2) {
                    v4u pw; pw.x = cvt_pk_bf16(X[8 * s2 + 0], X[8 * s2 + 1]); pw.y = cvt_pk_bf16(X[8 * s2 + 2], X[8 * s2 + 3]); pw.z = cvt_pk_bf16(X[8 * s2 + 4], X[8 * s2 + 5]); pw.w = cvt_pk_bf16(X[8 * s2 + 6], X[8 * s2 + 7]);
                    const bf16x8 pa = __builtin_bit_cast(bf16x8, pw);
#pragma unroll
                    for (int d = 0; d < 4; ++d) { bf16x8 Bv;
#pragma unroll
                        for (int j = 0; j < 8; ++j) Bv[j] = (short)vt[(32 * jt + 16 * s2 + 8 * (j >> 2) + 4 * hg + (j & 3)) * 128 + 32 * d + r];
                        o[d] = MFMA32(pa, Bv, o[d]); }
                }
            }
        }
        float g4[4];
#pragma unroll
        for (int d = 0; d < 4; ++d) g4[d] = gn[32 * d + r];
#pragma unroll
        for (int i = 0; i < 16; ++i) {
            float ss = o[0][i] * o[0][i] + o[1][i] * o[1][i] + o[2][i] * o[2][i] + o[3][i] * o[3][i];
            ss = sum32(ss);
            const float rstd = 1.0f / sqrtf(ss * (1.0f / 128.f) + EPS);
            const size_t tok = t0 + 32 * it + crow(i, hg);
#pragma unroll
            for (int d = 0; d < 4; ++d) { const float gr = bf2f(Z[tok * ZP + ZC_GR + h * 128 + 32 * d + r]);
                const float val = o[d][i] * rstd * g4[d] * (gr * sigmoidf_(gr));
                OA[tok * 1024 + h * 128 + 32 * d + r] = (bf16)f2bf(val); }
        }
    }
}


__device__ __forceinline__ size_t sc_off(int b, int c) { return (size_t)b * SC_PER_BATCH + (size_t)4096 * ((size_t)c * (c + 1) / 2); }
__device__ __forceinline__ unsigned score_code(float sc) {
    const _Float16 hf = (_Float16)sc; const unsigned bits = (unsigned)__builtin_bit_cast(unsigned short, hf);
    return (bits & 0x8000u) ? (~bits & 0xffffu) : (bits | 0x8000u);
}
__device__ __forceinline__ void idx_scores_oct(LAS unsigned char* wl, int lane, const bf16* Z, const bf16* IKC, const float* UW, unsigned short* SC, int b, int c, int oct) {
    const int r = lane & 31, hg = lane >> 5, n = 64 * (c + 1);
    const size_t t0 = (size_t)b * SEQ + (size_t)c * 64 + 8 * oct;
    bf16x8 A[4][4];
    { const int q = (r >> 2) & 1, head = (r & 3) + 4 * (r >> 3);
#pragma unroll
      for (int a = 0; a < 4; ++a)
#pragma unroll
        for (int s = 0; s < 4; ++s) A[a][s] = *(const bf16x8*)(Z + (t0 + 2 * a + q) * ZP + ZC_IQ + head * 64 + 16 * s + 8 * hg); }
    LAS float* ul = (LAS float*)wl;
    LDS_WAIT();
    ul[lane] = UW[t0 * 16 + lane]; ul[64 + lane] = UW[t0 * 16 + 64 + lane];
    LDS_WAIT();
    GAS unsigned short* row0 = (GAS unsigned short*)SC + sc_off(b, c) + (size_t)(8 * oct + hg) * n;
    const GAS bf16* kb = (const GAS bf16*)IKC + ((size_t)b * SEQ + r) * 64 + 8 * hg;
    const int npair = n / 64;
#define IDX_LOADB(dst, kt_) do { _Pragma("unroll") for (int t = 0; t < 2; ++t) _Pragma("unroll") for (int s = 0; s < 4; ++s) dst[t][s] = *(const GAS bf16x8*)(kb + (size_t)((kt_) + t) * 32 * 64 + 16 * s); } while (0)
#define IDX_STEP(Bc, kt_) do { _Pragma("unroll") for (int a = 0; a < 4; ++a) { \
            f32x2 u2[8]; \
            _Pragma("unroll") for (int i = 0; i < 4; ++i) { const f32x4 t4 = *(const LAS f32x4*)(ul + (2 * a + hg) * 16 + 4 * i); u2[2 * i] = (f32x2){t4.x, t4.y}; u2[2 * i + 1] = (f32x2){t4.z, t4.w}; } \
            f32x16 acc0, acc1; \
            _Pragma("unroll") for (int i = 0; i < 16; ++i) { acc0[i] = 0.f; acc1[i] = 0.f; } \
            _Pragma("unroll") for (int s = 0; s < 4; ++s) { acc0 = MFMA32(A[a][s], Bc[0][s], acc0); acc1 = MFMA32(A[a][s], Bc[1][s], acc1); } \
            f32x2 l0 = {0.f, 0.f}, l1 = {0.f, 0.f}; \
            _Pragma("unroll") for (int j = 0; j < 8; ++j) { l0 = (f32x2){acc0[2 * j], acc0[2 * j + 1]} * u2[j] + l0; l1 = (f32x2){acc1[2 * j], acc1[2 * j + 1]} * u2[j] + l1; } \
            float s0 = l0.x + l0.y, s1 = l1.x + l1.y; \
            _Pragma("unroll") for (int j = 0; j < 8; ++j) { \
                asm("v_fma_f32 %0, |%1|, %2, %0" : "+v"(s0) : "v"(acc0[2 * j]), "v"(u2[j].x)); asm("v_fma_f32 %0, |%1|, %2, %0" : "+v"(s1) : "v"(acc1[2 * j]), "v"(u2[j].x)); \
                asm("v_fma_f32 %0, |%1|, %2, %0" : "+v"(s0) : "v"(acc0[2 * j + 1]), "v"(u2[j].y)); asm("v_fma_f32 %0, |%1|, %2, %0" : "+v"(s1) : "v"(acc1[2 * j + 1]), "v"(u2[j].y)); } \
            const unsigned c0 = score_code(s0), c1 = score_code(s1); \
            const unsigned pa = (unsigned)DPP_I(c0, DPP_X1), pb = (unsigned)DPP_I(c1, DPP_X1); \
            GAS unsigned short* row = row0 + (size_t)(2 * a) * n; \
            if ((r & 1) == 0) *(GAS unsigned*)(row + (kt_) * 32 + r) = c0 | (pa << 16); \
            else *(GAS unsigned*)(row + ((kt_) + 1) * 32 + r - 1) = pb | (c1 << 16); \
            } } while (0)
    bf16x8 B0[2][4], B1[2][4];
    IDX_LOADB(B0, 0);
#pragma unroll 1
    for (int p = 0; p < npair; p += 2) {
        if (p + 1 < npair) IDX_LOADB(B1, 2 * (p + 1));
        IDX_STEP(B0, 2 * p);
        if (p + 1 < npair) {
            if (p + 2 < npair) IDX_LOADB(B0, 2 * (p + 2));
            IDX_STEP(B1, 2 * (p + 1));
        }
    }
#undef IDX_LOADB
#undef IDX_STEP
}
__device__ __forceinline__ void idx_select_row(int lane, const unsigned short* row, int n, LAS unsigned char* bmrow, LAS unsigned* bins  ) {
    const int nch = n / 8;
    if (n <= 256) {
#pragma unroll
        for (int s = 0; s < 16; ++s) { const int j = lane + 64 * s; bmrow[j] = (j < nch) ? 0xffu : 0u; }
        return;
    }
    v4u cw[16];
#pragma unroll
    for (int s = 0; s < 16; ++s) { const int j = lane + 64 * s; const unsigned m = (unsigned)((j - nch) >> 31);
        const int jc = j < nch ? j : nch - 1; const v4u t = *(const v4u*)(row + (size_t)jc * 8); cw[s] = (v4u){t.x & m, t.y & m, t.z & m, t.w & m}; }
    const int ns = (nch + 63) / 64;
#define WSCAN(v) do { _Pragma("unroll") for (int o_ = 1; o_ < 64; o_ <<= 1) { const int t_ = __builtin_amdgcn_ds_bpermute((lane - o_) << 2, (v)); if (lane >= o_) (v) += t_; } } while (0)
#pragma unroll
    for (int i = 0; i < 8; ++i) *(LAS v4u*)(bins + (i * 64 + lane) * 4) = (v4u){0u, 0u, 0u, 0u};
    LDS_WAIT();
#pragma unroll
    for (int s = 0; s < 16; ++s) if (s < ns) {
#pragma unroll
        for (int e = 0; e < 4; ++e) { const unsigned w = cw[s][e];
            __hip_atomic_fetch_add(bins + ((w & 0xffffu) >> 5), 1u, __ATOMIC_RELAXED, __HIP_MEMORY_SCOPE_WORKGROUP);
            __hip_atomic_fetch_add(bins + (w >> 21), 1u, __ATOMIC_RELAXED, __HIP_MEMORY_SCOPE_WORKGROUP); } }
    LDS_WAIT();
    int B, above;
    { unsigned bv[32]; int sl = 0;
#pragma unroll
      for (int i = 0; i < 8; ++i) { const v4u t = *(const LAS v4u*)(bins + lane * 32 + 4 * i); bv[4 * i] = t.x; bv[4 * i + 1] = t.y; bv[4 * i + 2] = t.z; bv[4 * i + 3] = t.w; sl += (int)(t.x + t.y + t.z + t.w); }
      int incl = sl; WSCAN(incl);
      const int tot = __builtin_amdgcn_readlane(incl, 63);
      int run = tot - incl;
      const bool mine = run < 256 && run + sl >= 256;
      int bl = 0, al = 0; bool found = false;
#pragma unroll
      for (int k = 31; k >= 0; --k) { const int cbin = (int)bv[k]; if (!found && run + cbin >= 256) { bl = 32 * lane + k; al = run; found = true; } run += cbin; }
      const unsigned long long mk = __builtin_amdgcn_ballot_w64(mine); const int src = (int)__builtin_ctzll(mk);
      B = __builtin_amdgcn_readlane(bl, src); above = __builtin_amdgcn_readlane(al, src); }
    LDS_WAIT();
    if (lane < 8) *(LAS v4u*)(bins + lane * 4) = (v4u){0u, 0u, 0u, 0u};
    LDS_WAIT();
#pragma unroll
    for (int s = 0; s < 16; ++s) if (s < ns) {
#pragma unroll
        for (int e = 0; e < 4; ++e) { const unsigned w = cw[s][e]; const unsigned lo = w & 0xffffu, hi = w >> 16;
            if ((int)(lo >> 5) == B) __hip_atomic_fetch_add(bins + (lo & 31u), 1u, __ATOMIC_RELAXED, __HIP_MEMORY_SCOPE_WORKGROUP);
            if ((int)(hi >> 5) == B) __hip_atomic_fetch_add(bins + (hi & 31u), 1u, __ATOMIC_RELAXED, __HIP_MEMORY_SCOPE_WORKGROUP); } }
    LDS_WAIT();
    unsigned thr; int cgt, ceq;
    { const int cl = lane < 32 ? (int)bins[lane] : 0; int incl = cl; WSCAN(incl);
      const int tot = __builtin_amdgcn_readlane(incl, 63);
      const int run = above + tot - incl;
      const bool mine = lane < 32 && run < 256 && run + cl >= 256;
      const unsigned long long mk = __builtin_amdgcn_ballot_w64(mine); const int src = (int)__builtin_ctzll(mk);
      thr = ((unsigned)B << 5) | (unsigned)src; cgt = __builtin_amdgcn_readlane(run, src); ceq = __builtin_amdgcn_readlane(cl, src); }
    LDS_WAIT();
#undef WSCAN
    const int need = 256 - cgt;
    const bool fast = (ceq == need);
    int run = 0;
#pragma unroll
    for (int s = 0; s < 16; ++s) {
        const int j = lane + 64 * s;
        unsigned gm = 0u, tm = 0u;
        if (s < ns) {
#pragma unroll
            for (int e = 0; e < 4; ++e) { const unsigned w = cw[s][e]; const unsigned lo = w & 0xffffu, hi = w >> 16;
                gm |= ((thr - lo) >> 31) << (2 * e); gm |= ((thr - hi) >> 31) << (2 * e + 1);
                tm |= (((lo ^ thr) - 1u) >> 31) << (2 * e); tm |= (((hi ^ thr) - 1u) >> 31) << (2 * e + 1); }
            if (fast) gm |= tm;
            else {
                const int tc = __builtin_popcount(tm); int incl = tc;
#pragma unroll
                for (int o = 1; o < 64; o <<= 1) { const int t = __builtin_amdgcn_ds_bpermute((lane - o) << 2, incl); if (lane >= o) incl += t; }
                int rank = run + incl - tc;
#pragma unroll
                for (int e = 0; e < 8; ++e) if ((tm >> e) & 1u) { if (rank < need) gm |= 1u << e; ++rank; }
                run += __builtin_amdgcn_readlane(incl, 63);
            }
        }
        bmrow[j] = (unsigned char)gm;
    }
}


__device__ __forceinline__ void bt_emit_tile(int lane, const LAS unsigned char* rows, unsigned* BT, int b, int c, int tile, bool zero) {
    unsigned long long w = 0ull;
    if (!zero) w = *(const LAS unsigned long long*)(rows + lane * 1024 + tile * 8);
    unsigned va = 0u, vb = 0u;
#pragma unroll
    for (int pos = 0; pos < 64; ++pos) { const int rr = (pos >> 1) & 15, p = pos >> 5, h = pos & 1, key = 32 * p + (rr & 3) + 8 * (rr >> 2) + 4 * h;
        const unsigned long long m = __builtin_amdgcn_ballot_w64(((w >> key) & 1ull) != 0ull);
        asm volatile("s_nop 1\n\tv_writelane_b32 %0, %1, %2" : "+v"(va) : "s"((unsigned)m), "n"(pos)); asm volatile("v_writelane_b32 %0, %1, %2" : "+v"(vb) : "s"((unsigned)(m >> 32)), "n"(pos)); }
    const size_t g0 = ((size_t)(b * 256 + 2 * c) * 128 + tile) * 64;
    BT[g0 + lane] = va; BT[g0 + 128 * 64 + lane] = vb;
}

namespace att {
constexpr int AD = 128, NW = 8, QBLK = 32, KVBLK = 64, QB = NW * QBLK;
constexpr int SHM_V = KVBLK * AD * 2, SHM_K = KVBLK * AD * 2;
constexpr int LI_OFF = 2 * SHM_V + 2 * SHM_K;
constexpr int LUT_OFF = LI_OFF + NW * 64 * 4;
constexpr int NM_OFF = LUT_OFF + 8 * 256 * 4;
constexpr int QI_OFF = NM_OFF + 32;
constexpr int ATT_LDS = NM_OFF + 64;
typedef unsigned u32x16 __attribute__((ext_vector_type(16)));
#define AS4C __attribute__((address_space(4)))
#define KSWZ(row, colB) ((row) * 256 + ((colB) ^ (((row) & 7) << 4)))
#define SBAR() __builtin_amdgcn_sched_barrier(0)
__device__ __forceinline__ int v_st(int k, int c) { const int kk = (k & ~0xC) | ((k & 4) << 1) | ((k & 8) >> 1); return ((kk >> 3) * 4 + (c >> 5)) * 512 + ((kk & 7) * 32 + (c & 31)) * 2; }
__device__ __forceinline__ int v_rd_base(int lane) { return ((lane & 3) << 3) | (((lane >> 2) & 3) << 6) | (((lane >> 4) & 1) << 5) | (((lane >> 5) & 1) << 8); }
constexpr int v_rd_off(int d0, int ks, int half) { return d0 * 512 + ks * 4096 + half * 2048; }
__device__ __forceinline__ unsigned cvtpk(float lo, float hi) { unsigned r; asm volatile("v_cvt_pk_bf16_f32 %0, %1, %2" : "=v"(r) : "v"(lo), "v"(hi)); return r; }
__device__ __forceinline__ bf16x8 load8(const bf16* p) { return *reinterpret_cast<const bf16x8*>(p); }
__device__ __forceinline__ void mask16(f32x16& p, const u32x16& ma, const u32x16& mb, float neg) {
#pragma unroll
    for (int r = 0; r < 16; ++r) { const unsigned lo = r < 8 ? ma[2 * r] : mb[2 * r - 16], hi = r < 8 ? ma[2 * r + 1] : mb[2 * r - 15];
        const unsigned long long mm = ((unsigned long long)hi << 32) | lo; float o;
        asm volatile("v_cndmask_b32_e64 %0, %1, %2, %3" : "=v"(o) : "v"(neg), "v"(p[r]), "s"(mm)); p[r] = o; }
}
#define MFMA_PAD(a, b) asm volatile("s_nop 15\n\ts_nop 7" : "+v"(a), "+v"(b))
__device__ __forceinline__ void bias_tile(f32x16& p0, f32x16& p1, const LAS float* lut) {
#pragma unroll
    for (int r = 0; r < 16; ++r) { const int c = (r & 3) + 8 * (r >> 2); p0[r] += lut[c]; p1[r] += lut[c + 32]; }
}
__device__ __forceinline__ void exp16(f32x16& p) {
#pragma unroll
    for (int r = 0; r < 16; ++r) p[r] = __builtin_amdgcn_exp2f(p[r]);
}
__device__ __forceinline__ void finishSM(f32x16& p0, f32x16& p1, float& l_reg, bf16x8& pa0, bf16x8& pa1, bf16x8& pa2, bf16x8& pa3) {
    exp16(p1);
    float ps = 0;
#pragma unroll
    for (int r = 0; r < 16; ++r) ps += p0[r];
#pragma unroll
    for (int r = 0; r < 16; ++r) ps += p1[r];
    l_reg += ps;
#define PK4(P, B_, OUT) do { unsigned a0 = cvtpk(P[B_+0], P[B_+1]), a1 = cvtpk(P[B_+2], P[B_+3]);                          \
        unsigned b0 = cvtpk(P[B_+4], P[B_+5]), b1 = cvtpk(P[B_+6], P[B_+7]);                                             \
        auto r0 = __builtin_amdgcn_permlane32_swap(a0, b0, false, false); auto r1 = __builtin_amdgcn_permlane32_swap(a1, b1, false, false); \
        v4u w = {r0[0], r1[0], r0[1], r1[1]}; OUT = *reinterpret_cast<bf16x8*>(&w); } while (0)
    PK4(p0, 0, pa0); PK4(p0, 8, pa1); PK4(p1, 0, pa2); PK4(p1, 8, pa3);
#undef PK4
}
template <int KB>
__device__ __forceinline__ void qkt(f32x16& p0, f32x16& p1, const char* K_lds, int r32, int hi, const bf16x8* qr, float init) {
#pragma unroll
    for (int r = 0; r < 16; ++r) { float i0 = init, i1 = init; asm volatile("" : "+v"(i0), "+v"(i1)); p0[r] = i0; p1[r] = i1; }
    const char* kb[4];
#pragma unroll
    for (int dd = 0; dd < 4; ++dd) kb[dd] = K_lds + KB * SHM_K + KSWZ(r32, (dd * 16 + hi * 8) * 2);
#pragma unroll
    for (int d0 = 0; d0 < 8; ++d0) { const char* a = kb[d0 & 3] + (d0 >> 2) * 128;
        bf16x8 b0 = *reinterpret_cast<const bf16x8*>(a);
        bf16x8 b1 = *reinterpret_cast<const bf16x8*>(a + 32 * 256);
        p0 = __builtin_amdgcn_mfma_f32_32x32x16_bf16(b0, qr[d0], p0, 0, 0, 0);
        p1 = __builtin_amdgcn_mfma_f32_32x32x16_bf16(b1, qr[d0], p1, 0, 0, 0); }
}
template <int VB>
__device__ __forceinline__ void pv_tile(f32x16* o, int vb0, bf16x8 pa0, bf16x8 pa1, bf16x8 pa2, bf16x8 pa3) {
#define TRRD(dst, off) asm volatile("ds_read_b64_tr_b16 %0, %1 offset:%2" : "=&v"(dst) : "v"(vb0), "i"(off) : "memory")
#define PV_D0(d0) do { s16x4 l0, l1, l2, l3, h0, h1, h2, h3; constexpr int b_ = VB * SHM_V + v_rd_off(d0, 0, 0); \
        TRRD(l0, b_); TRRD(h0, b_ + 2048); TRRD(l1, b_ + 4096); TRRD(h1, b_ + 6144); TRRD(l2, b_ + 8192); TRRD(h2, b_ + 10240); TRRD(l3, b_ + 12288); TRRD(h3, b_ + 14336); \
        asm volatile("s_waitcnt lgkmcnt(0)" ::: "memory"); SBAR();   \
        o[d0] = __builtin_amdgcn_mfma_f32_32x32x16_bf16(pa0, (bf16x8){l0[0], l0[1], l0[2], l0[3], h0[0], h0[1], h0[2], h0[3]}, o[d0], 0, 0, 0);   \
        o[d0] = __builtin_amdgcn_mfma_f32_32x32x16_bf16(pa1, (bf16x8){l1[0], l1[1], l1[2], l1[3], h1[0], h1[1], h1[2], h1[3]}, o[d0], 0, 0, 0);   \
        o[d0] = __builtin_amdgcn_mfma_f32_32x32x16_bf16(pa2, (bf16x8){l2[0], l2[1], l2[2], l2[3], h2[0], h2[1], h2[2], h2[3]}, o[d0], 0, 0, 0);   \
        o[d0] = __builtin_amdgcn_mfma_f32_32x32x16_bf16(pa3, (bf16x8){l3[0], l3[1], l3[2], l3[3], h3[0], h3[1], h3[2], h3[3]}, o[d0], 0, 0, 0); } while (0)
    PV_D0(0); PV_D0(1); PV_D0(2); PV_D0(3);
#undef PV_D0
#undef TRRD
}
struct BlockRef { const bf16* Q; const bf16* K; unsigned char* O; const unsigned* bt; int P0; int h; };
struct Seam { bf16x8 qr[8]; bf16x8 st_v0, st_v1, st_k0, st_k1; };
#define ROW(p, k0, rr) ((p) + (size_t)((k0) + (rr)) * ZP + sc)
#define VMW() asm volatile("s_waitcnt vmcnt(0)" ::: "memory")
#define VMWN(n) asm volatile("s_waitcnt vmcnt(%0)" :: "i"(n) : "memory")
#define SLOAD_H(Kp, k0) do { const bf16* r0_ = ROW(Kp, k0, sr); const bf16* r1_ = ROW(Kp, k0, 32 + sr);   \
                         S.st_v0 = load8(r0_ + (ZC_DV - ZC_DK)); S.st_v1 = load8(r1_ + (ZC_DV - ZC_DK)); S.st_k0 = load8(r0_); S.st_k1 = load8(r1_); } while (0)
#define SWRITE_HK(bf) do { *(bf16x8*)(K_lds + (bf) * SHM_K + kws) = S.st_k0; *(bf16x8*)(K_lds + (bf) * SHM_K + kws + 32 * 256) = S.st_k1; } while (0)
#define SWRITE_HV(bf) do { *(bf16x8*)(V_lds + (bf) * SHM_V + vst0) = S.st_v0; *(bf16x8*)(V_lds + (bf) * SHM_V + vst1) = S.st_v1; } while (0)
#define SWRITE_H(bf) do { SWRITE_HV(bf); SWRITE_HK(bf); } while (0)
#define MLOAD(dst0, dst1, ptr, byteoff) do { const AS4C u32x16* q_ = (const AS4C u32x16*)(const AS4C void*)(ptr); dst0 = q_[(byteoff) / 64]; dst1 = q_[(byteoff) / 64 + 1]; } while (0)
__device__ __forceinline__ void prime(const BlockRef& cur, char* lds, Seam& S) {
    const int tid = opaque_tid(), wid = __builtin_amdgcn_readfirstlane(tid >> 6), lane = tid & 63, r32 = lane & 31, hi = lane >> 5;
    const int sr = tid >> 4, sc = (tid & 15) * 8, kws = KSWZ(sr, sc * 2); char* K_lds = lds + 2 * SHM_V;
#pragma unroll
    for (int d0 = 0; d0 < 8; ++d0) S.qr[d0] = load8(cur.Q + (size_t)(wid * QBLK + r32) * ZP + d0 * 16 + hi * 8);
    SLOAD_H(cur.K, 0); VMW(); SWRITE_HK(0);
    __syncthreads();
}
__device__ __forceinline__ void block(const BlockRef& cur, const BlockRef& nxt, char* lds, Seam& S) {
    const int tid = opaque_tid(), wid = __builtin_amdgcn_readfirstlane(tid >> 6), lane = tid & 63, r32 = lane & 31, hi = lane >> 5;
    const int NT = cur.P0 / KVBLK + 4;
    const int qlo = cur.P0 + wid * QBLK, qch = qlo >> 6;
    char* V_lds = lds; char* K_lds = lds + 2 * SHM_V;
    float* li_l = (float*)(lds + LI_OFF) + wid * 64;
    const float ninit = *(const float*)(lds + NM_OFF + 4 * cur.h);
    const float NEG = -__builtin_inff();
    const unsigned* btw = cur.bt + (size_t)wid * (128 * 64);
    float l_reg = 0; f32x16 o[4];
#pragma unroll
    for (int d = 0; d < 4; ++d)
#pragma unroll
        for (int r = 0; r < 16; ++r) o[d][r] = 0.f;
    const int sr = tid >> 4, sc = (tid & 15) * 8, vst0 = v_st(sr, sc), vst1 = v_st(32 + sr, sc), kws = KSWZ(sr, sc * 2);
    const int vb0 = (int)(uintptr_t)V_lds + v_rd_base(lane);
    const bf16* Kh = cur.K;
#define KBASE(t) ((t) * KVBLK)
#define LUTB(t) (LUT_OFF + 4 * (cur.h * 256 + 191 + 4 * hi - qlo - r32 + (t) * KVBLK))
#define MASKT(P0_, P1_, t) do { if ((t) >= qch - 2 && (t) <= qch) bias_tile(P0_, P1_, (const LAS float*)(unsigned)LUTB(t)); \
        mask16(P0_, m0, m1, NEG); { const unsigned* mp_ = btw + (size_t)(t) * 64; MLOAD(m0, m1, mp_, 128); } \
        if (__builtin_expect(__all(ninit <= 0.f), 1)) { exp16(P0_); } else { l_reg = 0.f; }     \
        mask16(P1_, m0, m1, NEG); } while (0)
#define MREQ(t) do { const unsigned* mp_ = btw + (size_t)(t) * 64; MLOAD(m0, m1, mp_, 0); } while (0)
    constexpr int NQL = 8;
#define SEAM_K0() do { VMWN(NQL); SWRITE_HK(0); SBAR(); } while (0)
    f32x16 pA0, pA1, pB0, pB1; bf16x8 pa0, pa1, pa2, pa3; u32x16 m0, m1;
    SWRITE_HV(0); SBAR();
    MREQ(0);
    if (NT > 1) SLOAD_H(Kh, KBASE(1));
    SBAR(); qkt<0>(pA0, pA1, K_lds, r32, hi, S.qr, ninit);
    MFMA_PAD(pA0, pA1); MASKT(pA0, pA1, 0);
    if (NT > 1) { VMW(); SWRITE_H(1); }
    __syncthreads();
#define HALF_STEP(PX0, PX1, PY0, PY1, t, KB, VB, SB) do {                                                      \
        SBAR(); MREQ(t); qkt<KB>(PX0, PX1, K_lds, r32, hi, S.qr, ninit);                                             \
        finishSM(PY0, PY1, l_reg, pa0, pa1, pa2, pa3); SBAR();                                                           \
        if ((t) + 1 < NT) { SLOAD_H(Kh, KBASE((t) + 1)); SBAR(); }                                               \
        pv_tile<VB>(o, vb0, pa0, pa1, pa2, pa3); MASKT(PX0, PX1, (t));                                        \
        __syncthreads();                                                                                                      \
        if ((t) + 1 < NT) { VMW(); SWRITE_H(SB); }                                                                          \
        __syncthreads(); } while (0)
    for (int t = 1; t + 1 < NT; t += 2) {
        HALF_STEP(pB0, pB1, pA0, pA1, t, 1, 0, 0);
        HALF_STEP(pA0, pA1, pB0, pB1, t + 1, 0, 1, 1);
    }
    MREQ(NT - 1);
    SBAR(); qkt<1>(pB0, pB1, K_lds, r32, hi, S.qr, ninit); SBAR();
    SLOAD_H(nxt.K, 0); SBAR();
#pragma unroll
    for (int d0 = 0; d0 < 8; ++d0) S.qr[d0] = load8(nxt.Q + (size_t)(wid * QBLK + r32) * ZP + d0 * 16 + hi * 8);
    SBAR();
    finishSM(pA0, pA1, l_reg, pa0, pa1, pa2, pa3); SBAR();
    pv_tile<0>(o, vb0, pa0, pa1, pa2, pa3);
    MASKT(pB0, pB1, NT - 1); __syncthreads();
    finishSM(pB0, pB1, l_reg, pa0, pa1, pa2, pa3); SBAR(); pv_tile<1>(o, vb0, pa0, pa1, pa2, pa3);
    SBAR(); SEAM_K0();
    { auto rr = __builtin_amdgcn_permlane32_swap(__float_as_uint(l_reg), __float_as_uint(l_reg), false, false); l_reg = __uint_as_float(rr[0]) + __uint_as_float(rr[1]); }
    if (hi == 0) li_l[r32] = l_reg; asm volatile("s_waitcnt lgkmcnt(0)" ::: "memory");
    float rli[16];
#pragma unroll
    for (int r = 0; r < 16; ++r) rli[r] = __builtin_amdgcn_rcpf(fmaxf(li_l[crow(r, hi)], 1e-37f));
    unsigned char* Ow = cur.O + (size_t)(wid * QBLK) * 1024;
#pragma unroll
    for (int r = 0; r < 16; ++r) { const int orow = crow(r, hi);
#pragma unroll
        for (int d0 = 0; d0 < 4; ++d0) { const float v = o[d0][r] * rli[r] * 16.0f;
            const float v1 = DPP_F(v, 0x55), v2 = DPP_F(v, 0xAA), v3 = DPP_F(v, 0xFF);
            if ((r32 & 3) == 0) *(unsigned*)(Ow + (size_t)orow * 1024 + d0 * 32 + r32) = pk4_fp8(v, v1, v2, v3); } }
    __syncthreads();
#undef KBASE
#undef LUTB
#undef MASKT
#undef MREQ
#undef SEAM_K0
#undef HALF_STEP
}
#undef ROW
#undef VMW
#undef VMWN
#undef SLOAD_H
#undef SWRITE_HK
#undef SWRITE_HV
#undef SWRITE_H
#undef MLOAD
__device__ __forceinline__ BlockRef make_ref(int L, int pass, const bf16* Z, unsigned char* OB, const unsigned* BT) {
    const int bh = L >> 4, x = L & 15, b = bh >> 3, h = bh & 7, qb = pass ? 31 - x : x;
    BlockRef r; const size_t row0 = (size_t)b * SEQ + (size_t)qb * QB;
    r.Q = Z + row0 * ZP + ZC_DQ + h * AD; r.K = Z + (size_t)b * SEQ * ZP + ZC_DK + h * AD;
    r.O = OB + row0 * 1024 + h * AD; r.bt = BT + (size_t)(b * 256 + qb * 8) * (128 * 64); r.P0 = qb * QB; r.h = h; return r;
}
__device__ __forceinline__ int t5_bucket(int rel) {
    const int n = rel < 0 ? -rel : rel; int bk;
    if (n < 8) bk = n; else if (n < 12) bk = 8; else if (n < 16) bk = 9; else if (n < 23) bk = 10; else if (n < 32) bk = 11; else if (n < 46) bk = 12; else if (n < 64) bk = 13; else if (n < 91) bk = 14; else bk = 15;
    return (rel > 0 ? 16 : 0) + bk;
}
__device__ __forceinline__ BlockRef make_ref_blk(int i, const bf16* Z, unsigned char* OB, const unsigned* BT) {
    const int bh = i & 31, b = bh >> 3, h = bh & 7, qb = 31 - (i >> 5);
    BlockRef r; const size_t row0 = (size_t)b * SEQ + (size_t)qb * QB;
    r.Q = Z + row0 * ZP + ZC_DQ + h * AD; r.K = Z + (size_t)b * SEQ * ZP + ZC_DK + h * AD;
    r.O = OB + row0 * 1024 + h * AD; r.bt = BT + (size_t)(b * 256 + qb * 8) * (128 * 64); r.P0 = qb * QB; r.h = h; return r;
}
__device__ __forceinline__ int q_fetch(char* lds, gu32* qhead, int slot) {
    if (opaque_tid() == 0) { const unsigned v = __hip_atomic_fetch_add(qhead, 1u, RLX_AGENT); ((volatile unsigned*)(lds + QI_OFF))[slot] = v; }
    __syncthreads();
    return __builtin_amdgcn_readfirstlane((int)((volatile unsigned*)(lds + QI_OFF))[slot]);
}
__device__ __forceinline__ void attn_phase(char* lds, const bf16* Z, unsigned char* OB, const unsigned* BT, const float* rel_bias, const float* qg, const float* kg, gu32* qhead) {
    constexpr float L2E = 1.4426950408889634f;
    { float* lut = (float*)(lds + LUT_OFF);
      const int tid = opaque_tid();
      for (int i = tid; i < 8 * 256; i += 512) { const int h = i >> 8, rel = (i & 255) - 191; lut[i] = (rel_bias[t5_bucket(rel) * 8 + h] - rel_bias[15 * 8 + h]) * L2E; }
      if (tid < 64) { const int l = tid;
          float mq = fmaxf(fabsf(qg[l]), fabsf(qg[l + 64])), mk = fmaxf(fabsf(kg[l]), fabsf(kg[l + 64]));
          mq = wave_max(mq); mk = wave_max(mk);
          if (l < 8) { float mb = 0.f; for (int bk = 0; bk < 32; ++bk) mb = fmaxf(mb, rel_bias[bk * 8 + l] - rel_bias[15 * 8 + l]);
              ((float*)(lds + NM_OFF))[l] = -(11.313708498984761f * mq * mk + mb) * L2E; } } }
    asm volatile("" : "+s"(BT));
    __syncthreads();
    constexpr int total = NB * 8 * 32;
    const int i0 = q_fetch(lds, qhead, 0); if (i0 >= total) return;
    int i1 = q_fetch(lds, qhead, 1), slot = 0;
    BlockRef cur = make_ref_blk(i0, Z, OB, BT);
    Seam S;
    prime(cur, lds, S);
    for (;;) {
        const bool last = i1 >= total;
        const BlockRef nxt = last ? cur : make_ref_blk(i1, Z, OB, BT);
        block(cur, nxt, lds, S);
        if (last) break;
        cur = nxt; i1 = q_fetch(lds, qhead, slot); slot ^= 1;
    }
}
}

constexpr int RING_OFF = 0, RING_BYTES = 131072;
constexpr int LDSCTL_OFF = RING_BYTES, MISC_OFF = LDSCTL_OFF + 320;
constexpr int LDS_BYTES = 147456;

struct Frame {
    LAS unsigned char* lds;
    volatile LAS unsigned* MISC;
    gu32* ctl;
    int tid, lane, wave, vcu, G;
};

template <int MAP> __device__ __forceinline__ int rowmap(int n) {
    if (MAP == 0) return n;
    if (MAP == 1) {
        if (n < 1024) return n;
        if (n < 3072) return -1;
        if (n < 3088) return ZC_GLR - 2048 + (n - 3072);
        if (n < 6160) return -1;
        if (n < 7184) return ZC_IQ - 2048 + (n - 6160);
        if (n < 7248) return ZC_IK - 2048 + (n - 7184);
        return ZC_IW - 2048 + (n - 7248);
    }
    if (MAP == 4) return (n >= 1024 && n < 3072) ? n - 1024 : (n >= 3088 && n < 6160) ? n - 3088 + 2048 : -1;
    if (MAP == 2) { const int half = n >> 11, c = n & 2047; return (c >> 7) * 256 + half * 128 + (c & 127); }
    if (MAP == 3) return (n >> 7) * 256 + (n & 127);
    return n;
}
template <int MAP>
__device__ __forceinline__ void p0_transpose_item(const float* W, int K, int N, bf16* WT, int row_off, LAS float* scr, int item, int lane) {
    const int nblk = N / 32, kb = item / nblk, nb = item % nblk, k0 = 64 * kb, n0 = 32 * nb;
#pragma unroll 8
    for (int i = 0; i < 32; ++i) { const int kk = 2 * i + (lane >> 5); scr[kk * 33 + (lane & 31)] = W[(size_t)(k0 + kk) * N + n0 + (lane & 31)]; }
    LDS_WAIT(); asm volatile("" ::: "memory");
    const int c = lane & 7;
#pragma unroll
    for (int j = 0; j < 4; ++j) { const int n = (lane >> 3) + 8 * j; const LAS float* s = scr + (8 * c) * 33 + n;
        v4u o; o.x = pk2(s[0 * 33], s[1 * 33]); o.y = pk2(s[2 * 33], s[3 * 33]); o.z = pk2(s[4 * 33], s[5 * 33]); o.w = pk2(s[6 * 33], s[7 * 33]);
        const int rm = rowmap<MAP>(n0 + n); if (rm >= 0) *(GAS v4u*)(WT + (size_t)(row_off + rm) * K + k0 + 8 * c) = o; }
    LDS_WAIT(); asm volatile("" ::: "memory");
}
template <int MAP>
__device__ __forceinline__ void p0_transpose_item8(const float* W, int K, int N, unsigned char* WT, int row_off, LAS float* scr, int item, int lane, float scale) {
    const int nblk = N / 32, kb = item / nblk, nb = item % nblk, k0 = 64 * kb, n0 = 32 * nb;
#pragma unroll 8
    for (int i = 0; i < 32; ++i) { const int kk = 2 * i + (lane >> 5); scr[kk * 33 + (lane & 31)] = W[(size_t)(k0 + kk) * N + n0 + (lane & 31)] * scale; }
    LDS_WAIT(); asm volatile("" ::: "memory");
    const int c = lane & 3;
#pragma unroll
    for (int j = 0; j < 2; ++j) { const int n = (lane >> 2) + 16 * j; const LAS float* sp = scr + (16 * c) * 33 + n;
        v4u o; o.x = pk4_fp8(sp[0 * 33], sp[1 * 33], sp[2 * 33], sp[3 * 33]); o.y = pk4_fp8(sp[4 * 33], sp[5 * 33], sp[6 * 33], sp[7 * 33]);
        o.z = pk4_fp8(sp[8 * 33], sp[9 * 33], sp[10 * 33], sp[11 * 33]); o.w = pk4_fp8(sp[12 * 33], sp[13 * 33], sp[14 * 33], sp[15 * 33]);
        const int rm = rowmap<MAP>(n0 + n); if (rm >= 0) *(GAS v4u*)(WT + (size_t)(row_off + rm) * K + k0 + 16 * c) = o; }
    LDS_WAIT(); asm volatile("" ::: "memory");
}
constexpr int CONV_MOD = 8, CONV_DEPTH = 3;
template <int MAP>
__device__ __forceinline__ void conv_stream8(const float* W, int K, int N, unsigned char* WT, int erows, int row_add, LAS float* scr, int lane, int cw, int NCW) {
    const int nblk = N / 32, per_e = (K / 64) * nblk, total = NEXP * per_e;
    const int lr = lane >> 3, lc = (lane & 7) * 4;
    if (cw >= total) return;
    const int n_my = (total - cw + NCW - 1) / NCW, it_last = cw + (n_my - 1) * NCW;
    f32x4 v[CONV_DEPTH][8];
#define CONV_IT(j_) min(cw + (j_) * NCW, it_last)
#define CONV_LOAD(d_, it_) do { const int e_ = (it_) / per_e, r_ = (it_) - e_ * per_e, kb_ = r_ / nblk, nb_ = r_ - kb_ * nblk; \
        const float* s_ = W + (size_t)e_ * K * N + (size_t)(64 * kb_ + lr) * N + 32 * nb_ + lc; \
        _Pragma("unroll") for (int i = 0; i < 8; ++i) v[d_][i] = __builtin_nontemporal_load((const f32x4*)(s_ + (size_t)(8 * i) * N)); } while (0)
#pragma unroll
    for (int d = 0; d < CONV_DEPTH; ++d) { CONV_LOAD(d, CONV_IT(d)); asm volatile("" ::: "memory"); __builtin_amdgcn_sched_barrier(0); }
    for (int j0 = 0; j0 < n_my; j0 += CONV_DEPTH) {
#pragma unroll
        for (int d = 0; d < CONV_DEPTH; ++d) {
            const int it = CONV_IT(j0 + d);
            const int e = it / per_e, r = it - e * per_e, kb = r / nblk, nb = r - kb * nblk, k0 = 64 * kb, n0 = 32 * nb;
#pragma unroll
            for (int i = 0; i < 8; ++i) { LAS float* dd = scr + (8 * i + lr) * 33 + lc; dd[0] = v[d][i].x; dd[1] = v[d][i].y; dd[2] = v[d][i].z; dd[3] = v[d][i].w; }
            CONV_LOAD(d, CONV_IT(j0 + d + CONV_DEPTH));
            LDS_WAIT(); asm volatile("" ::: "memory");
            const int c = lane & 3;
#pragma unroll
            for (int j = 0; j < 2; ++j) { const int n = (lane >> 2) + 16 * j; const LAS float* sp = scr + (16 * c) * 33 + n;
                v4u o; o.x = pk4_fp8(32.f * sp[0 * 33], 32.f * sp[1 * 33], 32.f * sp[2 * 33], 32.f * sp[3 * 33]); o.y = pk4_fp8(32.f * sp[4 * 33], 32.f * sp[5 * 33], 32.f * sp[6 * 33], 32.f * sp[7 * 33]);
                o.z = pk4_fp8(32.f * sp[8 * 33], 32.f * sp[9 * 33], 32.f * sp[10 * 33], 32.f * sp[11 * 33]); o.w = pk4_fp8(32.f * sp[12 * 33], 32.f * sp[13 * 33], 32.f * sp[14 * 33], 32.f * sp[15 * 33]);
                *(GAS v4u*)(WT + (size_t)(e * erows + row_add + rowmap<MAP>(n0 + n)) * K + k0 + 16 * c) = o; }
            LDS_WAIT(); asm volatile("" ::: "memory");
        }
    }
#undef CONV_LOAD
#undef CONV_IT
}
__device__ __forceinline__ void p0_transpose_item_win(const float* W, bf16* WT, unsigned char* WT8, LAS float* scr, int item, int lane) {
    constexpr int K = D, N = 7264;
    const int nblk = N / 32, kb = item / nblk, nb = item % nblk, k0 = 64 * kb, n0 = 32 * nb;
#pragma unroll 8
    for (int i = 0; i < 32; ++i) { const int kk = 2 * i + (lane >> 5); scr[kk * 33 + (lane & 31)] = W[(size_t)(k0 + kk) * N + n0 + (lane & 31)]; }
    LDS_WAIT(); asm volatile("" ::: "memory");
    { const int c = lane & 7;
#pragma unroll
      for (int j = 0; j < 4; ++j) { const int n = (lane >> 3) + 8 * j; const LAS float* sp = scr + (8 * c) * 33 + n; const int rm = rowmap<1>(n0 + n);
        if (rm >= 0) { v4u o; o.x = pk2(sp[0 * 33], sp[1 * 33]); o.y = pk2(sp[2 * 33], sp[3 * 33]); o.z = pk2(sp[4 * 33], sp[5 * 33]); o.w = pk2(sp[6 * 33], sp[7 * 33]);
            *(GAS v4u*)(WT + (size_t)rm * K + k0 + 8 * c) = o; } } }
    { const int c = lane & 3;
#pragma unroll
      for (int j = 0; j < 2; ++j) { const int n = (lane >> 2) + 16 * j; const LAS float* sp = scr + (16 * c) * 33 + n; const int rm = rowmap<4>(n0 + n);
        if (rm >= 0) { v4u o; o.x = pk4_fp8(32.f * sp[0 * 33], 32.f * sp[1 * 33], 32.f * sp[2 * 33], 32.f * sp[3 * 33]); o.y = pk4_fp8(32.f * sp[4 * 33], 32.f * sp[5 * 33], 32.f * sp[6 * 33], 32.f * sp[7 * 33]);
            o.z = pk4_fp8(32.f * sp[8 * 33], 32.f * sp[9 * 33], 32.f * sp[10 * 33], 32.f * sp[11 * 33]); o.w = pk4_fp8(32.f * sp[12 * 33], 32.f * sp[13 * 33], 32.f * sp[14 * 33], 32.f * sp[15 * 33]);
            *(GAS v4u*)(WT8 + (size_t)rm * K + k0 + 16 * c) = o; } } }
    LDS_WAIT(); asm volatile("" ::: "memory");
}
__device__ __forceinline__ void rms_row_to_bf16(int lane, const float* xrow, const float* g, bf16* orow, unsigned char* orow8 = nullptr) {
    const GAS f32x4* xr = (const GAS f32x4*)xrow + lane;
    f32x4 v[8]; float s = 0.f;
#pragma unroll
    for (int j = 0; j < 8; ++j) { v[j] = xr[64 * j]; s += (v[j].x * v[j].x + v[j].y * v[j].y) + (v[j].z * v[j].z + v[j].w * v[j].w); }
    const float rstd = 1.0f / sqrtf(wave_sum(s) * (1.f / D) + EPS);
    GAS unsigned long long* o8 = (GAS unsigned long long*)orow + lane;
#pragma unroll
    for (int j = 0; j < 8; ++j) { const f32x4 gg = ((const GAS f32x4*)g)[64 * j + lane];
        o8[64 * j] = (unsigned long long)pk2(v[j].x * rstd * gg.x, v[j].y * rstd * gg.y) | ((unsigned long long)pk2(v[j].z * rstd * gg.z, v[j].w * rstd * gg.w) << 32);
        if (orow8) ((GAS unsigned*)orow8)[64 * j + lane] = pk4_fp8(v[j].x * rstd * gg.x, v[j].y * rstd * gg.y, v[j].z * rstd * gg.z, v[j].w * rstd * gg.w); }
}

#ifndef MK_DSA
#define MK_DSA 1
#endif
#ifndef MK_MOE
#define MK_MOE 1
#endif
#ifndef MK_GLA
#define MK_GLA 1
#endif
constexpr int PREF_OFF = LDSCTL_OFF, CNTL_OFF = MISC_OFF + 128;
__device__ __forceinline__ void rms_row_bf(int lane, const bf16* xrow, const float* g, bf16* orow, unsigned char* orow8) {
    const GAS v4u* xr = (const GAS v4u*)xrow + lane;
    v4u w[4]; float s = 0.f;
#pragma unroll
    for (int j = 0; j < 4; ++j) { w[j] = xr[64 * j];
        const float a0 = bflo(w[j].x), a1 = bfhi(w[j].x), a2 = bflo(w[j].y), a3 = bfhi(w[j].y), a4 = bflo(w[j].z), a5 = bfhi(w[j].z), a6 = bflo(w[j].w), a7 = bfhi(w[j].w);
        s += ((a0 * a0 + a1 * a1) + (a2 * a2 + a3 * a3)) + ((a4 * a4 + a5 * a5) + (a6 * a6 + a7 * a7)); }
    const float rstd = 1.0f / sqrtf(wave_sum(s) * (1.f / D) + EPS);
#pragma unroll
    for (int j = 0; j < 4; ++j) { const f32x4 g0 = ((const GAS f32x4*)g)[2 * (64 * j + lane)], g1 = ((const GAS f32x4*)g)[2 * (64 * j + lane) + 1];
        const float a0 = bflo(w[j].x) * rstd * g0.x, a1 = bfhi(w[j].x) * rstd * g0.y, a2 = bflo(w[j].y) * rstd * g0.z, a3 = bfhi(w[j].y) * rstd * g0.w;
        const float a4 = bflo(w[j].z) * rstd * g1.x, a5 = bfhi(w[j].z) * rstd * g1.y, a6 = bflo(w[j].w) * rstd * g1.z, a7 = bfhi(w[j].w) * rstd * g1.w;
        v4u o; o.x = pk2(a0, a1); o.y = pk2(a2, a3); o.z = pk2(a4, a5); o.w = pk2(a6, a7);
        ((GAS v4u*)orow)[64 * j + lane] = o;
        v2u o8; o8.x = pk4_fp8(a0, a1, a2, a3); o8.y = pk4_fp8(a4, a5, a6, a7);
        ((GAS v2u*)orow8)[64 * j + lane] = o8; }
}
__device__ __forceinline__ void combine_row_bf(int lane, const bf16* x1, const bf16* y0, const bf16* y1, const float* g, bf16* x2, unsigned char* orow8) {
    float v[4][8]; float s = 0.f;
#pragma unroll
    for (int j = 0; j < 4; ++j) { const v4u w = ((const GAS v4u*)x1)[64 * j + lane];
        v[j][0] = bflo(w.x); v[j][1] = bfhi(w.x); v[j][2] = bflo(w.y); v[j][3] = bfhi(w.y); v[j][4] = bflo(w.z); v[j][5] = bfhi(w.z); v[j][6] = bflo(w.w); v[j][7] = bfhi(w.w);
#if MK_MOE
        const v4u a = ((const GAS v4u*)y0)[64 * j + lane], b = ((const GAS v4u*)y1)[64 * j + lane];
        v[j][0] += bflo(a.x) + bflo(b.x); v[j][1] += bfhi(a.x) + bfhi(b.x); v[j][2] += bflo(a.y) + bflo(b.y); v[j][3] += bfhi(a.y) + bfhi(b.y);
        v[j][4] += bflo(a.z) + bflo(b.z); v[j][5] += bfhi(a.z) + bfhi(b.z); v[j][6] += bflo(a.w) + bflo(b.w); v[j][7] += bfhi(a.w) + bfhi(b.w);
#endif
        v4u o; o.x = pk2(v[j][0], v[j][1]); o.y = pk2(v[j][2], v[j][3]); o.z = pk2(v[j][4], v[j][5]); o.w = pk2(v[j][6], v[j][7]);
        ((GAS v4u*)x2)[64 * j + lane] = o;
        v[j][0] = bflo(o.x); v[j][1] = bfhi(o.x); v[j][2] = bflo(o.y); v[j][3] = bfhi(o.y); v[j][4] = bflo(o.z); v[j][5] = bfhi(o.z); v[j][6] = bflo(o.w); v[j][7] = bfhi(o.w);
#pragma unroll
        for (int q = 0; q < 8; ++q) s += v[j][q] * v[j][q]; }
    const float rstd = 1.0f / sqrtf(wave_sum(s) * (1.f / D) + EPS);
#pragma unroll
    for (int j = 0; j < 4; ++j) { const f32x4 g0 = ((const GAS f32x4*)g)[2 * (64 * j + lane)], g1 = ((const GAS f32x4*)g)[2 * (64 * j + lane) + 1];
        v2u o8; o8.x = pk4_fp8(v[j][0] * rstd * g0.x, v[j][1] * rstd * g0.y, v[j][2] * rstd * g0.z, v[j][3] * rstd * g0.w);
        o8.y = pk4_fp8(v[j][4] * rstd * g1.x, v[j][5] * rstd * g1.y, v[j][6] * rstd * g1.z, v[j][7] * rstd * g1.w);
        ((GAS v2u*)orow8)[64 * j + lane] = o8; }
}
__device__ __forceinline__ void combine_row(int lane, float* xio, const bf16* y0, const bf16* y1, const float* g, unsigned char* orow8) {
    GAS f32x4* xr = (GAS f32x4*)xio + lane;
    f32x4 v[8]; float s = 0.f;
#pragma unroll
    for (int j = 0; j < 8; ++j) { v[j] = xr[64 * j];
#if MK_MOE
        const v2u a = ((const GAS v2u*)y0)[64 * j + lane], b = ((const GAS v2u*)y1)[64 * j + lane];
        v[j].x += bflo(a.x) + bflo(b.x); v[j].y += bfhi(a.x) + bfhi(b.x); v[j].z += bflo(a.y) + bflo(b.y); v[j].w += bfhi(a.y) + bfhi(b.y);
#endif
        s += (v[j].x * v[j].x + v[j].y * v[j].y) + (v[j].z * v[j].z + v[j].w * v[j].w); }
    const float rstd = 1.0f / sqrtf(wave_sum(s) * (1.f / D) + EPS);
#pragma unroll
    for (int j = 0; j < 8; ++j) { const f32x4 gg = ((const GAS f32x4*)g)[64 * j + lane];
        xr[64 * j] = v[j];
        ((GAS unsigned*)orow8)[64 * j + lane] = pk4_fp8(v[j].x * rstd * gg.x, v[j].y * rstd * gg.y, v[j].z * rstd * gg.z, v[j].w * rstd * gg.w); }
}

struct Args { const float* in[27]; float* out; unsigned char* ws; int ph_lo, ph_hi; };

#define AS4 __attribute__((address_space(4)))
#define PHASE_LOCALS \
    const AS4 Args* ap = (const AS4 Args*)__builtin_amdgcn_kernarg_segment_ptr(); asm volatile("" : "+s"(ap)); \
    unsigned char* const ws = ap->ws; int tid_o = threadIdx.x; asm volatile("" : "+v"(tid_o)); \
    Frame F; F.lds = (LAS unsigned char*)lds_raw; F.MISC = (volatile LAS unsigned*)(F.lds + MISC_OFF); F.ctl = (gu32*)(ws + WS_CTL); \
    F.tid = tid_o; F.lane = tid_o & 63; F.wave = __builtin_amdgcn_readfirstlane(tid_o >> 6); F.G = gridDim.x; \
    { const int bx = blockIdx.x; F.vcu = (F.G % 8 == 0) ? (bx % 8) * (F.G / 8) + bx / 8 : bx; } \
    const int gw = F.vcu * NWAVES + F.wave, NGW = F.G * NWAVES; const int gt = blockIdx.x * 512 + F.tid, NGT = F.G * 512; \
    bf16* const HB = (bf16*)(ws + WS_HB); bf16* const ZB = (bf16*)(ws + WS_ZB); \
    LAS unsigned char* const wl = F.lds + RING_OFF + F.wave * 16384; \
    (void)gw; (void)NGW; (void)gt; (void)NGT; (void)HB; (void)ZB; (void)wl;
#ifndef MK_DBL
#define MK_DBL 0
#endif
#define REP2 for (int rep_ = 0; rep_ < 2; ++rep_)
#if (MK_DBL >> 0) & 1
#define REP_0 REP2
#else
#define REP_0
#endif
#if (MK_DBL >> 1) & 1
#define REP_1 REP2
#else
#define REP_1
#endif
#if (MK_DBL >> 2) & 1
#define REP_2 REP2
#else
#define REP_2
#endif
#if (MK_DBL >> 3) & 1
#define REP_3 REP2
#else
#define REP_3
#endif
#if (MK_DBL >> 4) & 1
#define REP_4 REP2
#else
#define REP_4
#endif
#if (MK_DBL >> 5) & 1
#define REP_5 REP2
#else
#define REP_5
#endif
#if (MK_DBL >> 6) & 1
#define REP_6 REP2
#else
#define REP_6
#endif
#if (MK_DBL >> 7) & 1
#define REP_7 REP2
#else
#define REP_7
#endif
#if (MK_DBL >> 8) & 1
#define REP_8 REP2
#else
#define REP_8
#endif
#if (MK_DBL >> 9) & 1
#define REP_9 REP2
#else
#define REP_9
#endif
#if (MK_DBL >> 10) & 1
#define REP_10 REP2
#else
#define REP_10
#endif
#if (MK_DBL >> 11) & 1
#define REP_11 REP2
#else
#define REP_11
#endif
#if (MK_DBL >> 12) & 1
#define REP_12 REP2
#else
#define REP_12
#endif
#if (MK_DBL >> 13) & 1
#define REP_13 REP2
#else
#define REP_13
#endif
#if (MK_DBL >> 14) & 1
#define REP_14 REP2
#else
#define REP_14
#endif
#define REP(k) REP_##k
#define IN(k) (ap->in[k])
#define GRID_BAR() do { XcdBarrier bb_; bb_.bar = (unsigned*)(F.ctl + CW_BAR); bb_.x = xb_xcc_id(); bb_.st = F.MISC + 8; xcd_barrier(bb_); } while (0)

__global__ void __launch_bounds__(NWAVES * 64, 2) mk_fwd(Args args) {
    extern __shared__ __attribute__((aligned(16))) unsigned char lds_raw[];
    (void)args;
    {
        PHASE_LOCALS
        for (int u = F.tid; u < (LDS_BYTES - LDSCTL_OFF) / 4; u += NWAVES * 64) ((LAS unsigned*)(F.lds + LDSCTL_OFF))[u] = 0u;
        __syncthreads();
        (void)xcd_barrier_post((unsigned*)(F.ctl + CW_BAR), F.MISC + 8);
    }
    REP(0)
    {
        PHASE_LOCALS
        LAS float* scr = (LAS float*)wl;
        constexpr int I_IN = (D / 64) * (7264 / 32), I_BG = (D / 64) * (4096 / 32), I_OG = (1024 / 64) * (D / 32), I_O = (D / 64) * (D / 32), I_PP = (PLE / 64) * (D / 32);
        constexpr int NITEMS = I_IN + I_BG + 2 * I_OG + 2 * I_O + I_PP;
        for (int it = gw; it < NITEMS; it += NGW) {
            int r = it;
            if (r < I_IN) { p0_transpose_item_win(IN(3), (bf16*)(ws + WS_WIN), ws + WS_WIN8, scr, r, F.lane); continue; } r -= I_IN;
            if (r < I_BG) { p0_transpose_item8<2>(IN(12), D, 4096, ws + WS_WBG8, 0, scr, r, F.lane, 32.0f); continue; } r -= I_BG;
            if (r < I_OG) { p0_transpose_item<0>(IN(7), 1024, D, (bf16*)(ws + WS_WOG), 0, scr, r, F.lane); continue; } r -= I_OG;
            if (r < I_OG) { p0_transpose_item8<0>(IN(11), 1024, D, ws + WS_WOD8, 0, scr, r, F.lane, 32.0f); continue; } r -= I_OG;
            if (r < I_O) { p0_transpose_item8<0>(IN(14), D, D, ws + WS_WO8, 0, scr, r, F.lane, 32.0f); continue; } r -= I_O;
            if (r < I_O) { p0_transpose_item8<0>(IN(24), D, D, ws + WS_WPG8, 0, scr, r, F.lane, 32.0f); continue; } r -= I_O;
            p0_transpose_item<0>(IN(26), PLE, D, (bf16*)(ws + WS_WPP), 0, scr, r, F.lane);
        }
        { GAS v4u* z = (GAS v4u*)((bf16*)(ws + WS_WIN) + (size_t)(ZC_IW + 16 - 2048) * D);
          for (int i = gt; i < 160 * D * 2 / 16; i += NGT) z[i] = (v4u){0u, 0u, 0u, 0u}; }
        { bf16* wr = (bf16*)(ws + WS_WR); const float* wg = IN(16); const float* we = IN(18);
          for (int i = gt; i < 256 * D; i += NGT) { const int n = i >> 11, k = i & 2047; const float v = n < 8 ? wg[k * 8 + n] : (n < 72 ? we[k * 64 + (n - 8)] : 0.f); wr[i] = (bf16)f2bf(v); } }
        for (int m = gw; m < T; m += NGW) rms_row_to_bf16(F.lane, IN(0) + (size_t)m * D, IN(2), HB + (size_t)m * D, (unsigned char*)ap->out + (size_t)m * D);
        GRID_BAR();
    }
    REP(1)
    {
        PHASE_LOCALS
        { pg8::StaticOrder S; S.init(T, ZN_A - 2048, F.G, (int)blockIdx.x);
          pg8::Gemm g{HB, (const bf16*)(ws + WS_WIN), D};
          pg8::EpiBf16Skip E{ZB, ZP, 4, 2048};
          pg8::gemm_phase<pg8::EpiBf16Skip, pg8::StaticOrder>(F.lds + RING_OFF, g, S, E); }
        { pg8::StaticOrder S; S.init(T, 5120, F.G, (int)blockIdx.x);
          pg8::Gemm8 g{(const unsigned char*)ap->out, ws + WS_WIN8, D / 2, 0x7f7f7f7f, 0x7a7a7a7a};
          pg8::EpiBf16Skip E{ZB + 1024, ZP, 8, ZN_A - 3072};
          pg8::gemm_phase8<pg8::EpiBf16Skip, pg8::StaticOrder>(F.lds + RING_OFF, g, S, E); }
        GRID_BAR();
    }
    REP(2)
    {
        PHASE_LOCALS
#if MK_GLA
        for (int task = blockIdx.x; task < NB * 128; task += F.G) {
            gla_prep_task(F.lds, ZB, IN(4), IN(5), (float*)(ws + WS_DEC), task);
            gla_local_unit(F.lds, F.wave, F.lane, ZB, (const float*)(ws + WS_DEC), (float*)(ws + WS_SLOC), task * 8 + F.wave);
            __syncthreads();
        }
#endif
        for (int m = gw; m < T; m += NGW) dsa_prep_row(F.lane, ZB, (size_t)m, IN(8), IN(9), (bf16*)(ws + WS_IKC), (float*)(ws + WS_UW));
        GRID_BAR();
    }
    REP(3)
    {
        PHASE_LOCALS
#if MK_GLA
        gla_scan((const float*)(ws + WS_SLOC), (const float*)(ws + WS_DEC), (bf16*)(ws + WS_STT), gt, NGT);
#endif
#if MK_DSA
        for (int task = blockIdx.x; task < NB * 64; task += F.G) {
            const int b = task >> 6, xq = task & 63;
#pragma unroll 1
            for (int half = 0; half < 2; ++half) {
                const int c = half ? 127 - xq : xq, n = 64 * (c + 1);
                unsigned char* wsl = ws; int lane_l = F.lane; asm volatile("" : "+s"(wsl), "+v"(lane_l));
                idx_scores_oct(wl, lane_l, (const bf16*)(wsl + WS_ZB), (const bf16*)(wsl + WS_IKC), (const float*)(wsl + WS_UW), (unsigned short*)(wsl + WS_SC), b, c, F.wave);
                VM_WAIT(); __syncthreads();
                asm volatile("" : "+s"(wsl), "+v"(lane_l));
#pragma unroll 1
                for (int q = 0; q < 8; ++q) { const int ql = F.wave * 8 + q;
                    idx_select_row(lane_l, (const unsigned short*)(wsl + WS_SC) + sc_off(b, c) + (size_t)ql * n, n, F.lds + RING_OFF + ql * 1024, (LAS unsigned*)(F.lds + RING_OFF + 65536 + F.wave * 8192)); }
                LDS_WAIT(); __syncthreads();
                asm volatile("" : "+s"(wsl), "+v"(lane_l));
                const int tend = (c | 3) + 1;
#pragma unroll 1
                for (int tile = F.wave; tile < tend; tile += NWAVES) bt_emit_tile(lane_l, F.lds + RING_OFF, (unsigned*)(wsl + WS_BM), b, c, tile, tile > c);
                __syncthreads();
            }
        }
#endif
        GRID_BAR();
    }
    REP(4)
    {
        PHASE_LOCALS
#if MK_GLA
        for (int u = gw; u < 4096; u += NGW) gla_out_unit(wl, F.lane, ZB, (const bf16*)(ws + WS_STT), IN(6), (bf16*)(ws + WS_OA), u);
        __syncthreads();
#endif
#if MK_MOE
        if (F.vcu % CONV_MOD == 0) {
            const int cw = (F.vcu / CONV_MOD) * NWAVES + F.wave, NCW = ((F.G + CONV_MOD - 1) / CONV_MOD) * NWAVES;
            LAS float* scr = (LAS float*)wl; const int lane_c = opaque_tid() & 63;
            conv_stream8<3>(IN(20), D, EFF, ws + WS_WGU8, 1024, 0, scr, lane_c, cw, NCW);
            conv_stream8<3>(IN(21), D, EFF, ws + WS_WGU8, 1024, 128, scr, lane_c, cw, NCW);
            conv_stream8<0>(IN(22), EFF, D, ws + WS_WDN8, D, 0, scr, lane_c, cw, NCW);
            __syncthreads();
        }
#endif
#if MK_DSA
        att::attn_phase((char*)lds_raw, ZB, ws + WS_OB, (const unsigned*)(ws + WS_BM), IN(10), IN(8), IN(9), F.ctl + CW_ATTQ);
#endif
        GRID_BAR();
    }
    REP(5)
    {
        PHASE_LOCALS
        pg8::StaticOrder S; S.init(T, D, F.G, (int)blockIdx.x);
        { pg8::Gemm g{(const bf16*)(ws + WS_OA), (const bf16*)(ws + WS_WOG), 1024}; pg8::EpiFp8 E{ws + WS_YA, D};
          pg8::gemm_phase<pg8::EpiFp8, pg8::StaticOrder>(F.lds + RING_OFF, g, S, E); }
        { pg8::Gemm8 g{ws + WS_OB, ws + WS_WOD8, 1024 / 2, 0x7b7b7b7b, 0x7a7a7a7a}; pg8::EpiFp8 E{ws + WS_YB, D};
          pg8::gemm_phase8<pg8::EpiFp8, pg8::StaticOrder>(F.lds + RING_OFF, g, S, E); }
        GRID_BAR();
    }
    REP(6)
    {
        PHASE_LOCALS
        pg8::StaticOrder S; S.init(T, 4096, F.G, (int)blockIdx.x);
        pg8::Gemm8 g{(const unsigned char*)ap->out, ws + WS_WBG8, D / 2, 0x7f7f7f7f, 0x7a7a7a7a};
        pg8::EpiGateMix E{ws + WS_YA, ws + WS_YB, ws + WS_U, IN(13)};
        pg8::gemm_phase8<pg8::EpiGateMix, pg8::StaticOrder>(F.lds + RING_OFF, g, S, E);
        GRID_BAR();
    }
    REP(7)
    {
        PHASE_LOCALS
        pg8::StaticOrder S; S.init(T, D, F.G, (int)blockIdx.x);
        pg8::Gemm8 g{ws + WS_U, ws + WS_WO8, D / 2, 0x7c7c7c7c, 0x7a7a7a7a};
        pg8::EpiResBf16P E{IN(0), (bf16*)ap->out, D};
        pg8::gemm_phase8<pg8::EpiResBf16P, pg8::StaticOrder>(F.lds + RING_OFF, g, S, E);
        GRID_BAR();
    }
    REP(8)
    {
        PHASE_LOCALS
        for (int m = gw; m < T; m += NGW) rms_row_bf(F.lane, (const bf16*)ap->out + (size_t)m * D, IN(15), (bf16*)(ws + WS_H2B) + (size_t)m * D, ws + WS_H8 + (size_t)m * D);
        { const GAS f32x4* p4 = (const GAS f32x4*)IN(1); GAS v2u* o = (GAS v2u*)(ws + WS_PBF);
          for (size_t i = (size_t)gt; i < (size_t)T * PLE / 4; i += (size_t)NGT) { const f32x4 v = p4[i]; v2u w; w.x = pk2(v.x, v.y); w.y = pk2(v.z, v.w); o[i] = w; } }
        GRID_BAR();
    }
#if MK_MOE
    REP(9)
    {
        PHASE_LOCALS
        pg8::StaticOrder S; S.init(T, 256, F.G, (int)blockIdx.x);
        pg8::Gemm g{(const bf16*)(ws + WS_H2B), (const bf16*)(ws + WS_WR), D};
        pg8::EpiF32 E{(float*)(ws + WS_LOGIT), 256};
        pg8::gemm_phase<pg8::EpiF32, pg8::StaticOrder>(F.lds + RING_OFF, g, S, E);
        VM_WAIT(); __syncthreads();
        { pg8::Unit ur;
          const int nu = (128 - (int)blockIdx.x + F.G - 1) / F.G;
#pragma unroll 1
          for (int iu = 0; iu < nu; ++iu) { S.next(iu, ur); const int t_lo = ur.pm * 256, t_hi = t_lo + 256;
        const float* LG = (const float*)(ws + WS_LOGIT); const float* bg = IN(17); const float* be = IN(19);
          unsigned* cnt = (unsigned*)(F.ctl + CW_CNT); int* tokrow = (int*)(ws + WS_TOKROW); float* tokw = (float*)(ws + WS_TOKW);
          for (int t = t_lo + F.tid; t < t_hi; t += NWAVES * 64) {
              const f32x4 a = *(const f32x4*)(LG + (size_t)t * 256), b2 = *(const f32x4*)(LG + (size_t)t * 256 + 4);
              float l[8] = {a.x + bg[0], a.y + bg[1], a.z + bg[2], a.w + bg[3], b2.x + bg[4], b2.y + bg[5], b2.z + bg[6], b2.w + bg[7]};
              int gi = 0; float gm = l[0];
#pragma unroll
              for (int i = 1; i < 8; ++i) if (l[i] > gm) { gm = l[i]; gi = i; }
              float se = 0.f;
#pragma unroll
              for (int i = 0; i < 8; ++i) se += __expf(l[i] - gm);
              const float grp_w = 1.0f / se;
              const f32x4 c0 = *(const f32x4*)(LG + (size_t)t * 256 + 8 + gi * 8), c1 = *(const f32x4*)(LG + (size_t)t * 256 + 12 + gi * 8);
              const float* bb = be + gi * 8;
              float ev[8] = {c0.x + bb[0], c0.y + bb[1], c0.z + bb[2], c0.w + bb[3], c1.x + bb[4], c1.y + bb[5], c1.z + bb[6], c1.w + bb[7]};
              int i0 = 0; float v0 = ev[0];
#pragma unroll
              for (int i = 1; i < 8; ++i) if (ev[i] > v0) { v0 = ev[i]; i0 = i; }
              int i1 = -1; float v1 = -__builtin_inff();
#pragma unroll
              for (int i = 0; i < 8; ++i) if (i != i0 && ev[i] > v1) { v1 = ev[i]; i1 = i; }
              const float w0 = 1.0f / (1.0f + __expf(v1 - v0)), w1 = 1.0f - w0;
              const int e0 = gi * 8 + i0, e1 = gi * 8 + i1;
              const unsigned p0 = atomicAdd(&cnt[e0], 1u), p1 = atomicAdd(&cnt[e1], 1u);
              tokrow[(size_t)e0 * ECAP + p0] = t * 2; tokw[(size_t)e0 * ECAP + p0] = grp_w * w0;
              tokrow[(size_t)e1 * ECAP + p1] = t * 2 + 1; tokw[(size_t)e1 * ECAP + p1] = grp_w * w1;
          }
          } }
        { pg8::PleOrder SP{F.G, (int)blockIdx.x};
          pg8::Gemm gp{(const bf16*)(ws + WS_PBF), (const bf16*)(ws + WS_WPP), PLE};
          pg8::EpiBf16 EP{(bf16*)(ws + WS_PLEB), D};
          pg8::gemm_phase<pg8::EpiBf16, pg8::PleOrder>(F.lds + RING_OFF, gp, SP, EP); }
        GRID_BAR();
    }
    REP(11)
    {
        PHASE_LOCALS
        LAS int* pref = (LAS int*)(F.lds + PREF_OFF); LAS int* cntl = (LAS int*)(F.lds + CNTL_OFF);
        if (F.tid < 64) cntl[F.tid] = (int)__hip_atomic_load((unsigned*)(F.ctl + CW_CNT) + F.tid, RLX_AGENT);
        __syncthreads();
        if (F.tid == 0) { int acc = 0; for (int e = 0; e < 64; ++e) { pref[e] = acc; acc += (cntl[e] + 255) >> 8; } pref[64] = acc; }
        __syncthreads();
        pg8::MoeOrder S{pref, cntl, (const int*)(ws + WS_TOKROW), 4, F.G, F.vcu, D / 2};
        pg8::Gemm8 g{ws + WS_H8, ws + WS_WGU8, D / 2, 0x7f7f7f7f, 0x7a7a7a7a};
        pg8::EpiMoe1 E{ws + WS_ACT};
        pg8::gemm_phase8<pg8::EpiMoe1, pg8::MoeOrder, true>(F.lds + RING_OFF, g, S, E);
        GRID_BAR();
    }
    REP(12)
    {
        PHASE_LOCALS
        LAS int* pref = (LAS int*)(F.lds + PREF_OFF); LAS int* cntl = (LAS int*)(F.lds + CNTL_OFF);
        pg8::MoeOrder S{pref, cntl, (const int*)(ws + WS_TOKROW), 8, F.G, F.vcu, EFF / 2};
        pg8::Gemm8 g{ws + WS_ACT, ws + WS_WDN8, EFF / 2, 0x7d7d7d7d, 0x7a7a7a7a};
        pg8::EpiMoe2 E{(bf16*)(ws + WS_Y0), (long long)(HB - (bf16*)(ws + WS_Y0)), (const int*)(ws + WS_TOKROW), (const float*)(ws + WS_TOKW), cntl};
        pg8::gemm_phase8<pg8::EpiMoe2, pg8::MoeOrder, false>(F.lds + RING_OFF, g, S, E);
        GRID_BAR();
    }
#endif
    REP(13)
    {
        PHASE_LOCALS
        for (int m = gw; m < T; m += NGW) combine_row_bf(F.lane, (const bf16*)ap->out + (size_t)m * D, (const bf16*)(ws + WS_Y0) + (size_t)m * D, HB + (size_t)m * D, IN(23), (bf16*)(ws + WS_X2B) + (size_t)m * D, ws + WS_H8 + (size_t)m * D);
        GRID_BAR();
    }
    REP(14)
    {
        PHASE_LOCALS
        pg8::StaticOrder S; S.init(T, D, F.G, (int)blockIdx.x);
        { pg8::Gemm8 g{ws + WS_H8, ws + WS_WPG8, D / 2, 0x7f7f7f7f, 0x7a7a7a7a};
          pg8::EpiPleFinal E{(const bf16*)(ws + WS_X2B), (const bf16*)(ws + WS_PLEB), ap->out, IN(25)};
          pg8::gemm_phase8<pg8::EpiPleFinal, pg8::StaticOrder>(F.lds + RING_OFF, g, S, E); }
    }
}

extern "C" void kernel_launch(void* const* d_in, const int* in_sizes, int n_in, void* d_out, int out_size, void* d_ws, size_t ws_size, hipStream_t stream) {
    static int grid = 0;
    if (grid == 0) {
        if (n_in != 27 || out_size != T * D || ws_size < WS_END) { fprintf(stderr, "kernel_launch: unexpected shapes (n_in %d out %d ws %zu, need %zu)\n", n_in, out_size, ws_size, (size_t)WS_END); grid = -1; return; }
        int dev = 0, cus = 0, per_cu = 0;
        if (hipGetDevice(&dev) != hipSuccess || hipDeviceGetAttribute(&cus, hipDeviceAttributeMultiprocessorCount, dev) != hipSuccess) { grid = -1; return; }
        if (hipFuncSetAttribute((const void*)mk_fwd, hipFuncAttributeMaxDynamicSharedMemorySize, LDS_BYTES) != hipSuccess) { fprintf(stderr, "kernel_launch: hipFuncSetAttribute failed\n"); grid = -1; return; }
        if (hipOccupancyMaxActiveBlocksPerMultiprocessor(&per_cu, (const void*)mk_fwd, NWAVES * 64, LDS_BYTES) != hipSuccess || per_cu < 1) { fprintf(stderr, "kernel_launch: occupancy query says %d\n", per_cu); }
        (void)hipGetLastError();
        grid = cus;
    }
    if (grid < 0) return;
    if (hipMemsetAsync((char*)d_ws + WS_CTL, 0, CTL_ZERO_BYTES, stream) != hipSuccess) return;
    Args a{};
    for (int i = 0; i < 27; ++i) a.in[i] = (const float*)d_in[i];
    a.out = (float*)d_out; a.ws = (unsigned char*)d_ws; a.ph_lo = 0; a.ph_hi = 99;
    hipLaunchKernelGGL(mk_fwd, dim3(grid), dim3(NWAVES * 64), LDS_BYTES, stream, a);
}
```

```cpp
#include <hip/hip_runtime.h>
#include <cstdio>
#include <cstdint>

#ifndef MK_STAGE
#define MK_STAGE 1
#endif

#define GAS __attribute__((address_space(1)))
#define LAS __attribute__((address_space(3)))
typedef unsigned short bf16;
typedef unsigned v4u __attribute__((ext_vector_type(4)));
typedef unsigned v2u __attribute__((ext_vector_type(2)));
typedef float f32x4 __attribute__((ext_vector_type(4)));
typedef float f32x2 __attribute__((ext_vector_type(2)));
typedef float f32x16 __attribute__((ext_vector_type(16)));
typedef short bf16x8 __attribute__((ext_vector_type(8)));
typedef short s16x4 __attribute__((ext_vector_type(4)));
typedef GAS unsigned gu32;
#define RLX_AGENT __ATOMIC_RELAXED, __HIP_MEMORY_SCOPE_AGENT
#define LDS_WAIT() asm volatile("s_waitcnt lgkmcnt(0)" ::: "memory")
#define VM_WAIT() asm volatile("s_waitcnt vmcnt(0)" ::: "memory")

constexpr int NB = 4, SEQ = 8192, T = NB * SEQ, D = 2048, PLE = 256;
constexpr int ZP = 7424;
constexpr int ZC_GQ = 0, ZC_GK = 512, ZC_GV = 1024, ZC_GR = 2048, ZC_GLR = 3072, ZC_IK = 3088, ZC_IW = 3152, ZC_IQ = 3328, ZN_A = 4352  , ZC_DQ = 4352, ZC_DK = 5376, ZC_DV = 6400;
constexpr int NEXP = 64, EFF = 512, ECAP = 32768;
constexpr int ACT_ROWS = 81920;
constexpr float EPS = 1e-6f;
constexpr int NWAVES = 8;

constexpr size_t MiB = 1u << 20;
constexpr size_t al(size_t x) { return (x + 255) & ~(size_t)255; }
constexpr size_t WS_CTL = 0, CTL_ZERO_BYTES = 1 * MiB;
constexpr size_t WS_WIN = WS_CTL + CTL_ZERO_BYTES;
constexpr size_t WS_WBG = WS_WIN + al((size_t)ZP * D * 2);
constexpr size_t WS_WOG = WS_WBG + al((size_t)4096 * D * 2);
constexpr size_t WS_WOD = WS_WOG + al((size_t)D * 1024 * 2);
constexpr size_t WS_WO = WS_WOD + al((size_t)D * 1024 * 2);
constexpr size_t WS_WPG = WS_WO + al((size_t)D * D * 2);
constexpr size_t WS_WPP = WS_WPG + al((size_t)D * D * 2);
constexpr size_t WS_WR = WS_WPP + al((size_t)D * PLE * 2);
constexpr size_t WS_HB = WS_WR + al((size_t)256 * D * 2);
constexpr size_t WS_ZB = WS_HB + al((size_t)T * D * 2);
constexpr size_t ZB_BYTES = (size_t)T * ZP * 2;
constexpr size_t WS_SC = WS_ZB + al(ZB_BYTES);
constexpr size_t SC_PER_BATCH = (size_t)64 * 64 * (128 * 129 / 2);
constexpr size_t SC_BYTES = (size_t)NB * SC_PER_BATCH * 2;
constexpr size_t WS_BM = WS_SC + al(SC_BYTES);
constexpr size_t WS_SLOC = WS_BM + al((size_t)T * 1024);
constexpr size_t WS_STT = WS_SLOC + al((size_t)4096 * 8192 * 4);
constexpr size_t WS_DEC = WS_STT + al((size_t)4096 * 8192 * 2);
constexpr size_t WS_IKC = WS_DEC + al((size_t)4096 * 64 * 4);
constexpr size_t WS_UW = WS_IKC + al((size_t)T * 64 * 2);
constexpr size_t WS_WBG8 = WS_UW + al((size_t)T * 16 * 4);
constexpr size_t WS_WPG8 = WS_WBG8 + al((size_t)4096 * D);
constexpr size_t WS_WOD8 = WS_WPG8 + al((size_t)D * D);
constexpr size_t WS_WO8 = WS_WOD8 + al((size_t)D * 1024);
constexpr size_t WS_END = WS_WO8 + al((size_t)D * D);
constexpr size_t WS_WIN8 = WS_WIN + (size_t)ZN_A * D * 2;
static_assert(WS_WIN8 + (size_t)5120 * D <= WS_WBG, "w_in copies fit their region");
constexpr size_t WS_OA = WS_SC, WS_OB = WS_SC + (size_t)T * 1024 * 2;
constexpr size_t WS_YA = WS_ZB, WS_YB = WS_ZB + (size_t)T * D * 2, WS_U = WS_ZB + 2 * (size_t)T * D * 2;
constexpr size_t WS_WGU = WS_ZB;
constexpr size_t WS_WDN = WS_WGU + (size_t)NEXP * 1024 * D * 2;
constexpr size_t WS_ACT = WS_WDN + (size_t)NEXP * D * EFF * 2;
static_assert(WS_ACT + (size_t)ACT_ROWS * EFF * 2 <= WS_ZB + ZB_BYTES, "MoE overlay fits in Z");
constexpr size_t WS_LOGIT = WS_SC;
constexpr size_t WS_TOKROW = WS_LOGIT + (size_t)T * 256 * 4;
constexpr size_t WS_TOKW = WS_TOKROW + (size_t)NEXP * ECAP * 4;
constexpr size_t WS_PLEB = WS_TOKW + (size_t)NEXP * ECAP * 4;
constexpr size_t WS_PBF = WS_PLEB + (size_t)T * D * 2;
static_assert(WS_PBF + (size_t)T * PLE * 2 <= WS_SC + SC_BYTES, "late overlays fit in SC");
constexpr size_t WS_H8 = WS_STT;
constexpr size_t WS_WGU8 = WS_HB;
constexpr size_t WS_WDN8 = WS_SC + SC_BYTES - (size_t)NEXP * D * EFF;
static_assert(WS_PBF + (size_t)T * PLE * 2 <= WS_WDN8 && WS_OB + (size_t)T * 1024 * 2 <= WS_WDN8 && WS_WDN8 % 256 == 0, "expert down weights behind the SC overlays");
constexpr size_t WS_X2B = WS_ZB;
constexpr size_t WS_H2B = WS_ZB;
constexpr size_t WS_Y0 = WS_SLOC;
static_assert(WS_END <= (size_t)1253000000, "workspace map within the guaranteed minimum");
constexpr int CW_BAR = 4096;
constexpr int CW_CNT = 16384;
constexpr int CW_ATTQ = 20480;

__device__ __forceinline__ unsigned f2bf(float f) { unsigned u = __builtin_bit_cast(unsigned, f); return (u + 0x7fffu + ((u >> 16) & 1u)) >> 16; }
__device__ __forceinline__ unsigned pk2(float lo, float hi) { return f2bf(lo) | (f2bf(hi) << 16); }
__device__ __forceinline__ unsigned pk4_fp8(float a, float b, float c, float d) { int w = 0; w = __builtin_amdgcn_cvt_pk_fp8_f32(a, b, w, false); w = __builtin_amdgcn_cvt_pk_fp8_f32(c, d, w, true); return (unsigned)w; }
__device__ __forceinline__ float bf2f(unsigned short b) { return __builtin_bit_cast(float, (unsigned)b << 16); }
__device__ __forceinline__ float bflo(unsigned w) { return __builtin_bit_cast(float, w << 16); }
__device__ __forceinline__ float bfhi(unsigned w) { return __builtin_bit_cast(float, w & 0xffff0000u); }
__device__ __forceinline__ unsigned cvt_pk_bf16(float lo, float hi) { unsigned r; asm volatile("v_cvt_pk_bf16_f32 %0, %1, %2" : "=v"(r) : "v"(lo), "v"(hi)); return r; }
#define DPP_I(v, ctrl) __builtin_amdgcn_update_dpp((int)(v), (int)(v), (ctrl), 0xF, 0xF, true)
#define DPP_F(v, ctrl) __builtin_bit_cast(float, __builtin_amdgcn_update_dpp(__builtin_bit_cast(int, (float)(v)), __builtin_bit_cast(int, (float)(v)), (ctrl), 0xF, 0xF, true))
constexpr int DPP_X1 = 0xB1, DPP_X2 = 0x4E, DPP_HM = 0x141, DPP_RM = 0x140;
__device__ __forceinline__ float sum8(float v) { v += DPP_F(v, DPP_X1); v += DPP_F(v, DPP_X2); v += DPP_F(v, DPP_HM); return v; }
__device__ __forceinline__ float sum16(float v) { v = sum8(v); v += DPP_F(v, DPP_RM); return v; }
__device__ __forceinline__ float sum32(float v) { v = sum16(v); auto r = __builtin_amdgcn_permlane16_swap(__float_as_uint(v), __float_as_uint(v), false, false); return __uint_as_float(r[0]) + __uint_as_float(r[1]); }
__device__ __forceinline__ float wave_sum(float v) { v = sum32(v); auto r = __builtin_amdgcn_permlane32_swap(__float_as_uint(v), __float_as_uint(v), false, false); return __uint_as_float(r[0]) + __uint_as_float(r[1]); }
__device__ __forceinline__ float wave_max(float v) {
    v = fmaxf(v, DPP_F(v, DPP_X1)); v = fmaxf(v, DPP_F(v, DPP_X2)); v = fmaxf(v, DPP_F(v, DPP_HM)); v = fmaxf(v, DPP_F(v, DPP_RM));
    { auto r = __builtin_amdgcn_permlane16_swap(__float_as_uint(v), __float_as_uint(v), false, false); v = fmaxf(__uint_as_float(r[0]), __uint_as_float(r[1])); }
    { auto r = __builtin_amdgcn_permlane32_swap(__float_as_uint(v), __float_as_uint(v), false, false); v = fmaxf(__uint_as_float(r[0]), __uint_as_float(r[1])); }
    return v;
}
__device__ __forceinline__ int wave_sum_i(int v) {
    v += DPP_I(v, DPP_X1); v += DPP_I(v, DPP_X2); v += DPP_I(v, DPP_HM); v += DPP_I(v, DPP_RM);
    { auto r = __builtin_amdgcn_permlane16_swap((unsigned)v, (unsigned)v, false, false); v = (int)(r[0] + r[1]); }
    { auto r = __builtin_amdgcn_permlane32_swap((unsigned)v, (unsigned)v, false, false); v = (int)(r[0] + r[1]); }
    return v;
}
__device__ __forceinline__ int opaque_tid() { int t = threadIdx.x; asm volatile("" : "+v"(t)); return t; }
__device__ __forceinline__ float sigmoidf_(float x) { return __builtin_amdgcn_rcpf(1.0f + __builtin_amdgcn_exp2f(-1.4426950408889634f * x)); }

#define XB_TMO      128
#define XB_XCNT(j)  (256  + 64 * (j))
#define XB_XSUB(j)  (1280 + 64 * (j))
#define XB_XGEN(j)  (2304 + 64 * (j))
#define XB_TOP      3328
#define XB_TOPGEN   3392
#define XCD_BAR_WORDS 3456
#define XB_SPIN_CAP (1u << 18)
__device__ __forceinline__ unsigned xb_ld(unsigned* p)              { return __hip_atomic_load(p, __ATOMIC_RELAXED, __HIP_MEMORY_SCOPE_AGENT); }
__device__ __forceinline__ unsigned xb_add(unsigned* p, unsigned v) { return __hip_atomic_fetch_add(p, v, __ATOMIC_RELAXED, __HIP_MEMORY_SCOPE_AGENT); }
__device__ __forceinline__ unsigned xb_xcc_id() { return (unsigned)__builtin_amdgcn_s_getreg((3 << 11) | 20) & 0xFu; }
#define XB_SPIN(cond, bar) do { unsigned _sp = 0; while (cond) { __builtin_amdgcn_s_sleep(1); \
    if ((++_sp & 255u) == 0u) { if (xb_ld(&(bar)[XB_TMO])) break; if (_sp > XB_SPIN_CAP) { atomicAdd(&(bar)[XB_TMO], 1u); break; } } } } while (0)
struct XcdBarrier { unsigned* bar; unsigned x; volatile LAS unsigned* st; };
__device__ __forceinline__ XcdBarrier xcd_barrier_post(unsigned* bar, volatile LAS unsigned* st) {
    XcdBarrier b; b.bar = bar; b.x = xb_xcc_id(); b.st = st;
    if (threadIdx.x == 0) (void)xb_add(&bar[XB_XCNT(b.x)], 1u);
    return b;
}
__device__ __forceinline__ void xcd_barrier_complete(unsigned* bar, unsigned x, unsigned& nloc, unsigned& nx) {
    const unsigned G = gridDim.x * gridDim.y * gridDim.z;
    unsigned sum, cnt, mine, sp = 0u;
    for (;;) {
        sum = 0u; cnt = 0u; mine = 0u;
#pragma unroll
        for (unsigned j = 0; j < 16; ++j) { const unsigned c = xb_ld(&bar[XB_XCNT(j)]); sum += c; cnt += (c > 0u) ? 1u : 0u; mine = (j == x) ? c : mine; }
        if (sum == G) break;
        __builtin_amdgcn_s_sleep(1);
        if ((++sp & 255u) == 0u) { if (xb_ld(&bar[XB_TMO])) break; if (sp > XB_SPIN_CAP) { atomicAdd(&bar[XB_TMO], 1u); break; } }
    }
    nloc = mine > 0u ? mine : 1u; nx = cnt > 0u ? cnt : 1u;
}
__device__ __forceinline__ void xcd_barrier(const XcdBarrier& b) {
    asm volatile("s_waitcnt vmcnt(0)" ::: "memory");
    __syncthreads();
    if (threadIdx.x == 0) {
        unsigned* bar = b.bar;
        __builtin_amdgcn_s_waitcnt(0);
        unsigned nloc = b.st[0], nx = b.st[1];
        if (nloc == 0u) { xcd_barrier_complete(bar, b.x, nloc, nx); b.st[0] = nloc; b.st[1] = nx; }
        const unsigned old = xb_add(&bar[XB_XSUB(b.x)], 1u);
        const unsigned gen = old / nloc;
        if (old + 1u == (gen + 1u) * nloc) {
            __builtin_amdgcn_fence(__ATOMIC_RELEASE, "agent");
            asm volatile("s_waitcnt vmcnt(0)" ::: "memory");
            const unsigned og = xb_add(&bar[XB_TOP], 1u);
            const unsigned tg = og / nx;
            if (og + 1u == (tg + 1u) * nx) xb_add(&bar[XB_TOPGEN], 1u);
            else XB_SPIN(xb_ld(&bar[XB_TOPGEN]) == tg, bar);
            __builtin_amdgcn_fence(__ATOMIC_ACQUIRE, "agent");
            xb_add(&bar[XB_XGEN(b.x)], 1u);
            asm volatile("s_waitcnt vmcnt(0)" ::: "memory");
        } else {
            XB_SPIN(xb_ld(&bar[XB_XGEN(b.x)]) == gen, bar);
            __builtin_amdgcn_fence(__ATOMIC_ACQUIRE, "agent");
            asm volatile("s_waitcnt vmcnt(0)" ::: "memory");
        }
    }
    __syncthreads();
}

namespace pg8 {
constexpr int BM = 256, BK = 64, HALF = 128, HTB = HALF * BK * 2, STAGE_BYTES = 8 * HTB, NXCD = 8, WGM = 8;
__host__ __device__ __forceinline__ int lds_byte(int r, int c) { const int st = (r >> 4) * 2 + (c >> 5), rr = r & 15, cc = c & 31, ob = rr * 64 + cc * 2; return st * 1024 + (ob ^ (((ob >> 9) & 1) << 5)); }
__host__ __device__ __forceinline__ void stage_rc(int b, int& R, int& C) { const int st = b / 1024, sb = b % 1024, swz = sb ^ (((sb >> 9) & 1) << 5); R = (st >> 1) * 16 + swz / 64; C = (st & 1) * 32 + (swz % 64) / 2; }
__host__ __device__ __forceinline__ int perm32(int rho) { const int n = rho >> 4, i = rho & 15; return 8 * (i >> 2) + 4 * n + (i & 3); }

struct Unit { int pm, pn; int e, mt; };
struct Gemm { const bf16* A; const bf16* Bt; int K; };

typedef int v8i __attribute__((ext_vector_type(8)));
typedef int v4i __attribute__((ext_vector_type(4)));
struct Gemm8 { const unsigned char* A; const unsigned char* Bt; int K; int sa, sb; };
struct F2x { bf16x8 v[2]; __device__ __forceinline__ bf16x8& operator[](int i) { return v[i]; } __device__ __forceinline__ const bf16x8& operator[](int i) const { return v[i]; } };
__host__ __device__ __forceinline__ int lds_byte8(int r, int g) { const int st = (r >> 4) * 2 + (g >> 1), ob = (r & 15) * 64 + 32 * (g & 1); return st * 1024 + (ob ^ (((ob >> 9) & 1) << 5)); }
struct StaticOrder {
    int nM, nN, nwg, G, c;
    __device__ void init(int M, int N, int G_, int c_) { nM = M / BM; nN = N / BM; nwg = nM * nN; G = G_; c = c_; }
    __device__ __forceinline__ bool next(int i, Unit& u) const {
        const long L = (long)i * G + c; if (L >= nwg) return false;
        int wgid = (int)L; { const int q = nwg / NXCD, r = nwg % NXCD, xcd = wgid % NXCD, off = wgid / NXCD; wgid = (xcd < r ? xcd * (q + 1) : r * (q + 1) + (xcd - r) * q) + off; }
        const int nig = WGM * nN, gid = wgid / nig, fm = gid * WGM, gsz = (nM - fm) < WGM ? (nM - fm) : WGM;
        u.pm = fm + ((wgid % nig) % gsz); u.pn = (wgid % nig) / gsz; u.e = 0; u.mt = 0; return true;
    }
    __device__ __forceinline__ void rows(const Unit&, int, int, unsigned (&)[2][2]) const {}
};

template <class Epi, class Sched, bool GATHER = false>
__device__ __forceinline__ void gemm_phase(LAS unsigned char* lds, const Gemm g, const Sched& S, const Epi& E) {
    int tid_ = threadIdx.x; asm volatile("" : "+v"(tid_));
    const int tid = tid_, wid = __builtin_amdgcn_readfirstlane(tid >> 6), lane = tid & 63, wr = wid >> 2, wc = wid & 3, fr = lane & 15, fq = lane >> 4;
    const int K = g.K, nt = K / BK;
    unsigned voffA[2], voffB[2]; int RA[2], CA[2];
#pragma unroll
    for (int i = 0; i < 2; ++i) { int R, C; stage_rc(tid * 16 + i * 8192, R, C); const int Rb = Epi::PERM ? ((R & ~31) + perm32(R & 31)) : R;
        RA[i] = R; CA[i] = C; voffA[i] = (unsigned)(R * K + C) * 2u; voffB[i] = (unsigned)(Rb * K + C) * 2u; }
    const size_t kstep = (size_t)(BK * 2);
    const size_t hstep = (size_t)HALF * K * 2;
    const size_t tstep = 2 * hstep;
    const unsigned ldsw = (unsigned)wid * 1024u;
    const int aoff = lds_byte(wr * 64 + fr, fq * 8), boff = lds_byte(wc * 32 + fr, fq * 8);
#define PG8_SA(b, h) (((b) * 2 + (h)) * HTB)
#define PG8_SB(b, h) ((4 + (b) * 2 + (h)) * HTB)
#define PG8_STAGE(bufoff, gbase, voff) do { _Pragma("unroll") for (int _i = 0; _i < 2; ++_i) \
        __builtin_amdgcn_global_load_lds((const unsigned*)((const char*)(gbase) + (voff)[_i]), (LAS unsigned*)(lds + (bufoff) + ldsw + _i * 8192), 16, 0, 0); } while (0)
#define PG8_STAGE_A(bufoff, gbase, h, AO) do { if constexpr (GATHER) { PG8_STAGE(bufoff, gbase, AO[h]); } else { PG8_STAGE(bufoff, (gbase) + (h) * hstep, voffA); } } while (0)
#define PG8_LDA(dst, b, h) do { _Pragma("unroll") for (int m = 0; m < 4; ++m) _Pragma("unroll") for (int k = 0; k < 2; ++k) dst[m][k] = *(const LAS bf16x8*)(lds + PG8_SA(b, h) + aoff + m * 2048 + k * 1024); } while (0)
#define PG8_LDB(dst, b, h) do { _Pragma("unroll") for (int n = 0; n < 2; ++n) _Pragma("unroll") for (int k = 0; k < 2; ++k) dst[n][k] = *(const LAS bf16x8*)(lds + PG8_SB(b, h) + boff + n * 2048 + k * 1024); } while (0)
#define PG8_MMA(ai, bj, At, Bt) do { __builtin_amdgcn_s_setprio(1); _Pragma("unroll") for (int m = 0; m < 4; ++m) _Pragma("unroll") for (int n = 0; n < 2; ++n) _Pragma("unroll") for (int k = 0; k < 2; ++k) \
        acc[ai][bj][m][n] = __builtin_amdgcn_mfma_f32_16x16x32_bf16(Bt[n][k], At[m][k], acc[ai][bj][m][n], 0, 0, 0); __builtin_amdgcn_s_setprio(0); } while (0)
#define PG8_WAIT_V(n) asm volatile("s_waitcnt vmcnt(" #n ")" ::: "memory")
#define PG8_WAIT_L(n) asm volatile("s_waitcnt lgkmcnt(" #n ")" ::: "memory")
#define PG8_BAR __builtin_amdgcn_s_barrier()
#define PG8_SCHED __builtin_amdgcn_sched_barrier(0)
    Unit cur, nxt; int ui = 0;
    if (!S.next(0, cur)) return;
    f32x4 acc[2][2][4][2];
#pragma unroll
    for (int a = 0; a < 2; ++a)
#pragma unroll
        for (int b = 0; b < 2; ++b)
#pragma unroll
            for (int m = 0; m < 4; ++m)
#pragma unroll
                for (int n = 0; n < 2; ++n) acc[a][b][m][n] = (f32x4){0.f, 0.f, 0.f, 0.f};
    bf16x8 At[4][2], B0[2][2], B1[2][2];
    unsigned aoc[2][2], aon[2][2];
    const char* cA; const char* cB = (const char*)g.Bt + (size_t)cur.pn * tstep;
    if constexpr (GATHER) { cA = (const char*)g.A; S.rows(cur, RA[0], RA[1], aoc);
#pragma unroll
        for (int h = 0; h < 2; ++h)
#pragma unroll
            for (int i = 0; i < 2; ++i) aoc[h][i] += (unsigned)CA[i] * 2u; }
    else { cA = (const char*)g.A + (size_t)cur.pm * tstep;
#pragma unroll
        for (int i = 0; i < 2; ++i) { aoc[0][i] = 0u; aoc[1][i] = 0u; } }
    PG8_STAGE(PG8_SB(0, 0), cB, voffB); PG8_STAGE(PG8_SB(0, 1), cB + hstep, voffB); PG8_STAGE_A(PG8_SA(0, 0), cA, 0, aoc); PG8_STAGE_A(PG8_SA(0, 1), cA, 1, aoc);
    if (wr == 1) PG8_BAR;
    PG8_WAIT_V(2); PG8_BAR;
    PG8_STAGE(PG8_SB(1, 0), cB + kstep, voffB); PG8_STAGE_A(PG8_SA(1, 0), cA + kstep, 0, aoc); PG8_STAGE(PG8_SB(1, 1), cB + hstep + kstep, voffB);
    PG8_WAIT_V(6); PG8_BAR;
    for (;;) {
        const bool has_next = S.next(ui + 1, nxt);
        const char* nA; const char* nB = has_next ? (const char*)g.Bt + (size_t)nxt.pn * tstep : cB;
        if constexpr (GATHER) { nA = cA;
            if (has_next) { S.rows(nxt, RA[0], RA[1], aon);
#pragma unroll
                for (int h = 0; h < 2; ++h)
#pragma unroll
                    for (int i = 0; i < 2; ++i) aon[h][i] += (unsigned)CA[i] * 2u; }
            else {
#pragma unroll
                for (int h = 0; h < 2; ++h)
#pragma unroll
                    for (int i = 0; i < 2; ++i) aon[h][i] = aoc[h][i]; } }
        else { nA = has_next ? (const char*)g.A + (size_t)nxt.pm * tstep : cA;
#pragma unroll
            for (int h = 0; h < 2; ++h)
#pragma unroll
                for (int i = 0; i < 2; ++i) aon[h][i] = aoc[h][i]; }
#pragma nounroll
        for (int t = 0; t < nt; t += 2) {
            const bool last = (t == nt - 2);
            const char* a1 = cA + (size_t)(t + 1) * kstep;
            const char* a2 = last ? nA : cA + (size_t)(t + 2) * kstep; const char* b2 = last ? nB : cB + (size_t)(t + 2) * kstep;
            const char* a3 = a2 + kstep; const char* b3 = b2 + kstep;
            unsigned ao2[2][2];
#pragma unroll
            for (int h = 0; h < 2; ++h)
#pragma unroll
                for (int i = 0; i < 2; ++i) ao2[h][i] = (GATHER && last) ? aon[h][i] : aoc[h][i];
            PG8_LDB(B0, 0, 0); PG8_LDB(B1, 0, 1); PG8_SCHED; PG8_LDA(At, 0, 0); PG8_STAGE_A(PG8_SA(1, 1), a1, 1, aoc);
            PG8_WAIT_V(8); PG8_WAIT_L(0); PG8_BAR; PG8_MMA(0, 0, At, B0); PG8_MMA(0, 1, At, B1); PG8_BAR; PG8_SCHED;
            PG8_LDA(At, 0, 1); PG8_STAGE(PG8_SB(0, 0), b2, voffB); PG8_STAGE(PG8_SB(0, 1), b2 + hstep, voffB); PG8_STAGE_A(PG8_SA(0, 0), a2, 0, ao2);
            PG8_WAIT_V(8); PG8_WAIT_L(0); PG8_BAR; PG8_MMA(1, 0, At, B0); PG8_MMA(1, 1, At, B1); PG8_BAR; PG8_SCHED;
            PG8_LDB(B0, 1, 0); PG8_LDB(B1, 1, 1); PG8_SCHED; PG8_LDA(At, 1, 0); PG8_STAGE_A(PG8_SA(0, 1), a2, 1, ao2);
            PG8_WAIT_V(8); PG8_WAIT_L(0); PG8_BAR; PG8_MMA(0, 0, At, B0); PG8_MMA(0, 1, At, B1); PG8_BAR; PG8_SCHED;
            PG8_LDA(At, 1, 1); PG8_STAGE(PG8_SB(1, 0), b3, voffB); PG8_STAGE(PG8_SB(1, 1), b3 + hstep, voffB); PG8_STAGE_A(PG8_SA(1, 0), a3, 0, ao2);
            PG8_WAIT_V(8); PG8_WAIT_L(0); PG8_BAR; PG8_MMA(1, 0, At, B0); PG8_MMA(1, 1, At, B1); PG8_BAR; PG8_SCHED;
        }
        if (wr == 0) PG8_BAR;
        asm volatile("s_nop 15\n\ts_nop 7" ::: "memory");
        E(acc, cur, wr, wc, fr, fq);
        if (!has_next) break;
#pragma unroll
        for (int a = 0; a < 2; ++a)
#pragma unroll
            for (int b = 0; b < 2; ++b)
#pragma unroll
                for (int m = 0; m < 4; ++m)
#pragma unroll
                    for (int n = 0; n < 2; ++n) acc[a][b][m][n] = (f32x4){0.f, 0.f, 0.f, 0.f};
        cur = nxt; cA = nA; cB = nB; ++ui;
#pragma unroll
        for (int h = 0; h < 2; ++h)
#pragma unroll
            for (int i = 0; i < 2; ++i) aoc[h][i] = aon[h][i];
        if (wr == 1) PG8_BAR;
    }
    PG8_WAIT_V(0);
    PG8_BAR;
#undef PG8_SA
#undef PG8_SB
#undef PG8_STAGE
#undef PG8_STAGE_A
#undef PG8_LDA
#undef PG8_LDB
#undef PG8_MMA
#undef PG8_WAIT_V
#undef PG8_WAIT_L
#undef PG8_BAR
#undef PG8_SCHED
}

template <class Epi, class Sched, bool GATHER = false>
__device__ __forceinline__ void gemm_phase8(LAS unsigned char* lds, const Gemm8 g, const Sched& S, const Epi& E) {
    int tid_ = threadIdx.x; asm volatile("" : "+v"(tid_));
    const int tid = tid_, wid = __builtin_amdgcn_readfirstlane(tid >> 6), lane = tid & 63, wr = wid >> 2, wc = wid & 3, fr = lane & 15, fq = lane >> 4;
    const int K = g.K, nt = K / BK;
    unsigned voffA[2], voffB[2]; int RA[2], CA[2];
#pragma unroll
    for (int i = 0; i < 2; ++i) { int R, C; stage_rc(tid * 16 + i * 8192, R, C); const int Rb = Epi::PERM ? ((R & ~31) + perm32(R & 31)) : R;
        RA[i] = R; CA[i] = C; voffA[i] = (unsigned)(R * K + C) * 2u; voffB[i] = (unsigned)(Rb * K + C) * 2u; }
    const size_t kstep = (size_t)(BK * 2);
    const size_t hstep = (size_t)HALF * K * 2;
    const size_t tstep = 2 * hstep;
    const unsigned ldsw = (unsigned)wid * 1024u;
    const int aoff = lds_byte8(wr * 64 + fr, fq), boff = lds_byte8(wc * 32 + fr, fq);
#define PG8_SA(b, h) (((b) * 2 + (h)) * HTB)
#define PG8_SB(b, h) ((4 + (b) * 2 + (h)) * HTB)
#define PG8_STAGE(bufoff, gbase, voff) do { _Pragma("unroll") for (int _i = 0; _i < 2; ++_i) \
        __builtin_amdgcn_global_load_lds((const unsigned*)((const char*)(gbase) + (voff)[_i]), (LAS unsigned*)(lds + (bufoff) + ldsw + _i * 8192), 16, 0, 0); } while (0)
#define PG8_STAGE_A(bufoff, gbase, h, AO) do { if constexpr (GATHER) { PG8_STAGE(bufoff, gbase, AO[h]); } else { PG8_STAGE(bufoff, (gbase) + (h) * hstep, voffA); } } while (0)
#define PG8_LD32(p) __builtin_shufflevector(*(const LAS v4i*)(p), *(const LAS v4i*)((p) + 16), 0, 1, 2, 3, 4, 5, 6, 7)
#define PG8_LDA(dst, b, h) do { _Pragma("unroll") for (int m = 0; m < 4; ++m) dst[m] = PG8_LD32(lds + PG8_SA(b, h) + aoff + m * 2048); } while (0)
#define PG8_LDB(dst, b, h) do { _Pragma("unroll") for (int n = 0; n < 2; ++n) dst[n] = PG8_LD32(lds + PG8_SB(b, h) + boff + n * 2048); } while (0)
#define PG8_MMA(ai, bj, At, Bt) do { __builtin_amdgcn_s_setprio(1); _Pragma("unroll") for (int m = 0; m < 4; ++m) _Pragma("unroll") for (int n = 0; n < 2; ++n) \
        asm volatile("v_mfma_scale_f32_16x16x128_f8f6f4 %0, %1, %2, %0, %3, %4 op_sel_hi:[0,0,0]" : "+v"(acc[ai][bj][m][n]) : "v"(Bt[n]), "v"(At[m]), "v"(vsb), "v"(vsa)); __builtin_amdgcn_s_setprio(0); } while (0)
#define PG8_WAIT_V(n) asm volatile("s_waitcnt vmcnt(" #n ")" ::: "memory")
#define PG8_WAIT_L(n) asm volatile("s_waitcnt lgkmcnt(" #n ")" ::: "memory")
#define PG8_BAR __builtin_amdgcn_s_barrier()
#define PG8_SCHED __builtin_amdgcn_sched_barrier(0)
    Unit cur, nxt; int ui = 0;
    if (!S.next(0, cur)) return;
    f32x4 acc[2][2][4][2];
#pragma unroll
    for (int a = 0; a < 2; ++a)
#pragma unroll
        for (int b = 0; b < 2; ++b)
#pragma unroll
            for (int m = 0; m < 4; ++m)
#pragma unroll
                for (int n = 0; n < 2; ++n) acc[a][b][m][n] = (f32x4){0.f, 0.f, 0.f, 0.f};
    v8i At[4], B0[2], B1[2]; const int vsa = g.sa, vsb = g.sb;
    unsigned aoc[2][2], aon[2][2];
    const char* cA; const char* cB = (const char*)g.Bt + (size_t)cur.pn * tstep;
    if constexpr (GATHER) { cA = (const char*)g.A; S.rows(cur, RA[0], RA[1], aoc);
#pragma unroll
        for (int h = 0; h < 2; ++h)
#pragma unroll
            for (int i = 0; i < 2; ++i) aoc[h][i] += (unsigned)CA[i] * 2u; }
    else { cA = (const char*)g.A + (size_t)cur.pm * tstep;
#pragma unroll
        for (int i = 0; i < 2; ++i) { aoc[0][i] = 0u; aoc[1][i] = 0u; } }
    PG8_STAGE(PG8_SB(0, 0), cB, voffB); PG8_STAGE(PG8_SB(0, 1), cB + hstep, voffB); PG8_STAGE_A(PG8_SA(0, 0), cA, 0, aoc); PG8_STAGE_A(PG8_SA(0, 1), cA, 1, aoc);
    if (wr == 1) PG8_BAR;
    PG8_WAIT_V(2); PG8_BAR;
    PG8_STAGE(PG8_SB(1, 0), cB + kstep, voffB); PG8_STAGE_A(PG8_SA(1, 0), cA + kstep, 0, aoc); PG8_STAGE(PG8_SB(1, 1), cB + hstep + kstep, voffB);
    PG8_WAIT_V(6); PG8_BAR;
    for (;;) {
        const bool has_next = S.next(ui + 1, nxt);
        const char* nA; const char* nB = has_next ? (const char*)g.Bt + (size_t)nxt.pn * tstep : cB;
        if constexpr (GATHER) { nA = cA;
            if (has_next) { S.rows(nxt, RA[0], RA[1], aon);
#pragma unroll
                for (int h = 0; h < 2; ++h)
#pragma unroll
                    for (int i = 0; i < 2; ++i) aon[h][i] += (unsigned)CA[i] * 2u; }
            else {
#pragma unroll
                for (int h = 0; h < 2; ++h)
#pragma unroll
                    for (int i = 0; i < 2; ++i) aon[h][i] = aoc[h][i]; } }
        else { nA = has_next ? (const char*)g.A + (size_t)nxt.pm * tstep : cA;
#pragma unroll
            for (int h = 0; h < 2; ++h)
#pragma unroll
                for (int i = 0; i < 2; ++i) aon[h][i] = aoc[h][i]; }
#pragma nounroll
        for (int t = 0; t < nt; t += 2) {
            const bool last = (t == nt - 2);
            const char* a1 = cA + (size_t)(t + 1) * kstep;
            const char* a2 = last ? nA : cA + (size_t)(t + 2) * kstep; const char* b2 = last ? nB : cB + (size_t)(t + 2) * kstep;
            const char* a3 = a2 + kstep; const char* b3 = b2 + kstep;
            unsigned ao2[2][2];
#pragma unroll
            for (int h = 0; h < 2; ++h)
#pragma unroll
                for (int i = 0; i < 2; ++i) ao2[h][i] = (GATHER && last) ? aon[h][i] : aoc[h][i];
            PG8_LDB(B0, 0, 0); PG8_LDB(B1, 0, 1); PG8_SCHED; PG8_LDA(At, 0, 0); PG8_STAGE_A(PG8_SA(1, 1), a1, 1, aoc);
            PG8_WAIT_V(8); PG8_WAIT_L(0); PG8_BAR; PG8_MMA(0, 0, At, B0); PG8_MMA(0, 1, At, B1); PG8_BAR; PG8_SCHED;
            PG8_LDA(At, 0, 1); PG8_STAGE(PG8_SB(0, 0), b2, voffB); PG8_STAGE(PG8_SB(0, 1), b2 + hstep, voffB); PG8_STAGE_A(PG8_SA(0, 0), a2, 0, ao2);
            PG8_WAIT_V(8); PG8_WAIT_L(0); PG8_BAR; PG8_MMA(1, 0, At, B0); PG8_MMA(1, 1, At, B1); PG8_BAR; PG8_SCHED;
            PG8_LDB(B0, 1, 0); PG8_LDB(B1, 1, 1); PG8_SCHED; PG8_LDA(At, 1, 0); PG8_STAGE_A(PG8_SA(0, 1), a2, 1, ao2);
            PG8_WAIT_V(8); PG8_WAIT_L(0); PG8_BAR; PG8_MMA(0, 0, At, B0); PG8_MMA(0, 1, At, B1); PG8_BAR; PG8_SCHED;
            PG8_LDA(At, 1, 1); PG8_STAGE(PG8_SB(1, 0), b3, voffB); PG8_STAGE(PG8_SB(1, 1), b3 + hstep, voffB); PG8_STAGE_A(PG8_SA(1, 0), a3, 0, ao2);
            PG8_WAIT_V(8); PG8_WAIT_L(0); PG8_BAR; PG8_MMA(1, 0, At, B0); PG8_MMA(1, 1, At, B1); PG8_BAR; PG8_SCHED;
        }
        if (wr == 0) PG8_BAR;
        asm volatile("s_nop 15\n\ts_nop 15\n\ts_nop 15" ::: "memory");
        { const int t2 = opaque_tid(), w2 = __builtin_amdgcn_readfirstlane(t2 >> 6), l2 = t2 & 63;
          E(acc, cur, w2 >> 2, w2 & 3, l2 & 15, l2 >> 4); }
        if (!has_next) break;
#pragma unroll
        for (int a = 0; a < 2; ++a)
#pragma unroll
            for (int b = 0; b < 2; ++b)
#pragma unroll
                for (int m = 0; m < 4; ++m)
#pragma unroll
                    for (int n = 0; n < 2; ++n) acc[a][b][m][n] = (f32x4){0.f, 0.f, 0.f, 0.f};
        cur = nxt; cA = nA; cB = nB; ++ui;
#pragma unroll
        for (int h = 0; h < 2; ++h)
#pragma unroll
            for (int i = 0; i < 2; ++i) aoc[h][i] = aon[h][i];
        if (wr == 1) PG8_BAR;
    }
    PG8_WAIT_V(0);
    PG8_BAR;
#undef PG8_SA
#undef PG8_SB
#undef PG8_STAGE
#undef PG8_STAGE_A
#undef PG8_LDA
#undef PG8_LD32
#undef PG8_LDB
#undef PG8_MMA
#undef PG8_WAIT_V
#undef PG8_WAIT_L
#undef PG8_BAR
#undef PG8_SCHED
}

struct EpiBf16Skip {
    static constexpr bool PERM = true;
    bf16* O; int ldc, pn_skip, skip;
    __device__ __forceinline__ void operator()(const f32x4 (&acc)[2][2][4][2], const Unit& u, int wr, int wc, int fr, int fq) const {
        const int row0 = u.pm * BM + wr * 64 + fr, col0 = u.pn * BM + wc * 32 + 8 * fq + (u.pn >= pn_skip ? skip : 0);
#pragma unroll
        for (int ai = 0; ai < 2; ++ai)
#pragma unroll
            for (int m = 0; m < 4; ++m) { bf16* rowp = O + (size_t)(row0 + ai * HALF + m * 16) * ldc + col0;
#pragma unroll
                for (int bj = 0; bj < 2; ++bj) { const f32x4 v0 = acc[ai][bj][m][0], v1 = acc[ai][bj][m][1];
                    v4u w; w.x = cvt_pk_bf16(v0[0], v0[1]); w.y = cvt_pk_bf16(v0[2], v0[3]); w.z = cvt_pk_bf16(v1[0], v1[1]); w.w = cvt_pk_bf16(v1[2], v1[3]);
                    *(v4u*)(rowp + bj * HALF) = w; } }
    }
};
struct EpiFp8 {
    static constexpr bool PERM = true;
    unsigned char* O; int ldc;
    __device__ __forceinline__ void operator()(const f32x4 (&acc)[2][2][4][2], const Unit& u, int wr, int wc, int fr, int fq) const {
        const int row0 = u.pm * BM + wr * 64 + fr, col0 = u.pn * BM + wc * 32 + 8 * fq;
#pragma unroll
        for (int ai = 0; ai < 2; ++ai)
#pragma unroll
            for (int m = 0; m < 4; ++m) { unsigned char* rowp = O + (size_t)(row0 + ai * HALF + m * 16) * ldc + col0;
#pragma unroll
                for (int bj = 0; bj < 2; ++bj) { const f32x4 v0 = acc[ai][bj][m][0] * 8.0f, v1 = acc[ai][bj][m][1] * 8.0f;
                    v2u w; w.x = pk4_fp8(v0[0], v0[1], v0[2], v0[3]); w.y = pk4_fp8(v1[0], v1[1], v1[2], v1[3]);
                    *(v2u*)(rowp + bj * HALF) = w; } }
    }
};
struct EpiBf16 {
    static constexpr bool PERM = true;
    bf16* O; int ldc;
    __device__ __forceinline__ void operator()(const f32x4 (&acc)[2][2][4][2], const Unit& u, int wr, int wc, int fr, int fq) const {
        const int row0 = u.pm * BM + wr * 64 + fr, col0 = u.pn * BM + wc * 32 + 8 * fq;
#pragma unroll
        for (int ai = 0; ai < 2; ++ai)
#pragma unroll
            for (int m = 0; m < 4; ++m) { bf16* rowp = O + (size_t)(row0 + ai * HALF + m * 16) * ldc + col0;
#pragma unroll
                for (int bj = 0; bj < 2; ++bj) { const f32x4 v0 = acc[ai][bj][m][0], v1 = acc[ai][bj][m][1];
                    v4u w; w.x = cvt_pk_bf16(v0[0], v0[1]); w.y = cvt_pk_bf16(v0[2], v0[3]); w.z = cvt_pk_bf16(v1[0], v1[1]); w.w = cvt_pk_bf16(v1[2], v1[3]);
                    *(v4u*)(rowp + bj * HALF) = w; } }
    }
};
struct EpiF32 {
    static constexpr bool PERM = false;
    float* C; int ldc;
    __device__ __forceinline__ void operator()(const f32x4 (&acc)[2][2][4][2], const Unit& u, int wr, int wc, int fr, int fq) const {
        const int row0 = u.pm * BM + wr * 64 + fr, col0 = u.pn * BM + wc * 32 + 4 * fq;
#pragma unroll
        for (int ai = 0; ai < 2; ++ai)
#pragma unroll
            for (int m = 0; m < 4; ++m) { float* rowp = C + (size_t)(row0 + ai * HALF + m * 16) * ldc + col0;
#pragma unroll
                for (int bj = 0; bj < 2; ++bj)
#pragma unroll
                    for (int n = 0; n < 2; ++n) *(f32x4*)(rowp + bj * HALF + n * 16) = acc[ai][bj][m][n]; }
    }
};
struct EpiResF32 {
    static constexpr bool PERM = false;
    const float* base; float* out; int ldc;
    __device__ __forceinline__ void operator()(const f32x4 (&acc)[2][2][4][2], const Unit& u, int wr, int wc, int fr, int fq) const {
        const int row0 = u.pm * BM + wr * 64 + fr, col0 = u.pn * BM + wc * 32 + 4 * fq;
#pragma unroll
        for (int ai = 0; ai < 2; ++ai)
#pragma unroll
            for (int m = 0; m < 4; ++m) { const size_t off = (size_t)(row0 + ai * HALF + m * 16) * ldc + col0;
#pragma unroll
                for (int bj = 0; bj < 2; ++bj)
#pragma unroll
                    for (int n = 0; n < 2; ++n) { const f32x4 b = *(const f32x4*)(base + off + bj * HALF + n * 16); *(f32x4*)(out + off + bj * HALF + n * 16) = b + acc[ai][bj][m][n]; } }
    }
};
struct EpiResBf16P {
    static constexpr bool PERM = true;
    const float* base; bf16* out; int ldc;
    __device__ __forceinline__ void operator()(const f32x4 (&acc)[2][2][4][2], const Unit& u, int wr, int wc, int fr, int fq) const {
        const int row0 = u.pm * BM + wr * 64 + fr, col0 = u.pn * BM + wc * 32 + 8 * fq;
#pragma unroll
        for (int ai = 0; ai < 2; ++ai)
#pragma unroll
            for (int m = 0; m < 4; ++m) { const size_t off = (size_t)(row0 + ai * HALF + m * 16) * ldc + col0;
#pragma unroll
                for (int bj = 0; bj < 2; ++bj) { const f32x4 v0 = *(const f32x4*)(base + off + bj * HALF) + acc[ai][bj][m][0], v1 = *(const f32x4*)(base + off + bj * HALF + 4) + acc[ai][bj][m][1];
                    v4u w; w.x = cvt_pk_bf16(v0[0], v0[1]); w.y = cvt_pk_bf16(v0[2], v0[3]); w.z = cvt_pk_bf16(v1[0], v1[1]); w.w = cvt_pk_bf16(v1[2], v1[3]);
                    *(v4u*)(out + off + bj * HALF) = w; } }
    }
};
struct EpiResF32P {
    static constexpr bool PERM = true;
    const float* base; float* out; int ldc;
    __device__ __forceinline__ void operator()(const f32x4 (&acc)[2][2][4][2], const Unit& u, int wr, int wc, int fr, int fq) const {
        const int row0 = u.pm * BM + wr * 64 + fr, col0 = u.pn * BM + wc * 32 + 8 * fq;
#pragma unroll
        for (int ai = 0; ai < 2; ++ai)
#pragma unroll
            for (int m = 0; m < 4; ++m) { const size_t off = (size_t)(row0 + ai * HALF + m * 16) * ldc + col0;
#pragma unroll
                for (int bj = 0; bj < 2; ++bj)
#pragma unroll
                    for (int n = 0; n < 2; ++n) { const f32x4 b = *(const f32x4*)(base + off + bj * HALF + n * 4); *(f32x4*)(out + off + bj * HALF + n * 4) = b + acc[ai][bj][m][n]; } }
    }
};
struct EpiGateMix {
    static constexpr bool PERM = true;
    const unsigned char* YA; const unsigned char* YB; unsigned char* U; const float* bias;
    __device__ __forceinline__ void operator()(const f32x4 (&acc)[2][2][4][2], const Unit& u, int wr, int wc, int fr, int fq) const {
        const int row0 = u.pm * BM + wr * 64 + fr, col0 = u.pn * HALF + wc * 32 + 8 * fq;
        const f32x4 ba0 = *(const f32x4*)(bias + col0), ba1 = *(const f32x4*)(bias + col0 + 4), bb0 = *(const f32x4*)(bias + D + col0), bb1 = *(const f32x4*)(bias + D + col0 + 4);
#pragma unroll
        for (int ai = 0; ai < 2; ++ai)
#pragma unroll
            for (int m = 0; m < 4; ++m) { const size_t off = (size_t)(row0 + ai * HALF + m * 16) * D + col0;
                const v2u ya = *(const v2u*)(YA + off), yb = *(const v2u*)(YB + off);
                const f32x4 a0 = acc[ai][0][m][0] + ba0, a1 = acc[ai][0][m][1] + ba1, b0 = acc[ai][1][m][0] + bb0, b1 = acc[ai][1][m][1] + bb1;
                float o[8];
                float va[8], vb[8];
                { const auto p0 = __builtin_amdgcn_cvt_pk_f32_fp8((int)ya.x, false), p1 = __builtin_amdgcn_cvt_pk_f32_fp8((int)ya.x, true), p2 = __builtin_amdgcn_cvt_pk_f32_fp8((int)ya.y, false), p3 = __builtin_amdgcn_cvt_pk_f32_fp8((int)ya.y, true);
                  va[0] = p0[0]; va[1] = p0[1]; va[2] = p1[0]; va[3] = p1[1]; va[4] = p2[0]; va[5] = p2[1]; va[6] = p3[0]; va[7] = p3[1]; }
                { const auto p0 = __builtin_amdgcn_cvt_pk_f32_fp8((int)yb.x, false), p1 = __builtin_amdgcn_cvt_pk_f32_fp8((int)yb.x, true), p2 = __builtin_amdgcn_cvt_pk_f32_fp8((int)yb.y, false), p3 = __builtin_amdgcn_cvt_pk_f32_fp8((int)yb.y, true);
                  vb[0] = p0[0]; vb[1] = p0[1]; vb[2] = p1[0]; vb[3] = p1[1]; vb[4] = p2[0]; vb[5] = p2[1]; vb[6] = p3[0]; vb[7] = p3[1]; }
#pragma unroll
                for (int j = 0; j < 8; ++j) { const float ga = sigmoidf_(j < 4 ? a0[j & 3] : a1[j & 3]), gb = sigmoidf_(j < 4 ? b0[j & 3] : b1[j & 3]);
                    o[j] = ga * va[j] + gb * vb[j]; }
                v2u w; w.x = pk4_fp8(o[0], o[1], o[2], o[3]); w.y = pk4_fp8(o[4], o[5], o[6], o[7]);
                *(v2u*)(U + off) = w;
                asm volatile("" ::: "memory"); }
    }
};
struct EpiPleFinal {
    static constexpr bool PERM = true;
    const bf16* x2; const bf16* P; float* out; const float* bias;
    __device__ __forceinline__ void operator()(const f32x4 (&acc)[2][2][4][2], const Unit& u, int wr, int wc, int fr, int fq) const {
        const int row0 = u.pm * BM + wr * 64 + fr, col0 = u.pn * BM + wc * 32 + 8 * fq;
#pragma unroll
        for (int bj = 0; bj < 2; ++bj) { const f32x4 bv0 = *(const f32x4*)(bias + col0 + bj * HALF), bv1 = *(const f32x4*)(bias + col0 + bj * HALF + 4);
#pragma unroll
            for (int ai = 0; ai < 2; ++ai)
#pragma unroll
                for (int m = 0; m < 4; ++m) { const size_t off = (size_t)(row0 + ai * HALF + m * 16) * D + col0 + bj * HALF;
                    const v4u pw = *(const v4u*)(P + off), xw = *(const v4u*)(x2 + off);
                    const f32x4 x0 = {bflo(xw.x), bfhi(xw.x), bflo(xw.y), bfhi(xw.y)}, x1 = {bflo(xw.z), bfhi(xw.z), bflo(xw.w), bfhi(xw.w)};
                    const f32x4 a0 = acc[ai][bj][m][0] + bv0, a1 = acc[ai][bj][m][1] + bv1;
                    f32x4 o0, o1;
                    o0[0] = x0[0] + sigmoidf_(a0[0]) * bflo(pw.x); o0[1] = x0[1] + sigmoidf_(a0[1]) * bfhi(pw.x); o0[2] = x0[2] + sigmoidf_(a0[2]) * bflo(pw.y); o0[3] = x0[3] + sigmoidf_(a0[3]) * bfhi(pw.y);
                    o1[0] = x1[0] + sigmoidf_(a1[0]) * bflo(pw.z); o1[1] = x1[1] + sigmoidf_(a1[1]) * bfhi(pw.z); o1[2] = x1[2] + sigmoidf_(a1[2]) * bflo(pw.w); o1[3] = x1[3] + sigmoidf_(a1[3]) * bfhi(pw.w);
                    *(f32x4*)(out + off) = o0; *(f32x4*)(out + off + 4) = o1; } }
    }
};

struct PleOrder {
    int G, c;
    __device__ __forceinline__ bool next(int i, Unit& u) const {
        int L;
        if (G == 256) { if (c >= 128) { if (i >= 6) return false; L = (c - 128) * 6 + i; } else { if (i >= 2) return false; L = 768 + c * 2 + i; } }
        else { L = i * G + c; if (L >= 1024) return false; }
        u.pm = L >> 3; u.pn = L & 7; u.e = 0; u.mt = 0; return true;
    }
    __device__ __forceinline__ void rows(const Unit&, int, int, unsigned (&)[2][2]) const {}
};
struct MoeOrder {
    const LAS int* pref;
    const LAS int* cntl;
    const int* tokrow; int NT, G, c, K;
    __device__ __forceinline__ bool next(int i, Unit& u) const {
        const int L = i * G + c; if (L >= pref[64] * NT) return false;
        const int tt = L / NT, pnl = L - tt * NT; int lo = 0, hi = 64;
        while (hi - lo > 1) { const int mid = (lo + hi) >> 1; if (pref[mid] <= tt) lo = mid; else hi = mid; }
        u.e = lo; u.mt = tt - pref[lo]; u.pm = tt; u.pn = lo * NT + pnl; return true;
    }
    __device__ __forceinline__ void rows(const Unit& u, int R0, int R1, unsigned (&off)[2][2]) const {
        const int n = cntl[u.e];
#pragma unroll
        for (int h = 0; h < 2; ++h)
#pragma unroll
            for (int i = 0; i < 2; ++i) { const int j = u.mt * 256 + h * 128 + (i ? R1 : R0);
                const int tk = (j < n) ? (tokrow[(size_t)u.e * ECAP + j] >> 1) : 0; off[h][i] = (unsigned)tk * (unsigned)(K * 2); }
    }
};
struct EpiMoe1 {
    static constexpr bool PERM = true;
    unsigned char* ACT;
    __device__ __forceinline__ void operator()(const f32x4 (&acc)[2][2][4][2], const Unit& u, int wr, int wc, int fr, int fq) const {
        const int row0 = u.pm * BM + wr * 64 + fr, col0 = (u.pn & 3) * HALF + wc * 32 + 8 * fq;
#pragma unroll
        for (int ai = 0; ai < 2; ++ai)
#pragma unroll
            for (int m = 0; m < 4; ++m) { float o[8];
#pragma unroll
                for (int j = 0; j < 8; ++j) { const float g = acc[ai][0][m][j >> 2][j & 3], up = acc[ai][1][m][j >> 2][j & 3]; o[j] = 4.0f * g * sigmoidf_(g) * up; }
                v2u w; w.x = pk4_fp8(o[0], o[1], o[2], o[3]); w.y = pk4_fp8(o[4], o[5], o[6], o[7]);
                *(v2u*)(ACT + (size_t)(row0 + ai * HALF + m * 16) * EFF + col0) = w; }
    }
};
struct EpiMoe2 {
    static constexpr bool PERM = true;
    bf16* Y0; long long ydelta; const int* tokrow; const float* tokw; const LAS int* cntl;
    __device__ __forceinline__ void operator()(const f32x4 (&acc)[2][2][4][2], const Unit& u, int wr, int wc, int fr, int fq) const {
        const int n = cntl[u.e], col0 = (u.pn & 7) * BM + wc * 32 + 8 * fq;
#pragma unroll
        for (int ai = 0; ai < 2; ++ai)
#pragma unroll
            for (int m = 0; m < 4; ++m) { const int j = u.mt * 256 + ai * HALF + wr * 64 + m * 16 + fr;
                if (j < n) { const int info = tokrow[(size_t)u.e * ECAP + j]; const float wt = tokw[(size_t)u.e * ECAP + j];
                    bf16* rowp = Y0 + (long long)(info & 1) * ydelta + (size_t)(info >> 1) * D + col0;
#pragma unroll
                    for (int bj = 0; bj < 2; ++bj) { const f32x4 v0 = acc[ai][bj][m][0] * wt, v1 = acc[ai][bj][m][1] * wt;
                        v4u w; w.x = cvt_pk_bf16(v0[0], v0[1]); w.y = cvt_pk_bf16(v0[2], v0[3]); w.z = cvt_pk_bf16(v1[0], v1[1]); w.w = cvt_pk_bf16(v1[2], v1[3]);
                        *(v4u*)(rowp + bj * HALF) = w; } } }
    }
};
}


#define MFMA32(a, b, c) __builtin_amdgcn_mfma_f32_32x32x16_bf16((a), (b), (c), 0, 0, 0)
__device__ __forceinline__ int crow(int r, int hi) { return (r & 3) + 8 * (r >> 2) + 4 * hi; }

constexpr int GLA_Q_OFF = 0, GLA_K_OFF = 65536, GLA_GLR_OFF = 132096;
__device__ __forceinline__ void gla_prep_task(LAS unsigned char* lds, bf16* Z, const float* w_alpha, const float* b_alpha, float* DEC, int task) {
    const int tid = opaque_tid(); const size_t t0 = (size_t)task * 64;
    LAS float* glr = (LAS float*)(lds + GLA_GLR_OFF);
    LAS unsigned short* qt = (LAS unsigned short*)(lds + GLA_Q_OFF); LAS unsigned short* kt = (LAS unsigned short*)(lds + GLA_K_OFF);
    __syncthreads();
#pragma unroll
    for (int i = 0; i < 8; ++i) { const int ch = tid + 512 * i, row = ch >> 6, c8 = (ch & 63) * 8;
        *(LAS v4u*)(qt + row * 512 + c8) = *(const GAS v4u*)(Z + (t0 + row) * ZP + ZC_GQ + c8);
        *(LAS v4u*)(kt + row * 512 + c8) = *(const GAS v4u*)(Z + (t0 + row) * ZP + ZC_GK + c8); }
    for (int i = tid; i < 1024; i += 512) glr[i] = bf2f(Z[(t0 + (i >> 4)) * ZP + ZC_GLR + (i & 15)]);
    float w[16];
#pragma unroll
    for (int i = 0; i < 16; ++i) w[i] = w_alpha[i * 512 + tid];
    const float bb = b_alpha[tid];
    __syncthreads();
    float G = 0.f;
#pragma unroll 4
    for (int r = 0; r < 64; ++r) {
        float pre = bb;
#pragma unroll
        for (int i = 0; i < 16; ++i) pre = fmaf(glr[r * 16 + i], w[i], pre);
        const float ls = fminf(pre, 0.f) - log1pf(__expf(-fabsf(pre)));
        G += ls * (1.0f / 16.0f);
        const float Gc = fmaxf(G, -80.f);
        const float eq = __expf(Gc), ek = __expf(-Gc);
        const float qv = bf2f(qt[r * 512 + tid]), kv = bf2f(kt[r * 512 + tid]);
        qt[r * 512 + tid] = (unsigned short)f2bf(qv * 0.125f * eq);
        kt[r * 512 + tid] = (unsigned short)f2bf(kv * ek);
    }
    DEC[(size_t)task * 512 + tid] = __expf(fmaxf(G, -80.f));
    __syncthreads();
#pragma unroll
    for (int i = 0; i < 8; ++i) { const int ch = tid + 512 * i, row = ch >> 6, c8 = (ch & 63) * 8;
        *(GAS v4u*)(Z + (t0 + row) * ZP + ZC_GQ + c8) = *(const LAS v4u*)(qt + row * 512 + c8);
        *(GAS v4u*)(Z + (t0 + row) * ZP + ZC_GK + c8) = *(const LAS v4u*)(kt + row * 512 + c8); }
    LDS_WAIT(); VM_WAIT(); __syncthreads();
}
__device__ __forceinline__ void dsa_prep_row(int lane, bf16* Z, size_t m, const float* qg, const float* kg, bf16* IKC, float* UW) {
#pragma unroll
    for (int which = 0; which < 2; ++which) {
        bf16* p = Z + m * ZP + (which ? ZC_DK : ZC_DQ) + lane * 16;
        const v4u a = *(const v4u*)p, b = *(const v4u*)(p + 8);
        float v[16]; const unsigned ww[8] = {a.x, a.y, a.z, a.w, b.x, b.y, b.z, b.w};
        float ss = 0.f;
#pragma unroll
        for (int i = 0; i < 8; ++i) { v[2 * i] = bflo(ww[i]); v[2 * i + 1] = bfhi(ww[i]); ss += v[2 * i] * v[2 * i] + v[2 * i + 1] * v[2 * i + 1]; }
        ss = sum8(ss);
        const float rstd = (1.0f / sqrtf(ss * (1.0f / 128.f) + EPS)) * (which ? 1.0f : 0.08838834764831845f * 1.4426950408889634f);
        const float* g = (which ? kg : qg) + (lane & 7) * 16;
        v4u o0, o1;
        o0.x = pk2(v[0] * rstd * g[0], v[1] * rstd * g[1]); o0.y = pk2(v[2] * rstd * g[2], v[3] * rstd * g[3]); o0.z = pk2(v[4] * rstd * g[4], v[5] * rstd * g[5]); o0.w = pk2(v[6] * rstd * g[6], v[7] * rstd * g[7]);
        o1.x = pk2(v[8] * rstd * g[8], v[9] * rstd * g[9]); o1.y = pk2(v[10] * rstd * g[10], v[11] * rstd * g[11]); o1.z = pk2(v[12] * rstd * g[12], v[13] * rstd * g[13]); o1.w = pk2(v[14] * rstd * g[14], v[15] * rstd * g[15]);
        *(v4u*)p = o0; *(v4u*)(p + 8) = o1;
    }
    if (lane < 8) *(v4u*)(IKC + m * 64 + lane * 8) = *(const v4u*)(Z + m * ZP + ZC_IK + lane * 8);
    if (lane < 16) UW[m * 16 + lane] = bf2f(Z[m * ZP + ZC_IW + lane]) * (0.5f / 32.0f);
}
#define FRAG_NAT(dst, tile, s, hg, col) do { _Pragma("unroll") for (int j_ = 0; j_ < 8; ++j_) dst[j_] = (short)(tile)[(16 * (s) + 8 * (hg) + j_) * 64 + (col)]; } while (0)
__device__ __forceinline__ void gla_local_unit(LAS unsigned char* lds, int wave, int lane, const bf16* Z, const float* DEC, float* SLOC, int u) {
    const int h = u & 7; const size_t t0 = (size_t)(u >> 3) * 64; const int r = lane & 31, hg = lane >> 5;
    const LAS unsigned short* kt = (const LAS unsigned short*)(lds + GLA_K_OFF) + h * 64;
    LAS unsigned short* vt = (LAS unsigned short*)(lds + GLA_Q_OFF + wave * 8192);
    const float d0 = DEC[(size_t)u * 64 + r], d1 = DEC[(size_t)u * 64 + 32 + r];
    bf16x8 Bk[2][4];
#pragma unroll
    for (int nt = 0; nt < 2; ++nt)
#pragma unroll
        for (int s = 0; s < 4; ++s) {
#pragma unroll
            for (int j = 0; j < 8; ++j) Bk[nt][s][j] = (short)kt[(16 * s + 8 * hg + j) * 512 + 32 * nt + r]; }
#pragma unroll 1
    for (int half = 0; half < 2; ++half) {
        LDS_WAIT();
#pragma unroll
        for (int i = 0; i < 8; ++i) { const int row = i * 8 + (lane >> 3), ch = lane & 7;
            *(LAS v4u*)(vt + row * 64 + ch * 8) = *(const v4u*)(Z + (t0 + row) * ZP + ZC_GV + h * 128 + half * 64 + ch * 8); }
        LDS_WAIT();
        f32x16 acc[2][2];
#pragma unroll
        for (int a = 0; a < 2; ++a)
#pragma unroll
            for (int b = 0; b < 2; ++b)
#pragma unroll
                for (int i = 0; i < 16; ++i) acc[a][b][i] = 0.f;
#pragma unroll
        for (int mt = 0; mt < 2; ++mt)
#pragma unroll
            for (int s = 0; s < 4; ++s) { bf16x8 Av; FRAG_NAT(Av, vt, s, hg, 32 * mt + r);
                acc[mt][0] = MFMA32(Av, Bk[0][s], acc[mt][0]); acc[mt][1] = MFMA32(Av, Bk[1][s], acc[mt][1]); }
        unsigned short* out = (unsigned short*)SLOC + (size_t)u * 8192;
#pragma unroll
        for (int mt = 0; mt < 2; ++mt)
#pragma unroll
            for (int i = 0; i < 16; ++i) { const int dv = half * 64 + 32 * mt + crow(i, hg);
                out[dv * 64 + r] = (unsigned short)f2bf(acc[mt][0][i] * d0); out[dv * 64 + 32 + r] = (unsigned short)f2bf(acc[mt][1][i] * d1); }
    }
}
__device__ __forceinline__ void gla_scan(const float* SLOC, const float* DEC, bf16* STT, int gt, int ngt) {
    for (int p = gt; p < 32 * 4096; p += ngt) {
        const int bh = p >> 12, ev = (p & 4095) * 2, b = bh >> 3, h = bh & 7, k = ev & 63;
        float s0 = 0.f, s1 = 0.f;
#pragma unroll 8
        for (int c = 0; c < 128; ++c) {
            const size_t u = ((size_t)(b * 128 + c) * 8 + h);
            const unsigned slw = *(const unsigned*)((const unsigned short*)SLOC + u * 8192 + ev); float2 sl; sl.x = bflo(slw); sl.y = bfhi(slw); const float2 dc = *(const float2*)(DEC + u * 64 + k);
            *(unsigned*)(STT + u * 8192 + ev) = pk2(s0, s1);
            s0 = fmaf(s0, dc.x, sl.x); s1 = fmaf(s1, dc.y, sl.y);
        }
    }
}
__device__ __forceinline__ void gla_out_unit(LAS unsigned char* wl, int lane, const bf16* Z, const bf16* STT, const float* gn, bf16* OA, int u) {
    const int h = u & 7; const size_t t0 = (size_t)(u >> 3) * 64; const int r = lane & 31, hg = lane >> 5;
    LAS unsigned short* vt = (LAS unsigned short*)wl;
    LDS_WAIT();
#pragma unroll
    for (int i = 0; i < 16; ++i) { const int row = i * 4 + (lane >> 4), ch = lane & 15;
        *(LAS v4u*)(vt + row * 128 + ch * 8) = *(const v4u*)(Z + (t0 + row) * ZP + ZC_GV + h * 128 + ch * 8); }
    bf16x8 Fq[2][4], Fk[2][4];
#pragma unroll
    for (int t = 0; t < 2; ++t)
#pragma unroll
        for (int s = 0; s < 4; ++s) {
            Fq[t][s] = *(const bf16x8*)(Z + (t0 + 32 * t + r) * ZP + ZC_GQ + h * 64 + 16 * s + 8 * hg);
            Fk[t][s] = *(const bf16x8*)(Z + (t0 + 32 * t + r) * ZP + ZC_GK + h * 64 + 16 * s + 8 * hg); }
    const bf16* st = STT + (size_t)u * 8192;
    LDS_WAIT();
#pragma unroll 1
    for (int it = 0; it < 2; ++it) {
        f32x16 o[4];
#pragma unroll
        for (int d = 0; d < 4; ++d)
#pragma unroll
            for (int i = 0; i < 16; ++i) o[d][i] = 0.f;
#pragma unroll
        for (int d = 0; d < 4; ++d)
#pragma unroll
            for (int s = 0; s < 4; ++s) { const bf16x8 Bs = *(const bf16x8*)(st + (32 * d + r) * 64 + 16 * s + 8 * hg); o[d] = MFMA32(Fq[it][s], Bs, o[d]); }
#pragma unroll
        for (int jt = 0; jt < 2; ++jt) {
            if (jt <= it) {
                f32x16 X;
#pragma unroll
                for (int i = 0; i < 16; ++i) X[i] = 0.f;
#pragma unroll
                for (int s = 0; s < 4; ++s) X = MFMA32(Fk[jt][s], Fq[it][s], X);
                asm volatile("s_nop 15\n\ts_nop 7" : "+v"(X));
                if (jt == it) {
#pragma unroll
                    for (int i = 0; i < 16; ++i) if (crow(i, hg) > r) X[i] = 0.f;
                }
#pragma unroll
                for (int s2 = 0; s2 < 2; ++s2) {
                    v4u pw; pw.x = cvt_pk_bf16(X[8 * s2 + 0], X[8 * s2 + 1]); pw.y = cvt_pk_bf16(X[8 * s2 + 2], X[8 * s2 + 3]); pw.z = cvt_pk_bf16(X[8 * s2 + 4], X[8 * s2 + 5]); pw.w = cvt_pk_bf16(X[8 * s2 + 6], X[8 * s2 + 7]);
                    const bf16x8 pa = __builtin_bit_cast(bf16x8, pw);
#pragma unroll
                    for (int d = 0; d < 4; ++d) { bf16x8 Bv;
#pragma unroll
                        for (int j = 0; j < 8; ++j) Bv[j] = (short)vt[(32 * jt + 16 * s2 + 8 * (j >> 2) + 4 * hg + (j & 3)) * 128 + 32 * d + r];
                        o[d] = MFMA32(pa, Bv, o[d]); }
                }
            }
        }
        float g4[4];
#pragma unroll
        for (int d = 0; d < 4; ++d) g4[d] = gn[32 * d + r];
#pragma unroll
        for (int i = 0; i < 16; ++i) {
            float ss = o[0][i] * o[0][i] + o[1][i] * o[1][i] + o[2][i] * o[2][i] + o[3][i] * o[3][i];
            ss = sum32(ss);
            const float rstd = 1.0f / sqrtf(ss * (1.0f / 128.f) + EPS);
            const size_t tok = t0 + 32 * it + crow(i, hg);
#pragma unroll
            for (int d = 0; d < 4; ++d) { const float gr = bf2f(Z[tok * ZP + ZC_GR + h * 128 + 32 * d + r]);
                const float val = o[d][i] * rstd * g4[d] * (gr * sigmoidf_(gr));
                OA[tok * 1024 + h * 128 + 32 * d + r] = (bf16)f2bf(val); }
        }
    }
}


__device__ __forceinline__ size_t sc_off(int b, int c) { return (size_t)b * SC_PER_BATCH + (size_t)4096 * ((size_t)c * (c + 1) / 2); }
__device__ __forceinline__ unsigned score_code(float sc) {
    const _Float16 hf = (_Float16)sc; const unsigned bits = (unsigned)__builtin_bit_cast(unsigned short, hf);
    return (bits & 0x8000u) ? (~bits & 0xffffu) : (bits | 0x8000u);
}
__device__ __forceinline__ void idx_scores_oct(LAS unsigned char* wl, int lane, const bf16* Z, const bf16* IKC, const float* UW, unsigned short* SC, int b, int c, int oct) {
    const int r = lane & 31, hg = lane >> 5, n = 64 * (c + 1);
    const size_t t0 = (size_t)b * SEQ + (size_t)c * 64 + 8 * oct;
    bf16x8 A[4][4];
    { const int q = (r >> 2) & 1, head = (r & 3) + 4 * (r >> 3);
#pragma unroll
      for (int a = 0; a < 4; ++a)
#pragma unroll
        for (int s = 0; s < 4; ++s) A[a][s] = *(const bf16x8*)(Z + (t0 + 2 * a + q) * ZP + ZC_IQ + head * 64 + 16 * s + 8 * hg); }
    LAS float* ul = (LAS float*)wl;
    LDS_WAIT();
    ul[lane] = UW[t0 * 16 + lane]; ul[64 + lane] = UW[t0 * 16 + 64 + lane];
    LDS_WAIT();
    GAS unsigned short* row0 = (GAS unsigned short*)SC + sc_off(b, c) + (size_t)(8 * oct + hg) * n;
    const GAS bf16* kb = (const GAS bf16*)IKC + ((size_t)b * SEQ + r) * 64 + 8 * hg;
    const int npair = n / 64;
#define IDX_LOADB(dst, kt_) do { _Pragma("unroll") for (int t = 0; t < 2; ++t) _Pragma("unroll") for (int s = 0; s < 4; ++s) dst[t][s] = *(const GAS bf16x8*)(kb + (size_t)((kt_) + t) * 32 * 64 + 16 * s); } while (0)
#define IDX_STEP(Bc, kt_) do { _Pragma("unroll") for (int a = 0; a < 4; ++a) { \
            f32x2 u2[8]; \
            _Pragma("unroll") for (int i = 0; i < 4; ++i) { const f32x4 t4 = *(const LAS f32x4*)(ul + (2 * a + hg) * 16 + 4 * i); u2[2 * i] = (f32x2){t4.x, t4.y}; u2[2 * i + 1] = (f32x2){t4.z, t4.w}; } \
            f32x16 acc0, acc1; \
            _Pragma("unroll") for (int i = 0; i < 16; ++i) { acc0[i] = 0.f; acc1[i] = 0.f; } \
            _Pragma("unroll") for (int s = 0; s < 4; ++s) { acc0 = MFMA32(A[a][s], Bc[0][s], acc0); acc1 = MFMA32(A[a][s], Bc[1][s], acc1); } \
            f32x2 l0 = {0.f, 0.f}, l1 = {0.f, 0.f}; \
            _Pragma("unroll") for (int j = 0; j < 8; ++j) { l0 = (f32x2){acc0[2 * j], acc0[2 * j + 1]} * u2[j] + l0; l1 = (f32x2){acc1[2 * j], acc1[2 * j + 1]} * u2[j] + l1; } \
            float s0 = l0.x + l0.y, s1 = l1.x + l1.y; \
            _Pragma("unroll") for (int j = 0; j < 8; ++j) { \
                asm("v_fma_f32 %0, |%1|, %2, %0" : "+v"(s0) : "v"(acc0[2 * j]), "v"(u2[j].x)); asm("v_fma_f32 %0, |%1|, %2, %0" : "+v"(s1) : "v"(acc1[2 * j]), "v"(u2[j].x)); \
                asm("v_fma_f32 %0, |%1|, %2, %0" : "+v"(s0) : "v"(acc0[2 * j + 1]), "v"(u2[j].y)); asm("v_fma_f32 %0, |%1|, %2, %0" : "+v"(s1) : "v"(acc1[2 * j + 1]), "v"(u2[j].y)); } \
            const unsigned c0 = score_code(s0), c1 = score_code(s1); \
            const unsigned pa = (unsigned)DPP_I(c0, DPP_X1), pb = (unsigned)DPP_I(c1, DPP_X1); \
            GAS unsigned short* row = row0 + (size_t)(2 * a) * n; \
            if ((r & 1) == 0) *(GAS unsigned*)(row + (kt_) * 32 + r) = c0 | (pa << 16); \
            else *(GAS unsigned*)(row + ((kt_) + 1) * 32 + r - 1) = pb | (c1 << 16); \
            } } while (0)
    bf16x8 B0[2][4], B1[2][4];
    IDX_LOADB(B0, 0);
#pragma unroll 1
    for (int p = 0; p < npair; p += 2) {
        if (p + 1 < npair) IDX_LOADB(B1, 2 * (p + 1));
        IDX_STEP(B0, 2 * p);
        if (p + 1 < npair) {
            if (p + 2 < npair) IDX_LOADB(B0, 2 * (p + 2));
            IDX_STEP(B1, 2 * (p + 1));
        }
    }
#undef IDX_LOADB
#undef IDX_STEP
}
__device__ __forceinline__ void idx_select_row(int lane, const unsigned short* row, int n, LAS unsigned char* bmrow, LAS unsigned* bins  ) {
    const int nch = n / 8;
    if (n <= 256) {
#pragma unroll
        for (int s = 0; s < 16; ++s) { const int j = lane + 64 * s; bmrow[j] = (j < nch) ? 0xffu : 0u; }
        return;
    }
    v4u cw[16];
#pragma unroll
    for (int s = 0; s < 16; ++s) { const int j = lane + 64 * s; const unsigned m = (unsigned)((j - nch) >> 31);
        const int jc = j < nch ? j : nch - 1; const v4u t = *(const v4u*)(row + (size_t)jc * 8); cw[s] = (v4u){t.x & m, t.y & m, t.z & m, t.w & m}; }
    const int ns = (nch + 63) / 64;
#define WSCAN(v) do { _Pragma("unroll") for (int o_ = 1; o_ < 64; o_ <<= 1) { const int t_ = __builtin_amdgcn_ds_bpermute((lane - o_) << 2, (v)); if (lane >= o_) (v) += t_; } } while (0)
#pragma unroll
    for (int i = 0; i < 8; ++i) *(LAS v4u*)(bins + (i * 64 + lane) * 4) = (v4u){0u, 0u, 0u, 0u};
    LDS_WAIT();
#pragma unroll
    for (int s = 0; s < 16; ++s) if (s < ns) {
#pragma unroll
        for (int e = 0; e < 4; ++e) { const unsigned w = cw[s][e];
            __hip_atomic_fetch_add(bins + ((w & 0xffffu) >> 5), 1u, __ATOMIC_RELAXED, __HIP_MEMORY_SCOPE_WORKGROUP);
            __hip_atomic_fetch_add(bins + (w >> 21), 1u, __ATOMIC_RELAXED, __HIP_MEMORY_SCOPE_WORKGROUP); } }
    LDS_WAIT();
    int B, above;
    { unsigned bv[32]; int sl = 0;
#pragma unroll
      for (int i = 0; i < 8; ++i) { const v4u t = *(const LAS v4u*)(bins + lane * 32 + 4 * i); bv[4 * i] = t.x; bv[4 * i + 1] = t.y; bv[4 * i + 2] = t.z; bv[4 * i + 3] = t.w; sl += (int)(t.x + t.y + t.z + t.w); }
      int incl = sl; WSCAN(incl);
      const int tot = __builtin_amdgcn_readlane(incl, 63);
      int run = tot - incl;
      const bool mine = run < 256 && run + sl >= 256;
      int bl = 0, al = 0; bool found = false;
#pragma unroll
      for (int k = 31; k >= 0; --k) { const int cbin = (int)bv[k]; if (!found && run + cbin >= 256) { bl = 32 * lane + k; al = run; found = true; } run += cbin; }
      const unsigned long long mk = __builtin_amdgcn_ballot_w64(mine); const int src = (int)__builtin_ctzll(mk);
      B = __builtin_amdgcn_readlane(bl, src); above = __builtin_amdgcn_readlane(al, src); }
    LDS_WAIT();
    if (lane < 8) *(LAS v4u*)(bins + lane * 4) = (v4u){0u, 0u, 0u, 0u};
    LDS_WAIT();
#pragma unroll
    for (int s = 0; s < 16; ++s) if (s < ns) {
#pragma unroll
        for (int e = 0; e < 4; ++e) { const unsigned w = cw[s][e]; const unsigned lo = w & 0xffffu, hi = w >> 16;
            if ((int)(lo >> 5) == B) __hip_atomic_fetch_add(bins + (lo & 31u), 1u, __ATOMIC_RELAXED, __HIP_MEMORY_SCOPE_WORKGROUP);
            if ((int)(hi >> 5) == B) __hip_atomic_fetch_add(bins + (hi & 31u), 1u, __ATOMIC_RELAXED, __HIP_MEMORY_SCOPE_WORKGROUP); } }
    LDS_WAIT();
    unsigned thr; int cgt, ceq;
    { const int cl = lane < 32 ? (int)bins[lane] : 0; int incl = cl; WSCAN(incl);
      const int tot = __builtin_amdgcn_readlane(incl, 63);
      const int run = above + tot - incl;
      const bool mine = lane < 32 && run < 256 && run + cl >= 256;
      const unsigned long long mk = __builtin_amdgcn_ballot_w64(mine); const int src = (int)__builtin_ctzll(mk);
      thr = ((unsigned)B << 5) | (unsigned)src; cgt = __builtin_amdgcn_readlane(run, src); ceq = __builtin_amdgcn_readlane(cl, src); }
    LDS_WAIT();
#undef WSCAN
    const int need = 256 - cgt;
    const bool fast = (ceq == need);
    int run = 0;
#pragma unroll
    for (int s = 0; s < 16; ++s) {
        const int j = lane + 64 * s;
        unsigned gm = 0u, tm = 0u;
        if (s < ns) {
#pragma unroll
            for (int e = 0; e < 4; ++e) { const unsigned w = cw[s][e]; const unsigned lo = w & 0xffffu, hi = w >> 16;
                gm |= ((thr - lo) >> 31) << (2 * e); gm |= ((thr - hi) >> 31) << (2 * e + 1);
                tm |= (((lo ^ thr) - 1u) >> 31) << (2 * e); tm |= (((hi ^ thr) - 1u) >> 31) << (2 * e + 1); }
            if (fast) gm |= tm;
            else {
                const int tc = __builtin_popcount(tm); int incl = tc;
#pragma unroll
                for (int o = 1; o < 64; o <<= 1) { const int t = __builtin_amdgcn_ds_bpermute((lane - o) << 2, incl); if (lane >= o) incl += t; }
                int rank = run + incl - tc;
#pragma unroll
                for (int e = 0; e < 8; ++e) if ((tm >> e) & 1u) { if (rank < need) gm |= 1u << e; ++rank; }
                run += __builtin_amdgcn_readlane(incl, 63);
            }
        }
        bmrow[j] = (unsigned char)gm;
    }
}


__device__ __forceinline__ void bt_emit_tile(int lane, const LAS unsigned char* rows, unsigned* BT, int b, int c, int tile, bool zero) {
    unsigned long long w = 0ull;
    if (!zero) w = *(const LAS unsigned long long*)(rows + lane * 1024 + tile * 8);
    unsigned va = 0u, vb = 0u;
#pragma unroll
    for (int pos = 0; pos < 64; ++pos) { const int rr = (pos >> 1) & 15, p = pos >> 5, h = pos & 1, key = 32 * p + (rr & 3) + 8 * (rr >> 2) + 4 * h;
        const unsigned long long m = __builtin_amdgcn_ballot_w64(((w >> key) & 1ull) != 0ull);
        asm volatile("s_nop 1\n\tv_writelane_b32 %0, %1, %2" : "+v"(va) : "s"((unsigned)m), "n"(pos)); asm volatile("v_writelane_b32 %0, %1, %2" : "+v"(vb) : "s"((unsigned)(m >> 32)), "n"(pos)); }
    const size_t g0 = ((size_t)(b * 256 + 2 * c) * 128 + tile) * 64;
    BT[g0 + lane] = va; BT[g0 + 128 * 64 + lane] = vb;
}

namespace att {
constexpr int AD = 128, NW = 8, QBLK = 32, KVBLK = 64, QB = NW * QBLK;
constexpr int SHM_V = KVBLK * AD * 2, SHM_K = KVBLK * AD * 2;
constexpr int LI_OFF = 2 * SHM_V + 2 * SHM_K;
constexpr int LUT_OFF = LI_OFF + NW * 64 * 4;
constexpr int NM_OFF = LUT_OFF + 8 * 256 * 4;
constexpr int QI_OFF = NM_OFF + 32;
constexpr int ATT_LDS = NM_OFF + 64;
typedef unsigned u32x16 __attribute__((ext_vector_type(16)));
#define AS4C __attribute__((address_space(4)))
#define KSWZ(row, colB) ((row) * 256 + ((colB) ^ (((row) & 7) << 4)))
#define SBAR() __builtin_amdgcn_sched_barrier(0)
__device__ __forceinline__ int v_st(int k, int c) { const int kk = (k & ~0xC) | ((k & 4) << 1) | ((k & 8) >> 1); return ((kk >> 3) * 4 + (c >> 5)) * 512 + ((kk & 7) * 32 + (c & 31)) * 2; }
__device__ __forceinline__ int v_rd_base(int lane) { return ((lane & 3) << 3) | (((lane >> 2) & 3) << 6) | (((lane >> 4) & 1) << 5) | (((lane >> 5) & 1) << 8); }
constexpr int v_rd_off(int d0, int ks, int half) { return d0 * 512 + ks * 4096 + half * 2048; }
__device__ __forceinline__ unsigned cvtpk(float lo, float hi) { unsigned r; asm volatile("v_cvt_pk_bf16_f32 %0, %1, %2" : "=v"(r) : "v"(lo), "v"(hi)); return r; }
__device__ __forceinline__ bf16x8 load8(const bf16* p) { return *reinterpret_cast<const bf16x8*>(p); }
__device__ __forceinline__ void mask16(f32x16& p, const u32x16& ma, const u32x16& mb, float neg) {
#pragma unroll
    for (int r = 0; r < 16; ++r) { const unsigned lo = r < 8 ? ma[2 * r] : mb[2 * r - 16], hi = r < 8 ? ma[2 * r + 1] : mb[2 * r - 15];
        const unsigned long long mm = ((unsigned long long)hi << 32) | lo; float o;
        asm volatile("v_cndmask_b32_e64 %0, %1, %2, %3" : "=v"(o) : "v"(neg), "v"(p[r]), "s"(mm)); p[r] = o; }
}
#define MFMA_PAD(a, b) asm volatile("s_nop 15\n\ts_nop 7" : "+v"(a), "+v"(b))
__device__ __forceinline__ void bias_tile(f32x16& p0, f32x16& p1, const LAS float* lut) {
#pragma unroll
    for (int r = 0; r < 16; ++r) { const int c = (r & 3) + 8 * (r >> 2); p0[r] += lut[c]; p1[r] += lut[c + 32]; }
}
__device__ __forceinline__ void exp16(f32x16& p) {
#pragma unroll
    for (int r = 0; r < 16; ++r) p[r] = __builtin_amdgcn_exp2f(p[r]);
}
__device__ __forceinline__ void finishSM(f32x16& p0, f32x16& p1, float& l_reg, bf16x8& pa0, bf16x8& pa1, bf16x8& pa2, bf16x8& pa3) {
    exp16(p1);
    float ps = 0;
#pragma unroll
    for (int r = 0; r < 16; ++r) ps += p0[r];
#pragma unroll
    for (int r = 0; r < 16; ++r) ps += p1[r];
    l_reg += ps;
#define PK4(P, B_, OUT) do { unsigned a0 = cvtpk(P[B_+0], P[B_+1]), a1 = cvtpk(P[B_+2], P[B_+3]);                          \
        unsigned b0 = cvtpk(P[B_+4], P[B_+5]), b1 = cvtpk(P[B_+6], P[B_+7]);                                             \
        auto r0 = __builtin_amdgcn_permlane32_swap(a0, b0, false, false); auto r1 = __builtin_amdgcn_permlane32_swap(a1, b1, false, false); \
        v4u w = {r0[0], r1[0], r0[1], r1[1]}; OUT = *reinterpret_cast<bf16x8*>(&w); } while (0)
    PK4(p0, 0, pa0); PK4(p0, 8, pa1); PK4(p1, 0, pa2); PK4(p1, 8, pa3);
#undef PK4
}
template <int KB>
__device__ __forceinline__ void qkt(f32x16& p0, f32x16& p1, const char* K_lds, int r32, int hi, const bf16x8* qr, float init) {
#pragma unroll
    for (int r = 0; r < 16; ++r) { float i0 = init, i1 = init; asm volatile("" : "+v"(i0), "+v"(i1)); p0[r] = i0; p1[r] = i1; }
    const char* kb[4];
#pragma unroll
    for (int dd = 0; dd < 4; ++dd) kb[dd] = K_lds + KB * SHM_K + KSWZ(r32, (dd * 16 + hi * 8) * 2);
#pragma unroll
    for (int d0 = 0; d0 < 8; ++d0) { const char* a = kb[d0 & 3] + (d0 >> 2) * 128;
        bf16x8 b0 = *reinterpret_cast<const bf16x8*>(a);
        bf16x8 b1 = *reinterpret_cast<const bf16x8*>(a + 32 * 256);
        p0 = __builtin_amdgcn_mfma_f32_32x32x16_bf16(b0, qr[d0], p0, 0, 0, 0);
        p1 = __builtin_amdgcn_mfma_f32_32x32x16_bf16(b1, qr[d0], p1, 0, 0, 0); }
}
template <int VB>
__device__ __forceinline__ void pv_tile(f32x16* o, int vb0, bf16x8 pa0, bf16x8 pa1, bf16x8 pa2, bf16x8 pa3) {
#define TRRD(dst, off) asm volatile("ds_read_b64_tr_b16 %0, %1 offset:%2" : "=&v"(dst) : "v"(vb0), "i"(off) : "memory")
#define PV_D0(d0) do { s16x4 l0, l1, l2, l3, h0, h1, h2, h3; constexpr int b_ = VB * SHM_V + v_rd_off(d0, 0, 0); \
        TRRD(l0, b_); TRRD(h0, b_ + 2048); TRRD(l1, b_ + 4096); TRRD(h1, b_ + 6144); TRRD(l2, b_ + 8192); TRRD(h2, b_ + 10240); TRRD(l3, b_ + 12288); TRRD(h3, b_ + 14336); \
        asm volatile("s_waitcnt lgkmcnt(0)" ::: "memory"); SBAR();   \
        o[d0] = __builtin_amdgcn_mfma_f32_32x32x16_bf16(pa0, (bf16x8){l0[0], l0[1], l0[2], l0[3], h0[0], h0[1], h0[2], h0[3]}, o[d0], 0, 0, 0);   \
        o[d0] = __builtin_amdgcn_mfma_f32_32x32x16_bf16(pa1, (bf16x8){l1[0], l1[1], l1[2], l1[3], h1[0], h1[1], h1[2], h1[3]}, o[d0], 0, 0, 0);   \
        o[d0] = __builtin_amdgcn_mfma_f32_32x32x16_bf16(pa2, (bf16x8){l2[0], l2[1], l2[2], l2[3], h2[0], h2[1], h2[2], h2[3]}, o[d0], 0, 0, 0);   \
        o[d0] = __builtin_amdgcn_mfma_f32_32x32x16_bf16(pa3, (bf16x8){l3[0], l3[1], l3[2], l3[3], h3[0], h3[1], h3[2], h3[3]}, o[d0], 0, 0, 0); } while (0)
    PV_D0(0); PV_D0(1); PV_D0(2); PV_D0(3);
#undef PV_D0
#undef TRRD
}
struct BlockRef { const bf16* Q; const bf16* K; unsigned char* O; const unsigned* bt; int P0; int h; };
struct Seam { bf16x8 qr[8]; bf16x8 st_v0, st_v1, st_k0, st_k1; };
#define ROW(p, k0, rr) ((p) + (size_t)((k0) + (rr)) * ZP + sc)
#define VMW() asm volatile("s_waitcnt vmcnt(0)" ::: "memory")
#define VMWN(n) asm volatile("s_waitcnt vmcnt(%0)" :: "i"(n) : "memory")
#define SLOAD_H(Kp, k0) do { const bf16* r0_ = ROW(Kp, k0, sr); const bf16* r1_ = ROW(Kp, k0, 32 + sr);   \
                         S.st_v0 = load8(r0_ + (ZC_DV - ZC_DK)); S.st_v1 = load8(r1_ + (ZC_DV - ZC_DK)); S.st_k0 = load8(r0_); S.st_k1 = load8(r1_); } while (0)
#define SWRITE_HK(bf) do { *(bf16x8*)(K_lds + (bf) * SHM_K + kws) = S.st_k0; *(bf16x8*)(K_lds + (bf) * SHM_K + kws + 32 * 256) = S.st_k1; } while (0)
#define SWRITE_HV(bf) do { *(bf16x8*)(V_lds + (bf) * SHM_V + vst0) = S.st_v0; *(bf16x8*)(V_lds + (bf) * SHM_V + vst1) = S.st_v1; } while (0)
#define SWRITE_H(bf) do { SWRITE_HV(bf); SWRITE_HK(bf); } while (0)
#define MLOAD(dst0, dst1, ptr, byteoff) do { const AS4C u32x16* q_ = (const AS4C u32x16*)(const AS4C void*)(ptr); dst0 = q_[(byteoff) / 64]; dst1 = q_[(byteoff) / 64 + 1]; } while (0)
__device__ __forceinline__ void prime(const BlockRef& cur, char* lds, Seam& S) {
    const int tid = opaque_tid(), wid = __builtin_amdgcn_readfirstlane(tid >> 6), lane = tid & 63, r32 = lane & 31, hi = lane >> 5;
    const int sr = tid >> 4, sc = (tid & 15) * 8, kws = KSWZ(sr, sc * 2); char* K_lds = lds + 2 * SHM_V;
#pragma unroll
    for (int d0 = 0; d0 < 8; ++d0) S.qr[d0] = load8(cur.Q + (size_t)(wid * QBLK + r32) * ZP + d0 * 16 + hi * 8);
    SLOAD_H(cur.K, 0); VMW(); SWRITE_HK(0);
    __syncthreads();
}
__device__ __forceinline__ void block(const BlockRef& cur, const BlockRef& nxt, char* lds, Seam& S) {
    const int tid = opaque_tid(), wid = __builtin_amdgcn_readfirstlane(tid >> 6), lane = tid & 63, r32 = lane & 31, hi = lane >> 5;
    const int NT = cur.P0 / KVBLK + 4;
    const int qlo = cur.P0 + wid * QBLK, qch = qlo >> 6;
    char* V_lds = lds; char* K_lds = lds + 2 * SHM_V;
    float* li_l = (float*)(lds + LI_OFF) + wid * 64;
    const float ninit = *(const float*)(lds + NM_OFF + 4 * cur.h);
    const float NEG = -__builtin_inff();
    const unsigned* btw = cur.bt + (size_t)wid * (128 * 64);
    float l_reg = 0; f32x16 o[4];
#pragma unroll
    for (int d = 0; d < 4; ++d)
#pragma unroll
        for (int r = 0; r < 16; ++r) o[d][r] = 0.f;
    const int sr = tid >> 4, sc = (tid & 15) * 8, vst0 = v_st(sr, sc), vst1 = v_st(32 + sr, sc), kws = KSWZ(sr, sc * 2);
    const int vb0 = (int)(uintptr_t)V_lds + v_rd_base(lane);
    const bf16* Kh = cur.K;
#define KBASE(t) ((t) * KVBLK)
#define LUTB(t) (LUT_OFF + 4 * (cur.h * 256 + 191 + 4 * hi - qlo - r32 + (t) * KVBLK))
#define MASKT(P0_, P1_, t) do { if ((t) >= qch - 2 && (t) <= qch) bias_tile(P0_, P1_, (const LAS float*)(unsigned)LUTB(t)); \
        mask16(P0_, m0, m1, NEG); { const unsigned* mp_ = btw + (size_t)(t) * 64; MLOAD(m0, m1, mp_, 128); } \
        if (__builtin_expect(__all(ninit <= 0.f), 1)) { exp16(P0_); } else { l_reg = 0.f; }     \
        mask16(P1_, m0, m1, NEG); } while (0)
#define MREQ(t) do { const unsigned* mp_ = btw + (size_t)(t) * 64; MLOAD(m0, m1, mp_, 0); } while (0)
    constexpr int NQL = 8;
#define SEAM_K0() do { VMWN(NQL); SWRITE_HK(0); SBAR(); } while (0)
    f32x16 pA0, pA1, pB0, pB1; bf16x8 pa0, pa1, pa2, pa3; u32x16 m0, m1;
    SWRITE_HV(0); SBAR();
    MREQ(0);
    if (NT > 1) SLOAD_H(Kh, KBASE(1));
    SBAR(); qkt<0>(pA0, pA1, K_lds, r32, hi, S.qr, ninit);
    MFMA_PAD(pA0, pA1); MASKT(pA0, pA1, 0);
    if (NT > 1) { VMW(); SWRITE_H(1); }
    __syncthreads();
#define HALF_STEP(PX0, PX1, PY0, PY1, t, KB, VB, SB) do {                                                      \
        SBAR(); MREQ(t); qkt<KB>(PX0, PX1, K_lds, r32, hi, S.qr, ninit);                                             \
        finishSM(PY0, PY1, l_reg, pa0, pa1, pa2, pa3); SBAR();                                                           \
        if ((t) + 1 < NT) { SLOAD_H(Kh, KBASE((t) + 1)); SBAR(); }                                               \
        pv_tile<VB>(o, vb0, pa0, pa1, pa2, pa3); MASKT(PX0, PX1, (t));                                        \
        __syncthreads();                                                                                                      \
        if ((t) + 1 < NT) { VMW(); SWRITE_H(SB); }                                                                          \
        __syncthreads(); } while (0)
    for (int t = 1; t + 1 < NT; t += 2) {
        HALF_STEP(pB0, pB1, pA0, pA1, t, 1, 0, 0);
        HALF_STEP(pA0, pA1, pB0, pB1, t + 1, 0, 1, 1);
    }
    MREQ(NT - 1);
    SBAR(); qkt<1>(pB0, pB1, K_lds, r32, hi, S.qr, ninit); SBAR();
    SLOAD_H(nxt.K, 0); SBAR();
#pragma unroll
    for (int d0 = 0; d0 < 8; ++d0) S.qr[d0] = load8(nxt.Q + (size_t)(wid * QBLK + r32) * ZP + d0 * 16 + hi * 8);
    SBAR();
    finishSM(pA0, pA1, l_reg, pa0, pa1, pa2, pa3); SBAR();
    pv_tile<0>(o, vb0, pa0, pa1, pa2, pa3);
    MASKT(pB0, pB1, NT - 1); __syncthreads();
    finishSM(pB0, pB1, l_reg, pa0, pa1, pa2, pa3); SBAR(); pv_tile<1>(o, vb0, pa0, pa1, pa2, pa3);
    SBAR(); SEAM_K0();
    { auto rr = __builtin_amdgcn_permlane32_swap(__float_as_uint(l_reg), __float_as_uint(l_reg), false, false); l_reg = __uint_as_float(rr[0]) + __uint_as_float(rr[1]); }
    if (hi == 0) li_l[r32] = l_reg; asm volatile("s_waitcnt lgkmcnt(0)" ::: "memory");
    float rli[16];
#pragma unroll
    for (int r = 0; r < 16; ++r) rli[r] = __builtin_amdgcn_rcpf(fmaxf(li_l[crow(r, hi)], 1e-37f));
    unsigned char* Ow = cur.O + (size_t)(wid * QBLK) * 1024;
#pragma unroll
    for (int r = 0; r < 16; ++r) { const int orow = crow(r, hi);
#pragma unroll
        for (int d0 = 0; d0 < 4; ++d0) { const float v = o[d0][r] * rli[r] * 16.0f;
            const float v1 = DPP_F(v, 0x55), v2 = DPP_F(v, 0xAA), v3 = DPP_F(v, 0xFF);
            if ((r32 & 3) == 0) *(unsigned*)(Ow + (size_t)orow * 1024 + d0 * 32 + r32) = pk4_fp8(v, v1, v2, v3); } }
    __syncthreads();
#undef KBASE
#undef LUTB
#undef MASKT
#undef MREQ
#undef SEAM_K0
#undef HALF_STEP
}
#undef ROW
#undef VMW
#undef VMWN
#undef SLOAD_H
#undef SWRITE_HK
#undef SWRITE_HV
#undef SWRITE_H
#undef MLOAD
__device__ __forceinline__ BlockRef make_ref(int L, int pass, const bf16* Z, unsigned char* OB, const unsigned* BT) {
    const int bh = L >> 4, x = L & 15, b = bh >> 3, h = bh & 7, qb = pass ? 31 - x : x;
    BlockRef r; const size_t row0 = (size_t)b * SEQ + (size_t)qb * QB;
    r.Q = Z + row0 * ZP + ZC_DQ + h * AD; r.K = Z + (size_t)b * SEQ * ZP + ZC_DK + h * AD;
    r.O = OB + row0 * 1024 + h * AD; r.bt = BT + (size_t)(b * 256 + qb * 8) * (128 * 64); r.P0 = qb * QB; r.h = h; return r;
}
__device__ __forceinline__ int t5_bucket(int rel) {
    const int n = rel < 0 ? -rel : rel; int bk;
    if (n < 8) bk = n; else if (n < 12) bk = 8; else if (n < 16) bk = 9; else if (n < 23) bk = 10; else if (n < 32) bk = 11; else if (n < 46) bk = 12; else if (n < 64) bk = 13; else if (n < 91) bk = 14; else bk = 15;
    return (rel > 0 ? 16 : 0) + bk;
}
__device__ __forceinline__ BlockRef make_ref_blk(int i, const bf16* Z, unsigned char* OB, const unsigned* BT) {
    const int bh = i & 31, b = bh >> 3, h = bh & 7, qb = 31 - (i >> 5);
    BlockRef r; const size_t row0 = (size_t)b * SEQ + (size_t)qb * QB;
    r.Q = Z + row0 * ZP + ZC_DQ + h * AD; r.K = Z + (size_t)b * SEQ * ZP + ZC_DK + h * AD;
    r.O = OB + row0 * 1024 + h * AD; r.bt = BT + (size_t)(b * 256 + qb * 8) * (128 * 64); r.P0 = qb * QB; r.h = h; return r;
}
__device__ __forceinline__ int q_fetch(char* lds, gu32* qhead, int slot) {
    if (opaque_tid() == 0) { const unsigned v = __hip_atomic_fetch_add(qhead, 1u, RLX_AGENT); ((volatile unsigned*)(lds + QI_OFF))[slot] = v; }
    __syncthreads();
    return __builtin_amdgcn_readfirstlane((int)((volatile unsigned*)(lds + QI_OFF))[slot]);
}
__device__ __forceinline__ void attn_phase(char* lds, const bf16* Z, unsigned char* OB, const unsigned* BT, const float* rel_bias, const float* qg, const float* kg, gu32* qhead) {
    constexpr float L2E = 1.4426950408889634f;
    { float* lut = (float*)(lds + LUT_OFF);
      const int tid = opaque_tid();
      for (int i = tid; i < 8 * 256; i += 512) { const int h = i >> 8, rel = (i & 255) - 191; lut[i] = (rel_bias[t5_bucket(rel) * 8 + h] - rel_bias[15 * 8 + h]) * L2E; }
      if (tid < 64) { const int l = tid;
          float mq = fmaxf(fabsf(qg[l]), fabsf(qg[l + 64])), mk = fmaxf(fabsf(kg[l]), fabsf(kg[l + 64]));
          mq = wave_max(mq); mk = wave_max(mk);
          if (l < 8) { float mb = 0.f; for (int bk = 0; bk < 32; ++bk) mb = fmaxf(mb, rel_bias[bk * 8 + l] - rel_bias[15 * 8 + l]);
              ((float*)(lds + NM_OFF))[l] = -(11.313708498984761f * mq * mk + mb) * L2E; } } }
    asm volatile("" : "+s"(BT));
    __syncthreads();
    constexpr int total = NB * 8 * 32;
    const int i0 = q_fetch(lds, qhead, 0); if (i0 >= total) return;
    int i1 = q_fetch(lds, qhead, 1), slot = 0;
    BlockRef cur = make_ref_blk(i0, Z, OB, BT);
    Seam S;
    prime(cur, lds, S);
    for (;;) {
        const bool last = i1 >= total;
        const BlockRef nxt = last ? cur : make_ref_blk(i1, Z, OB, BT);
        block(cur, nxt, lds, S);
        if (last) break;
        cur = nxt; i1 = q_fetch(lds, qhead, slot); slot ^= 1;
    }
}
}

constexpr int RING_OFF = 0, RING_BYTES = 131072;
constexpr int LDSCTL_OFF = RING_BYTES, MISC_OFF = LDSCTL_OFF + 320;
constexpr int LDS_BYTES = 147456;

struct Frame {
    LAS unsigned char* lds;
    volatile LAS unsigned* MISC;
    gu32* ctl;
    int tid, lane, wave, vcu, G;
};

template <int MAP> __device__ __forceinline__ int rowmap(int n) {
    if (MAP == 0) return n;
    if (MAP == 1) {
        if (n < 1024) return n;
        if (n < 3072) return -1;
        if (n < 3088) return ZC_GLR - 2048 + (n - 3072);
        if (n < 6160) return -1;
        if (n < 7184) return ZC_IQ - 2048 + (n - 6160);
        if (n < 7248) return ZC_IK - 2048 + (n - 7184);
        return ZC_IW - 2048 + (n - 7248);
    }
    if (MAP == 4) return (n >= 1024 && n < 3072) ? n - 1024 : (n >= 3088 && n < 6160) ? n - 3088 + 2048 : -1;
    if (MAP == 2) { const int half = n >> 11, c = n & 2047; return (c >> 7) * 256 + half * 128 + (c & 127); }
    if (MAP == 3) return (n >> 7) * 256 + (n & 127);
    return n;
}
template <int MAP>
__device__ __forceinline__ void p0_transpose_item(const float* W, int K, int N, bf16* WT, int row_off, LAS float* scr, int item, int lane) {
    const int nblk = N / 32, kb = item / nblk, nb = item % nblk, k0 = 64 * kb, n0 = 32 * nb;
#pragma unroll 8
    for (int i = 0; i < 32; ++i) { const int kk = 2 * i + (lane >> 5); scr[kk * 33 + (lane & 31)] = W[(size_t)(k0 + kk) * N + n0 + (lane & 31)]; }
    LDS_WAIT(); asm volatile("" ::: "memory");
    const int c = lane & 7;
#pragma unroll
    for (int j = 0; j < 4; ++j) { const int n = (lane >> 3) + 8 * j; const LAS float* s = scr + (8 * c) * 33 + n;
        v4u o; o.x = pk2(s[0 * 33], s[1 * 33]); o.y = pk2(s[2 * 33], s[3 * 33]); o.z = pk2(s[4 * 33], s[5 * 33]); o.w = pk2(s[6 * 33], s[7 * 33]);
        const int rm = rowmap<MAP>(n0 + n); if (rm >= 0) *(GAS v4u*)(WT + (size_t)(row_off + rm) * K + k0 + 8 * c) = o; }
    LDS_WAIT(); asm volatile("" ::: "memory");
}
template <int MAP>
__device__ __forceinline__ void p0_transpose_item8(const float* W, int K, int N, unsigned char* WT, int row_off, LAS float* scr, int item, int lane, float scale) {
    const int nblk = N / 32, kb = item / nblk, nb = item % nblk, k0 = 64 * kb, n0 = 32 * nb;
#pragma unroll 8
    for (int i = 0; i < 32; ++i) { const int kk = 2 * i + (lane >> 5); scr[kk * 33 + (lane & 31)] = W[(size_t)(k0 + kk) * N + n0 + (lane & 31)] * scale; }
    LDS_WAIT(); asm volatile("" ::: "memory");
    const int c = lane & 3;
#pragma unroll
    for (int j = 0; j < 2; ++j) { const int n = (lane >> 2) + 16 * j; const LAS float* sp = scr + (16 * c) * 33 + n;
        v4u o; o.x = pk4_fp8(sp[0 * 33], sp[1 * 33], sp[2 * 33], sp[3 * 33]); o.y = pk4_fp8(sp[4 * 33], sp[5 * 33], sp[6 * 33], sp[7 * 33]);
        o.z = pk4_fp8(sp[8 * 33], sp[9 * 33], sp[10 * 33], sp[11 * 33]); o.w = pk4_fp8(sp[12 * 33], sp[13 * 33], sp[14 * 33], sp[15 * 33]);
        const int rm = rowmap<MAP>(n0 + n); if (rm >= 0) *(GAS v4u*)(WT + (size_t)(row_off + rm) * K + k0 + 16 * c) = o; }
    LDS_WAIT(); asm volatile("" ::: "memory");
}
constexpr int CONV_MOD = 6, CONV_DEPTH = 3;
template <int MAP>
__device__ __forceinline__ void conv_stream8(const float* W, int K, int N, unsigned char* WT, int erows, int row_add, LAS float* scr, int lane, int cw, int NCW) {
    const int nblk = N / 32, per_e = (K / 64) * nblk, total = NEXP * per_e;
    const int lr = lane >> 3, lc = (lane & 7) * 4;
    if (cw >= total) return;
    const int n_my = (total - cw + NCW - 1) / NCW, it_last = cw + (n_my - 1) * NCW;
    f32x4 v[CONV_DEPTH][8];
#define CONV_IT(j_) min(cw + (j_) * NCW, it_last)
#define CONV_LOAD(d_, it_) do { const int e_ = (it_) / per_e, r_ = (it_) - e_ * per_e, kb_ = r_ / nblk, nb_ = r_ - kb_ * nblk; \
        const float* s_ = W + (size_t)e_ * K * N + (size_t)(64 * kb_ + lr) * N + 32 * nb_ + lc; \
        _Pragma("unroll") for (int i = 0; i < 8; ++i) v[d_][i] = __builtin_nontemporal_load((const f32x4*)(s_ + (size_t)(8 * i) * N)); } while (0)
#pragma unroll
    for (int d = 0; d < CONV_DEPTH; ++d) { CONV_LOAD(d, CONV_IT(d)); asm volatile("" ::: "memory"); __builtin_amdgcn_sched_barrier(0); }
    for (int j0 = 0; j0 < n_my; j0 += CONV_DEPTH) {
#pragma unroll
        for (int d = 0; d < CONV_DEPTH; ++d) {
            const int it = CONV_IT(j0 + d);
            const int e = it / per_e, r = it - e * per_e, kb = r / nblk, nb = r - kb * nblk, k0 = 64 * kb, n0 = 32 * nb;
#pragma unroll
            for (int i = 0; i < 8; ++i) { LAS float* dd = scr + (8 * i + lr) * 33 + lc; dd[0] = v[d][i].x; dd[1] = v[d][i].y; dd[2] = v[d][i].z; dd[3] = v[d][i].w; }
            CONV_LOAD(d, CONV_IT(j0 + d + CONV_DEPTH));
            LDS_WAIT(); asm volatile("" ::: "memory");
            const int c = lane & 3;
#pragma unroll
            for (int j = 0; j < 2; ++j) { const int n = (lane >> 2) + 16 * j; const LAS float* sp = scr + (16 * c) * 33 + n;
                v4u o; o.x = pk4_fp8(32.f * sp[0 * 33], 32.f * sp[1 * 33], 32.f * sp[2 * 33], 32.f * sp[3 * 33]); o.y = pk4_fp8(32.f * sp[4 * 33], 32.f * sp[5 * 33], 32.f * sp[6 * 33], 32.f * sp[7 * 33]);
                o.z = pk4_fp8(32.f * sp[8 * 33], 32.f * sp[9 * 33], 32.f * sp[10 * 33], 32.f * sp[11 * 33]); o.w = pk4_fp8(32.f * sp[12 * 33], 32.f * sp[13 * 33], 32.f * sp[14 * 33], 32.f * sp[15 * 33]);
                *(GAS v4u*)(WT + (size_t)(e * erows + row_add + rowmap<MAP>(n0 + n)) * K + k0 + 16 * c) = o; }
            LDS_WAIT(); asm volatile("" ::: "memory");
        }
    }
#undef CONV_LOAD
#undef CONV_IT
}
__device__ __forceinline__ void p0_transpose_item_win(const float* W, bf16* WT, unsigned char* WT8, LAS float* scr, int item, int lane) {
    constexpr int K = D, N = 7264;
    const int nblk = N / 32, kb = item / nblk, nb = item % nblk, k0 = 64 * kb, n0 = 32 * nb;
#pragma unroll 8
    for (int i = 0; i < 32; ++i) { const int kk = 2 * i + (lane >> 5); scr[kk * 33 + (lane & 31)] = W[(size_t)(k0 + kk) * N + n0 + (lane & 31)]; }
    LDS_WAIT(); asm volatile("" ::: "memory");
    { const int c = lane & 7;
#pragma unroll
      for (int j = 0; j < 4; ++j) { const int n = (lane >> 3) + 8 * j; const LAS float* sp = scr + (8 * c) * 33 + n; const int rm = rowmap<1>(n0 + n);
        if (rm >= 0) { v4u o; o.x = pk2(sp[0 * 33], sp[1 * 33]); o.y = pk2(sp[2 * 33], sp[3 * 33]); o.z = pk2(sp[4 * 33], sp[5 * 33]); o.w = pk2(sp[6 * 33], sp[7 * 33]);
            *(GAS v4u*)(WT + (size_t)rm * K + k0 + 8 * c) = o; } } }
    { const int c = lane & 3;
#pragma unroll
      for (int j = 0; j < 2; ++j) { const int n = (lane >> 2) + 16 * j; const LAS float* sp = scr + (16 * c) * 33 + n; const int rm = rowmap<4>(n0 + n);
        if (rm >= 0) { v4u o; o.x = pk4_fp8(32.f * sp[0 * 33], 32.f * sp[1 * 33], 32.f * sp[2 * 33], 32.f * sp[3 * 33]); o.y = pk4_fp8(32.f * sp[4 * 33], 32.f * sp[5 * 33], 32.f * sp[6 * 33], 32.f * sp[7 * 33]);
            o.z = pk4_fp8(32.f * sp[8 * 33], 32.f * sp[9 * 33], 32.f * sp[10 * 33], 32.f * sp[11 * 33]); o.w = pk4_fp8(32.f * sp[12 * 33], 32.f * sp[13 * 33], 32.f * sp[14 * 33], 32.f * sp[15 * 33]);
            *(GAS v4u*)(WT8 + (size_t)rm * K + k0 + 16 * c) = o; } } }
    LDS_WAIT(); asm volatile("" ::: "memory");
}
__device__ __forceinline__ void rms_row_to_bf16(int lane, const float* xrow, const float* g, bf16* orow, unsigned char* orow8 = nullptr) {
    const GAS f32x4* xr = (const GAS f32x4*)xrow + lane;
    f32x4 v[8]; float s = 0.f;
#pragma unroll
    for (int j = 0; j < 8; ++j) { v[j] = xr[64 * j]; s += (v[j].x * v[j].x + v[j].y * v[j].y) + (v[j].z * v[j].z + v[j].w * v[j].w); }
    const float rstd = 1.0f / sqrtf(wave_sum(s) * (1.f / D) + EPS);
    GAS unsigned long long* o8 = (GAS unsigned long long*)orow + lane;
#pragma unroll
    for (int j = 0; j < 8; ++j) { const f32x4 gg = ((const GAS f32x4*)g)[64 * j + lane];
        o8[64 * j] = (unsigned long long)pk2(v[j].x * rstd * gg.x, v[j].y * rstd * gg.y) | ((unsigned long long)pk2(v[j].z * rstd * gg.z, v[j].w * rstd * gg.w) << 32);
        if (orow8) ((GAS unsigned*)orow8)[64 * j + lane] = pk4_fp8(v[j].x * rstd * gg.x, v[j].y * rstd * gg.y, v[j].z * rstd * gg.z, v[j].w * rstd * gg.w); }
}

#ifndef MK_DSA
#define MK_DSA 1
#endif
#ifndef MK_MOE
#define MK_MOE 1
#endif
#ifndef MK_GLA
#define MK_GLA 1
#endif
constexpr int PREF_OFF = LDSCTL_OFF, CNTL_OFF = MISC_OFF + 128;
__device__ __forceinline__ void rms_row_bf(int lane, const bf16* xrow, const float* g, bf16* orow, unsigned char* orow8) {
    const GAS v4u* xr = (const GAS v4u*)xrow + lane;
    v4u w[4]; float s = 0.f;
#pragma unroll
    for (int j = 0; j < 4; ++j) { w[j] = xr[64 * j];
        const float a0 = bflo(w[j].x), a1 = bfhi(w[j].x), a2 = bflo(w[j].y), a3 = bfhi(w[j].y), a4 = bflo(w[j].z), a5 = bfhi(w[j].z), a6 = bflo(w[j].w), a7 = bfhi(w[j].w);
        s += ((a0 * a0 + a1 * a1) + (a2 * a2 + a3 * a3)) + ((a4 * a4 + a5 * a5) + (a6 * a6 + a7 * a7)); }
    const float rstd = 1.0f / sqrtf(wave_sum(s) * (1.f / D) + EPS);
#pragma unroll
    for (int j = 0; j < 4; ++j) { const f32x4 g0 = ((const GAS f32x4*)g)[2 * (64 * j + lane)], g1 = ((const GAS f32x4*)g)[2 * (64 * j + lane) + 1];
        const float a0 = bflo(w[j].x) * rstd * g0.x, a1 = bfhi(w[j].x) * rstd * g0.y, a2 = bflo(w[j].y) * rstd * g0.z, a3 = bfhi(w[j].y) * rstd * g0.w;
        const float a4 = bflo(w[j].z) * rstd * g1.x, a5 = bfhi(w[j].z) * rstd * g1.y, a6 = bflo(w[j].w) * rstd * g1.z, a7 = bfhi(w[j].w) * rstd * g1.w;
        v4u o; o.x = pk2(a0, a1); o.y = pk2(a2, a3); o.z = pk2(a4, a5); o.w = pk2(a6, a7);
        ((GAS v4u*)orow)[64 * j + lane] = o;
        v2u o8; o8.x = pk4_fp8(a0, a1, a2, a3); o8.y = pk4_fp8(a4, a5, a6, a7);
        ((GAS v2u*)orow8)[64 * j + lane] = o8; }
}
__device__ __forceinline__ void combine_row_bf(int lane, const bf16* x1, const bf16* y0, const bf16* y1, const float* g, bf16* x2, unsigned char* orow8) {
    float v[4][8]; float s = 0.f;
#pragma unroll
    for (int j = 0; j < 4; ++j) { const v4u w = ((const GAS v4u*)x1)[64 * j + lane];
        v[j][0] = bflo(w.x); v[j][1] = bfhi(w.x); v[j][2] = bflo(w.y); v[j][3] = bfhi(w.y); v[j][4] = bflo(w.z); v[j][5] = bfhi(w.z); v[j][6] = bflo(w.w); v[j][7] = bfhi(w.w);
#if MK_MOE
        const v4u a = ((const GAS v4u*)y0)[64 * j + lane], b = ((const GAS v4u*)y1)[64 * j + lane];
        v[j][0] += bflo(a.x) + bflo(b.x); v[j][1] += bfhi(a.x) + bfhi(b.x); v[j][2] += bflo(a.y) + bflo(b.y); v[j][3] += bfhi(a.y) + bfhi(b.y);
        v[j][4] += bflo(a.z) + bflo(b.z); v[j][5] += bfhi(a.z) + bfhi(b.z); v[j][6] += bflo(a.w) + bflo(b.w); v[j][7] += bfhi(a.w) + bfhi(b.w);
#endif
        v4u o; o.x = pk2(v[j][0], v[j][1]); o.y = pk2(v[j][2], v[j][3]); o.z = pk2(v[j][4], v[j][5]); o.w = pk2(v[j][6], v[j][7]);
        ((GAS v4u*)x2)[64 * j + lane] = o;
        v[j][0] = bflo(o.x); v[j][1] = bfhi(o.x); v[j][2] = bflo(o.y); v[j][3] = bfhi(o.y); v[j][4] = bflo(o.z); v[j][5] = bfhi(o.z); v[j][6] = bflo(o.w); v[j][7] = bfhi(o.w);
#pragma unroll
        for (int q = 0; q < 8; ++q) s += v[j][q] * v[j][q]; }
    const float rstd = 1.0f / sqrtf(wave_sum(s) * (1.f / D) + EPS);
#pragma unroll
    for (int j = 0; j < 4; ++j) { const f32x4 g0 = ((const GAS f32x4*)g)[2 * (64 * j + lane)], g1 = ((const GAS f32x4*)g)[2 * (64 * j + lane) + 1];
        v2u o8; o8.x = pk4_fp8(v[j][0] * rstd * g0.x, v[j][1] * rstd * g0.y, v[j][2] * rstd * g0.z, v[j][3] * rstd * g0.w);
        o8.y = pk4_fp8(v[j][4] * rstd * g1.x, v[j][5] * rstd * g1.y, v[j][6] * rstd * g1.z, v[j][7] * rstd * g1.w);
        ((GAS v2u*)orow8)[64 * j + lane] = o8; }
}
__device__ __forceinline__ void combine_row(int lane, float* xio, const bf16* y0, const bf16* y1, const float* g, unsigned char* orow8) {
    GAS f32x4* xr = (GAS f32x4*)xio + lane;
    f32x4 v[8]; float s = 0.f;
#pragma unroll
    for (int j = 0; j < 8; ++j) { v[j] = xr[64 * j];
#if MK_MOE
        const v2u a = ((const GAS v2u*)y0)[64 * j + lane], b = ((const GAS v2u*)y1)[64 * j + lane];
        v[j].x += bflo(a.x) + bflo(b.x); v[j].y += bfhi(a.x) + bfhi(b.x); v[j].z += bflo(a.y) + bflo(b.y); v[j].w += bfhi(a.y) + bfhi(b.y);
#endif
        s += (v[j].x * v[j].x + v[j].y * v[j].y) + (v[j].z * v[j].z + v[j].w * v[j].w); }
    const float rstd = 1.0f / sqrtf(wave_sum(s) * (1.f / D) + EPS);
#pragma unroll
    for (int j = 0; j < 8; ++j) { const f32x4 gg = ((const GAS f32x4*)g)[64 * j + lane];
        xr[64 * j] = v[j];
        ((GAS unsigned*)orow8)[64 * j + lane] = pk4_fp8(v[j].x * rstd * gg.x, v[j].y * rstd * gg.y, v[j].z * rstd * gg.z, v[j].w * rstd * gg.w); }
}

struct Args { const float* in[27]; float* out; unsigned char* ws; int ph_lo, ph_hi; };

#define AS4 __attribute__((address_space(4)))
#define PHASE_LOCALS \
    const AS4 Args* ap = (const AS4 Args*)__builtin_amdgcn_kernarg_segment_ptr(); asm volatile("" : "+s"(ap)); \
    unsigned char* const ws = ap->ws; int tid_o = threadIdx.x; asm volatile("" : "+v"(tid_o)); \
    Frame F; F.lds = (LAS unsigned char*)lds_raw; F.MISC = (volatile LAS unsigned*)(F.lds + MISC_OFF); F.ctl = (gu32*)(ws + WS_CTL); \
    F.tid = tid_o; F.lane = tid_o & 63; F.wave = __builtin_amdgcn_readfirstlane(tid_o >> 6); F.G = gridDim.x; \
    { const int bx = blockIdx.x; F.vcu = (F.G % 8 == 0) ? (bx % 8) * (F.G / 8) + bx / 8 : bx; } \
    const int gw = F.vcu * NWAVES + F.wave, NGW = F.G * NWAVES; const int gt = blockIdx.x * 512 + F.tid, NGT = F.G * 512; \
    bf16* const HB = (bf16*)(ws + WS_HB); bf16* const ZB = (bf16*)(ws + WS_ZB); \
    LAS unsigned char* const wl = F.lds + RING_OFF + F.wave * 16384; \
    (void)gw; (void)NGW; (void)gt; (void)NGT; (void)HB; (void)ZB; (void)wl;
#ifndef MK_DBL
#define MK_DBL 0
#endif
#define REP2 for (int rep_ = 0; rep_ < 2; ++rep_)
#if (MK_DBL >> 0) & 1
#define REP_0 REP2
#else
#define REP_0
#endif
#if (MK_DBL >> 1) & 1
#define REP_1 REP2
#else
#define REP_1
#endif
#if (MK_DBL >> 2) & 1
#define REP_2 REP2
#else
#define REP_2
#endif
#if (MK_DBL >> 3) & 1
#define REP_3 REP2
#else
#define REP_3
#endif
#if (MK_DBL >> 4) & 1
#define REP_4 REP2
#else
#define REP_4
#endif
#if (MK_DBL >> 5) & 1
#define REP_5 REP2
#else
#define REP_5
#endif
#if (MK_DBL >> 6) & 1
#define REP_6 REP2
#else
#define REP_6
#endif
#if (MK_DBL >> 7) & 1
#define REP_7 REP2
#else
#define REP_7
#endif
#if (MK_DBL >> 8) & 1
#define REP_8 REP2
#else
#define REP_8
#endif
#if (MK_DBL >> 9) & 1
#define REP_9 REP2
#else
#define REP_9
#endif
#if (MK_DBL >> 10) & 1
#define REP_10 REP2
#else
#define REP_10
#endif
#if (MK_DBL >> 11) & 1
#define REP_11 REP2
#else
#define REP_11
#endif
#if (MK_DBL >> 12) & 1
#define REP_12 REP2
#else
#define REP_12
#endif
#if (MK_DBL >> 13) & 1
#define REP_13 REP2
#else
#define REP_13
#endif
#if (MK_DBL >> 14) & 1
#define REP_14 REP2
#else
#define REP_14
#endif
#define REP(k) REP_##k
#define IN(k) (ap->in[k])
#define GRID_BAR() do { XcdBarrier bb_; bb_.bar = (unsigned*)(F.ctl + CW_BAR); bb_.x = xb_xcc_id(); bb_.st = F.MISC + 8; xcd_barrier(bb_); } while (0)

__global__ void __launch_bounds__(NWAVES * 64, 2) mk_fwd(Args args) {
    extern __shared__ __attribute__((aligned(16))) unsigned char lds_raw[];
    (void)args;
    {
        PHASE_LOCALS
        for (int u = F.tid; u < (LDS_BYTES - LDSCTL_OFF) / 4; u += NWAVES * 64) ((LAS unsigned*)(F.lds + LDSCTL_OFF))[u] = 0u;
        __syncthreads();
        (void)xcd_barrier_post((unsigned*)(F.ctl + CW_BAR), F.MISC + 8);
    }
    REP(0)
    {
        PHASE_LOCALS
        LAS float* scr = (LAS float*)wl;
        constexpr int I_IN = (D / 64) * (7264 / 32), I_BG = (D / 64) * (4096 / 32), I_OG = (1024 / 64) * (D / 32), I_O = (D / 64) * (D / 32), I_PP = (PLE / 64) * (D / 32);
        constexpr int NITEMS = I_IN + I_BG + 2 * I_OG + 2 * I_O + I_PP;
        for (int it = gw; it < NITEMS; it += NGW) {
            int r = it;
            if (r < I_IN) { p0_transpose_item_win(IN(3), (bf16*)(ws + WS_WIN), ws + WS_WIN8, scr, r, F.lane); continue; } r -= I_IN;
            if (r < I_BG) { p0_transpose_item8<2>(IN(12), D, 4096, ws + WS_WBG8, 0, scr, r, F.lane, 32.0f); continue; } r -= I_BG;
            if (r < I_OG) { p0_transpose_item<0>(IN(7), 1024, D, (bf16*)(ws + WS_WOG), 0, scr, r, F.lane); continue; } r -= I_OG;
            if (r < I_OG) { p0_transpose_item8<0>(IN(11), 1024, D, ws + WS_WOD8, 0, scr, r, F.lane, 32.0f); continue; } r -= I_OG;
            if (r < I_O) { p0_transpose_item8<0>(IN(14), D, D, ws + WS_WO8, 0, scr, r, F.lane, 32.0f); continue; } r -= I_O;
            if (r < I_O) { p0_transpose_item8<0>(IN(24), D, D, ws + WS_WPG8, 0, scr, r, F.lane, 32.0f); continue; } r -= I_O;
            p0_transpose_item<0>(IN(26), PLE, D, (bf16*)(ws + WS_WPP), 0, scr, r, F.lane);
        }
        { GAS v4u* z = (GAS v4u*)((bf16*)(ws + WS_WIN) + (size_t)(ZC_IW + 16 - 2048) * D);
          for (int i = gt; i < 160 * D * 2 / 16; i += NGT) z[i] = (v4u){0u, 0u, 0u, 0u}; }
        { bf16* wr = (bf16*)(ws + WS_WR); const float* wg = IN(16); const float* we = IN(18);
          for (int i = gt; i < 256 * D; i += NGT) { const int n = i >> 11, k = i & 2047; const float v = n < 8 ? wg[k * 8 + n] : (n < 72 ? we[k * 64 + (n - 8)] : 0.f); wr[i] = (bf16)f2bf(v); } }
        for (int m = gw; m < T; m += NGW) rms_row_to_bf16(F.lane, IN(0) + (size_t)m * D, IN(2), HB + (size_t)m * D, (unsigned char*)ap->out + (size_t)m * D);
        GRID_BAR();
    }
    REP(1)
    {
        PHASE_LOCALS
        { pg8::StaticOrder S; S.init(T, ZN_A - 2048, F.G, (int)blockIdx.x);
          pg8::Gemm g{HB, (const bf16*)(ws + WS_WIN), D};
          pg8::EpiBf16Skip E{ZB, ZP, 4, 2048};
          pg8::gemm_phase<pg8::EpiBf16Skip, pg8::StaticOrder>(F.lds + RING_OFF, g, S, E); }
        { pg8::StaticOrder S; S.init(T, 5120, F.G, (int)blockIdx.x);
          pg8::Gemm8 g{(const unsigned char*)ap->out, ws + WS_WIN8, D / 2, 0x7f7f7f7f, 0x7a7a7a7a};
          pg8::EpiBf16Skip E{ZB + 1024, ZP, 8, ZN_A - 3072};
          pg8::gemm_phase8<pg8::EpiBf16Skip, pg8::StaticOrder>(F.lds + RING_OFF, g, S, E); }
        GRID_BAR();
    }
    REP(2)
    {
        PHASE_LOCALS
#if MK_GLA
        for (int task = blockIdx.x; task < NB * 128; task += F.G) {
            gla_prep_task(F.lds, ZB, IN(4), IN(5), (float*)(ws + WS_DEC), task);
            gla_local_unit(F.lds, F.wave, F.lane, ZB, (const float*)(ws + WS_DEC), (float*)(ws + WS_SLOC), task * 8 + F.wave);
            __syncthreads();
        }
#endif
        for (int m = gw; m < T; m += NGW) dsa_prep_row(F.lane, ZB, (size_t)m, IN(8), IN(9), (bf16*)(ws + WS_IKC), (float*)(ws + WS_UW));
        GRID_BAR();
    }
    REP(3)
    {
        PHASE_LOCALS
#if MK_GLA
        gla_scan((const float*)(ws + WS_SLOC), (const float*)(ws + WS_DEC), (bf16*)(ws + WS_STT), gt, NGT);
#endif
#if MK_DSA
        for (int task = blockIdx.x; task < NB * 64; task += F.G) {
            const int b = task >> 6, xq = task & 63;
#pragma unroll 1
            for (int half = 0; half < 2; ++half) {
                const int c = half ? 127 - xq : xq, n = 64 * (c + 1);
                unsigned char* wsl = ws; int lane_l = F.lane; asm volatile("" : "+s"(wsl), "+v"(lane_l));
                idx_scores_oct(wl, lane_l, (const bf16*)(wsl + WS_ZB), (const bf16*)(wsl + WS_IKC), (const float*)(wsl + WS_UW), (unsigned short*)(wsl + WS_SC), b, c, F.wave);
                VM_WAIT(); __syncthreads();
                asm volatile("" : "+s"(wsl), "+v"(lane_l));
#pragma unroll 1
                for (int q = 0; q < 8; ++q) { const int ql = F.wave * 8 + q;
                    idx_select_row(lane_l, (const unsigned short*)(wsl + WS_SC) + sc_off(b, c) + (size_t)ql * n, n, F.lds + RING_OFF + ql * 1024, (LAS unsigned*)(F.lds + RING_OFF + 65536 + F.wave * 8192)); }
                LDS_WAIT(); __syncthreads();
                asm volatile("" : "+s"(wsl), "+v"(lane_l));
                const int tend = (c | 3) + 1;
#pragma unroll 1
                for (int tile = F.wave; tile < tend; tile += NWAVES) bt_emit_tile(lane_l, F.lds + RING_OFF, (unsigned*)(wsl + WS_BM), b, c, tile, tile > c);
                __syncthreads();
            }
        }
#endif
        GRID_BAR();
    }
    REP(4)
    {
        PHASE_LOCALS
#if MK_GLA
        for (int u = gw; u < 4096; u += NGW) gla_out_unit(wl, F.lane, ZB, (const bf16*)(ws + WS_STT), IN(6), (bf16*)(ws + WS_OA), u);
        __syncthreads();
#endif
#if MK_MOE
        if (F.vcu % CONV_MOD == 0) {
            const int cw = (F.vcu / CONV_MOD) * NWAVES + F.wave, NCW = ((F.G + CONV_MOD - 1) / CONV_MOD) * NWAVES;
            LAS float* scr = (LAS float*)wl; const int lane_c = opaque_tid() & 63;
            conv_stream8<3>(IN(20), D, EFF, ws + WS_WGU8, 1024, 0, scr, lane_c, cw, NCW);
            conv_stream8<3>(IN(21), D, EFF, ws + WS_WGU8, 1024, 128, scr, lane_c, cw, NCW);
            conv_stream8<0>(IN(22), EFF, D, ws + WS_WDN8, D, 0, scr, lane_c, cw, NCW);
            __syncthreads();
        }
#endif
#if MK_DSA
        att::attn_phase((char*)lds_raw, ZB, ws + WS_OB, (const unsigned*)(ws + WS_BM), IN(10), IN(8), IN(9), F.ctl + CW_ATTQ);
#endif
        GRID_BAR();
    }
    REP(5)
    {
        PHASE_LOCALS
        pg8::StaticOrder S; S.init(T, D, F.G, (int)blockIdx.x);
        { pg8::Gemm g{(const bf16*)(ws + WS_OA), (const bf16*)(ws + WS_WOG), 1024}; pg8::EpiFp8 E{ws + WS_YA, D};
          pg8::gemm_phase<pg8::EpiFp8, pg8::StaticOrder>(F.lds + RING_OFF, g, S, E); }
        { pg8::Gemm8 g{ws + WS_OB, ws + WS_WOD8, 1024 / 2, 0x7b7b7b7b, 0x7a7a7a7a}; pg8::EpiFp8 E{ws + WS_YB, D};
          pg8::gemm_phase8<pg8::EpiFp8, pg8::StaticOrder>(F.lds + RING_OFF, g, S, E); }
        GRID_BAR();
    }
    REP(6)
    {
        PHASE_LOCALS
        pg8::StaticOrder S; S.init(T, 4096, F.G, (int)blockIdx.x);
        pg8::Gemm8 g{(const unsigned char*)ap->out, ws + WS_WBG8, D / 2, 0x7f7f7f7f, 0x7a7a7a7a};
        pg8::EpiGateMix E{ws + WS_YA, ws + WS_YB, ws + WS_U, IN(13)};
        pg8::gemm_phase8<pg8::EpiGateMix, pg8::StaticOrder>(F.lds + RING_OFF, g, S, E);
        GRID_BAR();
    }
    REP(7)
    {
        PHASE_LOCALS
        pg8::StaticOrder S; S.init(T, D, F.G, (int)blockIdx.x);
        pg8::Gemm8 g{ws + WS_U, ws + WS_WO8, D / 2, 0x7c7c7c7c, 0x7a7a7a7a};
        pg8::EpiResBf16P E{IN(0), (bf16*)ap->out, D};
        pg8::gemm_phase8<pg8::EpiResBf16P, pg8::StaticOrder>(F.lds + RING_OFF, g, S, E);
        GRID_BAR();
    }
    REP(8)
    {
        PHASE_LOCALS
        for (int m = gw; m < T; m += NGW) rms_row_bf(F.lane, (const bf16*)ap->out + (size_t)m * D, IN(15), (bf16*)(ws + WS_H2B) + (size_t)m * D, ws + WS_H8 + (size_t)m * D);
        { const GAS f32x4* p4 = (const GAS f32x4*)IN(1); GAS v2u* o = (GAS v2u*)(ws + WS_PBF);
          for (size_t i = (size_t)gt; i < (size_t)T * PLE / 4; i += (size_t)NGT) { const f32x4 v = p4[i]; v2u w; w.x = pk2(v.x, v.y); w.y = pk2(v.z, v.w); o[i] = w; } }
        GRID_BAR();
    }
#if MK_MOE
    REP(9)
    {
        PHASE_LOCALS
        pg8::StaticOrder S; S.init(T, 256, F.G, (int)blockIdx.x);
        pg8::Gemm g{(const bf16*)(ws + WS_H2B), (const bf16*)(ws + WS_WR), D};
        pg8::EpiF32 E{(float*)(ws + WS_LOGIT), 256};
        pg8::gemm_phase<pg8::EpiF32, pg8::StaticOrder>(F.lds + RING_OFF, g, S, E);
        VM_WAIT(); __syncthreads();
        { pg8::Unit ur;
          const int nu = (128 - (int)blockIdx.x + F.G - 1) / F.G;
#pragma unroll 1
          for (int iu = 0; iu < nu; ++iu) { S.next(iu, ur); const int t_lo = ur.pm * 256, t_hi = t_lo + 256;
        const float* LG = (const float*)(ws + WS_LOGIT); const float* bg = IN(17); const float* be = IN(19);
          unsigned* cnt = (unsigned*)(F.ctl + CW_CNT); int* tokrow = (int*)(ws + WS_TOKROW); float* tokw = (float*)(ws + WS_TOKW);
          for (int t = t_lo + F.tid; t < t_hi; t += NWAVES * 64) {
              const f32x4 a = *(const f32x4*)(LG + (size_t)t * 256), b2 = *(const f32x4*)(LG + (size_t)t * 256 + 4);
              float l[8] = {a.x + bg[0], a.y + bg[1], a.z + bg[2], a.w + bg[3], b2.x + bg[4], b2.y + bg[5], b2.z + bg[6], b2.w + bg[7]};
              int gi = 0; float gm = l[0];
#pragma unroll
              for (int i = 1; i < 8; ++i) if (l[i] > gm) { gm = l[i]; gi = i; }
              float se = 0.f;
#pragma unroll
              for (int i = 0; i < 8; ++i) se += __expf(l[i] - gm);
              const float grp_w = 1.0f / se;
              const f32x4 c0 = *(const f32x4*)(LG + (size_t)t * 256 + 8 + gi * 8), c1 = *(const f32x4*)(LG + (size_t)t * 256 + 12 + gi * 8);
              const float* bb = be + gi * 8;
              float ev[8] = {c0.x + bb[0], c0.y + bb[1], c0.z + bb[2], c0.w + bb[3], c1.x + bb[4], c1.y + bb[5], c1.z + bb[6], c1.w + bb[7]};
              int i0 = 0; float v0 = ev[0];
#pragma unroll
              for (int i = 1; i < 8; ++i) if (ev[i] > v0) { v0 = ev[i]; i0 = i; }
              int i1 = -1; float v1 = -__builtin_inff();
#pragma unroll
              for (int i = 0; i < 8; ++i) if (i != i0 && ev[i] > v1) { v1 = ev[i]; i1 = i; }
              const float w0 = 1.0f / (1.0f + __expf(v1 - v0)), w1 = 1.0f - w0;
              const int e0 = gi * 8 + i0, e1 = gi * 8 + i1;
              const unsigned p0 = atomicAdd(&cnt[e0], 1u), p1 = atomicAdd(&cnt[e1], 1u);
              tokrow[(size_t)e0 * ECAP + p0] = t * 2; tokw[(size_t)e0 * ECAP + p0] = grp_w * w0;
              tokrow[(size_t)e1 * ECAP + p1] = t * 2 + 1; tokw[(size_t)e1 * ECAP + p1] = grp_w * w1;
          }
          } }
        { pg8::PleOrder SP{F.G, (int)blockIdx.x};
          pg8::Gemm gp{(const bf16*)(ws + WS_PBF), (const bf16*)(ws + WS_WPP), PLE};
          pg8::EpiBf16 EP{(bf16*)(ws + WS_PLEB), D};
          pg8::gemm_phase<pg8::EpiBf16, pg8::PleOrder>(F.lds + RING_OFF, gp, SP, EP); }
        GRID_BAR();
    }
    REP(11)
    {
        PHASE_LOCALS
        LAS int* pref = (LAS int*)(F.lds + PREF_OFF); LAS int* cntl = (LAS int*)(F.lds + CNTL_OFF);
        if (F.tid < 64) cntl[F.tid] = (int)__hip_atomic_load((unsigned*)(F.ctl + CW_CNT) + F.tid, RLX_AGENT);
        __syncthreads();
        if (F.tid == 0) { int acc = 0; for (int e = 0; e < 64; ++e) { pref[e] = acc; acc += (cntl[e] + 255) >> 8; } pref[64] = acc; }
        __syncthreads();
        pg8::MoeOrder S{pref, cntl, (const int*)(ws + WS_TOKROW), 4, F.G, F.vcu, D / 2};
        pg8::Gemm8 g{ws + WS_H8, ws + WS_WGU8, D / 2, 0x7f7f7f7f, 0x7a7a7a7a};
        pg8::EpiMoe1 E{ws + WS_ACT};
        pg8::gemm_phase8<pg8::EpiMoe1, pg8::MoeOrder, true>(F.lds + RING_OFF, g, S, E);
        GRID_BAR();
    }
    REP(12)
    {
        PHASE_LOCALS
        LAS int* pref = (LAS int*)(F.lds + PREF_OFF); LAS int* cntl = (LAS int*)(F.lds + CNTL_OFF);
        pg8::MoeOrder S{pref, cntl, (const int*)(ws + WS_TOKROW), 8, F.G, F.vcu, EFF / 2};
        pg8::Gemm8 g{ws + WS_ACT, ws + WS_WDN8, EFF / 2, 0x7d7d7d7d, 0x7a7a7a7a};
        pg8::EpiMoe2 E{(bf16*)(ws + WS_Y0), (long long)(HB - (bf16*)(ws + WS_Y0)), (const int*)(ws + WS_TOKROW), (const float*)(ws + WS_TOKW), cntl};
        pg8::gemm_phase8<pg8::EpiMoe2, pg8::MoeOrder, false>(F.lds + RING_OFF, g, S, E);
        GRID_BAR();
    }
#endif
    REP(13)
    {
        PHASE_LOCALS
        for (int m = gw; m < T; m += NGW) combine_row_bf(F.lane, (const bf16*)ap->out + (size_t)m * D, (const bf16*)(ws + WS_Y0) + (size_t)m * D, HB + (size_t)m * D, IN(23), (bf16*)(ws + WS_X2B) + (size_t)m * D, ws + WS_H8 + (size_t)m * D);
        GRID_BAR();
    }
    REP(14)
    {
        PHASE_LOCALS
        pg8::StaticOrder S; S.init(T, D, F.G, (int)blockIdx.x);
        { pg8::Gemm8 g{ws + WS_H8, ws + WS_WPG8, D / 2, 0x7f7f7f7f, 0x7a7a7a7a};
          pg8::EpiPleFinal E{(const bf16*)(ws + WS_X2B), (const bf16*)(ws + WS_PLEB), ap->out, IN(25)};
          pg8::gemm_phase8<pg8::EpiPleFinal, pg8::StaticOrder>(F.lds + RING_OFF, g, S, E); }
    }
}

extern "C" void kernel_launch(void* const* d_in, const int* in_sizes, int n_in, void* d_out, int out_size, void* d_ws, size_t ws_size, hipStream_t stream) {
    static int grid = 0;
    if (grid == 0) {
        if (n_in != 27 || out_size != T * D || ws_size < WS_END) { fprintf(stderr, "kernel_launch: unexpected shapes (n_in %d out %d ws %zu, need %zu)\n", n_in, out_size, ws_size, (size_t)WS_END); grid = -1; return; }
        int dev = 0, cus = 0, per_cu = 0;
        if (hipGetDevice(&dev) != hipSuccess || hipDeviceGetAttribute(&cus, hipDeviceAttributeMultiprocessorCount, dev) != hipSuccess) { grid = -1; return; }
        if (hipFuncSetAttribute((const void*)mk_fwd, hipFuncAttributeMaxDynamicSharedMemorySize, LDS_BYTES) != hipSuccess) { fprintf(stderr, "kernel_launch: hipFuncSetAttribute failed\n"); grid = -1; return; }
        if (hipOccupancyMaxActiveBlocksPerMultiprocessor(&per_cu, (const void*)mk_fwd, NWAVES * 64, LDS_BYTES) != hipSuccess || per_cu < 1) { fprintf(stderr, "kernel_launch: occupancy query says %d\n", per_cu); }
        (void)hipGetLastError();
        grid = cus;
    }
    if (grid < 0) return;
    if (hipMemsetAsync((char*)d_ws + WS_CTL, 0, CTL_ZERO_BYTES, stream) != hipSuccess) return;
    Args a{};
    for (int i = 0; i < 27; ++i) a.in[i] = (const float*)d_in[i];
    a.out = (float*)d_out; a.ws = (unsigned char*)d_ws; a.ph_lo = 0; a.ph_hi = 99;
    hipLaunchKernelGGL(mk_fwd, dim3(grid), dim3(NWAVES * 64), LDS_BYTES, stream, a);
}
```

```cpp
#include <hip/hip_runtime.h>
#include <cstdio>
#include <cstdint>

#ifndef MK_STAGE
#define MK_STAGE 1
#endif

#define GAS __attribute__((address_space(1)))
#define LAS __attribute__((address_space(3)))
typedef unsigned short bf16;
typedef unsigned v4u __attribute__((ext_vector_type(4)));
typedef unsigned v2u __attribute__((ext_vector_type(2)));
typedef float f32x4 __attribute__((ext_vector_type(4)));
typedef float f32x2 __attribute__((ext_vector_type(2)));
typedef float f32x16 __attribute__((ext_vector_type(16)));
typedef short bf16x8 __attribute__((ext_vector_type(8)));
typedef short s16x4 __attribute__((ext_vector_type(4)));
typedef GAS unsigned gu32;
#define RLX_AGENT __ATOMIC_RELAXED, __HIP_MEMORY_SCOPE_AGENT
#define LDS_WAIT() asm volatile("s_waitcnt lgkmcnt(0)" ::: "memory")
#define VM_WAIT() asm volatile("s_waitcnt vmcnt(0)" ::: "memory")

constexpr int NB = 4, SEQ = 8192, T = NB * SEQ, D = 2048, PLE = 256;
constexpr int ZP = 7424;
constexpr int ZC_GQ = 0, ZC_GK = 512, ZC_GV = 1024, ZC_GR = 2048, ZC_GLR = 3072, ZC_IK = 3088, ZC_IW = 3152, ZC_IQ = 3328, ZN_A = 4352  , ZC_DQ = 4352, ZC_DK = 5376, ZC_DV = 6400;
constexpr int NEXP = 64, EFF = 512, ECAP = 32768;
constexpr int ACT_ROWS = 81920;
constexpr float EPS = 1e-6f;
constexpr int NWAVES = 8;

constexpr size_t MiB = 1u << 20;
constexpr size_t al(size_t x) { return (x + 255) & ~(size_t)255; }
constexpr size_t WS_CTL = 0, CTL_ZERO_BYTES = 1 * MiB;
constexpr size_t WS_WIN = WS_CTL + CTL_ZERO_BYTES;
constexpr size_t WS_WBG = WS_WIN + al((size_t)ZP * D * 2);
constexpr size_t WS_WOG = WS_WBG + al((size_t)4096 * D * 2);
constexpr size_t WS_WOD = WS_WOG + al((size_t)D * 1024 * 2);
constexpr size_t WS_WO = WS_WOD + al((size_t)D * 1024 * 2);
constexpr size_t WS_WPG = WS_WO + al((size_t)D * D * 2);
constexpr size_t WS_WPP = WS_WPG + al((size_t)D * D * 2);
constexpr size_t WS_WR = WS_WPP + al((size_t)D * PLE * 2);
constexpr size_t WS_HB = WS_WR + al((size_t)256 * D * 2);
constexpr size_t WS_ZB = WS_HB + al((size_t)T * D * 2);
constexpr size_t ZB_BYTES = (size_t)T * ZP * 2;
constexpr size_t WS_SC = WS_ZB + al(ZB_BYTES);
constexpr size_t SC_PER_BATCH = (size_t)64 * 64 * (128 * 129 / 2);
constexpr size_t SC_BYTES = (size_t)NB * SC_PER_BATCH * 2;
constexpr size_t WS_BM = WS_SC + al(SC_BYTES);
constexpr size_t WS_SLOC = WS_BM + al((size_t)T * 1024);
constexpr size_t WS_STT = WS_SLOC + al((size_t)4096 * 8192 * 4);
constexpr size_t WS_DEC = WS_STT + al((size_t)4096 * 8192 * 2);
constexpr size_t WS_IKC = WS_DEC + al((size_t)4096 * 64 * 4);
constexpr size_t WS_UW = WS_IKC + al((size_t)T * 64 * 2);
constexpr size_t WS_WBG8 = WS_UW + al((size_t)T * 16 * 4);
constexpr size_t WS_WPG8 = WS_WBG8 + al((size_t)4096 * D);
constexpr size_t WS_WOD8 = WS_WPG8 + al((size_t)D * D);
constexpr size_t WS_WO8 = WS_WOD8 + al((size_t)D * 1024);
constexpr size_t WS_END = WS_WO8 + al((size_t)D * D);
constexpr size_t WS_WIN8 = WS_WIN + (size_t)ZN_A * D * 2;
static_assert(WS_WIN8 + (size_t)5120 * D <= WS_WBG, "w_in copies fit their region");
constexpr size_t WS_OA = WS_SC, WS_OB = WS_SC + (size_t)T * 1024 * 2;
constexpr size_t WS_YA = WS_ZB, WS_YB = WS_ZB + (size_t)T * D * 2, WS_U = WS_ZB + 2 * (size_t)T * D * 2;
constexpr size_t WS_WGU = WS_ZB;
constexpr size_t WS_WDN = WS_WGU + (size_t)NEXP * 1024 * D * 2;
constexpr size_t WS_ACT = WS_WDN + (size_t)NEXP * D * EFF * 2;
static_assert(WS_ACT + (size_t)ACT_ROWS * EFF * 2 <= WS_ZB + ZB_BYTES, "MoE overlay fits in Z");
constexpr size_t WS_LOGIT = WS_SC;
constexpr size_t WS_TOKROW = WS_LOGIT + (size_t)T * 256 * 4;
constexpr size_t WS_TOKW = WS_TOKROW + (size_t)NEXP * ECAP * 4;
constexpr size_t WS_PLEB = WS_TOKW + (size_t)NEXP * ECAP * 4;
constexpr size_t WS_PBF = WS_PLEB + (size_t)T * D * 2;
static_assert(WS_PBF + (size_t)T * PLE * 2 <= WS_SC + SC_BYTES, "late overlays fit in SC");
constexpr size_t WS_H8 = WS_STT;
constexpr size_t WS_WGU8 = WS_HB;
constexpr size_t WS_WDN8 = WS_SC + SC_BYTES - (size_t)NEXP * D * EFF;
static_assert(WS_PBF + (size_t)T * PLE * 2 <= WS_WDN8 && WS_OB + (size_t)T * 1024 * 2 <= WS_WDN8 && WS_WDN8 % 256 == 0, "expert down weights behind the SC overlays");
constexpr size_t WS_X2B = WS_ZB;
constexpr size_t WS_H2B = WS_ZB;
constexpr size_t WS_Y0 = WS_SLOC;
static_assert(WS_END <= (size_t)1253000000, "workspace map within the guaranteed minimum");
constexpr int CW_BAR = 4096;
constexpr int CW_CNT = 16384;
constexpr int CW_ATTQ = 20480;

__device__ __forceinline__ unsigned f2bf(float f) { unsigned u = __builtin_bit_cast(unsigned, f); return (u + 0x7fffu + ((u >> 16) & 1u)) >> 16; }
__device__ __forceinline__ unsigned pk2(float lo, float hi) { return f2bf(lo) | (f2bf(hi) << 16); }
__device__ __forceinline__ unsigned pk4_fp8(float a, float b, float c, float d) { int w = 0; w = __builtin_amdgcn_cvt_pk_fp8_f32(a, b, w, false); w = __builtin_amdgcn_cvt_pk_fp8_f32(c, d, w, true); return (unsigned)w; }
__device__ __forceinline__ float bf2f(unsigned short b) { return __builtin_bit_cast(float, (unsigned)b << 16); }
__device__ __forceinline__ float bflo(unsigned w) { return __builtin_bit_cast(float, w << 16); }
__device__ __forceinline__ float bfhi(unsigned w) { return __builtin_bit_cast(float, w & 0xffff0000u); }
__device__ __forceinline__ unsigned cvt_pk_bf16(float lo, float hi) { unsigned r; asm volatile("v_cvt_pk_bf16_f32 %0, %1, %2" : "=v"(r) : "v"(lo), "v"(hi)); return r; }
#define DPP_I(v, ctrl) __builtin_amdgcn_update_dpp((int)(v), (int)(v), (ctrl), 0xF, 0xF, true)
#define DPP_F(v, ctrl) __builtin_bit_cast(float, __builtin_amdgcn_update_dpp(__builtin_bit_cast(int, (float)(v)), __builtin_bit_cast(int, (float)(v)), (ctrl), 0xF, 0xF, true))
constexpr int DPP_X1 = 0xB1, DPP_X2 = 0x4E, DPP_HM = 0x141, DPP_RM = 0x140;
__device__ __forceinline__ float sum8(float v) { v += DPP_F(v, DPP_X1); v += DPP_F(v, DPP_X2); v += DPP_F(v, DPP_HM); return v; }
__device__ __forceinline__ float sum16(float v) { v = sum8(v); v += DPP_F(v, DPP_RM); return v; }
__device__ __forceinline__ float sum32(float v) { v = sum16(v); auto r = __builtin_amdgcn_permlane16_swap(__float_as_uint(v), __float_as_uint(v), false, false); return __uint_as_float(r[0]) + __uint_as_float(r[1]); }
__device__ __forceinline__ float wave_sum(float v) { v = sum32(v); auto r = __builtin_amdgcn_permlane32_swap(__float_as_uint(v), __float_as_uint(v), false, false); return __uint_as_float(r[0]) + __uint_as_float(r[1]); }
__device__ __forceinline__ float wave_max(float v) {
    v = fmaxf(v, DPP_F(v, DPP_X1)); v = fmaxf(v, DPP_F(v, DPP_X2)); v = fmaxf(v, DPP_F(v, DPP_HM)); v = fmaxf(v, DPP_F(v, DPP_RM));
    { auto r = __builtin_amdgcn_permlane16_swap(__float_as_uint(v), __float_as_uint(v), false, false); v = fmaxf(__uint_as_float(r[0]), __uint_as_float(r[1])); }
    { auto r = __builtin_amdgcn_permlane32_swap(__float_as_uint(v), __float_as_uint(v), false, false); v = fmaxf(__uint_as_float(r[0]), __uint_as_float(r[1])); }
    return v;
}
__device__ __forceinline__ int wave_sum_i(int v) {
    v += DPP_I(v, DPP_X1); v += DPP_I(v, DPP_X2); v += DPP_I(v, DPP_HM); v += DPP_I(v, DPP_RM);
    { auto r = __builtin_amdgcn_permlane16_swap((unsigned)v, (unsigned)v, false, false); v = (int)(r[0] + r[1]); }
    { auto r = __builtin_amdgcn_permlane32_swap((unsigned)v, (unsigned)v, false, false); v = (int)(r[0] + r[1]); }
    return v;
}
__device__ __forceinline__ int opaque_tid() { int t = threadIdx.x; asm volatile("" : "+v"(t)); return t; }
__device__ __forceinline__ float sigmoidf_(float x) { return __builtin_amdgcn_rcpf(1.0f + __builtin_amdgcn_exp2f(-1.4426950408889634f * x)); }

#define XB_TMO      128
#define XB_XCNT(j)  (256  + 64 * (j))
#define XB_XSUB(j)  (1280 + 64 * (j))
#define XB_XGEN(j)  (2304 + 64 * (j))
#define XB_TOP      3328
#define XB_TOPGEN   3392
#define XCD_BAR_WORDS 3456
#define XB_SPIN_CAP (1u << 18)
__device__ __forceinline__ unsigned xb_ld(unsigned* p)              { return __hip_atomic_load(p, __ATOMIC_RELAXED, __HIP_MEMORY_SCOPE_AGENT); }
__device__ __forceinline__ unsigned xb_add(unsigned* p, unsigned v) { return __hip_atomic_fetch_add(p, v, __ATOMIC_RELAXED, __HIP_MEMORY_SCOPE_AGENT); }
__device__ __forceinline__ unsigned xb_xcc_id() { return (unsigned)__builtin_amdgcn_s_getreg((3 << 11) | 20) & 0xFu; }
#define XB_SPIN(cond, bar) do { unsigned _sp = 0; while (cond) { __builtin_amdgcn_s_sleep(1); \
    if ((++_sp & 255u) == 0u) { if (xb_ld(&(bar)[XB_TMO])) break; if (_sp > XB_SPIN_CAP) { atomicAdd(&(bar)[XB_TMO], 1u); break; } } } } while (0)
struct XcdBarrier { unsigned* bar; unsigned x; volatile LAS unsigned* st; };
__device__ __forceinline__ XcdBarrier xcd_barrier_post(unsigned* bar, volatile LAS unsigned* st) {
    XcdBarrier b; b.bar = bar; b.x = xb_xcc_id(); b.st = st;
    if (threadIdx.x == 0) (void)xb_add(&bar[XB_XCNT(b.x)], 1u);
    return b;
}
__device__ __forceinline__ void xcd_barrier_complete(unsigned* bar, unsigned x, unsigned& nloc, unsigned& nx) {
    const unsigned G = gridDim.x * gridDim.y * gridDim.z;
    unsigned sum, cnt, mine, sp = 0u;
    for (;;) {
        sum = 0u; cnt = 0u; mine = 0u;
#pragma unroll
        for (unsigned j = 0; j < 16; ++j) { const unsigned c = xb_ld(&bar[XB_XCNT(j)]); sum += c; cnt += (c > 0u) ? 1u : 0u; mine = (j == x) ? c : mine; }
        if (sum == G) break;
        __builtin_amdgcn_s_sleep(1);
        if ((++sp & 255u) == 0u) { if (xb_ld(&bar[XB_TMO])) break; if (sp > XB_SPIN_CAP) { atomicAdd(&bar[XB_TMO], 1u); break; } }
    }
    nloc = mine > 0u ? mine : 1u; nx = cnt > 0u ? cnt : 1u;
}
__device__ __forceinline__ void xcd_barrier(const XcdBarrier& b) {
    asm volatile("s_waitcnt vmcnt(0)" ::: "memory");
    __syncthreads();
    if (threadIdx.x == 0) {
        unsigned* bar = b.bar;
        __builtin_amdgcn_s_waitcnt(0);
        unsigned nloc = b.st[0], nx = b.st[1];
        if (nloc == 0u) { xcd_barrier_complete(bar, b.x, nloc, nx); b.st[0] = nloc; b.st[1] = nx; }
        const unsigned old = xb_add(&bar[XB_XSUB(b.x)], 1u);
        const unsigned gen = old / nloc;
        if (old + 1u == (gen + 1u) * nloc) {
            __builtin_amdgcn_fence(__ATOMIC_RELEASE, "agent");
            asm volatile("s_waitcnt vmcnt(0)" ::: "memory");
            const unsigned og = xb_add(&bar[XB_TOP], 1u);
            const unsigned tg = og / nx;
            if (og + 1u == (tg + 1u) * nx) xb_add(&bar[XB_TOPGEN], 1u);
            else XB_SPIN(xb_ld(&bar[XB_TOPGEN]) == tg, bar);
            __builtin_amdgcn_fence(__ATOMIC_ACQUIRE, "agent");
            xb_add(&bar[XB_XGEN(b.x)], 1u);
            asm volatile("s_waitcnt vmcnt(0)" ::: "memory");
        } else {
            XB_SPIN(xb_ld(&bar[XB_XGEN(b.x)]) == gen, bar);
            __builtin_amdgcn_fence(__ATOMIC_ACQUIRE, "agent");
            asm volatile("s_waitcnt vmcnt(0)" ::: "memory");
        }
    }
    __syncthreads();
}

namespace pg8 {
constexpr int BM = 256, BK = 64, HALF = 128, HTB = HALF * BK * 2, STAGE_BYTES = 8 * HTB, NXCD = 8, WGM = 8;
__host__ __device__ __forceinline__ int lds_byte(int r, int c) { const int st = (r >> 4) * 2 + (c >> 5), rr = r & 15, cc = c & 31, ob = rr * 64 + cc * 2; return st * 1024 + (ob ^ (((ob >> 9) & 1) << 5)); }
__host__ __device__ __forceinline__ void stage_rc(int b, int& R, int& C) { const int st = b / 1024, sb = b % 1024, swz = sb ^ (((sb >> 9) & 1) << 5); R = (st >> 1) * 16 + swz / 64; C = (st & 1) * 32 + (swz % 64) / 2; }
__host__ __device__ __forceinline__ int perm32(int rho) { const int n = rho >> 4, i = rho & 15; return 8 * (i >> 2) + 4 * n + (i & 3); }

struct Unit { int pm, pn; int e, mt; };
struct Gemm { const bf16* A; const bf16* Bt; int K; };

typedef int v8i __attribute__((ext_vector_type(8)));
typedef int v4i __attribute__((ext_vector_type(4)));
struct Gemm8 { const unsigned char* A; const unsigned char* Bt; int K; int sa, sb; };
struct F2x { bf16x8 v[2]; __device__ __forceinline__ bf16x8& operator[](int i) { return v[i]; } __device__ __forceinline__ const bf16x8& operator[](int i) const { return v[i]; } };
__host__ __device__ __forceinline__ int lds_byte8(int r, int g) { const int st = (r >> 4) * 2 + (g >> 1), ob = (r & 15) * 64 + 32 * (g & 1); return st * 1024 + (ob ^ (((ob >> 9) & 1) << 5)); }
struct StaticOrder {
    int nM, nN, nwg, G, c;
    __device__ void init(int M, int N, int G_, int c_) { nM = M / BM; nN = N / BM; nwg = nM * nN; G = G_; c = c_; }
    __device__ __forceinline__ bool next(int i, Unit& u) const {
        const long L = (long)i * G + c; if (L >= nwg) return false;
        int wgid = (int)L; { const int q = nwg / NXCD, r = nwg % NXCD, xcd = wgid % NXCD, off = wgid / NXCD; wgid = (xcd < r ? xcd * (q + 1) : r * (q + 1) + (xcd - r) * q) + off; }
        const int nig = WGM * nN, gid = wgid / nig, fm = gid * WGM, gsz = (nM - fm) < WGM ? (nM - fm) : WGM;
        u.pm = fm + ((wgid % nig) % gsz); u.pn = (wgid % nig) / gsz; u.e = 0; u.mt = 0; return true;
    }
    __device__ __forceinline__ void rows(const Unit&, int, int, unsigned (&)[2][2]) const {}
};

template <class Epi, class Sched, bool GATHER = false>
__device__ __forceinline__ void gemm_phase(LAS unsigned char* lds, const Gemm g, const Sched& S, const Epi& E) {
    int tid_ = threadIdx.x; asm volatile("" : "+v"(tid_));
    const int tid = tid_, wid = __builtin_amdgcn_readfirstlane(tid >> 6), lane = tid & 63, wr = wid >> 2, wc = wid & 3, fr = lane & 15, fq = lane >> 4;
    const int K = g.K, nt = K / BK;
    unsigned voffA[2], voffB[2]; int RA[2], CA[2];
#pragma unroll
    for (int i = 0; i < 2; ++i) { int R, C; stage_rc(tid * 16 + i * 8192, R, C); const int Rb = Epi::PERM ? ((R & ~31) + perm32(R & 31)) : R;
        RA[i] = R; CA[i] = C; voffA[i] = (unsigned)(R * K + C) * 2u; voffB[i] = (unsigned)(Rb * K + C) * 2u; }
    const size_t kstep = (size_t)(BK * 2);
    const size_t hstep = (size_t)HALF * K * 2;
    const size_t tstep = 2 * hstep;
    const unsigned ldsw = (unsigned)wid * 1024u;
    const int aoff = lds_byte(wr * 64 + fr, fq * 8), boff = lds_byte(wc * 32 + fr, fq * 8);
#define PG8_SA(b, h) (((b) * 2 + (h)) * HTB)
#define PG8_SB(b, h) ((4 + (b) * 2 + (h)) * HTB)
#define PG8_STAGE(bufoff, gbase, voff) do { _Pragma("unroll") for (int _i = 0; _i < 2; ++_i) \
        __builtin_amdgcn_global_load_lds((const unsigned*)((const char*)(gbase) + (voff)[_i]), (LAS unsigned*)(lds + (bufoff) + ldsw + _i * 8192), 16, 0, 0); } while (0)
#define PG8_STAGE_A(bufoff, gbase, h, AO) do { if constexpr (GATHER) { PG8_STAGE(bufoff, gbase, AO[h]); } else { PG8_STAGE(bufoff, (gbase) + (h) * hstep, voffA); } } while (0)
#define PG8_LDA(dst, b, h) do { _Pragma("unroll") for (int m = 0; m < 4; ++m) _Pragma("unroll") for (int k = 0; k < 2; ++k) dst[m][k] = *(const LAS bf16x8*)(lds + PG8_SA(b, h) + aoff + m * 2048 + k * 1024); } while (0)
#define PG8_LDB(dst, b, h) do { _Pragma("unroll") for (int n = 0; n < 2; ++n) _Pragma("unroll") for (int k = 0; k < 2; ++k) dst[n][k] = *(const LAS bf16x8*)(lds + PG8_SB(b, h) + boff + n * 2048 + k * 1024); } while (0)
#define PG8_MMA(ai, bj, At, Bt) do { __builtin_amdgcn_s_setprio(1); _Pragma("unroll") for (int m = 0; m < 4; ++m) _Pragma("unroll") for (int n = 0; n < 2; ++n) _Pragma("unroll") for (int k = 0; k < 2; ++k) \
        acc[ai][bj][m][n] = __builtin_amdgcn_mfma_f32_16x16x32_bf16(Bt[n][k], At[m][k], acc[ai][bj][m][n], 0, 0, 0); __builtin_amdgcn_s_setprio(0); } while (0)
#define PG8_WAIT_V(n) asm volatile("s_waitcnt vmcnt(" #n ")" ::: "memory")
#define PG8_WAIT_L(n) asm volatile("s_waitcnt lgkmcnt(" #n ")" ::: "memory")
#define PG8_BAR __builtin_amdgcn_s_barrier()
#define PG8_SCHED __builtin_amdgcn_sched_barrier(0)
    Unit cur, nxt; int ui = 0;
    if (!S.next(0, cur)) return;
    f32x4 acc[2][2][4][2];
#pragma unroll
    for (int a = 0; a < 2; ++a)
#pragma unroll
        for (int b = 0; b < 2; ++b)
#pragma unroll
            for (int m = 0; m < 4; ++m)
#pragma unroll
                for (int n = 0; n < 2; ++n) acc[a][b][m][n] = (f32x4){0.f, 0.f, 0.f, 0.f};
    bf16x8 At[4][2], B0[2][2], B1[2][2];
    unsigned aoc[2][2], aon[2][2];
    const char* cA; const char* cB = (const char*)g.Bt + (size_t)cur.pn * tstep;
    if constexpr (GATHER) { cA = (const char*)g.A; S.rows(cur, RA[0], RA[1], aoc);
#pragma unroll
        for (int h = 0; h < 2; ++h)
#pragma unroll
            for (int i = 0; i < 2; ++i) aoc[h][i] += (unsigned)CA[i] * 2u; }
    else { cA = (const char*)g.A + (size_t)cur.pm * tstep;
#pragma unroll
        for (int i = 0; i < 2; ++i) { aoc[0][i] = 0u; aoc[1][i] = 0u; } }
    PG8_STAGE(PG8_SB(0, 0), cB, voffB); PG8_STAGE(PG8_SB(0, 1), cB + hstep, voffB); PG8_STAGE_A(PG8_SA(0, 0), cA, 0, aoc); PG8_STAGE_A(PG8_SA(0, 1), cA, 1, aoc);
    if (wr == 1) PG8_BAR;
    PG8_WAIT_V(2); PG8_BAR;
    PG8_STAGE(PG8_SB(1, 0), cB + kstep, voffB); PG8_STAGE_A(PG8_SA(1, 0), cA + kstep, 0, aoc); PG8_STAGE(PG8_SB(1, 1), cB + hstep + kstep, voffB);
    PG8_WAIT_V(6); PG8_BAR;
    for (;;) {
        const bool has_next = S.next(ui + 1, nxt);
        const char* nA; const char* nB = has_next ? (const char*)g.Bt + (size_t)nxt.pn * tstep : cB;
        if constexpr (GATHER) { nA = cA;
            if (has_next) { S.rows(nxt, RA[0], RA[1], aon);
#pragma unroll
                for (int h = 0; h < 2; ++h)
#pragma unroll
                    for (int i = 0; i < 2; ++i) aon[h][i] += (unsigned)CA[i] * 2u; }
            else {
#pragma unroll
                for (int h = 0; h < 2; ++h)
#pragma unroll
                    for (int i = 0; i < 2; ++i) aon[h][i] = aoc[h][i]; } }
        else { nA = has_next ? (const char*)g.A + (size_t)nxt.pm * tstep : cA;
#pragma unroll
            for (int h = 0; h < 2; ++h)
#pragma unroll
                for (int i = 0; i < 2; ++i) aon[h][i] = aoc[h][i]; }
#pragma nounroll
        for (int t = 0; t < nt; t += 2) {
            const bool last = (t == nt - 2);
            const char* a1 = cA + (size_t)(t + 1) * kstep;
            const char* a2 = last ? nA : cA + (size_t)(t + 2) * kstep; const char* b2 = last ? nB : cB + (size_t)(t + 2) * kstep;
            const char* a3 = a2 + kstep; const char* b3 = b2 + kstep;
            unsigned ao2[2][2];
#pragma unroll
            for (int h = 0; h < 2; ++h)
#pragma unroll
                for (int i = 0; i < 2; ++i) ao2[h][i] = (GATHER && last) ? aon[h][i] : aoc[h][i];
            PG8_LDB(B0, 0, 0); PG8_LDB(B1, 0, 1); PG8_SCHED; PG8_LDA(At, 0, 0); PG8_STAGE_A(PG8_SA(1, 1), a1, 1, aoc);
            PG8_WAIT_V(8); PG8_WAIT_L(0); PG8_BAR; PG8_MMA(0, 0, At, B0); PG8_MMA(0, 1, At, B1); PG8_BAR; PG8_SCHED;
            PG8_LDA(At, 0, 1); PG8_STAGE(PG8_SB(0, 0), b2, voffB); PG8_STAGE(PG8_SB(0, 1), b2 + hstep, voffB); PG8_STAGE_A(PG8_SA(0, 0), a2, 0, ao2);
            PG8_WAIT_V(8); PG8_WAIT_L(0); PG8_BAR; PG8_MMA(1, 0, At, B0); PG8_MMA(1, 1, At, B1); PG8_BAR; PG8_SCHED;
            PG8_LDB(B0, 1, 0); PG8_LDB(B1, 1, 1); PG8_SCHED; PG8_LDA(At, 1, 0); PG8_STAGE_A(PG8_SA(0, 1), a2, 1, ao2);
            PG8_WAIT_V(8); PG8_WAIT_L(0); PG8_BAR; PG8_MMA(0, 0, At, B0); PG8_MMA(0, 1, At, B1); PG8_BAR; PG8_SCHED;
            PG8_LDA(At, 1, 1); PG8_STAGE(PG8_SB(1, 0), b3, voffB); PG8_STAGE(PG8_SB(1, 1), b3 + hstep, voffB); PG8_STAGE_A(PG8_SA(1, 0), a3, 0, ao2);
            PG8_WAIT_V(8); PG8_WAIT_L(0); PG8_BAR; PG8_MMA(1, 0, At, B0); PG8_MMA(1, 1, At, B1); PG8_BAR; PG8_SCHED;
        }
        if (wr == 0) PG8_BAR;
        asm volatile("s_nop 15\n\ts_nop 7" ::: "memory");
        E(acc, cur, wr, wc, fr, fq);
        if (!has_next) break;
#pragma unroll
        for (int a = 0; a < 2; ++a)
#pragma unroll
            for (int b = 0; b < 2; ++b)
#pragma unroll
                for (int m = 0; m < 4; ++m)
#pragma unroll
                    for (int n = 0; n < 2; ++n) acc[a][b][m][n] = (f32x4){0.f, 0.f, 0.f, 0.f};
        cur = nxt; cA = nA; cB = nB; ++ui;
#pragma unroll
        for (int h = 0; h < 2; ++h)
#pragma unroll
            for (int i = 0; i < 2; ++i) aoc[h][i] = aon[h][i];
        if (wr == 1) PG8_BAR;
    }
    PG8_WAIT_V(0);
    PG8_BAR;
#undef PG8_SA
#undef PG8_SB
#undef PG8_STAGE
#undef PG8_STAGE_A
#undef PG8_LDA
#undef PG8_LDB
#undef PG8_MMA
#undef PG8_WAIT_V
#undef PG8_WAIT_L
#undef PG8_BAR
#undef PG8_SCHED
}

template <class Epi, class Sched, bool GATHER = false>
__device__ __forceinline__ void gemm_phase8(LAS unsigned char* lds, const Gemm8 g, const Sched& S, const Epi& E) {
    int tid_ = threadIdx.x; asm volatile("" : "+v"(tid_));
    const int tid = tid_, wid = __builtin_amdgcn_readfirstlane(tid >> 6), lane = tid & 63, wr = wid >> 2, wc = wid & 3, fr = lane & 15, fq = lane >> 4;
    const int K = g.K, nt = K / BK;
    unsigned voffA[2], voffB[2]; int RA[2], CA[2];
#pragma unroll
    for (int i = 0; i < 2; ++i) { int R, C; stage_rc(tid * 16 + i * 8192, R, C); const int Rb = Epi::PERM ? ((R & ~31) + perm32(R & 31)) : R;
        RA[i] = R; CA[i] = C; voffA[i] = (unsigned)(R * K + C) * 2u; voffB[i] = (unsigned)(Rb * K + C) * 2u; }
    const size_t kstep = (size_t)(BK * 2);
    const size_t hstep = (size_t)HALF * K * 2;
    const size_t tstep = 2 * hstep;
    const unsigned ldsw = (unsigned)wid * 1024u;
    const int aoff = lds_byte8(wr * 64 + fr, fq), boff = lds_byte8(wc * 32 + fr, fq);
#define PG8_SA(b, h) (((b) * 2 + (h)) * HTB)
#define PG8_SB(b, h) ((4 + (b) * 2 + (h)) * HTB)
#define PG8_STAGE(bufoff, gbase, voff) do { _Pragma("unroll") for (int _i = 0; _i < 2; ++_i) \
        __builtin_amdgcn_global_load_lds((const unsigned*)((const char*)(gbase) + (voff)[_i]), (LAS unsigned*)(lds + (bufoff) + ldsw + _i * 8192), 16, 0, 0); } while (0)
#define PG8_STAGE_A(bufoff, gbase, h, AO) do { if constexpr (GATHER) { PG8_STAGE(bufoff, gbase, AO[h]); } else { PG8_STAGE(bufoff, (gbase) + (h) * hstep, voffA); } } while (0)
#define PG8_LD32(p) __builtin_shufflevector(*(const LAS v4i*)(p), *(const LAS v4i*)((p) + 16), 0, 1, 2, 3, 4, 5, 6, 7)
#define PG8_LDA(dst, b, h) do { _Pragma("unroll") for (int m = 0; m < 4; ++m) dst[m] = PG8_LD32(lds + PG8_SA(b, h) + aoff + m * 2048); } while (0)
#define PG8_LDB(dst, b, h) do { _Pragma("unroll") for (int n = 0; n < 2; ++n) dst[n] = PG8_LD32(lds + PG8_SB(b, h) + boff + n * 2048); } while (0)
#define PG8_MMA(ai, bj, At, Bt) do { __builtin_amdgcn_s_setprio(1); _Pragma("unroll") for (int m = 0; m < 4; ++m) _Pragma("unroll") for (int n = 0; n < 2; ++n) \
        asm volatile("v_mfma_scale_f32_16x16x128_f8f6f4 %0, %1, %2, %0, %3, %4 op_sel_hi:[0,0,0]" : "+v"(acc[ai][bj][m][n]) : "v"(Bt[n]), "v"(At[m]), "v"(vsb), "v"(vsa)); __builtin_amdgcn_s_setprio(0); } while (0)
#define PG8_WAIT_V(n) asm volatile("s_waitcnt vmcnt(" #n ")" ::: "memory")
#define PG8_WAIT_L(n) asm volatile("s_waitcnt lgkmcnt(" #n ")" ::: "memory")
#define PG8_BAR __builtin_amdgcn_s_barrier()
#define PG8_SCHED __builtin_amdgcn_sched_barrier(0)
    Unit cur, nxt; int ui = 0;
    if (!S.next(0, cur)) return;
    f32x4 acc[2][2][4][2];
#pragma unroll
    for (int a = 0; a < 2; ++a)
#pragma unroll
        for (int b = 0; b < 2; ++b)
#pragma unroll
            for (int m = 0; m < 4; ++m)
#pragma unroll
                for (int n = 0; n < 2; ++n) acc[a][b][m][n] = (f32x4){0.f, 0.f, 0.f, 0.f};
    v8i At[4], B0[2], B1[2]; const int vsa = g.sa, vsb = g.sb;
    unsigned aoc[2][2], aon[2][2];
    const char* cA; const char* cB = (const char*)g.Bt + (size_t)cur.pn * tstep;
    if constexpr (GATHER) { cA = (const char*)g.A; S.rows(cur, RA[0], RA[1], aoc);
#pragma unroll
        for (int h = 0; h < 2; ++h)
#pragma unroll
            for (int i = 0; i < 2; ++i) aoc[h][i] += (unsigned)CA[i] * 2u; }
    else { cA = (const char*)g.A + (size_t)cur.pm * tstep;
#pragma unroll
        for (int i = 0; i < 2; ++i) { aoc[0][i] = 0u; aoc[1][i] = 0u; } }
    PG8_STAGE(PG8_SB(0, 0), cB, voffB); PG8_STAGE(PG8_SB(0, 1), cB + hstep, voffB); PG8_STAGE_A(PG8_SA(0, 0), cA, 0, aoc); PG8_STAGE_A(PG8_SA(0, 1), cA, 1, aoc);
    if (wr == 1) PG8_BAR;
    PG8_WAIT_V(2); PG8_BAR;
    PG8_STAGE(PG8_SB(1, 0), cB + kstep, voffB); PG8_STAGE_A(PG8_SA(1, 0), cA + kstep, 0, aoc); PG8_STAGE(PG8_SB(1, 1), cB + hstep + kstep, voffB);
    PG8_WAIT_V(6); PG8_BAR;
    for (;;) {
        const bool has_next = S.next(ui + 1, nxt);
        const char* nA; const char* nB = has_next ? (const char*)g.Bt + (size_t)nxt.pn * tstep : cB;
        if constexpr (GATHER) { nA = cA;
            if (has_next) { S.rows(nxt, RA[0], RA[1], aon);
#pragma unroll
                for (int h = 0; h < 2; ++h)
#pragma unroll
                    for (int i = 0; i < 2; ++i) aon[h][i] += (unsigned)CA[i] * 2u; }
            else {
#pragma unroll
                for (int h = 0; h < 2; ++h)
#pragma unroll
                    for (int i = 0; i < 2; ++i) aon[h][i] = aoc[h][i]; } }
        else { nA = has_next ? (const char*)g.A + (size_t)nxt.pm * tstep : cA;
#pragma unroll
            for (int h = 0; h < 2; ++h)
#pragma unroll
                for (int i = 0; i < 2; ++i) aon[h][i] = aoc[h][i]; }
#pragma nounroll
        for (int t = 0; t < nt; t += 2) {
            const bool last = (t == nt - 2);
            const char* a1 = cA + (size_t)(t + 1) * kstep;
            const char* a2 = last ? nA : cA + (size_t)(t + 2) * kstep; const char* b2 = last ? nB : cB + (size_t)(t + 2) * kstep;
            const char* a3 = a2 + kstep; const char* b3 = b2 + kstep;
            unsigned ao2[2][2];
#pragma unroll
            for (int h = 0; h < 2; ++h)
#pragma unroll
                for (int i = 0; i < 2; ++i) ao2[h][i] = (GATHER && last) ? aon[h][i] : aoc[h][i];
            PG8_LDB(B0, 0, 0); PG8_LDB(B1, 0, 1); PG8_SCHED; PG8_LDA(At, 0, 0); PG8_STAGE_A(PG8_SA(1, 1), a1, 1, aoc);
            PG8_WAIT_V(8); PG8_WAIT_L(0); PG8_BAR; PG8_MMA(0, 0, At, B0); PG8_MMA(0, 1, At, B1); PG8_BAR; PG8_SCHED;
            PG8_LDA(At, 0, 1); PG8_STAGE(PG8_SB(0, 0), b2, voffB); PG8_STAGE(PG8_SB(0, 1), b2 + hstep, voffB); PG8_STAGE_A(PG8_SA(0, 0), a2, 0, ao2);
            PG8_WAIT_V(8); PG8_WAIT_L(0); PG8_BAR; PG8_MMA(1, 0, At, B0); PG8_MMA(1, 1, At, B1); PG8_BAR; PG8_SCHED;
            PG8_LDB(B0, 1, 0); PG8_LDB(B1, 1, 1); PG8_SCHED; PG8_LDA(At, 1, 0); PG8_STAGE_A(PG8_SA(0, 1), a2, 1, ao2);
            PG8_WAIT_V(8); PG8_WAIT_L(0); PG8_BAR; PG8_MMA(0, 0, At, B0); PG8_MMA(0, 1, At, B1); PG8_BAR; PG8_SCHED;
            PG8_LDA(At, 1, 1); PG8_STAGE(PG8_SB(1, 0), b3, voffB); PG8_STAGE(PG8_SB(1, 1), b3 + hstep, voffB); PG8_STAGE_A(PG8_SA(1, 0), a3, 0, ao2);
            PG8_WAIT_V(8); PG8_WAIT_L(0); PG8_BAR; PG8_MMA(1, 0, At, B0); PG8_MMA(1, 1, At, B1); PG8_BAR; PG8_SCHED;
        }
        if (wr == 0) PG8_BAR;
        asm volatile("s_nop 15\n\ts_nop 15\n\ts_nop 15" ::: "memory");
        { const int t2 = opaque_tid(), w2 = __builtin_amdgcn_readfirstlane(t2 >> 6), l2 = t2 & 63;
          E(acc, cur, w2 >> 2, w2 & 3, l2 & 15, l2 >> 4); }
        if (!has_next) break;
#pragma unroll
        for (int a = 0; a < 2; ++a)
#pragma unroll
            for (int b = 0; b < 2; ++b)
#pragma unroll
                for (int m = 0; m < 4; ++m)
#pragma unroll
                    for (int n = 0; n < 2; ++n) acc[a][b][m][n] = (f32x4){0.f, 0.f, 0.f, 0.f};
        cur = nxt; cA = nA; cB = nB; ++ui;
#pragma unroll
        for (int h = 0; h < 2; ++h)
#pragma unroll
            for (int i = 0; i < 2; ++i) aoc[h][i] = aon[h][i];
        if (wr == 1) PG8_BAR;
    }
    PG8_WAIT_V(0);
    PG8_BAR;
#undef PG8_SA
#undef PG8_SB
#undef PG8_STAGE
#undef PG8_STAGE_A
#undef PG8_LDA
#undef PG8_LD32
#undef PG8_LDB
#undef PG8_MMA
#undef PG8_WAIT_V
#undef PG8_WAIT_L
#undef PG8_BAR
#undef PG8_SCHED
}

struct EpiBf16Skip {
    static constexpr bool PERM = true;
    bf16* O; int ldc, pn_skip, skip;
    __device__ __forceinline__ void operator()(const f32x4 (&acc)[2][2][4][2], const Unit& u, int wr, int wc, int fr, int fq) const {
        const int row0 = u.pm * BM + wr * 64 + fr, col0 = u.pn * BM + wc * 32 + 8 * fq + (u.pn >= pn_skip ? skip : 0);
#pragma unroll
        for (int ai = 0; ai < 2; ++ai)
#pragma unroll
            for (int m = 0; m < 4; ++m) { bf16* rowp = O + (size_t)(row0 + ai * HALF + m * 16) * ldc + col0;
#pragma unroll
                for (int bj = 0; bj < 2; ++bj) { const f32x4 v0 = acc[ai][bj][m][0], v1 = acc[ai][bj][m][1];
                    v4u w; w.x = cvt_pk_bf16(v0[0], v0[1]); w.y = cvt_pk_bf16(v0[2], v0[3]); w.z = cvt_pk_bf16(v1[0], v1[1]); w.w = cvt_pk_bf16(v1[2], v1[3]);
                    *(v4u*)(rowp + bj * HALF) = w; } }
    }
};
struct EpiFp8 {
    static constexpr bool PERM = true;
    unsigned char* O; int ldc;
    __device__ __forceinline__ void operator()(const f32x4 (&acc)[2][2][4][2], const Unit& u, int wr, int wc, int fr, int fq) const {
        const int row0 = u.pm * BM + wr * 64 + fr, col0 = u.pn * BM + wc * 32 + 8 * fq;
#pragma unroll
        for (int ai = 0; ai < 2; ++ai)
#pragma unroll
            for (int m = 0; m < 4; ++m) { unsigned char* rowp = O + (size_t)(row0 + ai * HALF + m * 16) * ldc + col0;
#pragma unroll
                for (int bj = 0; bj < 2; ++bj) { const f32x4 v0 = acc[ai][bj][m][0] * 8.0f, v1 = acc[ai][bj][m][1] * 8.0f;
                    v2u w; w.x = pk4_fp8(v0[0], v0[1], v0[2], v0[3]); w.y = pk4_fp8(v1[0], v1[1], v1[2], v1[3]);
                    *(v2u*)(rowp + bj * HALF) = w; } }
    }
};
struct EpiBf16 {
    static constexpr bool PERM = true;
    bf16* O; int ldc;
    __device__ __forceinline__ void operator()(const f32x4 (&acc)[2][2][4][2], const Unit& u, int wr, int wc, int fr, int fq) const {
        const int row0 = u.pm * BM + wr * 64 + fr, col0 = u.pn * BM + wc * 32 + 8 * fq;
#pragma unroll
        for (int ai = 0; ai < 2; ++ai)
#pragma unroll
            for (int m = 0; m < 4; ++m) { bf16* rowp = O + (size_t)(row0 + ai * HALF + m * 16) * ldc + col0;
#pragma unroll
                for (int bj = 0; bj < 2; ++bj) { const f32x4 v0 = acc[ai][bj][m][0], v1 = acc[ai][bj][m][1];
                    v4u w; w.x = cvt_pk_bf16(v0[0], v0[1]); w.y = cvt_pk_bf16(v0[2], v0[3]); w.z = cvt_pk_bf16(v1[0], v1[1]); w.w = cvt_pk_bf16(v1[2], v1[3]);
                    *(v4u*)(rowp + bj * HALF) = w; } }
    }
};
struct EpiF32 {
    static constexpr bool PERM = false;
    float* C; int ldc;
    __device__ __forceinline__ void operator()(const f32x4 (&acc)[2][2][4][2], const Unit& u, int wr, int wc, int fr, int fq) const {
        const int row0 = u.pm * BM + wr * 64 + fr, col0 = u.pn * BM + wc * 32 + 4 * fq;
#pragma unroll
        for (int ai = 0; ai < 2; ++ai)
#pragma unroll
            for (int m = 0; m < 4; ++m) { float* rowp = C + (size_t)(row0 + ai * HALF + m * 16) * ldc + col0;
#pragma unroll
                for (int bj = 0; bj < 2; ++bj)
#pragma unroll
                    for (int n = 0; n < 2; ++n) *(f32x4*)(rowp + bj * HALF + n * 16) = acc[ai][bj][m][n]; }
    }
};
struct EpiResF32 {
    static constexpr bool PERM = false;
    const float* base; float* out; int ldc;
    __device__ __forceinline__ void operator()(const f32x4 (&acc)[2][2][4][2], const Unit& u, int wr, int wc, int fr, int fq) const {
        const int row0 = u.pm * BM + wr * 64 + fr, col0 = u.pn * BM + wc * 32 + 4 * fq;
#pragma unroll
        for (int ai = 0; ai < 2; ++ai)
#pragma unroll
            for (int m = 0; m < 4; ++m) { const size_t off = (size_t)(row0 + ai * HALF + m * 16) * ldc + col0;
#pragma unroll
                for (int bj = 0; bj < 2; ++bj)
#pragma unroll
                    for (int n = 0; n < 2; ++n) { const f32x4 b = *(const f32x4*)(base + off + bj * HALF + n * 16); *(f32x4*)(out + off + bj * HALF + n * 16) = b + acc[ai][bj][m][n]; } }
    }
};
struct EpiResBf16P {
    static constexpr bool PERM = true;
    const float* base; bf16* out; int ldc;
    __device__ __forceinline__ void operator()(const f32x4 (&acc)[2][2][4][2], const Unit& u, int wr, int wc, int fr, int fq) const {
        const int row0 = u.pm * BM + wr * 64 + fr, col0 = u.pn * BM + wc * 32 + 8 * fq;
#pragma unroll
        for (int ai = 0; ai < 2; ++ai)
#pragma unroll
            for (int m = 0; m < 4; ++m) { const size_t off = (size_t)(row0 + ai * HALF + m * 16) * ldc + col0;
#pragma unroll
                for (int bj = 0; bj < 2; ++bj) { const f32x4 v0 = *(const f32x4*)(base + off + bj * HALF) + acc[ai][bj][m][0], v1 = *(const f32x4*)(base + off + bj * HALF + 4) + acc[ai][bj][m][1];
                    v4u w; w.x = cvt_pk_bf16(v0[0], v0[1]); w.y = cvt_pk_bf16(v0[2], v0[3]); w.z = cvt_pk_bf16(v1[0], v1[1]); w.w = cvt_pk_bf16(v1[2], v1[3]);
                    *(v4u*)(out + off + bj * HALF) = w; } }
    }
};
struct EpiResF32P {
    static constexpr bool PERM = true;
    const float* base; float* out; int ldc;
    __device__ __forceinline__ void operator()(const f32x4 (&acc)[2][2][4][2], const Unit& u, int wr, int wc, int fr, int fq) const {
        const int row0 = u.pm * BM + wr * 64 + fr, col0 = u.pn * BM + wc * 32 + 8 * fq;
#pragma unroll
        for (int ai = 0; ai < 2; ++ai)
#pragma unroll
            for (int m = 0; m < 4; ++m) { const size_t off = (size_t)(row0 + ai * HALF + m * 16) * ldc + col0;
#pragma unroll
                for (int bj = 0; bj < 2; ++bj)
#pragma unroll
                    for (int n = 0; n < 2; ++n) { const f32x4 b = *(const f32x4*)(base + off + bj * HALF + n * 4); *(f32x4*)(out + off + bj * HALF + n * 4) = b + acc[ai][bj][m][n]; } }
    }
};
struct EpiGateMix {
    static constexpr bool PERM = true;
    const unsigned char* YA; const unsigned char* YB; unsigned char* U; const float* bias;
    __device__ __forceinline__ void operator()(const f32x4 (&acc)[2][2][4][2], const Unit& u, int wr, int wc, int fr, int fq) const {
        const int row0 = u.pm * BM + wr * 64 + fr, col0 = u.pn * HALF + wc * 32 + 8 * fq;
        const f32x4 ba0 = *(const f32x4*)(bias + col0), ba1 = *(const f32x4*)(bias + col0 + 4), bb0 = *(const f32x4*)(bias + D + col0), bb1 = *(const f32x4*)(bias + D + col0 + 4);
#pragma unroll
        for (int ai = 0; ai < 2; ++ai)
#pragma unroll
            for (int m = 0; m < 4; ++m) { const size_t off = (size_t)(row0 + ai * HALF + m * 16) * D + col0;
                const v2u ya = *(const v2u*)(YA + off), yb = *(const v2u*)(YB + off);
                const f32x4 a0 = acc[ai][0][m][0] + ba0, a1 = acc[ai][0][m][1] + ba1, b0 = acc[ai][1][m][0] + bb0, b1 = acc[ai][1][m][1] + bb1;
                float o[8];
                float va[8], vb[8];
                { const auto p0 = __builtin_amdgcn_cvt_pk_f32_fp8((int)ya.x, false), p1 = __builtin_amdgcn_cvt_pk_f32_fp8((int)ya.x, true), p2 = __builtin_amdgcn_cvt_pk_f32_fp8((int)ya.y, false), p3 = __builtin_amdgcn_cvt_pk_f32_fp8((int)ya.y, true);
                  va[0] = p0[0]; va[1] = p0[1]; va[2] = p1[0]; va[3] = p1[1]; va[4] = p2[0]; va[5] = p2[1]; va[6] = p3[0]; va[7] = p3[1]; }
                { const auto p0 = __builtin_amdgcn_cvt_pk_f32_fp8((int)yb.x, false), p1 = __builtin_amdgcn_cvt_pk_f32_fp8((int)yb.x, true), p2 = __builtin_amdgcn_cvt_pk_f32_fp8((int)yb.y, false), p3 = __builtin_amdgcn_cvt_pk_f32_fp8((int)yb.y, true);
                  vb[0] = p0[0]; vb[1] = p0[1]; vb[2] = p1[0]; vb[3] = p1[1]; vb[4] = p2[0]; vb[5] = p2[1]; vb[6] = p3[0]; vb[7] = p3[1]; }
#pragma unroll
                for (int j = 0; j < 8; ++j) { const float ga = sigmoidf_(j < 4 ? a0[j & 3] : a1[j & 3]), gb = sigmoidf_(j < 4 ? b0[j & 3] : b1[j & 3]);
                    o[j] = ga * va[j] + gb * vb[j]; }
                v2u w; w.x = pk4_fp8(o[0], o[1], o[2], o[3]); w.y = pk4_fp8(o[4], o[5], o[6], o[7]);
                *(v2u*)(U + off) = w;
                asm volatile("" ::: "memory"); }
    }
};
struct EpiPleFinal {
    static constexpr bool PERM = true;
    const bf16* x2; const bf16* P; float* out; const float* bias;
    __device__ __forceinline__ void operator()(const f32x4 (&acc)[2][2][4][2], const Unit& u, int wr, int wc, int fr, int fq) const {
        const int row0 = u.pm * BM + wr * 64 + fr, col0 = u.pn * BM + wc * 32 + 8 * fq;
#pragma unroll
        for (int bj = 0; bj < 2; ++bj) { const f32x4 bv0 = *(const f32x4*)(bias + col0 + bj * HALF), bv1 = *(const f32x4*)(bias + col0 + bj * HALF + 4);
#pragma unroll
            for (int ai = 0; ai < 2; ++ai)
#pragma unroll
                for (int m = 0; m < 4; ++m) { const size_t off = (size_t)(row0 + ai * HALF + m * 16) * D + col0 + bj * HALF;
                    const v4u pw = *(const v4u*)(P + off), xw = *(const v4u*)(x2 + off);
                    const f32x4 x0 = {bflo(xw.x), bfhi(xw.x), bflo(xw.y), bfhi(xw.y)}, x1 = {bflo(xw.z), bfhi(xw.z), bflo(xw.w), bfhi(xw.w)};
                    const f32x4 a0 = acc[ai][bj][m][0] + bv0, a1 = acc[ai][bj][m][1] + bv1;
                    f32x4 o0, o1;
                    o0[0] = x0[0] + sigmoidf_(a0[0]) * bflo(pw.x); o0[1] = x0[1] + sigmoidf_(a0[1]) * bfhi(pw.x); o0[2] = x0[2] + sigmoidf_(a0[2]) * bflo(pw.y); o0[3] = x0[3] + sigmoidf_(a0[3]) * bfhi(pw.y);
                    o1[0] = x1[0] + sigmoidf_(a1[0]) * bflo(pw.z); o1[1] = x1[1] + sigmoidf_(a1[1]) * bfhi(pw.z); o1[2] = x1[2] + sigmoidf_(a1[2]) * bflo(pw.w); o1[3] = x1[3] + sigmoidf_(a1[3]) * bfhi(pw.w);
                    *(f32x4*)(out + off) = o0; *(f32x4*)(out + off + 4) = o1; } }
    }
};

struct PleOrder {
    int G, c;
    __device__ __forceinline__ bool next(int i, Unit& u) const {
        int L;
        if (G == 256) { if (c >= 128) { if (i >= 6) return false; L = (c - 128) * 6 + i; } else { if (i >= 2) return false; L = 768 + c * 2 + i; } }
        else { L = i * G + c; if (L >= 1024) return false; }
        u.pm = L >> 3; u.pn = L & 7; u.e = 0; u.mt = 0; return true;
    }
    __device__ __forceinline__ void rows(const Unit&, int, int, unsigned (&)[2][2]) const {}
};
struct MoeOrder {
    const LAS int* pref;
    const LAS int* cntl;
    const int* tokrow; int NT, G, c, K;
    __device__ __forceinline__ bool next(int i, Unit& u) const {
        const int L = i * G + c; if (L >= pref[64] * NT) return false;
        const int tt = L / NT, pnl = L - tt * NT; int lo = 0, hi = 64;
        while (hi - lo > 1) { const int mid = (lo + hi) >> 1; if (pref[mid] <= tt) lo = mid; else hi = mid; }
        u.e = lo; u.mt = tt - pref[lo]; u.pm = tt; u.pn = lo * NT + pnl; return true;
    }
    __device__ __forceinline__ void rows(const Unit& u, int R0, int R1, unsigned (&off)[2][2]) const {
        const int n = cntl[u.e];
#pragma unroll
        for (int h = 0; h < 2; ++h)
#pragma unroll
            for (int i = 0; i < 2; ++i) { const int j = u.mt * 256 + h * 128 + (i ? R1 : R0);
                const int tk = (j < n) ? (tokrow[(size_t)u.e * ECAP + j] >> 1) : 0; off[h][i] = (unsigned)tk * (unsigned)(K * 2); }
    }
};
struct EpiMoe1 {
    static constexpr bool PERM = true;
    unsigned char* ACT;
    __device__ __forceinline__ void operator()(const f32x4 (&acc)[2][2][4][2], const Unit& u, int wr, int wc, int fr, int fq) const {
        const int row0 = u.pm * BM + wr * 64 + fr, col0 = (u.pn & 3) * HALF + wc * 32 + 8 * fq;
#pragma unroll
        for (int ai = 0; ai < 2; ++ai)
#pragma unroll
            for (int m = 0; m < 4; ++m) { float o[8];
#pragma unroll
                for (int j = 0; j < 8; ++j) { const float g = acc[ai][0][m][j >> 2][j & 3], up = acc[ai][1][m][j >> 2][j & 3]; o[j] = 4.0f * g * sigmoidf_(g) * up; }
                v2u w; w.x = pk4_fp8(o[0], o[1], o[2], o[3]); w.y = pk4_fp8(o[4], o[5], o[6], o[7]);
                *(v2u*)(ACT + (size_t)(row0 + ai * HALF + m * 16) * EFF + col0) = w; }
    }
};
struct EpiMoe2 {
    static constexpr bool PERM = true;
    bf16* Y0; long long ydelta; const int* tokrow; const float* tokw; const LAS int* cntl;
    __device__ __forceinline__ void operator()(const f32x4 (&acc)[2][2][4][2], const Unit& u, int wr, int wc, int fr, int fq) const {
        const int n = cntl[u.e], col0 = (u.pn & 7) * BM + wc * 32 + 8 * fq;
#pragma unroll
        for (int ai = 0; ai < 2; ++ai)
#pragma unroll
            for (int m = 0; m < 4; ++m) { const int j = u.mt * 256 + ai * HALF + wr * 64 + m * 16 + fr;
                if (j < n) { const int info = tokrow[(size_t)u.e * ECAP + j]; const float wt = tokw[(size_t)u.e * ECAP + j];
                    bf16* rowp = Y0 + (long long)(info & 1) * ydelta + (size_t)(info >> 1) * D + col0;
#pragma unroll
                    for (int bj = 0; bj < 2; ++bj) { const f32x4 v0 = acc[ai][bj][m][0] * wt, v1 = acc[ai][bj][m][1] * wt;
                        v4u w; w.x = cvt_pk_bf16(v0[0], v0[1]); w.y = cvt_pk_bf16(v0[2], v0[3]); w.z = cvt_pk_bf16(v1[0], v1[1]); w.w = cvt_pk_bf16(v1[2], v1[3]);
                        *(v4u*)(rowp + bj * HALF) = w; } } }
    }
};
}


#define MFMA32(a, b, c) __builtin_amdgcn_mfma_f32_32x32x16_bf16((a), (b), (c), 0, 0, 0)
__device__ __forceinline__ int crow(int r, int hi) { return (r & 3) + 8 * (r >> 2) + 4 * hi; }

constexpr int GLA_Q_OFF = 0, GLA_K_OFF = 65536, GLA_GLR_OFF = 132096;
__device__ __forceinline__ void gla_prep_task(LAS unsigned char* lds, bf16* Z, const float* w_alpha, const float* b_alpha, float* DEC, int task) {
    const int tid = opaque_tid(); const size_t t0 = (size_t)task * 64;
    LAS float* glr = (LAS float*)(lds + GLA_GLR_OFF);
    LAS unsigned short* qt = (LAS unsigned short*)(lds + GLA_Q_OFF); LAS unsigned short* kt = (LAS unsigned short*)(lds + GLA_K_OFF);
    __syncthreads();
#pragma unroll
    for (int i = 0; i < 8; ++i) { const int ch = tid + 512 * i, row = ch >> 6, c8 = (ch & 63) * 8;
        *(LAS v4u*)(qt + row * 512 + c8) = *(const GAS v4u*)(Z + (t0 + row) * ZP + ZC_GQ + c8);
        *(LAS v4u*)(kt + row * 512 + c8) = *(const GAS v4u*)(Z + (t0 + row) * ZP + ZC_GK + c8); }
    for (int i = tid; i < 1024; i += 512) glr[i] = bf2f(Z[(t0 + (i >> 4)) * ZP + ZC_GLR + (i & 15)]);
    float w[16];
#pragma unroll
    for (int i = 0; i < 16; ++i) w[i] = w_alpha[i * 512 + tid];
    const float bb = b_alpha[tid];
    __syncthreads();
    float G = 0.f;
#pragma unroll 4
    for (int r = 0; r < 64; ++r) {
        float pre = bb;
#pragma unroll
        for (int i = 0; i < 16; ++i) pre = fmaf(glr[r * 16 + i], w[i], pre);
        const float ls = fminf(pre, 0.f) - log1pf(__expf(-fabsf(pre)));
        G += ls * (1.0f / 16.0f);
        const float Gc = fmaxf(G, -80.f);
        const float eq = __expf(Gc), ek = __expf(-Gc);
        const float qv = bf2f(qt[r * 512 + tid]), kv = bf2f(kt[r * 512 + tid]);
        qt[r * 512 + tid] = (unsigned short)f2bf(qv * 0.125f * eq);
        kt[r * 512 + tid] = (unsigned short)f2bf(kv * ek);
    }
    DEC[(size_t)task * 512 + tid] = __expf(fmaxf(G, -80.f));
    __syncthreads();
#pragma unroll
    for (int i = 0; i < 8; ++i) { const int ch = tid + 512 * i, row = ch >> 6, c8 = (ch & 63) * 8;
        *(GAS v4u*)(Z + (t0 + row) * ZP + ZC_GQ + c8) = *(const LAS v4u*)(qt + row * 512 + c8);
        *(GAS v4u*)(Z + (t0 + row) * ZP + ZC_GK + c8) = *(const LAS v4u*)(kt + row * 512 + c8); }
    LDS_WAIT(); VM_WAIT(); __syncthreads();
}
__device__ __forceinline__ void dsa_prep_row(int lane, bf16* Z, size_t m, const float* qg, const float* kg, bf16* IKC, float* UW) {
#pragma unroll
    for (int which = 0; which < 2; ++which) {
        bf16* p = Z + m * ZP + (which ? ZC_DK : ZC_DQ) + lane * 16;
        const v4u a = *(const v4u*)p, b = *(const v4u*)(p + 8);
        float v[16]; const unsigned ww[8] = {a.x, a.y, a.z, a.w, b.x, b.y, b.z, b.w};
        float ss = 0.f;
#pragma unroll
        for (int i = 0; i < 8; ++i) { v[2 * i] = bflo(ww[i]); v[2 * i + 1] = bfhi(ww[i]); ss += v[2 * i] * v[2 * i] + v[2 * i + 1] * v[2 * i + 1]; }
        ss = sum8(ss);
        const float rstd = (1.0f / sqrtf(ss * (1.0f / 128.f) + EPS)) * (which ? 1.0f : 0.08838834764831845f * 1.4426950408889634f);
        const float* g = (which ? kg : qg) + (lane & 7) * 16;
        v4u o0, o1;
        o0.x = pk2(v[0] * rstd * g[0], v[1] * rstd * g[1]); o0.y = pk2(v[2] * rstd * g[2], v[3] * rstd * g[3]); o0.z = pk2(v[4] * rstd * g[4], v[5] * rstd * g[5]); o0.w = pk2(v[6] * rstd * g[6], v[7] * rstd * g[7]);
        o1.x = pk2(v[8] * rstd * g[8], v[9] * rstd * g[9]); o1.y = pk2(v[10] * rstd * g[10], v[11] * rstd * g[11]); o1.z = pk2(v[12] * rstd * g[12], v[13] * rstd * g[13]); o1.w = pk2(v[14] * rstd * g[14], v[15] * rstd * g[15]);
        *(v4u*)p = o0; *(v4u*)(p + 8) = o1;
    }
    if (lane < 8) *(v4u*)(IKC + m * 64 + lane * 8) = *(const v4u*)(Z + m * ZP + ZC_IK + lane * 8);
    if (lane < 16) UW[m * 16 + lane] = bf2f(Z[m * ZP + ZC_IW + lane]) * (0.5f / 32.0f);
}
#define FRAG_NAT(dst, tile, s, hg, col) do { _Pragma("unroll") for (int j_ = 0; j_ < 8; ++j_) dst[j_] = (short)(tile)[(16 * (s) + 8 * (hg) + j_) * 64 + (col)]; } while (0)
__device__ __forceinline__ void gla_local_unit(LAS unsigned char* lds, int wave, int lane, const bf16* Z, const float* DEC, float* SLOC, int u) {
    const int h = u & 7; const size_t t0 = (size_t)(u >> 3) * 64; const int r = lane & 31, hg = lane >> 5;
    const LAS unsigned short* kt = (const LAS unsigned short*)(lds + GLA_K_OFF) + h * 64;
    LAS unsigned short* vt = (LAS unsigned short*)(lds + GLA_Q_OFF + wave * 8192);
    const float d0 = DEC[(size_t)u * 64 + r], d1 = DEC[(size_t)u * 64 + 32 + r];
    bf16x8 Bk[2][4];
#pragma unroll
    for (int nt = 0; nt < 2; ++nt)
#pragma unroll
        for (int s = 0; s < 4; ++s) {
#pragma unroll
            for (int j = 0; j < 8; ++j) Bk[nt][s][j] = (short)kt[(16 * s + 8 * hg + j) * 512 + 32 * nt + r]; }
#pragma unroll 1
    for (int half = 0; half < 2; ++half) {
        LDS_WAIT();
#pragma unroll
        for (int i = 0; i < 8; ++i) { const int row = i * 8 + (lane >> 3), ch = lane & 7;
            *(LAS v4u*)(vt + row * 64 + ch * 8) = *(const v4u*)(Z + (t0 + row) * ZP + ZC_GV + h * 128 + half * 64 + ch * 8); }
        LDS_WAIT();
        f32x16 acc[2][2];
#pragma unroll
        for (int a = 0; a < 2; ++a)
#pragma unroll
            for (int b = 0; b < 2; ++b)
#pragma unroll
                for (int i = 0; i < 16; ++i) acc[a][b][i] = 0.f;
#pragma unroll
        for (int mt = 0; mt < 2; ++mt)
#pragma unroll
            for (int s = 0; s < 4; ++s) { bf16x8 Av; FRAG_NAT(Av, vt, s, hg, 32 * mt + r);
                acc[mt][0] = MFMA32(Av, Bk[0][s], acc[mt][0]); acc[mt][1] = MFMA32(Av, Bk[1][s], acc[mt][1]); }
        unsigned short* out = (unsigned short*)SLOC + (size_t)u * 8192;
#pragma unroll
        for (int mt = 0; mt < 2; ++mt)
#pragma unroll
            for (int i = 0; i < 16; ++i) { const int dv = half * 64 + 32 * mt + crow(i, hg);
                out[dv * 64 + r] = (unsigned short)f2bf(acc[mt][0][i] * d0); out[dv * 64 + 32 + r] = (unsigned short)f2bf(acc[mt][1][i] * d1); }
    }
}
__device__ __forceinline__ void gla_scan(const float* SLOC, const float* DEC, bf16* STT, int gt, int ngt) {
    for (int p = gt; p < 32 * 4096; p += ngt) {
        const int bh = p >> 12, ev = (p & 4095) * 2, b = bh >> 3, h = bh & 7, k = ev & 63;
        float s0 = 0.f, s1 = 0.f;
#pragma unroll 8
        for (int c = 0; c < 128; ++c) {
            const size_t u = ((size_t)(b * 128 + c) * 8 + h);
            const unsigned slw = *(const unsigned*)((const unsigned short*)SLOC + u * 8192 + ev); float2 sl; sl.x = bflo(slw); sl.y = bfhi(slw); const float2 dc = *(const float2*)(DEC + u * 64 + k);
            *(unsigned*)(STT + u * 8192 + ev) = pk2(s0, s1);
            s0 = fmaf(s0, dc.x, sl.x); s1 = fmaf(s1, dc.y, sl.y);
        }
    }
}
__device__ __forceinline__ void gla_out_unit(LAS unsigned char* wl, int lane, const bf16* Z, const bf16* STT, const float* gn, bf16* OA, int u) {
    const int h = u & 7; const size_t t0 = (size_t)(u >> 3) * 64; const int r = lane & 31, hg = lane >> 5;
    LAS unsigned short* vt = (LAS unsigned short*)wl;
    LDS_WAIT();
#pragma unroll
    for (int i = 0; i < 16; ++i) { const int row = i * 4 + (lane >> 4), ch = lane & 15;
        *(LAS v4u*)(vt + row * 128 + ch * 8) = *(const v4u*)(Z + (t0 + row) * ZP + ZC_GV + h * 128 + ch * 8); }
    bf16x8 Fq[2][4], Fk[2][4];
#pragma unroll
    for (int t = 0; t < 2; ++t)
#pragma unroll
        for (int s = 0; s < 4; ++s) {
            Fq[t][s] = *(const bf16x8*)(Z + (t0 + 32 * t + r) * ZP + ZC_GQ + h * 64 + 16 * s + 8 * hg);
            Fk[t][s] = *(const bf16x8*)(Z + (t0 + 32 * t + r) * ZP + ZC_GK + h * 64 + 16 * s + 8 * hg); }
    const bf16* st = STT + (size_t)u * 8192;
    LDS_WAIT();
#pragma unroll 1
    for (int it = 0; it < 2; ++it) {
        f32x16 o[4];
#pragma unroll
        for (int d = 0; d < 4; ++d)
#pragma unroll
            for (int i = 0; i < 16; ++i) o[d][i] = 0.f;
#pragma unroll
        for (int d = 0; d < 4; ++d)
#pragma unroll
            for (int s = 0; s < 4; ++s) { const bf16x8 Bs = *(const bf16x8*)(st + (32 * d + r) * 64 + 16 * s + 8 * hg); o[d] = MFMA32(Fq[it][s], Bs, o[d]); }
#pragma unroll
        for (int jt = 0; jt < 2; ++jt) {
            if (jt <= it) {
                f32x16 X;
#pragma unroll
                for (int i = 0; i < 16; ++i) X[i] = 0.f;
#pragma unroll
                for (int s = 0; s < 4; ++s) X = MFMA32(Fk[jt][s], Fq[it][s], X);
                asm volatile("s_nop 15\n\ts_nop 7" : "+v"(X));
                if (jt == it) {
#pragma unroll
                    for (int i = 0; i < 16; ++i) if (crow(i, hg) > r) X[i] = 0.f;
                }
#pragma unroll
                for (int s2 = 0; s2 < 2; ++s2) {
                    v4u pw; pw.x = cvt_pk_bf16(X[8 * s2 + 0], X[8 * s2 + 1]); pw.y = cvt_pk_bf16(X[8 * s2 + 2], X[8 * s2 + 3]); pw.z = cvt_pk_bf16(X[8 * s2 + 4], X[8 * s2 + 5]); pw.w = cvt_pk_bf16(X[8 * s2 + 6], X[8 * s2 + 7]);
                    const bf16x8 pa = __builtin_bit_cast(bf16x8, pw);
#pragma unroll
                    for (int d = 0; d < 4; ++d) { bf16x8 Bv;
#pragma unroll
                        for (int j = 0; j < 8; ++j) Bv[j] = (short)vt[(32 * jt + 16 * s2 + 8 * (j >> 2) + 4 * hg + (j & 3)) * 128 + 32 * d + r];
                        o[d] = MFMA32(pa, Bv, o[d]); }
                }
            }
        }
        float g4[4];
#pragma unroll
        for (int d = 0; d < 4; ++d) g4[d] = gn[32 * d + r];
#pragma unroll
        for (int i = 0; i < 16; ++i) {
            float ss = o[0][i] * o[0][i] + o[1][i] * o[1][i] + o[2][i] * o[2][i] + o[3][i] * o[3][i];
            ss = sum32(ss);
            const float rstd = 1.0f / sqrtf(ss * (1.0f / 128.f) + EPS);
            const size_t tok = t0 + 32 * it + crow(i, hg);
#pragma unroll
            for (int d = 0; d < 4; ++d) { const float gr = bf2f(Z[tok * ZP + ZC_GR + h * 128 + 32 * d + r]);
                const float val = o[d][i] * rstd * g4[d] * (gr * sigmoidf_(gr));
                OA[tok * 1024 + h * 128 + 32 * d + r] = (bf16)f2bf(val); }
        }
    }
}


__device__ __forceinline__ size_t sc_off(int b, int c) { return (size_t)b * SC_PER_BATCH + (size_t)4096 * ((size_t)c * (c + 1) / 2); }
__device__ __forceinline__ unsigned score_code(float sc) {
    const _Float16 hf = (_Float16)sc; const unsigned bits = (unsigned)__builtin_bit_cast(unsigned short, hf);
    return (bits & 0x8000u) ? (~bits & 0xffffu) : (bits | 0x8000u);
}
__device__ __forceinline__ void idx_scores_oct(LAS unsigned char* wl, int lane, const bf16* Z, const bf16* IKC, const float* UW, unsigned short* SC, int b, int c, int oct) {
    const int r = lane & 31, hg = lane >> 5, n = 64 * (c + 1);
    const size_t t0 = (size_t)b * SEQ + (size_t)c * 64 + 8 * oct;
    bf16x8 A[4][4];
    { const int q = (r >> 2) & 1, head = (r & 3) + 4 * (r >> 3);
#pragma unroll
      for (int a = 0; a < 4; ++a)
#pragma unroll
        for (int s = 0; s < 4; ++s) A[a][s] = *(const bf16x8*)(Z + (t0 + 2 * a + q) * ZP + ZC_IQ + head * 64 + 16 * s + 8 * hg); }
    LAS float* ul = (LAS float*)wl;
    LDS_WAIT();
    ul[lane] = UW[t0 * 16 + lane]; ul[64 + lane] = UW[t0 * 16 + 64 + lane];
    LDS_WAIT();
    GAS unsigned short* row0 = (GAS unsigned short*)SC + sc_off(b, c) + (size_t)(8 * oct + hg) * n;
    const GAS bf16* kb = (const GAS bf16*)IKC + ((size_t)b * SEQ + r) * 64 + 8 * hg;
    const int npair = n / 64;
#define IDX_LOADB(dst, kt_) do { _Pragma("unroll") for (int t = 0; t < 2; ++t) _Pragma("unroll") for (int s = 0; s < 4; ++s) dst[t][s] = *(const GAS bf16x8*)(kb + (size_t)((kt_) + t) * 32 * 64 + 16 * s); } while (0)
#define IDX_STEP(Bc, kt_) do { _Pragma("unroll") for (int a = 0; a < 4; ++a) { \
            f32x2 u2[8]; \
            _Pragma("unroll") for (int i = 0; i < 4; ++i) { const f32x4 t4 = *(const LAS f32x4*)(ul + (2 * a + hg) * 16 + 4 * i); u2[2 * i] = (f32x2){t4.x, t4.y}; u2[2 * i + 1] = (f32x2){t4.z, t4.w}; } \
            f32x16 acc0, acc1; \
            _Pragma("unroll") for (int i = 0; i < 16; ++i) { acc0[i] = 0.f; acc1[i] = 0.f; } \
            _Pragma("unroll") for (int s = 0; s < 4; ++s) { acc0 = MFMA32(A[a][s], Bc[0][s], acc0); acc1 = MFMA32(A[a][s], Bc[1][s], acc1); } \
            f32x2 l0 = {0.f, 0.f}, l1 = {0.f, 0.f}; \
            _Pragma("unroll") for (int j = 0; j < 8; ++j) { l0 = (f32x2){acc0[2 * j], acc0[2 * j + 1]} * u2[j] + l0; l1 = (f32x2){acc1[2 * j], acc1[2 * j + 1]} * u2[j] + l1; } \
            float s0 = l0.x + l0.y, s1 = l1.x + l1.y; \
            _Pragma("unroll") for (int j = 0; j < 8; ++j) { \
                asm("v_fma_f32 %0, |%1|, %2, %0" : "+v"(s0) : "v"(acc0[2 * j]), "v"(u2[j].x)); asm("v_fma_f32 %0, |%1|, %2, %0" : "+v"(s1) : "v"(acc1[2 * j]), "v"(u2[j].x)); \
                asm("v_fma_f32 %0, |%1|, %2, %0" : "+v"(s0) : "v"(acc0[2 * j + 1]), "v"(u2[j].y)); asm("v_fma_f32 %0, |%1|, %2, %0" : "+v"(s1) : "v"(acc1[2 * j + 1]), "v"(u2[j].y)); } \
            const unsigned c0 = score_code(s0), c1 = score_code(s1); \
            const unsigned pa = (unsigned)DPP_I(c0, DPP_X1), pb = (unsigned)DPP_I(c1, DPP_X1); \
            GAS unsigned short* row = row0 + (size_t)(2 * a) * n; \
            if ((r & 1) == 0) *(GAS unsigned*)(row + (kt_) * 32 + r) = c0 | (pa << 16); \
            else *(GAS unsigned*)(row + ((kt_) + 1) * 32 + r - 1) = pb | (c1 << 16); \
            } } while (0)
    bf16x8 B0[2][4], B1[2][4];
    IDX_LOADB(B0, 0);
#pragma unroll 1
    for (int p = 0; p < npair; p += 2) {
        if (p + 1 < npair) IDX_LOADB(B1, 2 * (p + 1));
        IDX_STEP(B0, 2 * p);
        if (p + 1 < npair) {
            if (p + 2 < npair) IDX_LOADB(B0, 2 * (p + 2));
            IDX_STEP(B1, 2 * (p + 1));
        }
    }
#undef IDX_LOADB
#undef IDX_STEP
}
__device__ __forceinline__ void idx_select_row(int lane, const unsigned short* row, int n, LAS unsigned char* bmrow, LAS unsigned* bins  ) {
    const int nch = n / 8;
    if (n <= 256) {
#pragma unroll
        for (int s = 0; s < 16; ++s) { const int j = lane + 64 * s; bmrow[j] = (j < nch) ? 0xffu : 0u; }
        return;
    }
    v4u cw[16];
#pragma unroll
    for (int s = 0; s < 16; ++s) { const int j = lane + 64 * s; const unsigned m = (unsigned)((j - nch) >> 31);
        const int jc = j < nch ? j : nch - 1; const v4u t = *(const v4u*)(row + (size_t)jc * 8); cw[s] = (v4u){t.x & m, t.y & m, t.z & m, t.w & m}; }
    const int ns = (nch + 63) / 64;
#define WSCAN(v) do { _Pragma("unroll") for (int o_ = 1; o_ < 64; o_ <<= 1) { const int t_ = __builtin_amdgcn_ds_bpermute((lane - o_) << 2, (v)); if (lane >= o_) (v) += t_; } } while (0)
#pragma unroll
    for (int i = 0; i < 8; ++i) *(LAS v4u*)(bins + (i * 64 + lane) * 4) = (v4u){0u, 0u, 0u, 0u};
    LDS_WAIT();
#pragma unroll
    for (int s = 0; s < 16; ++s) if (s < ns) {
#pragma unroll
        for (int e = 0; e < 4; ++e) { const unsigned w = cw[s][e];
            __hip_atomic_fetch_add(bins + ((w & 0xffffu) >> 5), 1u, __ATOMIC_RELAXED, __HIP_MEMORY_SCOPE_WORKGROUP);
            __hip_atomic_fetch_add(bins + (w >> 21), 1u, __ATOMIC_RELAXED, __HIP_MEMORY_SCOPE_WORKGROUP); } }
    LDS_WAIT();
    int B, above;
    { unsigned bv[32]; int sl = 0;
#pragma unroll
      for (int i = 0; i < 8; ++i) { const v4u t = *(const LAS v4u*)(bins + lane * 32 + 4 * i); bv[4 * i] = t.x; bv[4 * i + 1] = t.y; bv[4 * i + 2] = t.z; bv[4 * i + 3] = t.w; sl += (int)(t.x + t.y + t.z + t.w); }
      int incl = sl; WSCAN(incl);
      const int tot = __builtin_amdgcn_readlane(incl, 63);
      int run = tot - incl;
      const bool mine = run < 256 && run + sl >= 256;
      int bl = 0, al = 0; bool found = false;
#pragma unroll
      for (int k = 31; k >= 0; --k) { const int cbin = (int)bv[k]; if (!found && run + cbin >= 256) { bl = 32 * lane + k; al = run; found = true; } run += cbin; }
      const unsigned long long mk = __builtin_amdgcn_ballot_w64(mine); const int src = (int)__builtin_ctzll(mk);
      B = __builtin_amdgcn_readlane(bl, src); above = __builtin_amdgcn_readlane(al, src); }
    LDS_WAIT();
    if (lane < 8) *(LAS v4u*)(bins + lane * 4) = (v4u){0u, 0u, 0u, 0u};
    LDS_WAIT();
#pragma unroll
    for (int s = 0; s < 16; ++s) if (s < ns) {
#pragma unroll
        for (int e = 0; e < 4; ++e) { const unsigned w = cw[s][e]; const unsigned lo = w & 0xffffu, hi = w >> 16;
            if ((int)(lo >> 5) == B) __hip_atomic_fetch_add(bins + (lo & 31u), 1u, __ATOMIC_RELAXED, __HIP_MEMORY_SCOPE_WORKGROUP);
            if ((int)(hi >> 5) == B) __hip_atomic_fetch_add(bins + (hi & 31u), 1u, __ATOMIC_RELAXED, __HIP_MEMORY_SCOPE_WORKGROUP); } }
    LDS_WAIT();
    unsigned thr; int cgt, ceq;
    { const int cl = lane < 32 ? (int)bins[lane] : 0; int incl = cl; WSCAN(incl);
      const int tot = __builtin_amdgcn_readlane(incl, 63);
      const int run = above + tot - incl;
      const bool mine = lane < 32 && run < 256 && run + cl >= 256;
      const unsigned long long mk = __builtin_amdgcn_ballot_w64(mine); const int src = (int)__builtin_ctzll(mk);
      thr = ((unsigned)B << 5) | (unsigned)src; cgt = __builtin_amdgcn_readlane(run, src); ceq = __builtin_amdgcn_readlane(cl, src); }
    LDS_WAIT();
#undef WSCAN
    const int need = 256 - cgt;
    const bool fast = (ceq == need);
    int run = 0;
#pragma unroll
    for (int s = 0; s < 16; ++s) {
        const int j = lane + 64 * s;
        unsigned gm = 0u, tm = 0u;
        if (s < ns) {
#pragma unroll
            for (int e = 0; e < 4; ++e) { const unsigned w = cw[s][e]; const unsigned lo = w & 0xffffu, hi = w >> 16;
                gm |= ((thr - lo) >> 31) << (2 * e); gm |= ((thr - hi) >> 31) << (2 * e + 1);
                tm |= (((lo ^ thr) - 1u) >> 31) << (2 * e); tm |= (((hi ^ thr) - 1u) >> 31) << (2 * e + 1); }
            if (fast) gm |= tm;
            else {
                const int tc = __builtin_popcount(tm); int incl = tc;
#pragma unroll
                for (int o = 1; o < 64; o <<= 1) { const int t = __builtin_amdgcn_ds_bpermute((lane - o) << 2, incl); if (lane >= o) incl += t; }
                int rank = run + incl - tc;
#pragma unroll
                for (int e = 0; e < 8; ++e) if ((tm >> e) & 1u) { if (rank < need) gm |= 1u << e; ++rank; }
                run += __builtin_amdgcn_readlane(incl, 63);
            }
        }
        bmrow[j] = (unsigned char)gm;
    }
}


__device__ __forceinline__ void bt_emit_tile(int lane, const LAS unsigned char* rows, unsigned* BT, int b, int c, int tile, bool zero) {
    unsigned long long w = 0ull;
    if (!zero) w = *(const LAS unsigned long long*)(rows + lane * 1024 + tile * 8);
    unsigned va = 0u, vb = 0u;
#pragma unroll
    for (int pos = 0; pos < 64; ++pos) { const int rr = (pos >> 1) & 15, p = pos >> 5, h = pos & 1, key = 32 * p + (rr & 3) + 8 * (rr >> 2) + 4 * h;
        const unsigned long long m = __builtin_amdgcn_ballot_w64(((w >> key) & 1ull) != 0ull);
        asm volatile("s_nop 1\n\tv_writelane_b32 %0, %1, %2" : "+v"(va) : "s"((unsigned)m), "n"(pos)); asm volatile("v_writelane_b32 %0, %1, %2" : "+v"(vb) : "s"((unsigned)(m >> 32)), "n"(pos)); }
    const size_t g0 = ((size_t)(b * 256 + 2 * c) * 128 + tile) * 64;
    BT[g0 + lane] = va; BT[g0 + 128 * 64 + lane] = vb;
}

namespace att {
constexpr int AD = 128, NW = 8, QBLK = 32, KVBLK = 64, QB = NW * QBLK;
constexpr int SHM_V = KVBLK * AD * 2, SHM_K = KVBLK * AD * 2;
constexpr int LI_OFF = 2 * SHM_V + 2 * SHM_K;
constexpr int LUT_OFF = LI_OFF + NW * 64 * 4;
constexpr int NM_OFF = LUT_OFF + 8 * 256 * 4;
constexpr int QI_OFF = NM_OFF + 32;
constexpr int ATT_LDS = NM_OFF + 64;
typedef unsigned u32x16 __attribute__((ext_vector_type(16)));
#define AS4C __attribute__((address_space(4)))
#define KSWZ(row, colB) ((row) * 256 + ((colB) ^ (((row) & 7) << 4)))
#define SBAR() __builtin_amdgcn_sched_barrier(0)
__device__ __forceinline__ int v_st(int k, int c) { const int kk = (k & ~0xC) | ((k & 4) << 1) | ((k & 8) >> 1); return ((kk >> 3) * 4 + (c >> 5)) * 512 + ((kk & 7) * 32 + (c & 31)) * 2; }
__device__ __forceinline__ int v_rd_base(int lane) { return ((lane & 3) << 3) | (((lane >> 2) & 3) << 6) | (((lane >> 4) & 1) << 5) | (((lane >> 5) & 1) << 8); }
constexpr int v_rd_off(int d0, int ks, int half) { return d0 * 512 + ks * 4096 + half * 2048; }
__device__ __forceinline__ unsigned cvtpk(float lo, float hi) { unsigned r; asm volatile("v_cvt_pk_bf16_f32 %0, %1, %2" : "=v"(r) : "v"(lo), "v"(hi)); return r; }
__device__ __forceinline__ bf16x8 load8(const bf16* p) { return *reinterpret_cast<const bf16x8*>(p); }
__device__ __forceinline__ void mask16(f32x16& p, const u32x16& ma, const u32x16& mb, float neg) {
#pragma unroll
    for (int r = 0; r < 16; ++r) { const unsigned lo = r < 8 ? ma[2 * r] : mb[2 * r - 16], hi = r < 8 ? ma[2 * r + 1] : mb[2 * r - 15];
        const unsigned long long mm = ((unsigned long long)hi << 32) | lo; float o;
        asm volatile("v_cndmask_b32_e64 %0, %1, %2, %3" : "=v"(o) : "v"(neg), "v"(p[r]), "s"(mm)); p[r] = o; }
}
#define MFMA_PAD(a, b) asm volatile("s_nop 15\n\ts_nop 7" : "+v"(a), "+v"(b))
__device__ __forceinline__ void bias_tile(f32x16& p0, f32x16& p1, const LAS float* lut) {
#pragma unroll
    for (int r = 0; r < 16; ++r) { const int c = (r & 3) + 8 * (r >> 2); p0[r] += lut[c]; p1[r] += lut[c + 32]; }
}
__device__ __forceinline__ void exp16(f32x16& p) {
#pragma unroll
    for (int r = 0; r < 16; ++r) p[r] = __builtin_amdgcn_exp2f(p[r]);
}
__device__ __forceinline__ void finishSM(f32x16& p0, f32x16& p1, float& l_reg, bf16x8& pa0, bf16x8& pa1, bf16x8& pa2, bf16x8& pa3) {
    exp16(p1);
    float ps = 0;
#pragma unroll
    for (int r = 0; r < 16; ++r) ps += p0[r];
#pragma unroll
    for (int r = 0; r < 16; ++r) ps += p1[r];
    l_reg += ps;
#define PK4(P, B_, OUT) do { unsigned a0 = cvtpk(P[B_+0], P[B_+1]), a1 = cvtpk(P[B_+2], P[B_+3]);                          \
        unsigned b0 = cvtpk(P[B_+4], P[B_+5]), b1 = cvtpk(P[B_+6], P[B_+7]);                                             \
        auto r0 = __builtin_amdgcn_permlane32_swap(a0, b0, false, false); auto r1 = __builtin_amdgcn_permlane32_swap(a1, b1, false, false); \
        v4u w = {r0[0], r1[0], r0[1], r1[1]}; OUT = *reinterpret_cast<bf16x8*>(&w); } while (0)
    PK4(p0, 0, pa0); PK4(p0, 8, pa1); PK4(p1, 0, pa2); PK4(p1, 8, pa3);
#undef PK4
}
template <int KB>
__device__ __forceinline__ void qkt(f32x16& p0, f32x16& p1, const char* K_lds, int r32, int hi, const bf16x8* qr, float init) {
#pragma unroll
    for (int r = 0; r < 16; ++r) { float i0 = init, i1 = init; asm volatile("" : "+v"(i0), "+v"(i1)); p0[r] = i0; p1[r] = i1; }
    const char* kb[4];
#pragma unroll
    for (int dd = 0; dd < 4; ++dd) kb[dd] = K_lds + KB * SHM_K + KSWZ(r32, (dd * 16 + hi * 8) * 2);
#pragma unroll
    for (int d0 = 0; d0 < 8; ++d0) { const char* a = kb[d0 & 3] + (d0 >> 2) * 128;
        bf16x8 b0 = *reinterpret_cast<const bf16x8*>(a);
        bf16x8 b1 = *reinterpret_cast<const bf16x8*>(a + 32 * 256);
        p0 = __builtin_amdgcn_mfma_f32_32x32x16_bf16(b0, qr[d0], p0, 0, 0, 0);
        p1 = __builtin_amdgcn_mfma_f32_32x32x16_bf16(b1, qr[d0], p1, 0, 0, 0); }
}
template <int VB>
__device__ __forceinline__ void pv_tile(f32x16* o, int vb0, bf16x8 pa0, bf16x8 pa1, bf16x8 pa2, bf16x8 pa3) {
#define TRRD(dst, off) asm volatile("ds_read_b64_tr_b16 %0, %1 offset:%2" : "=&v"(dst) : "v"(vb0), "i"(off) : "memory")
#define PV_D0(d0) do { s16x4 l0, l1, l2, l3, h0, h1, h2, h3; constexpr int b_ = VB * SHM_V + v_rd_off(d0, 0, 0); \
        TRRD(l0, b_); TRRD(h0, b_ + 2048); TRRD(l1, b_ + 4096); TRRD(h1, b_ + 6144); TRRD(l2, b_ + 8192); TRRD(h2, b_ + 10240); TRRD(l3, b_ + 12288); TRRD(h3, b_ + 14336); \
        asm volatile("s_waitcnt lgkmcnt(0)" ::: "memory"); SBAR();   \
        o[d0] = __builtin_amdgcn_mfma_f32_32x32x16_bf16(pa0, (bf16x8){l0[0], l0[1], l0[2], l0[3], h0[0], h0[1], h0[2], h0[3]}, o[d0], 0, 0, 0);   \
        o[d0] = __builtin_amdgcn_mfma_f32_32x32x16_bf16(pa1, (bf16x8){l1[0], l1[1], l1[2], l1[3], h1[0], h1[1], h1[2], h1[3]}, o[d0], 0, 0, 0);   \
        o[d0] = __builtin_amdgcn_mfma_f32_32x32x16_bf16(pa2, (bf16x8){l2[0], l2[1], l2[2], l2[3], h2[0], h2[1], h2[2], h2[3]}, o[d0], 0, 0, 0);   \
        o[d0] = __builtin_amdgcn_mfma_f32_32x32x16_bf16(pa3, (bf16x8){l3[0], l3[1], l3[2], l3[3], h3[0], h3[1], h3[2], h3[3]}, o[d0], 0, 0, 0); } while (0)
    PV_D0(0); PV_D0(1); PV_D0(2); PV_D0(3);
#undef PV_D0
#undef TRRD
}
struct BlockRef { const bf16* Q; const bf16* K; unsigned char* O; const unsigned* bt; int P0; int h; };
struct Seam { bf16x8 qr[8]; bf16x8 st_v0, st_v1, st_k0, st_k1; };
#define ROW(p, k0, rr) ((p) + (size_t)((k0) + (rr)) * ZP + sc)
#define VMW() asm volatile("s_waitcnt vmcnt(0)" ::: "memory")
#define VMWN(n) asm volatile("s_waitcnt vmcnt(%0)" :: "i"(n) : "memory")
#define SLOAD_H(Kp, k0) do { const bf16* r0_ = ROW(Kp, k0, sr); const bf16* r1_ = ROW(Kp, k0, 32 + sr);   \
                         S.st_v0 = load8(r0_ + (ZC_DV - ZC_DK)); S.st_v1 = load8(r1_ + (ZC_DV - ZC_DK)); S.st_k0 = load8(r0_); S.st_k1 = load8(r1_); } while (0)
#define SWRITE_HK(bf) do { *(bf16x8*)(K_lds + (bf) * SHM_K + kws) = S.st_k0; *(bf16x8*)(K_lds + (bf) * SHM_K + kws + 32 * 256) = S.st_k1; } while (0)
#define SWRITE_HV(bf) do { *(bf16x8*)(V_lds + (bf) * SHM_V + vst0) = S.st_v0; *(bf16x8*)(V_lds + (bf) * SHM_V + vst1) = S.st_v1; } while (0)
#define SWRITE_H(bf) do { SWRITE_HV(bf); SWRITE_HK(bf); } while (0)
#define MLOAD(dst0, dst1, ptr, byteoff) do { const AS4C u32x16* q_ = (const AS4C u32x16*)(const AS4C void*)(ptr); dst0 = q_[(byteoff) / 64]; dst1 = q_[(byteoff) / 64 + 1]; } while (0)
__device__ __forceinline__ void prime(const BlockRef& cur, char* lds, Seam& S) {
    const int tid = opaque_tid(), wid = __builtin_amdgcn_readfirstlane(tid >> 6), lane = tid & 63, r32 = lane & 31, hi = lane >> 5;
    const int sr = tid >> 4, sc = (tid & 15) * 8, kws = KSWZ(sr, sc * 2); char* K_lds = lds + 2 * SHM_V;
#pragma unroll
    for (int d0 = 0; d0 < 8; ++d0) S.qr[d0] = load8(cur.Q + (size_t)(wid * QBLK + r32) * ZP + d0 * 16 + hi * 8);
    SLOAD_H(cur.K, 0); VMW(); SWRITE_HK(0);
    __syncthreads();
}
__device__ __forceinline__ void block(const BlockRef& cur, const BlockRef& nxt, char* lds, Seam& S) {
    const int tid = opaque_tid(), wid = __builtin_amdgcn_readfirstlane(tid >> 6), lane = tid & 63, r32 = lane & 31, hi = lane >> 5;
    const int NT = cur.P0 / KVBLK + 4;
    const int qlo = cur.P0 + wid * QBLK, qch = qlo >> 6;
    char* V_lds = lds; char* K_lds = lds + 2 * SHM_V;
    float* li_l = (float*)(lds + LI_OFF) + wid * 64;
    const float ninit = *(const float*)(lds + NM_OFF + 4 * cur.h);
    const float NEG = -__builtin_inff();
    const unsigned* btw = cur.bt + (size_t)wid * (128 * 64);
    float l_reg = 0; f32x16 o[4];
#pragma unroll
    for (int d = 0; d < 4; ++d)
#pragma unroll
        for (int r = 0; r < 16; ++r) o[d][r] = 0.f;
    const int sr = tid >> 4, sc = (tid & 15) * 8, vst0 = v_st(sr, sc), vst1 = v_st(32 + sr, sc), kws = KSWZ(sr, sc * 2);
    const int vb0 = (int)(uintptr_t)V_lds + v_rd_base(lane);
    const bf16* Kh = cur.K;
#define KBASE(t) ((t) * KVBLK)
#define LUTB(t) (LUT_OFF + 4 * (cur.h * 256 + 191 + 4 * hi - qlo - r32 + (t) * KVBLK))
#define MASKT(P0_, P1_, t) do { if ((t) >= qch - 2 && (t) <= qch) bias_tile(P0_, P1_, (const LAS float*)(unsigned)LUTB(t)); \
        mask16(P0_, m0, m1, NEG); { const unsigned* mp_ = btw + (size_t)(t) * 64; MLOAD(m0, m1, mp_, 128); } \
        if (__builtin_expect(__all(ninit <= 0.f), 1)) { exp16(P0_); } else { l_reg = 0.f; }     \
        mask16(P1_, m0, m1, NEG); } while (0)
#define MREQ(t) do { const unsigned* mp_ = btw + (size_t)(t) * 64; MLOAD(m0, m1, mp_, 0); } while (0)
    constexpr int NQL = 8;
#define SEAM_K0() do { VMWN(NQL); SWRITE_HK(0); SBAR(); } while (0)
    f32x16 pA0, pA1, pB0, pB1; bf16x8 pa0, pa1, pa2, pa3; u32x16 m0, m1;
    SWRITE_HV(0); SBAR();
    MREQ(0);
    if (NT > 1) SLOAD_H(Kh, KBASE(1));
    SBAR(); qkt<0>(pA0, pA1, K_lds, r32, hi, S.qr, ninit);
    MFMA_PAD(pA0, pA1); MASKT(pA0, pA1, 0);
    if (NT > 1) { VMW(); SWRITE_H(1); }
    __syncthreads();
#define HALF_STEP(PX0, PX1, PY0, PY1, t, KB, VB, SB) do {                                                      \
        SBAR(); MREQ(t); qkt<KB>(PX0, PX1, K_lds, r32, hi, S.qr, ninit);                                             \
        finishSM(PY0, PY1, l_reg, pa0, pa1, pa2, pa3); SBAR();                                                           \
        if ((t) + 1 < NT) { SLOAD_H(Kh, KBASE((t) + 1)); SBAR(); }                                               \
        pv_tile<VB>(o, vb0, pa0, pa1, pa2, pa3); MASKT(PX0, PX1, (t));                                        \
        __syncthreads();                                                                                                      \
        if ((t) + 1 < NT) { VMW(); SWRITE_H(SB); }                                                                          \
        __syncthreads(); } while (0)
    for (int t = 1; t + 1 < NT; t += 2) {
        HALF_STEP(pB0, pB1, pA0, pA1, t, 1, 0, 0);
        HALF_STEP(pA0, pA1, pB0, pB1, t + 1, 0, 1, 1);
    }
    MREQ(NT - 1);
    SBAR(); qkt<1>(pB0, pB1, K_lds, r32, hi, S.qr, ninit); SBAR();
    SLOAD_H(nxt.K, 0); SBAR();
#pragma unroll
    for (int d0 = 0; d0 < 8; ++d0) S.qr[d0] = load8(nxt.Q + (size_t)(wid * QBLK + r32) * ZP + d0 * 16 + hi * 8);
    SBAR();
    finishSM(pA0, pA1, l_reg, pa0, pa1, pa2, pa3); SBAR();
    pv_tile<0>(o, vb0, pa0, pa1, pa2, pa3);
    MASKT(pB0, pB1, NT - 1); __syncthreads();
    finishSM(pB0, pB1, l_reg, pa0, pa1, pa2, pa3); SBAR(); pv_tile<1>(o, vb0, pa0, pa1, pa2, pa3);
    SBAR(); SEAM_K0();
    { auto rr = __builtin_amdgcn_permlane32_swap(__float_as_uint(l_reg), __float_as_uint(l_reg), false, false); l_reg = __uint_as_float(rr[0]) + __uint_as_float(rr[1]); }
    if (hi == 0) li_l[r32] = l_reg; asm volatile("s_waitcnt lgkmcnt(0)" ::: "memory");
    float rli[16];
#pragma unroll
    for (int r = 0; r < 16; ++r) rli[r] = __builtin_amdgcn_rcpf(fmaxf(li_l[crow(r, hi)], 1e-37f));
    unsigned char* Ow = cur.O + (size_t)(wid * QBLK) * 1024;
#pragma unroll
    for (int r = 0; r < 16; ++r) { const int orow = crow(r, hi);
#pragma unroll
        for (int d0 = 0; d0 < 4; ++d0) { const float v = o[d0][r] * rli[r] * 16.0f;
            const float v1 = DPP_F(v, 0x55), v2 = DPP_F(v, 0xAA), v3 = DPP_F(v, 0xFF);
            if ((r32 & 3) == 0) *(unsigned*)(Ow + (size_t)orow * 1024 + d0 * 32 + r32) = pk4_fp8(v, v1, v2, v3); } }
    __syncthreads();
#undef KBASE
#undef LUTB
#undef MASKT
#undef MREQ
#undef SEAM_K0
#undef HALF_STEP
}
#undef ROW
#undef VMW
#undef VMWN
#undef SLOAD_H
#undef SWRITE_HK
#undef SWRITE_HV
#undef SWRITE_H
#undef MLOAD
__device__ __forceinline__ BlockRef make_ref(int L, int pass, const bf16* Z, unsigned char* OB, const unsigned* BT) {
    const int bh = L >> 4, x = L & 15, b = bh >> 3, h = bh & 7, qb = pass ? 31 - x : x;
    BlockRef r; const size_t row0 = (size_t)b * SEQ + (size_t)qb * QB;
    r.Q = Z + row0 * ZP + ZC_DQ + h * AD; r.K = Z + (size_t)b * SEQ * ZP + ZC_DK + h * AD;
    r.O = OB + row0 * 1024 + h * AD; r.bt = BT + (size_t)(b * 256 + qb * 8) * (128 * 64); r.P0 = qb * QB; r.h = h; return r;
}
__device__ __forceinline__ int t5_bucket(int rel) {
    const int n = rel < 0 ? -rel : rel; int bk;
    if (n < 8) bk = n; else if (n < 12) bk = 8; else if (n < 16) bk = 9; else if (n < 23) bk = 10; else if (n < 32) bk = 11; else if (n < 46) bk = 12; else if (n < 64) bk = 13; else if (n < 91) bk = 14; else bk = 15;
    return (rel > 0 ? 16 : 0) + bk;
}
__device__ __forceinline__ BlockRef make_ref_blk(int i, const bf16* Z, unsigned char* OB, const unsigned* BT) {
    const int bh = i & 31, b = bh >> 3, h = bh & 7, qb = 31 - (i >> 5);
    BlockRef r; const size_t row0 = (size_t)b * SEQ + (size_t)qb * QB;
    r.Q = Z + row0 * ZP + ZC_DQ + h * AD; r.K = Z + (size_t)b * SEQ * ZP + ZC_DK + h * AD;
    r.O = OB + row0 * 1024 + h * AD; r.bt = BT + (size_t)(b * 256 + qb * 8) * (128 * 64); r.P0 = qb * QB; r.h = h; return r;
}
__device__ __forceinline__ int q_fetch(char* lds, gu32* qhead, int slot) {
    if (opaque_tid() == 0) { const unsigned v = __hip_atomic_fetch_add(qhead, 1u, RLX_AGENT); ((volatile unsigned*)(lds + QI_OFF))[slot] = v; }
    __syncthreads();
    return __builtin_amdgcn_readfirstlane((int)((volatile unsigned*)(lds + QI_OFF))[slot]);
}
__device__ __forceinline__ void attn_phase(char* lds, const bf16* Z, unsigned char* OB, const unsigned* BT, const float* rel_bias, const float* qg, const float* kg, gu32* qhead) {
    constexpr float L2E = 1.4426950408889634f;
    { float* lut = (float*)(lds + LUT_OFF);
      const int tid = opaque_tid();
      for (int i = tid; i < 8 * 256; i += 512) { const int h = i >> 8, rel = (i & 255) - 191; lut[i] = (rel_bias[t5_bucket(rel) * 8 + h] - rel_bias[15 * 8 + h]) * L2E; }
      if (tid < 64) { const int l = tid;
          float mq = fmaxf(fabsf(qg[l]), fabsf(qg[l + 64])), mk = fmaxf(fabsf(kg[l]), fabsf(kg[l + 64]));
          mq = wave_max(mq); mk = wave_max(mk);
          if (l < 8) { float mb = 0.f; for (int bk = 0; bk < 32; ++bk) mb = fmaxf(mb, rel_bias[bk * 8 + l] - rel_bias[15 * 8 + l]);
              ((float*)(lds + NM_OFF))[l] = -(11.313708498984761f * mq * mk + mb) * L2E; } } }
    asm volatile("" : "+s"(BT));
    __syncthreads();
    constexpr int total = NB * 8 * 32;
    const int i0 = q_fetch(lds, qhead, 0); if (i0 >= total) return;
    int i1 = q_fetch(lds, qhead, 1), slot = 0;
    BlockRef cur = make_ref_blk(i0, Z, OB, BT);
    Seam S;
    prime(cur, lds, S);
    for (;;) {
        const bool last = i1 >= total;
        const BlockRef nxt = last ? cur : make_ref_blk(i1, Z, OB, BT);
        block(cur, nxt, lds, S);
        if (last) break;
        cur = nxt; i1 = q_fetch(lds, qhead, slot); slot ^= 1;
    }
}
}

constexpr int RING_OFF = 0, RING_BYTES = 131072;
constexpr int LDSCTL_OFF = RING_BYTES, MISC_OFF = LDSCTL_OFF + 320;
constexpr int LDS_BYTES = 147456;

struct Frame {
    LAS unsigned char* lds;
    volatile LAS unsigned* MISC;
    gu32* ctl;
    int tid, lane, wave, vcu, G;
};

template <int MAP> __device__ __forceinline__ int rowmap(int n) {
    if (MAP == 0) return n;
    if (MAP == 1) {
        if (n < 1024) return n;
        if (n < 3072) return -1;
        if (n < 3088) return ZC_GLR - 2048 + (n - 3072);
        if (n < 6160) return -1;
        if (n < 7184) return ZC_IQ - 2048 + (n - 6160);
        if (n < 7248) return ZC_IK - 2048 + (n - 7184);
        return ZC_IW - 2048 + (n - 7248);
    }
    if (MAP == 4) return (n >= 1024 && n < 3072) ? n - 1024 : (n >= 3088 && n < 6160) ? n - 3088 + 2048 : -1;
    if (MAP == 2) { const int half = n >> 11, c = n & 2047; return (c >> 7) * 256 + half * 128 + (c & 127); }
    if (MAP == 3) return (n >> 7) * 256 + (n & 127);
    return n;
}
template <int MAP>
__device__ __forceinline__ void p0_transpose_item(const float* W, int K, int N, bf16* WT, int row_off, LAS float* scr, int item, int lane) {
    const int nblk = N / 32, kb = item / nblk, nb = item % nblk, k0 = 64 * kb, n0 = 32 * nb;
#pragma unroll 8
    for (int i = 0; i < 32; ++i) { const int kk = 2 * i + (lane >> 5); scr[kk * 33 + (lane & 31)] = W[(size_t)(k0 + kk) * N + n0 + (lane & 31)]; }
    LDS_WAIT(); asm volatile("" ::: "memory");
    const int c = lane & 7;
#pragma unroll
    for (int j = 0; j < 4; ++j) { const int n = (lane >> 3) + 8 * j; const LAS float* s = scr + (8 * c) * 33 + n;
        v4u o; o.x = pk2(s[0 * 33], s[1 * 33]); o.y = pk2(s[2 * 33], s[3 * 33]); o.z = pk2(s[4 * 33], s[5 * 33]); o.w = pk2(s[6 * 33], s[7 * 33]);
        const int rm = rowmap<MAP>(n0 + n); if (rm >= 0) *(GAS v4u*)(WT + (size_t)(row_off + rm) * K + k0 + 8 * c) = o; }
    LDS_WAIT(); asm volatile("" ::: "memory");
}
template <int MAP>
__device__ __forceinline__ void p0_transpose_item8(const float* W, int K, int N, unsigned char* WT, int row_off, LAS float* scr, int item, int lane, float scale) {
    const int nblk = N / 32, kb = item / nblk, nb = item % nblk, k0 = 64 * kb, n0 = 32 * nb;
#pragma unroll 8
    for (int i = 0; i < 32; ++i) { const int kk = 2 * i + (lane >> 5); scr[kk * 33 + (lane & 31)] = W[(size_t)(k0 + kk) * N + n0 + (lane & 31)] * scale; }
    LDS_WAIT(); asm volatile("" ::: "memory");
    const int c = lane & 3;
#pragma unroll
    for (int j = 0; j < 2; ++j) { const int n = (lane >> 2) + 16 * j; const LAS float* sp = scr + (16 * c) * 33 + n;
        v4u o; o.x = pk4_fp8(sp[0 * 33], sp[1 * 33], sp[2 * 33], sp[3 * 33]); o.y = pk4_fp8(sp[4 * 33], sp[5 * 33], sp[6 * 33], sp[7 * 33]);
        o.z = pk4_fp8(sp[8 * 33], sp[9 * 33], sp[10 * 33], sp[11 * 33]); o.w = pk4_fp8(sp[12 * 33], sp[13 * 33], sp[14 * 33], sp[15 * 33]);
        const int rm = rowmap<MAP>(n0 + n); if (rm >= 0) *(GAS v4u*)(WT + (size_t)(row_off + rm) * K + k0 + 16 * c) = o; }
    LDS_WAIT(); asm volatile("" ::: "memory");
}
constexpr int CONV_MOD = 6, CONV_DEPTH = 3;
template <int MAP>
__device__ __forceinline__ void conv_stream8(const float* W, int K, int N, unsigned char* WT, int erows, int row_add, LAS float* scr, int lane, int cw, int NCW) {
    const int nblk = N / 32, per_e = (K / 64) * nblk, total = NEXP * per_e;
    const int lr = lane >> 3, lc = (lane & 7) * 4;
    if (cw >= total) return;
    const int n_my = (total - cw + NCW - 1) / NCW, it_last = cw + (n_my - 1) * NCW;
    f32x4 v[CONV_DEPTH][8];
#define CONV_IT(j_) min(cw + (j_) * NCW, it_last)
#define CONV_LOAD(d_, it_) do { const int e_ = (it_) / per_e, r_ = (it_) - e_ * per_e, kb_ = r_ / nblk, nb_ = r_ - kb_ * nblk; \
        const float* s_ = W + (size_t)e_ * K * N + (size_t)(64 * kb_ + lr) * N + 32 * nb_ + lc; \
        _Pragma("unroll") for (int i = 0; i < 8; ++i) v[d_][i] = __builtin_nontemporal_load((const f32x4*)(s_ + (size_t)(8 * i) * N)); } while (0)
#pragma unroll
    for (int d = 0; d < CONV_DEPTH; ++d) { CONV_LOAD(d, CONV_IT(d)); asm volatile("" ::: "memory"); __builtin_amdgcn_sched_barrier(0); }
    for (int j0 = 0; j0 < n_my; j0 += CONV_DEPTH) {
#pragma unroll
        for (int d = 0; d < CONV_DEPTH; ++d) {
            const int it = CONV_IT(j0 + d);
            const int e = it / per_e, r = it - e * per_e, kb = r / nblk, nb = r - kb * nblk, k0 = 64 * kb, n0 = 32 * nb;
#pragma unroll
            for (int i = 0; i < 8; ++i) { LAS float* dd = scr + (8 * i + lr) * 33 + lc; dd[0] = v[d][i].x; dd[1] = v[d][i].y; dd[2] = v[d][i].z; dd[3] = v[d][i].w; }
            CONV_LOAD(d, CONV_IT(j0 + d + CONV_DEPTH));
            LDS_WAIT(); asm volatile("" ::: "memory");
            const int c = lane & 3;
#pragma unroll
            for (int j = 0; j < 2; ++j) { const int n = (lane >> 2) + 16 * j; const LAS float* sp = scr + (16 * c) * 33 + n;
                v4u o; o.x = pk4_fp8(32.f * sp[0 * 33], 32.f * sp[1 * 33], 32.f * sp[2 * 33], 32.f * sp[3 * 33]); o.y = pk4_fp8(32.f * sp[4 * 33], 32.f * sp[5 * 33], 32.f * sp[6 * 33], 32.f * sp[7 * 33]);
                o.z = pk4_fp8(32.f * sp[8 * 33], 32.f * sp[9 * 33], 32.f * sp[10 * 33], 32.f * sp[11 * 33]); o.w = pk4_fp8(32.f * sp[12 * 33], 32.f * sp[13 * 33], 32.f * sp[14 * 33], 32.f * sp[15 * 33]);
                __builtin_nontemporal_store(o, (GAS v4u*)(WT + (size_t)(e * erows + row_add + rowmap<MAP>(n0 + n)) * K + k0 + 16 * c)); }
            LDS_WAIT(); asm volatile("" ::: "memory");
        }
    }
#undef CONV_LOAD
#undef CONV_IT
}
__device__ __forceinline__ void p0_transpose_item_win(const float* W, bf16* WT, unsigned char* WT8, LAS float* scr, int item, int lane) {
    constexpr int K = D, N = 7264;
    const int nblk = N / 32, kb = item / nblk, nb = item % nblk, k0 = 64 * kb, n0 = 32 * nb;
#pragma unroll 8
    for (int i = 0; i < 32; ++i) { const int kk = 2 * i + (lane >> 5); scr[kk * 33 + (lane & 31)] = W[(size_t)(k0 + kk) * N + n0 + (lane & 31)]; }
    LDS_WAIT(); asm volatile("" ::: "memory");
    { const int c = lane & 7;
#pragma unroll
      for (int j = 0; j < 4; ++j) { const int n = (lane >> 3) + 8 * j; const LAS float* sp = scr + (8 * c) * 33 + n; const int rm = rowmap<1>(n0 + n);
        if (rm >= 0) { v4u o; o.x = pk2(sp[0 * 33], sp[1 * 33]); o.y = pk2(sp[2 * 33], sp[3 * 33]); o.z = pk2(sp[4 * 33], sp[5 * 33]); o.w = pk2(sp[6 * 33], sp[7 * 33]);
            *(GAS v4u*)(WT + (size_t)rm * K + k0 + 8 * c) = o; } } }
    { const int c = lane & 3;
#pragma unroll
      for (int j = 0; j < 2; ++j) { const int n = (lane >> 2) + 16 * j; const LAS float* sp = scr + (16 * c) * 33 + n; const int rm = rowmap<4>(n0 + n);
        if (rm >= 0) { v4u o; o.x = pk4_fp8(32.f * sp[0 * 33], 32.f * sp[1 * 33], 32.f * sp[2 * 33], 32.f * sp[3 * 33]); o.y = pk4_fp8(32.f * sp[4 * 33], 32.f * sp[5 * 33], 32.f * sp[6 * 33], 32.f * sp[7 * 33]);
            o.z = pk4_fp8(32.f * sp[8 * 33], 32.f * sp[9 * 33], 32.f * sp[10 * 33], 32.f * sp[11 * 33]); o.w = pk4_fp8(32.f * sp[12 * 33], 32.f * sp[13 * 33], 32.f * sp[14 * 33], 32.f * sp[15 * 33]);
            *(GAS v4u*)(WT8 + (size_t)rm * K + k0 + 16 * c) = o; } } }
    LDS_WAIT(); asm volatile("" ::: "memory");
}
__device__ __forceinline__ void rms_row_to_bf16(int lane, const float* xrow, const float* g, bf16* orow, unsigned char* orow8 = nullptr) {
    const GAS f32x4* xr = (const GAS f32x4*)xrow + lane;
    f32x4 v[8]; float s = 0.f;
#pragma unroll
    for (int j = 0; j < 8; ++j) { v[j] = xr[64 * j]; s += (v[j].x * v[j].x + v[j].y * v[j].y) + (v[j].z * v[j].z + v[j].w * v[j].w); }
    const float rstd = 1.0f / sqrtf(wave_sum(s) * (1.f / D) + EPS);
    GAS unsigned long long* o8 = (GAS unsigned long long*)orow + lane;
#pragma unroll
    for (int j = 0; j < 8; ++j) { const f32x4 gg = ((const GAS f32x4*)g)[64 * j + lane];
        o8[64 * j] = (unsigned long long)pk2(v[j].x * rstd * gg.x, v[j].y * rstd * gg.y) | ((unsigned long long)pk2(v[j].z * rstd * gg.z, v[j].w * rstd * gg.w) << 32);
        if (orow8) ((GAS unsigned*)orow8)[64 * j + lane] = pk4_fp8(v[j].x * rstd * gg.x, v[j].y * rstd * gg.y, v[j].z * rstd * gg.z, v[j].w * rstd * gg.w); }
}

#ifndef MK_DSA
#define MK_DSA 1
#endif
#ifndef MK_MOE
#define MK_MOE 1
#endif
#ifndef MK_GLA
#define MK_GLA 1
#endif
constexpr int PREF_OFF = LDSCTL_OFF, CNTL_OFF = MISC_OFF + 128;
__device__ __forceinline__ void rms_row_bf(int lane, const bf16* xrow, const float* g, bf16* orow, unsigned char* orow8) {
    const GAS v4u* xr = (const GAS v4u*)xrow + lane;
    v4u w[4]; float s = 0.f;
#pragma unroll
    for (int j = 0; j < 4; ++j) { w[j] = xr[64 * j];
        const float a0 = bflo(w[j].x), a1 = bfhi(w[j].x), a2 = bflo(w[j].y), a3 = bfhi(w[j].y), a4 = bflo(w[j].z), a5 = bfhi(w[j].z), a6 = bflo(w[j].w), a7 = bfhi(w[j].w);
        s += ((a0 * a0 + a1 * a1) + (a2 * a2 + a3 * a3)) + ((a4 * a4 + a5 * a5) + (a6 * a6 + a7 * a7)); }
    const float rstd = 1.0f / sqrtf(wave_sum(s) * (1.f / D) + EPS);
#pragma unroll
    for (int j = 0; j < 4; ++j) { const f32x4 g0 = ((const GAS f32x4*)g)[2 * (64 * j + lane)], g1 = ((const GAS f32x4*)g)[2 * (64 * j + lane) + 1];
        const float a0 = bflo(w[j].x) * rstd * g0.x, a1 = bfhi(w[j].x) * rstd * g0.y, a2 = bflo(w[j].y) * rstd * g0.z, a3 = bfhi(w[j].y) * rstd * g0.w;
        const float a4 = bflo(w[j].z) * rstd * g1.x, a5 = bfhi(w[j].z) * rstd * g1.y, a6 = bflo(w[j].w) * rstd * g1.z, a7 = bfhi(w[j].w) * rstd * g1.w;
        v4u o; o.x = pk2(a0, a1); o.y = pk2(a2, a3); o.z = pk2(a4, a5); o.w = pk2(a6, a7);
        ((GAS v4u*)orow)[64 * j + lane] = o;
        v2u o8; o8.x = pk4_fp8(a0, a1, a2, a3); o8.y = pk4_fp8(a4, a5, a6, a7);
        ((GAS v2u*)orow8)[64 * j + lane] = o8; }
}
__device__ __forceinline__ void combine_row_bf(int lane, const bf16* x1, const bf16* y0, const bf16* y1, const float* g, bf16* x2, unsigned char* orow8) {
    float v[4][8]; float s = 0.f;
#pragma unroll
    for (int j = 0; j < 4; ++j) { const v4u w = ((const GAS v4u*)x1)[64 * j + lane];
        v[j][0] = bflo(w.x); v[j][1] = bfhi(w.x); v[j][2] = bflo(w.y); v[j][3] = bfhi(w.y); v[j][4] = bflo(w.z); v[j][5] = bfhi(w.z); v[j][6] = bflo(w.w); v[j][7] = bfhi(w.w);
#if MK_MOE
        const v4u a = ((const GAS v4u*)y0)[64 * j + lane], b = ((const GAS v4u*)y1)[64 * j + lane];
        v[j][0] += bflo(a.x) + bflo(b.x); v[j][1] += bfhi(a.x) + bfhi(b.x); v[j][2] += bflo(a.y) + bflo(b.y); v[j][3] += bfhi(a.y) + bfhi(b.y);
        v[j][4] += bflo(a.z) + bflo(b.z); v[j][5] += bfhi(a.z) + bfhi(b.z); v[j][6] += bflo(a.w) + bflo(b.w); v[j][7] += bfhi(a.w) + bfhi(b.w);
#endif
        v4u o; o.x = pk2(v[j][0], v[j][1]); o.y = pk2(v[j][2], v[j][3]); o.z = pk2(v[j][4], v[j][5]); o.w = pk2(v[j][6], v[j][7]);
        ((GAS v4u*)x2)[64 * j + lane] = o;
        v[j][0] = bflo(o.x); v[j][1] = bfhi(o.x); v[j][2] = bflo(o.y); v[j][3] = bfhi(o.y); v[j][4] = bflo(o.z); v[j][5] = bfhi(o.z); v[j][6] = bflo(o.w); v[j][7] = bfhi(o.w);
#pragma unroll
        for (int q = 0; q < 8; ++q) s += v[j][q] * v[j][q]; }
    const float rstd = 1.0f / sqrtf(wave_sum(s) * (1.f / D) + EPS);
#pragma unroll
    for (int j = 0; j < 4; ++j) { const f32x4 g0 = ((const GAS f32x4*)g)[2 * (64 * j + lane)], g1 = ((const GAS f32x4*)g)[2 * (64 * j + lane) + 1];
        v2u o8; o8.x = pk4_fp8(v[j][0] * rstd * g0.x, v[j][1] * rstd * g0.y, v[j][2] * rstd * g0.z, v[j][3] * rstd * g0.w);
        o8.y = pk4_fp8(v[j][4] * rstd * g1.x, v[j][5] * rstd * g1.y, v[j][6] * rstd * g1.z, v[j][7] * rstd * g1.w);
        ((GAS v2u*)orow8)[64 * j + lane] = o8; }
}
__device__ __forceinline__ void combine_row(int lane, float* xio, const bf16* y0, const bf16* y1, const float* g, unsigned char* orow8) {
    GAS f32x4* xr = (GAS f32x4*)xio + lane;
    f32x4 v[8]; float s = 0.f;
#pragma unroll
    for (int j = 0; j < 8; ++j) { v[j] = xr[64 * j];
#if MK_MOE
        const v2u a = ((const GAS v2u*)y0)[64 * j + lane], b = ((const GAS v2u*)y1)[64 * j + lane];
        v[j].x += bflo(a.x) + bflo(b.x); v[j].y += bfhi(a.x) + bfhi(b.x); v[j].z += bflo(a.y) + bflo(b.y); v[j].w += bfhi(a.y) + bfhi(b.y);
#endif
        s += (v[j].x * v[j].x + v[j].y * v[j].y) + (v[j].z * v[j].z + v[j].w * v[j].w); }
    const float rstd = 1.0f / sqrtf(wave_sum(s) * (1.f / D) + EPS);
#pragma unroll
    for (int j = 0; j < 8; ++j) { const f32x4 gg = ((const GAS f32x4*)g)[64 * j + lane];
        xr[64 * j] = v[j];
        ((GAS unsigned*)orow8)[64 * j + lane] = pk4_fp8(v[j].x * rstd * gg.x, v[j].y * rstd * gg.y, v[j].z * rstd * gg.z, v[j].w * rstd * gg.w); }
}

struct Args { const float* in[27]; float* out; unsigned char* ws; int ph_lo, ph_hi; };

#define AS4 __attribute__((address_space(4)))
#define PHASE_LOCALS \
    const AS4 Args* ap = (const AS4 Args*)__builtin_amdgcn_kernarg_segment_ptr(); asm volatile("" : "+s"(ap)); \
    unsigned char* const ws = ap->ws; int tid_o = threadIdx.x; asm volatile("" : "+v"(tid_o)); \
    Frame F; F.lds = (LAS unsigned char*)lds_raw; F.MISC = (volatile LAS unsigned*)(F.lds + MISC_OFF); F.ctl = (gu32*)(ws + WS_CTL); \
    F.tid = tid_o; F.lane = tid_o & 63; F.wave = __builtin_amdgcn_readfirstlane(tid_o >> 6); F.G = gridDim.x; \
    { const int bx = blockIdx.x; F.vcu = (F.G % 8 == 0) ? (bx % 8) * (F.G / 8) + bx / 8 : bx; } \
    const int gw = F.vcu * NWAVES + F.wave, NGW = F.G * NWAVES; const int gt = blockIdx.x * 512 + F.tid, NGT = F.G * 512; \
    bf16* const HB = (bf16*)(ws + WS_HB); bf16* const ZB = (bf16*)(ws + WS_ZB); \
    LAS unsigned char* const wl = F.lds + RING_OFF + F.wave * 16384; \
    (void)gw; (void)NGW; (void)gt; (void)NGT; (void)HB; (void)ZB; (void)wl;
#ifndef MK_DBL
#define MK_DBL 0
#endif
#define REP2 for (int rep_ = 0; rep_ < 2; ++rep_)
#if (MK_DBL >> 0) & 1
#define REP_0 REP2
#else
#define REP_0
#endif
#if (MK_DBL >> 1) & 1
#define REP_1 REP2
#else
#define REP_1
#endif
#if (MK_DBL >> 2) & 1
#define REP_2 REP2
#else
#define REP_2
#endif
#if (MK_DBL >> 3) & 1
#define REP_3 REP2
#else
#define REP_3
#endif
#if (MK_DBL >> 4) & 1
#define REP_4 REP2
#else
#define REP_4
#endif
#if (MK_DBL >> 5) & 1
#define REP_5 REP2
#else
#define REP_5
#endif
#if (MK_DBL >> 6) & 1
#define REP_6 REP2
#else
#define REP_6
#endif
#if (MK_DBL >> 7) & 1
#define REP_7 REP2
#else
#define REP_7
#endif
#if (MK_DBL >> 8) & 1
#define REP_8 REP2
#else
#define REP_8
#endif
#if (MK_DBL >> 9) & 1
#define REP_9 REP2
#else
#define REP_9
#endif
#if (MK_DBL >> 10) & 1
#define REP_10 REP2
#else
#define REP_10
#endif
#if (MK_DBL >> 11) & 1
#define REP_11 REP2
#else
#define REP_11
#endif
#if (MK_DBL >> 12) & 1
#define REP_12 REP2
#else
#define REP_12
#endif
#if (MK_DBL >> 13) & 1
#define REP_13 REP2
#else
#define REP_13
#endif
#if (MK_DBL >> 14) & 1
#define REP_14 REP2
#else
#define REP_14
#endif
#define REP(k) REP_##k
#define IN(k) (ap->in[k])
#define GRID_BAR() do { XcdBarrier bb_; bb_.bar = (unsigned*)(F.ctl + CW_BAR); bb_.x = xb_xcc_id(); bb_.st = F.MISC + 8; xcd_barrier(bb_); } while (0)

__global__ void __launch_bounds__(NWAVES * 64, 2) mk_fwd(Args args) {
    extern __shared__ __attribute__((aligned(16))) unsigned char lds_raw[];
    (void)args;
    {
        PHASE_LOCALS
        for (int u = F.tid; u < (LDS_BYTES - LDSCTL_OFF) / 4; u += NWAVES * 64) ((LAS unsigned*)(F.lds + LDSCTL_OFF))[u] = 0u;
        __syncthreads();
        (void)xcd_barrier_post((unsigned*)(F.ctl + CW_BAR), F.MISC + 8);
    }
    REP(0)
    {
        PHASE_LOCALS
        LAS float* scr = (LAS float*)wl;
        constexpr int I_IN = (D / 64) * (7264 / 32), I_BG = (D / 64) * (4096 / 32), I_OG = (1024 / 64) * (D / 32), I_O = (D / 64) * (D / 32), I_PP = (PLE / 64) * (D / 32);
        constexpr int NITEMS = I_IN + I_BG + 2 * I_OG + 2 * I_O + I_PP;
        for (int it = gw; it < NITEMS; it += NGW) {
            int r = it;
            if (r < I_IN) { p0_transpose_item_win(IN(3), (bf16*)(ws + WS_WIN), ws + WS_WIN8, scr, r, F.lane); continue; } r -= I_IN;
            if (r < I_BG) { p0_transpose_item8<2>(IN(12), D, 4096, ws + WS_WBG8, 0, scr, r, F.lane, 32.0f); continue; } r -= I_BG;
            if (r < I_OG) { p0_transpose_item<0>(IN(7), 1024, D, (bf16*)(ws + WS_WOG), 0, scr, r, F.lane); continue; } r -= I_OG;
            if (r < I_OG) { p0_transpose_item8<0>(IN(11), 1024, D, ws + WS_WOD8, 0, scr, r, F.lane, 32.0f); continue; } r -= I_OG;
            if (r < I_O) { p0_transpose_item8<0>(IN(14), D, D, ws + WS_WO8, 0, scr, r, F.lane, 32.0f); continue; } r -= I_O;
            if (r < I_O) { p0_transpose_item8<0>(IN(24), D, D, ws + WS_WPG8, 0, scr, r, F.lane, 32.0f); continue; } r -= I_O;
            p0_transpose_item<0>(IN(26), PLE, D, (bf16*)(ws + WS_WPP), 0, scr, r, F.lane);
        }
        { GAS v4u* z = (GAS v4u*)((bf16*)(ws + WS_WIN) + (size_t)(ZC_IW + 16 - 2048) * D);
          for (int i = gt; i < 160 * D * 2 / 16; i += NGT) z[i] = (v4u){0u, 0u, 0u, 0u}; }
        { bf16* wr = (bf16*)(ws + WS_WR); const float* wg = IN(16); const float* we = IN(18);
          for (int i = gt; i < 256 * D; i += NGT) { const int n = i >> 11, k = i & 2047; const float v = n < 8 ? wg[k * 8 + n] : (n < 72 ? we[k * 64 + (n - 8)] : 0.f); wr[i] = (bf16)f2bf(v); } }
        for (int m = gw; m < T; m += NGW) rms_row_to_bf16(F.lane, IN(0) + (size_t)m * D, IN(2), HB + (size_t)m * D, (unsigned char*)ap->out + (size_t)m * D);
        GRID_BAR();
    }
    REP(1)
    {
        PHASE_LOCALS
        { pg8::StaticOrder S; S.init(T, ZN_A - 2048, F.G, (int)blockIdx.x);
          pg8::Gemm g{HB, (const bf16*)(ws + WS_WIN), D};
          pg8::EpiBf16Skip E{ZB, ZP, 4, 2048};
          pg8::gemm_phase<pg8::EpiBf16Skip, pg8::StaticOrder>(F.lds + RING_OFF, g, S, E); }
        { pg8::StaticOrder S; S.init(T, 5120, F.G, (int)blockIdx.x);
          pg8::Gemm8 g{(const unsigned char*)ap->out, ws + WS_WIN8, D / 2, 0x7f7f7f7f, 0x7a7a7a7a};
          pg8::EpiBf16Skip E{ZB + 1024, ZP, 8, ZN_A - 3072};
          pg8::gemm_phase8<pg8::EpiBf16Skip, pg8::StaticOrder>(F.lds + RING_OFF, g, S, E); }
        GRID_BAR();
    }
    REP(2)
    {
        PHASE_LOCALS
#if MK_GLA
        for (int task = blockIdx.x; task < NB * 128; task += F.G) {
            gla_prep_task(F.lds, ZB, IN(4), IN(5), (float*)(ws + WS_DEC), task);
            gla_local_unit(F.lds, F.wave, F.lane, ZB, (const float*)(ws + WS_DEC), (float*)(ws + WS_SLOC), task * 8 + F.wave);
            __syncthreads();
        }
#endif
        for (int m = gw; m < T; m += NGW) dsa_prep_row(F.lane, ZB, (size_t)m, IN(8), IN(9), (bf16*)(ws + WS_IKC), (float*)(ws + WS_UW));
        GRID_BAR();
    }
    REP(3)
    {
        PHASE_LOCALS
#if MK_GLA
        gla_scan((const float*)(ws + WS_SLOC), (const float*)(ws + WS_DEC), (bf16*)(ws + WS_STT), gt, NGT);
#endif
#if MK_DSA
        for (int task = blockIdx.x; task < NB * 64; task += F.G) {
            const int b = task >> 6, xq = task & 63;
#pragma unroll 1
            for (int half = 0; half < 2; ++half) {
                const int c = half ? 127 - xq : xq, n = 64 * (c + 1);
                unsigned char* wsl = ws; int lane_l = F.lane; asm volatile("" : "+s"(wsl), "+v"(lane_l));
                idx_scores_oct(wl, lane_l, (const bf16*)(wsl + WS_ZB), (const bf16*)(wsl + WS_IKC), (const float*)(wsl + WS_UW), (unsigned short*)(wsl + WS_SC), b, c, F.wave);
                VM_WAIT(); __syncthreads();
                asm volatile("" : "+s"(wsl), "+v"(lane_l));
#pragma unroll 1
                for (int q = 0; q < 8; ++q) { const int ql = F.wave * 8 + q;
                    idx_select_row(lane_l, (const unsigned short*)(wsl + WS_SC) + sc_off(b, c) + (size_t)ql * n, n, F.lds + RING_OFF + ql * 1024, (LAS unsigned*)(F.lds + RING_OFF + 65536 + F.wave * 8192)); }
                LDS_WAIT(); __syncthreads();
                asm volatile("" : "+s"(wsl), "+v"(lane_l));
                const int tend = (c | 3) + 1;
#pragma unroll 1
                for (int tile = F.wave; tile < tend; tile += NWAVES) bt_emit_tile(lane_l, F.lds + RING_OFF, (unsigned*)(wsl + WS_BM), b, c, tile, tile > c);
                __syncthreads();
            }
        }
#endif
        GRID_BAR();
    }
    REP(4)
    {
        PHASE_LOCALS
#if MK_GLA
        for (int u = gw; u < 4096; u += NGW) gla_out_unit(wl, F.lane, ZB, (const bf16*)(ws + WS_STT), IN(6), (bf16*)(ws + WS_OA), u);
        __syncthreads();
#endif
#if MK_MOE
        if (F.vcu % CONV_MOD == 0) {
            const int cw = (F.vcu / CONV_MOD) * NWAVES + F.wave, NCW = ((F.G + CONV_MOD - 1) / CONV_MOD) * NWAVES;
            LAS float* scr = (LAS float*)wl; const int lane_c = opaque_tid() & 63;
            conv_stream8<3>(IN(20), D, EFF, ws + WS_WGU8, 1024, 0, scr, lane_c, cw, NCW);
            conv_stream8<3>(IN(21), D, EFF, ws + WS_WGU8, 1024, 128, scr, lane_c, cw, NCW);
            conv_stream8<0>(IN(22), EFF, D, ws + WS_WDN8, D, 0, scr, lane_c, cw, NCW);
            __syncthreads();
        }
#endif
#if MK_DSA
        att::attn_phase((char*)lds_raw, ZB, ws + WS_OB, (const unsigned*)(ws + WS_BM), IN(10), IN(8), IN(9), F.ctl + CW_ATTQ);
#endif
        GRID_BAR();
    }
    REP(5)
    {
        PHASE_LOCALS
        pg8::StaticOrder S; S.init(T, D, F.G, (int)blockIdx.x);
        { pg8::Gemm g{(const bf16*)(ws + WS_OA), (const bf16*)(ws + WS_WOG), 1024}; pg8::EpiFp8 E{ws + WS_YA, D};
          pg8::gemm_phase<pg8::EpiFp8, pg8::StaticOrder>(F.lds + RING_OFF, g, S, E); }
        { pg8::Gemm8 g{ws + WS_OB, ws + WS_WOD8, 1024 / 2, 0x7b7b7b7b, 0x7a7a7a7a}; pg8::EpiFp8 E{ws + WS_YB, D};
          pg8::gemm_phase8<pg8::EpiFp8, pg8::StaticOrder>(F.lds + RING_OFF, g, S, E); }
        GRID_BAR();
    }
    REP(6)
    {
        PHASE_LOCALS
        pg8::StaticOrder S; S.init(T, 4096, F.G, (int)blockIdx.x);
        pg8::Gemm8 g{(const unsigned char*)ap->out, ws + WS_WBG8, D / 2, 0x7f7f7f7f, 0x7a7a7a7a};
        pg8::EpiGateMix E{ws + WS_YA, ws + WS_YB, ws + WS_U, IN(13)};
        pg8::gemm_phase8<pg8::EpiGateMix, pg8::StaticOrder>(F.lds + RING_OFF, g, S, E);
        GRID_BAR();
    }
    REP(7)
    {
        PHASE_LOCALS
        pg8::StaticOrder S; S.init(T, D, F.G, (int)blockIdx.x);
        pg8::Gemm8 g{ws + WS_U, ws + WS_WO8, D / 2, 0x7c7c7c7c, 0x7a7a7a7a};
        pg8::EpiResBf16P E{IN(0), (bf16*)ap->out, D};
        pg8::gemm_phase8<pg8::EpiResBf16P, pg8::StaticOrder>(F.lds + RING_OFF, g, S, E);
        GRID_BAR();
    }
    REP(8)
    {
        PHASE_LOCALS
        for (int m = gw; m < T; m += NGW) rms_row_bf(F.lane, (const bf16*)ap->out + (size_t)m * D, IN(15), (bf16*)(ws + WS_H2B) + (size_t)m * D, ws + WS_H8 + (size_t)m * D);
        { const GAS f32x4* p4 = (const GAS f32x4*)IN(1); GAS v2u* o = (GAS v2u*)(ws + WS_PBF);
          for (size_t i = (size_t)gt; i < (size_t)T * PLE / 4; i += (size_t)NGT) { const f32x4 v = p4[i]; v2u w; w.x = pk2(v.x, v.y); w.y = pk2(v.z, v.w); o[i] = w; } }
        GRID_BAR();
    }
#if MK_MOE
    REP(9)
    {
        PHASE_LOCALS
        pg8::StaticOrder S; S.init(T, 256, F.G, (int)blockIdx.x);
        pg8::Gemm g{(const bf16*)(ws + WS_H2B), (const bf16*)(ws + WS_WR), D};
        pg8::EpiF32 E{(float*)(ws + WS_LOGIT), 256};
        pg8::gemm_phase<pg8::EpiF32, pg8::StaticOrder>(F.lds + RING_OFF, g, S, E);
        VM_WAIT(); __syncthreads();
        { pg8::Unit ur;
          const int nu = (128 - (int)blockIdx.x + F.G - 1) / F.G;
#pragma unroll 1
          for (int iu = 0; iu < nu; ++iu) { S.next(iu, ur); const int t_lo = ur.pm * 256, t_hi = t_lo + 256;
        const float* LG = (const float*)(ws + WS_LOGIT); const float* bg = IN(17); const float* be = IN(19);
          unsigned* cnt = (unsigned*)(F.ctl + CW_CNT); int* tokrow = (int*)(ws + WS_TOKROW); float* tokw = (float*)(ws + WS_TOKW);
          for (int t = t_lo + F.tid; t < t_hi; t += NWAVES * 64) {
              const f32x4 a = *(const f32x4*)(LG + (size_t)t * 256), b2 = *(const f32x4*)(LG + (size_t)t * 256 + 4);
              float l[8] = {a.x + bg[0], a.y + bg[1], a.z + bg[2], a.w + bg[3], b2.x + bg[4], b2.y + bg[5], b2.z + bg[6], b2.w + bg[7]};
              int gi = 0; float gm = l[0];
#pragma unroll
              for (int i = 1; i < 8; ++i) if (l[i] > gm) { gm = l[i]; gi = i; }
              float se = 0.f;
#pragma unroll
              for (int i = 0; i < 8; ++i) se += __expf(l[i] - gm);
              const float grp_w = 1.0f / se;
              const f32x4 c0 = *(const f32x4*)(LG + (size_t)t * 256 + 8 + gi * 8), c1 = *(const f32x4*)(LG + (size_t)t * 256 + 12 + gi * 8);
              const float* bb = be + gi * 8;
              float ev[8] = {c0.x + bb[0], c0.y + bb[1], c0.z + bb[2], c0.w + bb[3], c1.x + bb[4], c1.y + bb[5], c1.z + bb[6], c1.w + bb[7]};
              int i0 = 0; float v0 = ev[0];
#pragma unroll
              for (int i = 1; i < 8; ++i) if (ev[i] > v0) { v0 = ev[i]; i0 = i; }
              int i1 = -1; float v1 = -__builtin_inff();
#pragma unroll
              for (int i = 0; i < 8; ++i) if (i != i0 && ev[i] > v1) { v1 = ev[i]; i1 = i; }
              const float w0 = 1.0f / (1.0f + __expf(v1 - v0)), w1 = 1.0f - w0;
              const int e0 = gi * 8 + i0, e1 = gi * 8 + i1;
              const unsigned p0 = atomicAdd(&cnt[e0], 1u), p1 = atomicAdd(&cnt[e1], 1u);
              tokrow[(size_t)e0 * ECAP + p0] = t * 2; tokw[(size_t)e0 * ECAP + p0] = grp_w * w0;
              tokrow[(size_t)e1 * ECAP + p1] = t * 2 + 1; tokw[(size_t)e1 * ECAP + p1] = grp_w * w1;
          }
          } }
        { pg8::PleOrder SP{F.G, (int)blockIdx.x};
          pg8::Gemm gp{(const bf16*)(ws + WS_PBF), (const bf16*)(ws + WS_WPP), PLE};
          pg8::EpiBf16 EP{(bf16*)(ws + WS_PLEB), D};
          pg8::gemm_phase<pg8::EpiBf16, pg8::PleOrder>(F.lds + RING_OFF, gp, SP, EP); }
        GRID_BAR();
    }
    REP(11)
    {
        PHASE_LOCALS
        LAS int* pref = (LAS int*)(F.lds + PREF_OFF); LAS int* cntl = (LAS int*)(F.lds + CNTL_OFF);
        if (F.tid < 64) cntl[F.tid] = (int)__hip_atomic_load((unsigned*)(F.ctl + CW_CNT) + F.tid, RLX_AGENT);
        __syncthreads();
        if (F.tid == 0) { int acc = 0; for (int e = 0; e < 64; ++e) { pref[e] = acc; acc += (cntl[e] + 255) >> 8; } pref[64] = acc; }
        __syncthreads();
        pg8::MoeOrder S{pref, cntl, (const int*)(ws + WS_TOKROW), 4, F.G, F.vcu, D / 2};
        pg8::Gemm8 g{ws + WS_H8, ws + WS_WGU8, D / 2, 0x7f7f7f7f, 0x7a7a7a7a};
        pg8::EpiMoe1 E{ws + WS_ACT};
        pg8::gemm_phase8<pg8::EpiMoe1, pg8::MoeOrder, true>(F.lds + RING_OFF, g, S, E);
        GRID_BAR();
    }
    REP(12)
    {
        PHASE_LOCALS
        LAS int* pref = (LAS int*)(F.lds + PREF_OFF); LAS int* cntl = (LAS int*)(F.lds + CNTL_OFF);
        pg8::MoeOrder S{pref, cntl, (const int*)(ws + WS_TOKROW), 8, F.G, F.vcu, EFF / 2};
        pg8::Gemm8 g{ws + WS_ACT, ws + WS_WDN8, EFF / 2, 0x7d7d7d7d, 0x7a7a7a7a};
        pg8::EpiMoe2 E{(bf16*)(ws + WS_Y0), (long long)(HB - (bf16*)(ws + WS_Y0)), (const int*)(ws + WS_TOKROW), (const float*)(ws + WS_TOKW), cntl};
        pg8::gemm_phase8<pg8::EpiMoe2, pg8::MoeOrder, false>(F.lds + RING_OFF, g, S, E);
        GRID_BAR();
    }
#endif
    REP(13)
    {
        PHASE_LOCALS
        for (int m = gw; m < T; m += NGW) combine_row_bf(F.lane, (const bf16*)ap->out + (size_t)m * D, (const bf16*)(ws + WS_Y0) + (size_t)m * D, HB + (size_t)m * D, IN(23), (bf16*)(ws + WS_X2B) + (size_t)m * D, ws + WS_H8 + (size_t)m * D);
        GRID_BAR();
    }
    REP(14)
    {
        PHASE_LOCALS
        pg8::StaticOrder S; S.init(T, D, F.G, (int)blockIdx.x);
        { pg8::Gemm8 g{ws + WS_H8, ws + WS_WPG8, D / 2, 0x7f7f7f7f, 0x7a7a7a7a};
          pg8::EpiPleFinal E{(const bf16*)(ws + WS_X2B), (const bf16*)(ws + WS_PLEB), ap->out, IN(25)};
          pg8::gemm_phase8<pg8::EpiPleFinal, pg8::StaticOrder>(F.lds + RING_OFF, g, S, E); }
    }
}

extern "C" void kernel_launch(void* const* d_in, const int* in_sizes, int n_in, void* d_out, int out_size, void* d_ws, size_t ws_size, hipStream_t stream) {
    static int grid = 0;
    if (grid == 0) {
        if (n_in != 27 || out_size != T * D || ws_size < WS_END) { fprintf(stderr, "kernel_launch: unexpected shapes (n_in %d out %d ws %zu, need %zu)\n", n_in, out_size, ws_size, (size_t)WS_END); grid = -1; return; }
        int dev = 0, cus = 0, per_cu = 0;
        if (hipGetDevice(&dev) != hipSuccess || hipDeviceGetAttribute(&cus, hipDeviceAttributeMultiprocessorCount, dev) != hipSuccess) { grid = -1; return; }
        if (hipFuncSetAttribute((const void*)mk_fwd, hipFuncAttributeMaxDynamicSharedMemorySize, LDS_BYTES) != hipSuccess) { fprintf(stderr, "kernel_launch: hipFuncSetAttribute failed\n"); grid = -1; return; }
        if (hipOccupancyMaxActiveBlocksPerMultiprocessor(&per_cu, (const void*)mk_fwd, NWAVES * 64, LDS_BYTES) != hipSuccess || per_cu < 1) { fprintf(stderr, "kernel_launch: occupancy query says %d\n", per_cu); }
        (void)hipGetLastError();
        grid = cus;
    }
    if (grid < 0) return;
    if (hipMemsetAsync((char*)d_ws + WS_CTL, 0, CTL_ZERO_BYTES, stream) != hipSuccess) return;
    Args a{};
    for (int i = 0; i < 27; ++i) a.in[i] = (const float*)d_in[i];
    a.out = (float*)d_out; a.ws = (unsigned char*)d_ws; a.ph_lo = 0; a.ph_hi = 99;
    hipLaunchKernelGGL(mk_fwd, dim3(grid), dim3(NWAVES * 64), LDS_BYTES, stream, a);
}
```

```cpp
#include <hip/hip_runtime.h>
#include <cstdio>
#include <cstdint>

#ifndef MK_STAGE
#define MK_STAGE 1
#endif

#define GAS __attribute__((address_space(1)))
#define LAS __attribute__((address_space(3)))
typedef unsigned short bf16;
typedef unsigned v4u __attribute__((ext_vector_type(4)));
typedef unsigned v2u __attribute__((ext_vector_type(2)));
typedef float f32x4 __attribute__((ext_vector_type(4)));
typedef float f32x2 __attribute__((ext_vector_type(2)));
typedef float f32x16 __attribute__((ext_vector_type(16)));
typedef short bf16x8 __attribute__((ext_vector_type(8)));
typedef short s16x4 __attribute__((ext_vector_type(4)));
typedef GAS unsigned gu32;
#define RLX_AGENT __ATOMIC_RELAXED, __HIP_MEMORY_SCOPE_AGENT
#define LDS_WAIT() asm volatile("s_waitcnt lgkmcnt(0)" ::: "memory")
#define VM_WAIT() asm volatile("s_waitcnt vmcnt(0)" ::: "memory")

constexpr int NB = 4, SEQ = 8192, T = NB * SEQ, D = 2048, PLE = 256;
constexpr int ZP = 7424;
constexpr int ZC_GQ = 0, ZC_GK = 512, ZC_GV = 1024, ZC_GR = 2048, ZC_GLR = 3072, ZC_IK = 3088, ZC_IW = 3152, ZC_IQ = 3328, ZN_A = 4352  , ZC_DQ = 4352, ZC_DK = 5376, ZC_DV = 6400;
constexpr int NEXP = 64, EFF = 512, ECAP = 32768;
constexpr int ACT_ROWS = 81920;
constexpr float EPS = 1e-6f;
constexpr int NWAVES = 8;

constexpr size_t MiB = 1u << 20;
constexpr size_t al(size_t x) { return (x + 255) & ~(size_t)255; }
constexpr size_t WS_CTL = 0, CTL_ZERO_BYTES = 1 * MiB;
constexpr size_t WS_WIN = WS_CTL + CTL_ZERO_BYTES;
constexpr size_t WS_WBG = WS_WIN + al((size_t)ZP * D * 2);
constexpr size_t WS_WOG = WS_WBG + al((size_t)4096 * D * 2);
constexpr size_t WS_WOD = WS_WOG + al((size_t)D * 1024 * 2);
constexpr size_t WS_WO = WS_WOD + al((size_t)D * 1024 * 2);
constexpr size_t WS_WPG = WS_WO + al((size_t)D * D * 2);
constexpr size_t WS_WPP = WS_WPG + al((size_t)D * D * 2);
constexpr size_t WS_WR = WS_WPP + al((size_t)D * PLE * 2);
constexpr size_t WS_HB = WS_WR + al((size_t)256 * D * 2);
constexpr size_t WS_ZB = WS_HB + al((size_t)T * D * 2);
constexpr size_t ZB_BYTES = (size_t)T * ZP * 2;
constexpr size_t WS_SC = WS_ZB + al(ZB_BYTES);
constexpr size_t SC_PER_BATCH = (size_t)64 * 64 * (128 * 129 / 2);
constexpr size_t SC_BYTES = (size_t)NB * SC_PER_BATCH * 2;
constexpr size_t WS_BM = WS_SC + al(SC_BYTES);
constexpr size_t WS_SLOC = WS_BM + al((size_t)T * 1024);
constexpr size_t WS_STT = WS_SLOC + al((size_t)4096 * 8192 * 4);
constexpr size_t WS_DEC = WS_STT + al((size_t)4096 * 8192 * 2);
constexpr size_t WS_IKC = WS_DEC + al((size_t)4096 * 64 * 4);
constexpr size_t WS_UW = WS_IKC + al((size_t)T * 64 * 2);
constexpr size_t WS_WBG8 = WS_UW + al((size_t)T * 16 * 4);
constexpr size_t WS_WPG8 = WS_WBG8 + al((size_t)4096 * D);
constexpr size_t WS_WOD8 = WS_WPG8 + al((size_t)D * D);
constexpr size_t WS_WO8 = WS_WOD8 + al((size_t)D * 1024);
constexpr size_t WS_END = WS_WO8 + al((size_t)D * D);
constexpr size_t WS_WIN8 = WS_WIN + (size_t)ZN_A * D * 2;
static_assert(WS_WIN8 + (size_t)5120 * D <= WS_WBG, "w_in copies fit their region");
constexpr size_t WS_OA = WS_SC, WS_OB = WS_SC + (size_t)T * 1024 * 2;
constexpr size_t WS_YA = WS_ZB, WS_YB = WS_ZB + (size_t)T * D * 2, WS_U = WS_ZB + 2 * (size_t)T * D * 2;
constexpr size_t WS_WGU = WS_ZB;
constexpr size_t WS_WDN = WS_WGU + (size_t)NEXP * 1024 * D * 2;
constexpr size_t WS_ACT = WS_WDN + (size_t)NEXP * D * EFF * 2;
static_assert(WS_ACT + (size_t)ACT_ROWS * EFF * 2 <= WS_ZB + ZB_BYTES, "MoE overlay fits in Z");
constexpr size_t WS_LOGIT = WS_SC;
constexpr size_t WS_TOKROW = WS_LOGIT + (size_t)T * 256 * 4;
constexpr size_t WS_TOKW = WS_TOKROW + (size_t)NEXP * ECAP * 4;
constexpr size_t WS_PLEB = WS_TOKW + (size_t)NEXP * ECAP * 4;
constexpr size_t WS_PBF = WS_PLEB + (size_t)T * D * 2;
static_assert(WS_PBF + (size_t)T * PLE * 2 <= WS_SC + SC_BYTES, "late overlays fit in SC");
constexpr size_t WS_H8 = WS_STT;
constexpr size_t WS_WGU8 = WS_HB;
constexpr size_t WS_WDN8 = WS_SC + SC_BYTES - (size_t)NEXP * D * EFF;
static_assert(WS_PBF + (size_t)T * PLE * 2 <= WS_WDN8 && WS_OB + (size_t)T * 1024 * 2 <= WS_WDN8 && WS_WDN8 % 256 == 0, "expert down weights behind the SC overlays");
constexpr size_t WS_X2B = WS_ZB;
constexpr size_t WS_H2B = WS_ZB;
constexpr size_t WS_Y0 = WS_SLOC;
static_assert(WS_END <= (size_t)1253000000, "workspace map within the guaranteed minimum");
constexpr int CW_BAR = 4096;
constexpr int CW_CNT = 16384;
constexpr int CW_ATTQ = 20480;

__device__ __forceinline__ unsigned f2bf(float f) { unsigned u = __builtin_bit_cast(unsigned, f); return (u + 0x7fffu + ((u >> 16) & 1u)) >> 16; }
__device__ __forceinline__ unsigned pk2(float lo, float hi) { return f2bf(lo) | (f2bf(hi) << 16); }
__device__ __forceinline__ unsigned pk4_fp8(float a, float b, float c, float d) { int w = 0; w = __builtin_amdgcn_cvt_pk_fp8_f32(a, b, w, false); w = __builtin_amdgcn_cvt_pk_fp8_f32(c, d, w, true); return (unsigned)w; }
__device__ __forceinline__ float bf2f(unsigned short b) { return __builtin_bit_cast(float, (unsigned)b << 16); }
__device__ __forceinline__ float bflo(unsigned w) { return __builtin_bit_cast(float, w << 16); }
__device__ __forceinline__ float bfhi(unsigned w) { return __builtin_bit_cast(float, w & 0xffff0000u); }
__device__ __forceinline__ unsigned cvt_pk_bf16(float lo, float hi) { unsigned r; asm volatile("v_cvt_pk_bf16_f32 %0, %1, %2" : "=v"(r) : "v"(lo), "v"(hi)); return r; }
#define DPP_I(v, ctrl) __builtin_amdgcn_update_dpp((int)(v), (int)(v), (ctrl), 0xF, 0xF, true)
#define DPP_F(v, ctrl) __builtin_bit_cast(float, __builtin_amdgcn_update_dpp(__builtin_bit_cast(int, (float)(v)), __builtin_bit_cast(int, (float)(v)), (ctrl), 0xF, 0xF, true))
constexpr int DPP_X1 = 0xB1, DPP_X2 = 0x4E, DPP_HM = 0x141, DPP_RM = 0x140;
__device__ __forceinline__ float sum8(float v) { v += DPP_F(v, DPP_X1); v += DPP_F(v, DPP_X2); v += DPP_F(v, DPP_HM); return v; }
__device__ __forceinline__ float sum16(float v) { v = sum8(v); v += DPP_F(v, DPP_RM); return v; }
__device__ __forceinline__ float sum32(float v) { v = sum16(v); auto r = __builtin_amdgcn_permlane16_swap(__float_as_uint(v), __float_as_uint(v), false, false); return __uint_as_float(r[0]) + __uint_as_float(r[1]); }
__device__ __forceinline__ float wave_sum(float v) { v = sum32(v); auto r = __builtin_amdgcn_permlane32_swap(__float_as_uint(v), __float_as_uint(v), false, false); return __uint_as_float(r[0]) + __uint_as_float(r[1]); }
__device__ __forceinline__ float wave_max(float v) {
    v = fmaxf(v, DPP_F(v, DPP_X1)); v = fmaxf(v, DPP_F(v, DPP_X2)); v = fmaxf(v, DPP_F(v, DPP_HM)); v = fmaxf(v, DPP_F(v, DPP_RM));
    { auto r = __builtin_amdgcn_permlane16_swap(__float_as_uint(v), __float_as_uint(v), false, false); v = fmaxf(__uint_as_float(r[0]), __uint_as_float(r[1])); }
    { auto r = __builtin_amdgcn_permlane32_swap(__float_as_uint(v), __float_as_uint(v), false, false); v = fmaxf(__uint_as_float(r[0]), __uint_as_float(r[1])); }
    return v;
}
__device__ __forceinline__ int wave_sum_i(int v) {
    v += DPP_I(v, DPP_X1); v += DPP_I(v, DPP_X2); v += DPP_I(v, DPP_HM); v += DPP_I(v, DPP_RM);
    { auto r = __builtin_amdgcn_permlane16_swap((unsigned)v, (unsigned)v, false, false); v = (int)(r[0] + r[1]); }
    { auto r = __builtin_amdgcn_permlane32_swap((unsigned)v, (unsigned)v, false, false); v = (int)(r[0] + r[1]); }
    return v;
}
__device__ __forceinline__ int opaque_tid() { int t = threadIdx.x; asm volatile("" : "+v"(t)); return t; }
__device__ __forceinline__ float sigmoidf_(float x) { return __builtin_amdgcn_rcpf(1.0f + __builtin_amdgcn_exp2f(-1.4426950408889634f * x)); }

#define XB_TMO      128
#define XB_XCNT(j)  (256  + 64 * (j))
#define XB_XSUB(j)  (1280 + 64 * (j))
#define XB_XGEN(j)  (2304 + 64 * (j))
#define XB_TOP      3328
#define XB_TOPGEN   3392
#define XCD_BAR_WORDS 3456
#define XB_SPIN_CAP (1u << 18)
__device__ __forceinline__ unsigned xb_ld(unsigned* p)              { return __hip_atomic_load(p, __ATOMIC_RELAXED, __HIP_MEMORY_SCOPE_AGENT); }
__device__ __forceinline__ unsigned xb_add(unsigned* p, unsigned v) { return __hip_atomic_fetch_add(p, v, __ATOMIC_RELAXED, __HIP_MEMORY_SCOPE_AGENT); }
__device__ __forceinline__ unsigned xb_xcc_id() { return (unsigned)__builtin_amdgcn_s_getreg((3 << 11) | 20) & 0xFu; }
#define XB_SPIN(cond, bar) do { unsigned _sp = 0; while (cond) { __builtin_amdgcn_s_sleep(1); \
    if ((++_sp & 255u) == 0u) { if (xb_ld(&(bar)[XB_TMO])) break; if (_sp > XB_SPIN_CAP) { atomicAdd(&(bar)[XB_TMO], 1u); break; } } } } while (0)
struct XcdBarrier { unsigned* bar; unsigned x; volatile LAS unsigned* st; };
__device__ __forceinline__ XcdBarrier xcd_barrier_post(unsigned* bar, volatile LAS unsigned* st) {
    XcdBarrier b; b.bar = bar; b.x = xb_xcc_id(); b.st = st;
    if (threadIdx.x == 0) (void)xb_add(&bar[XB_XCNT(b.x)], 1u);
    return b;
}
__device__ __forceinline__ void xcd_barrier_complete(unsigned* bar, unsigned x, unsigned& nloc, unsigned& nx) {
    const unsigned G = gridDim.x * gridDim.y * gridDim.z;
    unsigned sum, cnt, mine, sp = 0u;
    for (;;) {
        sum = 0u; cnt = 0u; mine = 0u;
#pragma unroll
        for (unsigned j = 0; j < 16; ++j) { const unsigned c = xb_ld(&bar[XB_XCNT(j)]); sum += c; cnt += (c > 0u) ? 1u : 0u; mine = (j == x) ? c : mine; }
        if (sum == G) break;
        __builtin_amdgcn_s_sleep(1);
        if ((++sp & 255u) == 0u) { if (xb_ld(&bar[XB_TMO])) break; if (sp > XB_SPIN_CAP) { atomicAdd(&bar[XB_TMO], 1u); break; } }
    }
    nloc = mine > 0u ? mine : 1u; nx = cnt > 0u ? cnt : 1u;
}
__device__ __forceinline__ void xcd_barrier(const XcdBarrier& b) {
    asm volatile("s_waitcnt vmcnt(0)" ::: "memory");
    __syncthreads();
    if (threadIdx.x == 0) {
        unsigned* bar = b.bar;
        __builtin_amdgcn_s_waitcnt(0);
        unsigned nloc = b.st[0], nx = b.st[1];
        if (nloc == 0u) { xcd_barrier_complete(bar, b.x, nloc, nx); b.st[0] = nloc; b.st[1] = nx; }
        const unsigned old = xb_add(&bar[XB_XSUB(b.x)], 1u);
        const unsigned gen = old / nloc;
        if (old + 1u == (gen + 1u) * nloc) {
            __builtin_amdgcn_fence(__ATOMIC_RELEASE, "agent");
            asm volatile("s_waitcnt vmcnt(0)" ::: "memory");
            const unsigned og = xb_add(&bar[XB_TOP], 1u);
            const unsigned tg = og / nx;
            if (og + 1u == (tg + 1u) * nx) xb_add(&bar[XB_TOPGEN], 1u);
            else XB_SPIN(xb_ld(&bar[XB_TOPGEN]) == tg, bar);
            __builtin_amdgcn_fence(__ATOMIC_ACQUIRE, "agent");
            xb_add(&bar[XB_XGEN(b.x)], 1u);
            asm volatile("s_waitcnt vmcnt(0)" ::: "memory");
        } else {
            XB_SPIN(xb_ld(&bar[XB_XGEN(b.x)]) == gen, bar);
            __builtin_amdgcn_fence(__ATOMIC_ACQUIRE, "agent");
            asm volatile("s_waitcnt vmcnt(0)" ::: "memory");
        }
    }
    __syncthreads();
}

namespace pg8 {
constexpr int BM = 256, BK = 64, HALF = 128, HTB = HALF * BK * 2, STAGE_BYTES = 8 * HTB, NXCD = 8, WGM = 8;
__host__ __device__ __forceinline__ int lds_byte(int r, int c) { const int st = (r >> 4) * 2 + (c >> 5), rr = r & 15, cc = c & 31, ob = rr * 64 + cc * 2; return st * 1024 + (ob ^ (((ob >> 9) & 1) << 5)); }
__host__ __device__ __forceinline__ void stage_rc(int b, int& R, int& C) { const int st = b / 1024, sb = b % 1024, swz = sb ^ (((sb >> 9) & 1) << 5); R = (st >> 1) * 16 + swz / 64; C = (st & 1) * 32 + (swz % 64) / 2; }
__host__ __device__ __forceinline__ int perm32(int rho) { const int n = rho >> 4, i = rho & 15; return 8 * (i >> 2) + 4 * n + (i & 3); }

struct Unit { int pm, pn; int e, mt; };
struct Gemm { const bf16* A; const bf16* Bt; int K; };

typedef int v8i __attribute__((ext_vector_type(8)));
typedef int v4i __attribute__((ext_vector_type(4)));
struct Gemm8 { const unsigned char* A; const unsigned char* Bt; int K; int sa, sb; };
struct F2x { bf16x8 v[2]; __device__ __forceinline__ bf16x8& operator[](int i) { return v[i]; } __device__ __forceinline__ const bf16x8& operator[](int i) const { return v[i]; } };
__host__ __device__ __forceinline__ int lds_byte8(int r, int g) { const int st = (r >> 4) * 2 + (g >> 1), ob = (r & 15) * 64 + 32 * (g & 1); return st * 1024 + (ob ^ (((ob >> 9) & 1) << 5)); }
struct StaticOrder {
    int nM, nN, nwg, G, c;
    __device__ void init(int M, int N, int G_, int c_) { nM = M / BM; nN = N / BM; nwg = nM * nN; G = G_; c = c_; }
    __device__ __forceinline__ bool next(int i, Unit& u) const {
        const long L = (long)i * G + c; if (L >= nwg) return false;
        int wgid = (int)L; { const int q = nwg / NXCD, r = nwg % NXCD, xcd = wgid % NXCD, off = wgid / NXCD; wgid = (xcd < r ? xcd * (q + 1) : r * (q + 1) + (xcd - r) * q) + off; }
        const int nig = WGM * nN, gid = wgid / nig, fm = gid * WGM, gsz = (nM - fm) < WGM ? (nM - fm) : WGM;
        u.pm = fm + ((wgid % nig) % gsz); u.pn = (wgid % nig) / gsz; u.e = 0; u.mt = 0; return true;
    }
    __device__ __forceinline__ void rows(const Unit&, int, int, unsigned (&)[2][2]) const {}
};

template <class Epi, class Sched, bool GATHER = false>
__device__ __forceinline__ void gemm_phase(LAS unsigned char* lds, const Gemm g, const Sched& S, const Epi& E) {
    int tid_ = threadIdx.x; asm volatile("" : "+v"(tid_));
    const int tid = tid_, wid = __builtin_amdgcn_readfirstlane(tid >> 6), lane = tid & 63, wr = wid >> 2, wc = wid & 3, fr = lane & 15, fq = lane >> 4;
    const int K = g.K, nt = K / BK;
    unsigned voffA[2], voffB[2]; int RA[2], CA[2];
#pragma unroll
    for (int i = 0; i < 2; ++i) { int R, C; stage_rc(tid * 16 + i * 8192, R, C); const int Rb = Epi::PERM ? ((R & ~31) + perm32(R & 31)) : R;
        RA[i] = R; CA[i] = C; voffA[i] = (unsigned)(R * K + C) * 2u; voffB[i] = (unsigned)(Rb * K + C) * 2u; }
    const size_t kstep = (size_t)(BK * 2);
    const size_t hstep = (size_t)HALF * K * 2;
    const size_t tstep = 2 * hstep;
    const unsigned ldsw = (unsigned)wid * 1024u;
    const int aoff = lds_byte(wr * 64 + fr, fq * 8), boff = lds_byte(wc * 32 + fr, fq * 8);
#define PG8_SA(b, h) (((b) * 2 + (h)) * HTB)
#define PG8_SB(b, h) ((4 + (b) * 2 + (h)) * HTB)
#define PG8_STAGE(bufoff, gbase, voff) do { _Pragma("unroll") for (int _i = 0; _i < 2; ++_i) \
        __builtin_amdgcn_global_load_lds((const unsigned*)((const char*)(gbase) + (voff)[_i]), (LAS unsigned*)(lds + (bufoff) + ldsw + _i * 8192), 16, 0, 0); } while (0)
#define PG8_STAGE_A(bufoff, gbase, h, AO) do { if constexpr (GATHER) { PG8_STAGE(bufoff, gbase, AO[h]); } else { PG8_STAGE(bufoff, (gbase) + (h) * hstep, voffA); } } while (0)
#define PG8_LDA(dst, b, h) do { _Pragma("unroll") for (int m = 0; m < 4; ++m) _Pragma("unroll") for (int k = 0; k < 2; ++k) dst[m][k] = *(const LAS bf16x8*)(lds + PG8_SA(b, h) + aoff + m * 2048 + k * 1024); } while (0)
#define PG8_LDB(dst, b, h) do { _Pragma("unroll") for (int n = 0; n < 2; ++n) _Pragma("unroll") for (int k = 0; k < 2; ++k) dst[n][k] = *(const LAS bf16x8*)(lds + PG8_SB(b, h) + boff + n * 2048 + k * 1024); } while (0)
#define PG8_MMA(ai, bj, At, Bt) do { __builtin_amdgcn_s_setprio(1); _Pragma("unroll") for (int m = 0; m < 4; ++m) _Pragma("unroll") for (int n = 0; n < 2; ++n) _Pragma("unroll") for (int k = 0; k < 2; ++k) \
        acc[ai][bj][m][n] = __builtin_amdgcn_mfma_f32_16x16x32_bf16(Bt[n][k], At[m][k], acc[ai][bj][m][n], 0, 0, 0); __builtin_amdgcn_s_setprio(0); } while (0)
#define PG8_WAIT_V(n) asm volatile("s_waitcnt vmcnt(" #n ")" ::: "memory")
#define PG8_WAIT_L(n) asm volatile("s_waitcnt lgkmcnt(" #n ")" ::: "memory")
#define PG8_BAR __builtin_amdgcn_s_barrier()
#define PG8_SCHED __builtin_amdgcn_sched_barrier(0)
    Unit cur, nxt; int ui = 0;
    if (!S.next(0, cur)) return;
    f32x4 acc[2][2][4][2];
#pragma unroll
    for (int a = 0; a < 2; ++a)
#pragma unroll
        for (int b = 0; b < 2; ++b)
#pragma unroll
            for (int m = 0; m < 4; ++m)
#pragma unroll
                for (int n = 0; n < 2; ++n) acc[a][b][m][n] = (f32x4){0.f, 0.f, 0.f, 0.f};
    bf16x8 At[4][2], B0[2][2], B1[2][2];
    unsigned aoc[2][2], aon[2][2];
    const char* cA; const char* cB = (const char*)g.Bt + (size_t)cur.pn * tstep;
    if constexpr (GATHER) { cA = (const char*)g.A; S.rows(cur, RA[0], RA[1], aoc);
#pragma unroll
        for (int h = 0; h < 2; ++h)
#pragma unroll
            for (int i = 0; i < 2; ++i) aoc[h][i] += (unsigned)CA[i] * 2u; }
    else { cA = (const char*)g.A + (size_t)cur.pm * tstep;
#pragma unroll
        for (int i = 0; i < 2; ++i) { aoc[0][i] = 0u; aoc[1][i] = 0u; } }
    PG8_STAGE(PG8_SB(0, 0), cB, voffB); PG8_STAGE(PG8_SB(0, 1), cB + hstep, voffB); PG8_STAGE_A(PG8_SA(0, 0), cA, 0, aoc); PG8_STAGE_A(PG8_SA(0, 1), cA, 1, aoc);
    if (wr == 1) PG8_BAR;
    PG8_WAIT_V(2); PG8_BAR;
    PG8_STAGE(PG8_SB(1, 0), cB + kstep, voffB); PG8_STAGE_A(PG8_SA(1, 0), cA + kstep, 0, aoc); PG8_STAGE(PG8_SB(1, 1), cB + hstep + kstep, voffB);
    PG8_WAIT_V(6); PG8_BAR;
    for (;;) {
        const bool has_next = S.next(ui + 1, nxt);
        const char* nA; const char* nB = has_next ? (const char*)g.Bt + (size_t)nxt.pn * tstep : cB;
        if constexpr (GATHER) { nA = cA;
            if (has_next) { S.rows(nxt, RA[0], RA[1], aon);
#pragma unroll
                for (int h = 0; h < 2; ++h)
#pragma unroll
                    for (int i = 0; i < 2; ++i) aon[h][i] += (unsigned)CA[i] * 2u; }
            else {
#pragma unroll
                for (int h = 0; h < 2; ++h)
#pragma unroll
                    for (int i = 0; i < 2; ++i) aon[h][i] = aoc[h][i]; } }
        else { nA = has_next ? (const char*)g.A + (size_t)nxt.pm * tstep : cA;
#pragma unroll
            for (int h = 0; h < 2; ++h)
#pragma unroll
                for (int i = 0; i < 2; ++i) aon[h][i] = aoc[h][i]; }
#pragma nounroll
        for (int t = 0; t < nt; t += 2) {
            const bool last = (t == nt - 2);
            const char* a1 = cA + (size_t)(t + 1) * kstep;
            const char* a2 = last ? nA : cA + (size_t)(t + 2) * kstep; const char* b2 = last ? nB : cB + (size_t)(t + 2) * kstep;
            const char* a3 = a2 + kstep; const char* b3 = b2 + kstep;
            unsigned ao2[2][2];
#pragma unroll
            for (int h = 0; h < 2; ++h)
#pragma unroll
                for (int i = 0; i < 2; ++i) ao2[h][i] = (GATHER && last) ? aon[h][i] : aoc[h][i];
            PG8_LDB(B0, 0, 0); PG8_LDB(B1, 0, 1); PG8_SCHED; PG8_LDA(At, 0, 0); PG8_STAGE_A(PG8_SA(1, 1), a1, 1, aoc);
            PG8_WAIT_V(8); PG8_WAIT_L(0); PG8_BAR; PG8_MMA(0, 0, At, B0); PG8_MMA(0, 1, At, B1); PG8_BAR; PG8_SCHED;
            PG8_LDA(At, 0, 1); PG8_STAGE(PG8_SB(0, 0), b2, voffB); PG8_STAGE(PG8_SB(0, 1), b2 + hstep, voffB); PG8_STAGE_A(PG8_SA(0, 0), a2, 0, ao2);
            PG8_WAIT_V(8); PG8_WAIT_L(0); PG8_BAR; PG8_MMA(1, 0, At, B0); PG8_MMA(1, 1, At, B1); PG8_BAR; PG8_SCHED;
            PG8_LDB(B0, 1, 0); PG8_LDB(B1, 1, 1); PG8_SCHED; PG8_LDA(At, 1, 0); PG8_STAGE_A(PG8_SA(0, 1), a2, 1, ao2);
            PG8_WAIT_V(8); PG8_WAIT_L(0); PG8_BAR; PG8_MMA(0, 0, At, B0); PG8_MMA(0, 1, At, B1); PG8_BAR; PG8_SCHED;
            PG8_LDA(At, 1, 1); PG8_STAGE(PG8_SB(1, 0), b3, voffB); PG8_STAGE(PG8_SB(1, 1), b3 + hstep, voffB); PG8_STAGE_A(PG8_SA(1, 0), a3, 0, ao2);
            PG8_WAIT_V(8); PG8_WAIT_L(0); PG8_BAR; PG8_MMA(1, 0, At, B0); PG8_MMA(1, 1, At, B1); PG8_BAR; PG8_SCHED;
        }
        if (wr == 0) PG8_BAR;
        asm volatile("s_nop 15\n\ts_nop 7" ::: "memory");
        E(acc, cur, wr, wc, fr, fq);
        if (!has_next) break;
#pragma unroll
        for (int a = 0; a < 2; ++a)
#pragma unroll
            for (int b = 0; b < 2; ++b)
#pragma unroll
                for (int m = 0; m < 4; ++m)
#pragma unroll
                    for (int n = 0; n < 2; ++n) acc[a][b][m][n] = (f32x4){0.f, 0.f, 0.f, 0.f};
        cur = nxt; cA = nA; cB = nB; ++ui;
#pragma unroll
        for (int h = 0; h < 2; ++h)
#pragma unroll
            for (int i = 0; i < 2; ++i) aoc[h][i] = aon[h][i];
        if (wr == 1) PG8_BAR;
    }
    PG8_WAIT_V(0);
    PG8_BAR;
#undef PG8_SA
#undef PG8_SB
#undef PG8_STAGE
#undef PG8_STAGE_A
#undef PG8_LDA
#undef PG8_LDB
#undef PG8_MMA
#undef PG8_WAIT_V
#undef PG8_WAIT_L
#undef PG8_BAR
#undef PG8_SCHED
}

template <class Epi, class Sched, bool GATHER = false>
__device__ __forceinline__ void gemm_phase8(LAS unsigned char* lds, const Gemm8 g, const Sched& S, const Epi& E) {
    int tid_ = threadIdx.x; asm volatile("" : "+v"(tid_));
    const int tid = tid_, wid = __builtin_amdgcn_readfirstlane(tid >> 6), lane = tid & 63, wr = wid >> 2, wc = wid & 3, fr = lane & 15, fq = lane >> 4;
    const int K = g.K, nt = K / BK;
    unsigned voffA[2], voffB[2]; int RA[2], CA[2];
#pragma unroll
    for (int i = 0; i < 2; ++i) { int R, C; stage_rc(tid * 16 + i * 8192, R, C); const int Rb = Epi::PERM ? ((R & ~31) + perm32(R & 31)) : R;
        RA[i] = R; CA[i] = C; voffA[i] = (unsigned)(R * K + C) * 2u; voffB[i] = (unsigned)(Rb * K + C) * 2u; }
    const size_t kstep = (size_t)(BK * 2);
    const size_t hstep = (size_t)HALF * K * 2;
    const size_t tstep = 2 * hstep;
    const unsigned ldsw = (unsigned)wid * 1024u;
    const int aoff = lds_byte8(wr * 64 + fr, fq), boff = lds_byte8(wc * 32 + fr, fq);
#define PG8_SA(b, h) (((b) * 2 + (h)) * HTB)
#define PG8_SB(b, h) ((4 + (b) * 2 + (h)) * HTB)
#define PG8_STAGE(bufoff, gbase, voff) do { _Pragma("unroll") for (int _i = 0; _i < 2; ++_i) \
        __builtin_amdgcn_global_load_lds((const unsigned*)((const char*)(gbase) + (voff)[_i]), (LAS unsigned*)(lds + (bufoff) + ldsw + _i * 8192), 16, 0, 0); } while (0)
#define PG8_STAGE_A(bufoff, gbase, h, AO) do { if constexpr (GATHER) { PG8_STAGE(bufoff, gbase, AO[h]); } else { PG8_STAGE(bufoff, (gbase) + (h) * hstep, voffA); } } while (0)
#define PG8_LD32(p) __builtin_shufflevector(*(const LAS v4i*)(p), *(const LAS v4i*)((p) + 16), 0, 1, 2, 3, 4, 5, 6, 7)
#define PG8_LDA(dst, b, h) do { _Pragma("unroll") for (int m = 0; m < 4; ++m) dst[m] = PG8_LD32(lds + PG8_SA(b, h) + aoff + m * 2048); } while (0)
#define PG8_LDB(dst, b, h) do { _Pragma("unroll") for (int n = 0; n < 2; ++n) dst[n] = PG8_LD32(lds + PG8_SB(b, h) + boff + n * 2048); } while (0)
#define PG8_MMA(ai, bj, At, Bt) do { __builtin_amdgcn_s_setprio(1); _Pragma("unroll") for (int m = 0; m < 4; ++m) _Pragma("unroll") for (int n = 0; n < 2; ++n) \
        asm volatile("v_mfma_scale_f32_16x16x128_f8f6f4 %0, %1, %2, %0, %3, %4 op_sel_hi:[0,0,0]" : "+v"(acc[ai][bj][m][n]) : "v"(Bt[n]), "v"(At[m]), "v"(vsb), "v"(vsa)); __builtin_amdgcn_s_setprio(0); } while (0)
#define PG8_WAIT_V(n) asm volatile("s_waitcnt vmcnt(" #n ")" ::: "memory")
#define PG8_WAIT_L(n) asm volatile("s_waitcnt lgkmcnt(" #n ")" ::: "memory")
#define PG8_BAR __builtin_amdgcn_s_barrier()
#define PG8_SCHED __builtin_amdgcn_sched_barrier(0)
    Unit cur, nxt; int ui = 0;
    if (!S.next(0, cur)) return;
    f32x4 acc[2][2][4][2];
#pragma unroll
    for (int a = 0; a < 2; ++a)
#pragma unroll
        for (int b = 0; b < 2; ++b)
#pragma unroll
            for (int m = 0; m < 4; ++m)
#pragma unroll
                for (int n = 0; n < 2; ++n) acc[a][b][m][n] = (f32x4){0.f, 0.f, 0.f, 0.f};
    v8i At[4], B0[2], B1[2]; const int vsa = g.sa, vsb = g.sb;
    unsigned aoc[2][2], aon[2][2];
    const char* cA; const char* cB = (const char*)g.Bt + (size_t)cur.pn * tstep;
    if constexpr (GATHER) { cA = (const char*)g.A; S.rows(cur, RA[0], RA[1], aoc);
#pragma unroll
        for (int h = 0; h < 2; ++h)
#pragma unroll
            for (int i = 0; i < 2; ++i) aoc[h][i] += (unsigned)CA[i] * 2u; }
    else { cA = (const char*)g.A + (size_t)cur.pm * tstep;
#pragma unroll
        for (int i = 0; i < 2; ++i) { aoc[0][i] = 0u; aoc[1][i] = 0u; } }
    PG8_STAGE(PG8_SB(0, 0), cB, voffB); PG8_STAGE(PG8_SB(0, 1), cB + hstep, voffB); PG8_STAGE_A(PG8_SA(0, 0), cA, 0, aoc); PG8_STAGE_A(PG8_SA(0, 1), cA, 1, aoc);
    if (wr == 1) PG8_BAR;
    PG8_WAIT_V(2); PG8_BAR;
    PG8_STAGE(PG8_SB(1, 0), cB + kstep, voffB); PG8_STAGE_A(PG8_SA(1, 0), cA + kstep, 0, aoc); PG8_STAGE(PG8_SB(1, 1), cB + hstep + kstep, voffB);
    PG8_WAIT_V(6); PG8_BAR;
    for (;;) {
        const bool has_next = S.next(ui + 1, nxt);
        const char* nA; const char* nB = has_next ? (const char*)g.Bt + (size_t)nxt.pn * tstep : cB;
        if constexpr (GATHER) { nA = cA;
            if (has_next) { S.rows(nxt, RA[0], RA[1], aon);
#pragma unroll
                for (int h = 0; h < 2; ++h)
#pragma unroll
                    for (int i = 0; i < 2; ++i) aon[h][i] += (unsigned)CA[i] * 2u; }
            else {
#pragma unroll
                for (int h = 0; h < 2; ++h)
#pragma unroll
                    for (int i = 0; i < 2; ++i) aon[h][i] = aoc[h][i]; } }
        else { nA = has_next ? (const char*)g.A + (size_t)nxt.pm * tstep : cA;
#pragma unroll
            for (int h = 0; h < 2; ++h)
#pragma unroll
                for (int i = 0; i < 2; ++i) aon[h][i] = aoc[h][i]; }
#pragma nounroll
        for (int t = 0; t < nt; t += 2) {
            const bool last = (t == nt - 2);
            const char* a1 = cA + (size_t)(t + 1) * kstep;
            const char* a2 = last ? nA : cA + (size_t)(t + 2) * kstep; const char* b2 = last ? nB : cB + (size_t)(t + 2) * kstep;
            const char* a3 = a2 + kstep; const char* b3 = b2 + kstep;
            unsigned ao2[2][2];
#pragma unroll
            for (int h = 0; h < 2; ++h)
#pragma unroll
                for (int i = 0; i < 2; ++i) ao2[h][i] = (GATHER && last) ? aon[h][i] : aoc[h][i];
            PG8_LDB(B0, 0, 0); PG8_LDB(B1, 0, 1); PG8_SCHED; PG8_LDA(At, 0, 0); PG8_STAGE_A(PG8_SA(1, 1), a1, 1, aoc);
            PG8_WAIT_V(8); PG8_WAIT_L(0); PG8_BAR; PG8_MMA(0, 0, At, B0); PG8_MMA(0, 1, At, B1); PG8_BAR; PG8_SCHED;
            PG8_LDA(At, 0, 1); PG8_STAGE(PG8_SB(0, 0), b2, voffB); PG8_STAGE(PG8_SB(0, 1), b2 + hstep, voffB); PG8_STAGE_A(PG8_SA(0, 0), a2, 0, ao2);
            PG8_WAIT_V(8); PG8_WAIT_L(0); PG8_BAR; PG8_MMA(1, 0, At, B0); PG8_MMA(1, 1, At, B1); PG8_BAR; PG8_SCHED;
            PG8_LDB(B0, 1, 0); PG8_LDB(B1, 1, 1); PG8_SCHED; PG8_LDA(At, 1, 0); PG8_STAGE_A(PG8_SA(0, 1), a2, 1, ao2);
            PG8_WAIT_V(8); PG8_WAIT_L(0); PG8_BAR; PG8_MMA(0, 0, At, B0); PG8_MMA(0, 1, At, B1); PG8_BAR; PG8_SCHED;
            PG8_LDA(At, 1, 1); PG8_STAGE(PG8_SB(1, 0), b3, voffB); PG8_STAGE(PG8_SB(1, 1), b3 + hstep, voffB); PG8_STAGE_A(PG8_SA(1, 0), a3, 0, ao2);
            PG8_WAIT_V(8); PG8_WAIT_L(0); PG8_BAR; PG8_MMA(1, 0, At, B0); PG8_MMA(1, 1, At, B1); PG8_BAR; PG8_SCHED;
        }
        if (wr == 0) PG8_BAR;
        asm volatile("s_nop 15\n\ts_nop 15\n\ts_nop 15" ::: "memory");
        { const int t2 = opaque_tid(), w2 = __builtin_amdgcn_readfirstlane(t2 >> 6), l2 = t2 & 63;
          E(acc, cur, w2 >> 2, w2 & 3, l2 & 15, l2 >> 4); }
        if (!has_next) break;
#pragma unroll
        for (int a = 0; a < 2; ++a)
#pragma unroll
            for (int b = 0; b < 2; ++b)
#pragma unroll
                for (int m = 0; m < 4; ++m)
#pragma unroll
                    for (int n = 0; n < 2; ++n) acc[a][b][m][n] = (f32x4){0.f, 0.f, 0.f, 0.f};
        cur = nxt; cA = nA; cB = nB; ++ui;
#pragma unroll
        for (int h = 0; h < 2; ++h)
#pragma unroll
            for (int i = 0; i < 2; ++i) aoc[h][i] = aon[h][i];
        if (wr == 1) PG8_BAR;
    }
    PG8_WAIT_V(0);
    PG8_BAR;
#undef PG8_SA
#undef PG8_SB
#undef PG8_STAGE
#undef PG8_STAGE_A
#undef PG8_LDA
#undef PG8_LD32
#undef PG8_LDB
#undef PG8_MMA
#undef PG8_WAIT_V
#undef PG8_WAIT_L
#undef PG8_BAR
#undef PG8_SCHED
}

struct EpiBf16Skip {
    static constexpr bool PERM = true;
    bf16* O; int ldc, pn_skip, skip;
    __device__ __forceinline__ void operator()(const f32x4 (&acc)[2][2][4][2], const Unit& u, int wr, int wc, int fr, int fq) const {
        const int row0 = u.pm * BM + wr * 64 + fr, col0 = u.pn * BM + wc * 32 + 8 * fq + (u.pn >= pn_skip ? skip : 0);
#pragma unroll
        for (int ai = 0; ai < 2; ++ai)
#pragma unroll
            for (int m = 0; m < 4; ++m) { bf16* rowp = O + (size_t)(row0 + ai * HALF + m * 16) * ldc + col0;
#pragma unroll
                for (int bj = 0; bj < 2; ++bj) { const f32x4 v0 = acc[ai][bj][m][0], v1 = acc[ai][bj][m][1];
                    v4u w; w.x = cvt_pk_bf16(v0[0], v0[1]); w.y = cvt_pk_bf16(v0[2], v0[3]); w.z = cvt_pk_bf16(v1[0], v1[1]); w.w = cvt_pk_bf16(v1[2], v1[3]);
                    *(v4u*)(rowp + bj * HALF) = w; } }
    }
};
struct EpiFp8 {
    static constexpr bool PERM = true;
    unsigned char* O; int ldc;
    __device__ __forceinline__ void operator()(const f32x4 (&acc)[2][2][4][2], const Unit& u, int wr, int wc, int fr, int fq) const {
        const int row0 = u.pm * BM + wr * 64 + fr, col0 = u.pn * BM + wc * 32 + 8 * fq;
#pragma unroll
        for (int ai = 0; ai < 2; ++ai)
#pragma unroll
            for (int m = 0; m < 4; ++m) { unsigned char* rowp = O + (size_t)(row0 + ai * HALF + m * 16) * ldc + col0;
#pragma unroll
                for (int bj = 0; bj < 2; ++bj) { const f32x4 v0 = acc[ai][bj][m][0] * 8.0f, v1 = acc[ai][bj][m][1] * 8.0f;
                    v2u w; w.x = pk4_fp8(v0[0], v0[1], v0[2], v0[3]); w.y = pk4_fp8(v1[0], v1[1], v1[2], v1[3]);
                    *(v2u*)(rowp + bj * HALF) = w; } }
    }
};
struct EpiBf16 {
    static constexpr bool PERM = true;
    bf16* O; int ldc;
    __device__ __forceinline__ void operator()(const f32x4 (&acc)[2][2][4][2], const Unit& u, int wr, int wc, int fr, int fq) const {
        const int row0 = u.pm * BM + wr * 64 + fr, col0 = u.pn * BM + wc * 32 + 8 * fq;
#pragma unroll
        for (int ai = 0; ai < 2; ++ai)
#pragma unroll
            for (int m = 0; m < 4; ++m) { bf16* rowp = O + (size_t)(row0 + ai * HALF + m * 16) * ldc + col0;
#pragma unroll
                for (int bj = 0; bj < 2; ++bj) { const f32x4 v0 = acc[ai][bj][m][0], v1 = acc[ai][bj][m][1];
                    v4u w; w.x = cvt_pk_bf16(v0[0], v0[1]); w.y = cvt_pk_bf16(v0[2], v0[3]); w.z = cvt_pk_bf16(v1[0], v1[1]); w.w = cvt_pk_bf16(v1[2], v1[3]);
                    *(v4u*)(rowp + bj * HALF) = w; } }
    }
};
struct EpiF32 {
    static constexpr bool PERM = false;
    float* C; int ldc;
    __device__ __forceinline__ void operator()(const f32x4 (&acc)[2][2][4][2], const Unit& u, int wr, int wc, int fr, int fq) const {
        const int row0 = u.pm * BM + wr * 64 + fr, col0 = u.pn * BM + wc * 32 + 4 * fq;
#pragma unroll
        for (int ai = 0; ai < 2; ++ai)
#pragma unroll
            for (int m = 0; m < 4; ++m) { float* rowp = C + (size_t)(row0 + ai * HALF + m * 16) * ldc + col0;
#pragma unroll
                for (int bj = 0; bj < 2; ++bj)
#pragma unroll
                    for (int n = 0; n < 2; ++n) *(f32x4*)(rowp + bj * HALF + n * 16) = acc[ai][bj][m][n]; }
    }
};
struct EpiResF32 {
    static constexpr bool PERM = false;
    const float* base; float* out; int ldc;
    __device__ __forceinline__ void operator()(const f32x4 (&acc)[2][2][4][2], const Unit& u, int wr, int wc, int fr, int fq) const {
        const int row0 = u.pm * BM + wr * 64 + fr, col0 = u.pn * BM + wc * 32 + 4 * fq;
#pragma unroll
        for (int ai = 0; ai < 2; ++ai)
#pragma unroll
            for (int m = 0; m < 4; ++m) { const size_t off = (size_t)(row0 + ai * HALF + m * 16) * ldc + col0;
#pragma unroll
                for (int bj = 0; bj < 2; ++bj)
#pragma unroll
                    for (int n = 0; n < 2; ++n) { const f32x4 b = *(const f32x4*)(base + off + bj * HALF + n * 16); *(f32x4*)(out + off + bj * HALF + n * 16) = b + acc[ai][bj][m][n]; } }
    }
};
struct EpiResBf16P {
    static constexpr bool PERM = true;
    const float* base; bf16* out; int ldc;
    __device__ __forceinline__ void operator()(const f32x4 (&acc)[2][2][4][2], const Unit& u, int wr, int wc, int fr, int fq) const {
        const int row0 = u.pm * BM + wr * 64 + fr, col0 = u.pn * BM + wc * 32 + 8 * fq;
#pragma unroll
        for (int ai = 0; ai < 2; ++ai)
#pragma unroll
            for (int m = 0; m < 4; ++m) { const size_t off = (size_t)(row0 + ai * HALF + m * 16) * ldc + col0;
#pragma unroll
                for (int bj = 0; bj < 2; ++bj) { const f32x4 v0 = *(const f32x4*)(base + off + bj * HALF) + acc[ai][bj][m][0], v1 = *(const f32x4*)(base + off + bj * HALF + 4) + acc[ai][bj][m][1];
                    v4u w; w.x = cvt_pk_bf16(v0[0], v0[1]); w.y = cvt_pk_bf16(v0[2], v0[3]); w.z = cvt_pk_bf16(v1[0], v1[1]); w.w = cvt_pk_bf16(v1[2], v1[3]);
                    *(v4u*)(out + off + bj * HALF) = w; } }
    }
};
struct EpiResF32P {
    static constexpr bool PERM = true;
    const float* base; float* out; int ldc;
    __device__ __forceinline__ void operator()(const f32x4 (&acc)[2][2][4][2], const Unit& u, int wr, int wc, int fr, int fq) const {
        const int row0 = u.pm * BM + wr * 64 + fr, col0 = u.pn * BM + wc * 32 + 8 * fq;
#pragma unroll
        for (int ai = 0; ai < 2; ++ai)
#pragma unroll
            for (int m = 0; m < 4; ++m) { const size_t off = (size_t)(row0 + ai * HALF + m * 16) * ldc + col0;
#pragma unroll
                for (int bj = 0; bj < 2; ++bj)
#pragma unroll
                    for (int n = 0; n < 2; ++n) { const f32x4 b = *(const f32x4*)(base + off + bj * HALF + n * 4); *(f32x4*)(out + off + bj * HALF + n * 4) = b + acc[ai][bj][m][n]; } }
    }
};
struct EpiGateMix {
    static constexpr bool PERM = true;
    const unsigned char* YA; const unsigned char* YB; unsigned char* U; const float* bias;
    __device__ __forceinline__ void operator()(const f32x4 (&acc)[2][2][4][2], const Unit& u, int wr, int wc, int fr, int fq) const {
        const int row0 = u.pm * BM + wr * 64 + fr, col0 = u.pn * HALF + wc * 32 + 8 * fq;
        const f32x4 ba0 = *(const f32x4*)(bias + col0), ba1 = *(const f32x4*)(bias + col0 + 4), bb0 = *(const f32x4*)(bias + D + col0), bb1 = *(const f32x4*)(bias + D + col0 + 4);
#pragma unroll
        for (int ai = 0; ai < 2; ++ai)
#pragma unroll
            for (int m = 0; m < 4; ++m) { const size_t off = (size_t)(row0 + ai * HALF + m * 16) * D + col0;
                const v2u ya = *(const v2u*)(YA + off), yb = *(const v2u*)(YB + off);
                const f32x4 a0 = acc[ai][0][m][0] + ba0, a1 = acc[ai][0][m][1] + ba1, b0 = acc[ai][1][m][0] + bb0, b1 = acc[ai][1][m][1] + bb1;
                float o[8];
                float va[8], vb[8];
                { const auto p0 = __builtin_amdgcn_cvt_pk_f32_fp8((int)ya.x, false), p1 = __builtin_amdgcn_cvt_pk_f32_fp8((int)ya.x, true), p2 = __builtin_amdgcn_cvt_pk_f32_fp8((int)ya.y, false), p3 = __builtin_amdgcn_cvt_pk_f32_fp8((int)ya.y, true);
                  va[0] = p0[0]; va[1] = p0[1]; va[2] = p1[0]; va[3] = p1[1]; va[4] = p2[0]; va[5] = p2[1]; va[6] = p3[0]; va[7] = p3[1]; }
                { const auto p0 = __builtin_amdgcn_cvt_pk_f32_fp8((int)yb.x, false), p1 = __builtin_amdgcn_cvt_pk_f32_fp8((int)yb.x, true), p2 = __builtin_amdgcn_cvt_pk_f32_fp8((int)yb.y, false), p3 = __builtin_amdgcn_cvt_pk_f32_fp8((int)yb.y, true);
                  vb[0] = p0[0]; vb[1] = p0[1]; vb[2] = p1[0]; vb[3] = p1[1]; vb[4] = p2[0]; vb[5] = p2[1]; vb[6] = p3[0]; vb[7] = p3[1]; }
#pragma unroll
                for (int j = 0; j < 8; ++j) { const float ga = sigmoidf_(j < 4 ? a0[j & 3] : a1[j & 3]), gb = sigmoidf_(j < 4 ? b0[j & 3] : b1[j & 3]);
                    o[j] = ga * va[j] + gb * vb[j]; }
                v2u w; w.x = pk4_fp8(o[0], o[1], o[2], o[3]); w.y = pk4_fp8(o[4], o[5], o[6], o[7]);
                *(v2u*)(U + off) = w;
                asm volatile("" ::: "memory"); }
    }
};
struct EpiPleFinal {
    static constexpr bool PERM = true;
    const bf16* x2; const bf16* P; float* out; const float* bias;
    __device__ __forceinline__ void operator()(const f32x4 (&acc)[2][2][4][2], const Unit& u, int wr, int wc, int fr, int fq) const {
        const int row0 = u.pm * BM + wr * 64 + fr, col0 = u.pn * BM + wc * 32 + 8 * fq;
#pragma unroll
        for (int bj = 0; bj < 2; ++bj) { const f32x4 bv0 = *(const f32x4*)(bias + col0 + bj * HALF), bv1 = *(const f32x4*)(bias + col0 + bj * HALF + 4);
#pragma unroll
            for (int ai = 0; ai < 2; ++ai)
#pragma unroll
                for (int m = 0; m < 4; ++m) { const size_t off = (size_t)(row0 + ai * HALF + m * 16) * D + col0 + bj * HALF;
                    const v4u pw = *(const v4u*)(P + off), xw = *(const v4u*)(x2 + off);
                    const f32x4 x0 = {bflo(xw.x), bfhi(xw.x), bflo(xw.y), bfhi(xw.y)}, x1 = {bflo(xw.z), bfhi(xw.z), bflo(xw.w), bfhi(xw.w)};
                    const f32x4 a0 = acc[ai][bj][m][0] + bv0, a1 = acc[ai][bj][m][1] + bv1;
                    f32x4 o0, o1;
                    o0[0] = x0[0] + sigmoidf_(a0[0]) * bflo(pw.x); o0[1] = x0[1] + sigmoidf_(a0[1]) * bfhi(pw.x); o0[2] = x0[2] + sigmoidf_(a0[2]) * bflo(pw.y); o0[3] = x0[3] + sigmoidf_(a0[3]) * bfhi(pw.y);
                    o1[0] = x1[0] + sigmoidf_(a1[0]) * bflo(pw.z); o1[1] = x1[1] + sigmoidf_(a1[1]) * bfhi(pw.z); o1[2] = x1[2] + sigmoidf_(a1[2]) * bflo(pw.w); o1[3] = x1[3] + sigmoidf_(a1[3]) * bfhi(pw.w);
                    *(f32x4*)(out + off) = o0; *(f32x4*)(out + off + 4) = o1; } }
    }
};

struct PleOrder {
    int G, c;
    __device__ __forceinline__ bool next(int i, Unit& u) const {
        int L;
        if (G == 256) { if (c >= 128) { if (i >= 6) return false; L = (c - 128) * 6 + i; } else { if (i >= 2) return false; L = 768 + c * 2 + i; } }
        else { L = i * G + c; if (L >= 1024) return false; }
        u.pm = L >> 3; u.pn = L & 7; u.e = 0; u.mt = 0; return true;
    }
    __device__ __forceinline__ void rows(const Unit&, int, int, unsigned (&)[2][2]) const {}
};
struct MoeOrder {
    const LAS int* pref;
    const LAS int* cntl;
    const int* tokrow; int NT, G, c, K;
    __device__ __forceinline__ bool next(int i, Unit& u) const {
        const int L = i * G + c; if (L >= pref[64] * NT) return false;
        const int tt = L / NT, pnl = L - tt * NT; int lo = 0, hi = 64;
        while (hi - lo > 1) { const int mid = (lo + hi) >> 1; if (pref[mid] <= tt) lo = mid; else hi = mid; }
        u.e = lo; u.mt = tt - pref[lo]; u.pm = tt; u.pn = lo * NT + pnl; return true;
    }
    __device__ __forceinline__ void rows(const Unit& u, int R0, int R1, unsigned (&off)[2][2]) const {
        const int n = cntl[u.e];
#pragma unroll
        for (int h = 0; h < 2; ++h)
#pragma unroll
            for (int i = 0; i < 2; ++i) { const int j = u.mt * 256 + h * 128 + (i ? R1 : R0);
                const int tk = (j < n) ? (tokrow[(size_t)u.e * ECAP + j] >> 1) : 0; off[h][i] = (unsigned)tk * (unsigned)(K * 2); }
    }
};
struct EpiMoe1 {
    static constexpr bool PERM = true;
    unsigned char* ACT;
    __device__ __forceinline__ void operator()(const f32x4 (&acc)[2][2][4][2], const Unit& u, int wr, int wc, int fr, int fq) const {
        const int row0 = u.pm * BM + wr * 64 + fr, col0 = (u.pn & 3) * HALF + wc * 32 + 8 * fq;
#pragma unroll
        for (int ai = 0; ai < 2; ++ai)
#pragma unroll
            for (int m = 0; m < 4; ++m) { float o[8];
#pragma unroll
                for (int j = 0; j < 8; ++j) { const float g = acc[ai][0][m][j >> 2][j & 3], up = acc[ai][1][m][j >> 2][j & 3]; o[j] = 4.0f * g * sigmoidf_(g) * up; }
                v2u w; w.x = pk4_fp8(o[0], o[1], o[2], o[3]); w.y = pk4_fp8(o[4], o[5], o[6], o[7]);
                *(v2u*)(ACT + (size_t)(row0 + ai * HALF + m * 16) * EFF + col0) = w; }
    }
};
struct EpiMoe2 {
    static constexpr bool PERM = true;
    bf16* Y0; long long ydelta; const int* tokrow; const float* tokw; const LAS int* cntl;
    __device__ __forceinline__ void operator()(const f32x4 (&acc)[2][2][4][2], const Unit& u, int wr, int wc, int fr, int fq) const {
        const int n = cntl[u.e], col0 = (u.pn & 7) * BM + wc * 32 + 8 * fq;
#pragma unroll
        for (int ai = 0; ai < 2; ++ai)
#pragma unroll
            for (int m = 0; m < 4; ++m) { const int j = u.mt * 256 + ai * HALF + wr * 64 + m * 16 + fr;
                if (j < n) { const int info = tokrow[(size_t)u.e * ECAP + j]; const float wt = tokw[(size_t)u.e * ECAP + j];
                    bf16* rowp = Y0 + (long long)(info & 1) * ydelta + (size_t)(info >> 1) * D + col0;
#pragma unroll
                    for (int bj = 0; bj < 2; ++bj) { const f32x4 v0 = acc[ai][bj][m][0] * wt, v1 = acc[ai][bj][m][1] * wt;
                        v4u w; w.x = cvt_pk_bf16(v0[0], v0[1]); w.y = cvt_pk_bf16(v0[2], v0[3]); w.z = cvt_pk_bf16(v1[0], v1[1]); w.w = cvt_pk_bf16(v1[2], v1[3]);
                        *(v4u*)(rowp + bj * HALF) = w; } } }
    }
};
}


#define MFMA32(a, b, c) __builtin_amdgcn_mfma_f32_32x32x16_bf16((a), (b), (c), 0, 0, 0)
__device__ __forceinline__ int crow(int r, int hi) { return (r & 3) + 8 * (r >> 2) + 4 * hi; }

constexpr int GLA_Q_OFF = 0, GLA_K_OFF = 65536, GLA_GLR_OFF = 132096;
__device__ __forceinline__ void gla_prep_task(LAS unsigned char* lds, bf16* Z, const float* w_alpha, const float* b_alpha, float* DEC, int task) {
    const int tid = opaque_tid(); const size_t t0 = (size_t)task * 64;
    LAS float* glr = (LAS float*)(lds + GLA_GLR_OFF);
    LAS unsigned short* qt = (LAS unsigned short*)(lds + GLA_Q_OFF); LAS unsigned short* kt = (LAS unsigned short*)(lds + GLA_K_OFF);
    __syncthreads();
#pragma unroll
    for (int i = 0; i < 8; ++i) { const int ch = tid + 512 * i, row = ch >> 6, c8 = (ch & 63) * 8;
        *(LAS v4u*)(qt + row * 512 + c8) = *(const GAS v4u*)(Z + (t0 + row) * ZP + ZC_GQ + c8);
        *(LAS v4u*)(kt + row * 512 + c8) = *(const GAS v4u*)(Z + (t0 + row) * ZP + ZC_GK + c8); }
    for (int i = tid; i < 1024; i += 512) glr[i] = bf2f(Z[(t0 + (i >> 4)) * ZP + ZC_GLR + (i & 15)]);
    float w[16];
#pragma unroll
    for (int i = 0; i < 16; ++i) w[i] = w_alpha[i * 512 + tid];
    const float bb = b_alpha[tid];
    __syncthreads();
    float G = 0.f;
#pragma unroll 4
    for (int r = 0; r < 64; ++r) {
        float pre = bb;
#pragma unroll
        for (int i = 0; i < 16; ++i) pre = fmaf(glr[r * 16 + i], w[i], pre);
        const float ls = fminf(pre, 0.f) - log1pf(__expf(-fabsf(pre)));
        G += ls * (1.0f / 16.0f);
        const float Gc = fmaxf(G, -80.f);
        const float eq = __expf(Gc), ek = __expf(-Gc);
        const float qv = bf2f(qt[r * 512 + tid]), kv = bf2f(kt[r * 512 + tid]);
        qt[r * 512 + tid] = (unsigned short)f2bf(qv * 0.125f * eq);
        kt[r * 512 + tid] = (unsigned short)f2bf(kv * ek);
    }
    DEC[(size_t)task * 512 + tid] = __expf(fmaxf(G, -80.f));
    __syncthreads();
#pragma unroll
    for (int i = 0; i < 8; ++i) { const int ch = tid + 512 * i, row = ch >> 6, c8 = (ch & 63) * 8;
        *(GAS v4u*)(Z + (t0 + row) * ZP + ZC_GQ + c8) = *(const LAS v4u*)(qt + row * 512 + c8);
        *(GAS v4u*)(Z + (t0 + row) * ZP + ZC_GK + c8) = *(const LAS v4u*)(kt + row * 512 + c8); }
    LDS_WAIT(); VM_WAIT(); __syncthreads();
}
__device__ __forceinline__ void dsa_prep_row(int lane, bf16* Z, size_t m, const float* qg, const float* kg, bf16* IKC, float* UW) {
#pragma unroll
    for (int which = 0; which < 2; ++which) {
        bf16* p = Z + m * ZP + (which ? ZC_DK : ZC_DQ) + lane * 16;
        const v4u a = *(const v4u*)p, b = *(const v4u*)(p + 8);
        float v[16]; const unsigned ww[8] = {a.x, a.y, a.z, a.w, b.x, b.y, b.z, b.w};
        float ss = 0.f;
#pragma unroll
        for (int i = 0; i < 8; ++i) { v[2 * i] = bflo(ww[i]); v[2 * i + 1] = bfhi(ww[i]); ss += v[2 * i] * v[2 * i] + v[2 * i + 1] * v[2 * i + 1]; }
        ss = sum8(ss);
        const float rstd = (1.0f / sqrtf(ss * (1.0f / 128.f) + EPS)) * (which ? 1.0f : 0.08838834764831845f * 1.4426950408889634f);
        const float* g = (which ? kg : qg) + (lane & 7) * 16;
        v4u o0, o1;
        o0.x = pk2(v[0] * rstd * g[0], v[1] * rstd * g[1]); o0.y = pk2(v[2] * rstd * g[2], v[3] * rstd * g[3]); o0.z = pk2(v[4] * rstd * g[4], v[5] * rstd * g[5]); o0.w = pk2(v[6] * rstd * g[6], v[7] * rstd * g[7]);
        o1.x = pk2(v[8] * rstd * g[8], v[9] * rstd * g[9]); o1.y = pk2(v[10] * rstd * g[10], v[11] * rstd * g[11]); o1.z = pk2(v[12] * rstd * g[12], v[13] * rstd * g[13]); o1.w = pk2(v[14] * rstd * g[14], v[15] * rstd * g[15]);
        *(v4u*)p = o0; *(v4u*)(p + 8) = o1;
    }
    if (lane < 8) *(v4u*)(IKC + m * 64 + lane * 8) = *(const v4u*)(Z + m * ZP + ZC_IK + lane * 8);
    if (lane < 16) UW[m * 16 + lane] = bf2f(Z[m * ZP + ZC_IW + lane]) * (0.5f / 32.0f);
}
#define FRAG_NAT(dst, tile, s, hg, col) do { _Pragma("unroll") for (int j_ = 0; j_ < 8; ++j_) dst[j_] = (short)(tile)[(16 * (s) + 8 * (hg) + j_) * 64 + (col)]; } while (0)
__device__ __forceinline__ void gla_local_unit(LAS unsigned char* lds, int wave, int lane, const bf16* Z, const float* DEC, float* SLOC, int u) {
    const int h = u & 7; const size_t t0 = (size_t)(u >> 3) * 64; const int r = lane & 31, hg = lane >> 5;
    const LAS unsigned short* kt = (const LAS unsigned short*)(lds + GLA_K_OFF) + h * 64;
    LAS unsigned short* vt = (LAS unsigned short*)(lds + GLA_Q_OFF + wave * 8192);
    const float d0 = DEC[(size_t)u * 64 + r], d1 = DEC[(size_t)u * 64 + 32 + r];
    bf16x8 Bk[2][4];
#pragma unroll
    for (int nt = 0; nt < 2; ++nt)
#pragma unroll
        for (int s = 0; s < 4; ++s) {
#pragma unroll
            for (int j = 0; j < 8; ++j) Bk[nt][s][j] = (short)kt[(16 * s + 8 * hg + j) * 512 + 32 * nt + r]; }
#pragma unroll 1
    for (int half = 0; half < 2; ++half) {
        LDS_WAIT();
#pragma unroll
        for (int i = 0; i < 8; ++i) { const int row = i * 8 + (lane >> 3), ch = lane & 7;
            *(LAS v4u*)(vt + row * 64 + ch * 8) = *(const v4u*)(Z + (t0 + row) * ZP + ZC_GV + h * 128 + half * 64 + ch * 8); }
        LDS_WAIT();
        f32x16 acc[2][2];
#pragma unroll
        for (int a = 0; a < 2; ++a)
#pragma unroll
            for (int b = 0; b < 2; ++b)
#pragma unroll
                for (int i = 0; i < 16; ++i) acc[a][b][i] = 0.f;
#pragma unroll
        for (int mt = 0; mt < 2; ++mt)
#pragma unroll
            for (int s = 0; s < 4; ++s) { bf16x8 Av; FRAG_NAT(Av, vt, s, hg, 32 * mt + r);
                acc[mt][0] = MFMA32(Av, Bk[0][s], acc[mt][0]); acc[mt][1] = MFMA32(Av, Bk[1][s], acc[mt][1]); }
        unsigned short* out = (unsigned short*)SLOC + (size_t)u * 8192;
#pragma unroll
        for (int mt = 0; mt < 2; ++mt)
#pragma unroll
            for (int i = 0; i < 16; ++i) { const int dv = half * 64 + 32 * mt + crow(i, hg);
                out[dv * 64 + r] = (unsigned short)f2bf(acc[mt][0][i] * d0); out[dv * 64 + 32 + r] = (unsigned short)f2bf(acc[mt][1][i] * d1); }
    }
}
__device__ __forceinline__ void gla_scan(const float* SLOC, const float* DEC, bf16* STT, int gt, int ngt) {
    for (int p = gt; p < 32 * 4096; p += ngt) {
        const int bh = p >> 12, ev = (p & 4095) * 2, b = bh >> 3, h = bh & 7, k = ev & 63;
        float s0 = 0.f, s1 = 0.f;
#pragma unroll 8
        for (int c = 0; c < 128; ++c) {
            const size_t u = ((size_t)(b * 128 + c) * 8 + h);
            const unsigned slw = *(const unsigned*)((const unsigned short*)SLOC + u * 8192 + ev); float2 sl; sl.x = bflo(slw); sl.y = bfhi(slw); const float2 dc = *(const float2*)(DEC + u * 64 + k);
            *(unsigned*)(STT + u * 8192 + ev) = pk2(s0, s1);
            s0 = fmaf(s0, dc.x, sl.x); s1 = fmaf(s1, dc.y, sl.y);
        }
    }
}
__device__ __forceinline__ void gla_out_unit(LAS unsigned char* wl, int lane, const bf16* Z, const bf16* STT, const float* gn, bf16* OA, int u) {
    const int h = u & 7; const size_t t0 = (size_t)(u >> 3) * 64; const int r = lane & 31, hg = lane >> 5;
    LAS unsigned short* vt = (LAS unsigned short*)wl;
    LDS_WAIT();
#pragma unroll
    for (int i = 0; i < 16; ++i) { const int row = i * 4 + (lane >> 4), ch = lane & 15;
        *(LAS v4u*)(vt + row * 128 + ch * 8) = *(const v4u*)(Z + (t0 + row) * ZP + ZC_GV + h * 128 + ch * 8); }
    bf16x8 Fq[2][4], Fk[2][4];
#pragma unroll
    for (int t = 0; t < 2; ++t)
#pragma unroll
        for (int s = 0; s < 4; ++s) {
            Fq[t][s] = *(const bf16x8*)(Z + (t0 + 32 * t + r) * ZP + ZC_GQ + h * 64 + 16 * s + 8 * hg);
            Fk[t][s] = *(const bf16x8*)(Z + (t0 + 32 * t + r) * ZP + ZC_GK + h * 64 + 16 * s + 8 * hg); }
    const bf16* st = STT + (size_t)u * 8192;
    LDS_WAIT();
#pragma unroll 1
    for (int it = 0; it < 2; ++it) {
        f32x16 o[4];
#pragma unroll
        for (int d = 0; d < 4; ++d)
#pragma unroll
            for (int i = 0; i < 16; ++i) o[d][i] = 0.f;
#pragma unroll
        for (int d = 0; d < 4; ++d)
#pragma unroll
            for (int s = 0; s < 4; ++s) { const bf16x8 Bs = *(const bf16x8*)(st + (32 * d + r) * 64 + 16 * s + 8 * hg); o[d] = MFMA32(Fq[it][s], Bs, o[d]); }
#pragma unroll
        for (int jt = 0; jt < 2; ++jt) {
            if (jt <= it) {
                f32x16 X;
#pragma unroll
                for (int i = 0; i < 16; ++i) X[i] = 0.f;
#pragma unroll
                for (int s = 0; s < 4; ++s) X = MFMA32(Fk[jt][s], Fq[it][s], X);
                asm volatile("s_nop 15\n\ts_nop 7" : "+v"(X));
                if (jt == it) {
#pragma unroll
                    for (int i = 0; i < 16; ++i) if (crow(i, hg) > r) X[i] = 0.f;
                }
#pragma unroll
                for (int s2 = 0; s2 < 2; ++s2) {
                    v4u pw; pw.x = cvt_pk_bf16(X[8 * s2 + 0], X[8 * s2 + 1]); pw.y = cvt_pk_bf16(X[8 * s2 + 2], X[8 * s2 + 3]); pw.z = cvt_pk_bf16(X[8 * s2 + 4], X[8 * s2 + 5]); pw.w = cvt_pk_bf16(X[8 * s2 + 6], X[8 * s2 + 7]);
                    const bf16x8 pa = __builtin_bit_cast(bf16x8, pw);
#pragma unroll
                    for (int d = 0; d < 4; ++d) { bf16x8 Bv;
#pragma unroll
                        for (int j = 0; j < 8; ++j) Bv[j] = (short)vt[(32 * jt + 16 * s2 + 8 * (j >> 2) + 4 * hg + (j & 3)) * 128 + 32 * d + r];
                        o[d] = MFMA32(pa, Bv, o[d]); }
                }
            }
        }
        float g4[4];
#pragma unroll
        for (int d = 0; d < 4; ++d) g4[d] = gn[32 * d + r];
#pragma unroll
        for (int i = 0; i < 16; ++i) {
            float ss = o[0][i] * o[0][i] + o[1][i] * o[1][i] + o[2][i] * o[2][i] + o[3][i] * o[3][i];
            ss = sum32(ss);
            const float rstd = 1.0f / sqrtf(ss * (1.0f / 128.f) + EPS);
            const size_t tok = t0 + 32 * it + crow(i, hg);
#pragma unroll
            for (int d = 0; d < 4; ++d) { const float gr = bf2f(Z[tok * ZP + ZC_GR + h * 128 + 32 * d + r]);
                const float val = o[d][i] * rstd * g4[d] * (gr * sigmoidf_(gr));
                OA[tok * 1024 + h * 128 + 32 * d + r] = (bf16)f2bf(val); }
        }
    }
}


__device__ __forceinline__ size_t sc_off(int b, int c) { return (size_t)b * SC_PER_BATCH + (size_t)4096 * ((size_t)c * (c + 1) / 2); }
__device__ __forceinline__ unsigned score_code(float sc) {
    const _Float16 hf = (_Float16)sc; const unsigned bits = (unsigned)__builtin_bit_cast(unsigned short, hf);
    return (bits & 0x8000u) ? (~bits & 0xffffu) : (bits | 0x8000u);
}
__device__ __forceinline__ void idx_scores_oct(LAS unsigned char* wl, int lane, const bf16* Z, const bf16* IKC, const float* UW, unsigned short* SC, int b, int c, int oct) {
    const int r = lane & 31, hg = lane >> 5, n = 64 * (c + 1);
    const size_t t0 = (size_t)b * SEQ + (size_t)c * 64 + 8 * oct;
    bf16x8 A[4][4];
    { const int q = (r >> 2) & 1, head = (r & 3) + 4 * (r >> 3);
#pragma unroll
      for (int a = 0; a < 4; ++a)
#pragma unroll
        for (int s = 0; s < 4; ++s) A[a][s] = *(const bf16x8*)(Z + (t0 + 2 * a + q) * ZP + ZC_IQ + head * 64 + 16 * s + 8 * hg); }
    LAS float* ul = (LAS float*)wl;
    LDS_WAIT();
    ul[lane] = UW[t0 * 16 + lane]; ul[64 + lane] = UW[t0 * 16 + 64 + lane];
    LDS_WAIT();
    GAS unsigned short* row0 = (GAS unsigned short*)SC + sc_off(b, c) + (size_t)(8 * oct + hg) * n;
    const GAS bf16* kb = (const GAS bf16*)IKC + ((size_t)b * SEQ + r) * 64 + 8 * hg;
    const int npair = n / 64;
#define IDX_LOADB(dst, kt_) do { _Pragma("unroll") for (int t = 0; t < 2; ++t) _Pragma("unroll") for (int s = 0; s < 4; ++s) dst[t][s] = *(const GAS bf16x8*)(kb + (size_t)((kt_) + t) * 32 * 64 + 16 * s); } while (0)
#define IDX_STEP(Bc, kt_) do { _Pragma("unroll") for (int a = 0; a < 4; ++a) { \
            f32x2 u2[8]; \
            _Pragma("unroll") for (int i = 0; i < 4; ++i) { const f32x4 t4 = *(const LAS f32x4*)(ul + (2 * a + hg) * 16 + 4 * i); u2[2 * i] = (f32x2){t4.x, t4.y}; u2[2 * i + 1] = (f32x2){t4.z, t4.w}; } \
            f32x16 acc0, acc1; \
            _Pragma("unroll") for (int i = 0; i < 16; ++i) { acc0[i] = 0.f; acc1[i] = 0.f; } \
            _Pragma("unroll") for (int s = 0; s < 4; ++s) { acc0 = MFMA32(A[a][s], Bc[0][s], acc0); acc1 = MFMA32(A[a][s], Bc[1][s], acc1); } \
            f32x2 l0 = {0.f, 0.f}, l1 = {0.f, 0.f}; \
            _Pragma("unroll") for (int j = 0; j < 8; ++j) { l0 = (f32x2){acc0[2 * j], acc0[2 * j + 1]} * u2[j] + l0; l1 = (f32x2){acc1[2 * j], acc1[2 * j + 1]} * u2[j] + l1; } \
            float s0 = l0.x + l0.y, s1 = l1.x + l1.y; \
            _Pragma("unroll") for (int j = 0; j < 8; ++j) { \
                asm("v_fma_f32 %0, |%1|, %2, %0" : "+v"(s0) : "v"(acc0[2 * j]), "v"(u2[j].x)); asm("v_fma_f32 %0, |%1|, %2, %0" : "+v"(s1) : "v"(acc1[2 * j]), "v"(u2[j].x)); \
                asm("v_fma_f32 %0, |%1|, %2, %0" : "+v"(s0) : "v"(acc0[2 * j + 1]), "v"(u2[j].y)); asm("v_fma_f32 %0, |%1|, %2, %0" : "+v"(s1) : "v"(acc1[2 * j + 1]), "v"(u2[j].y)); } \
            const unsigned c0 = score_code(s0), c1 = score_code(s1); \
            const unsigned pa = (unsigned)DPP_I(c0, DPP_X1), pb = (unsigned)DPP_I(c1, DPP_X1); \
            GAS unsigned short* row = row0 + (size_t)(2 * a) * n; \
            if ((r & 1) == 0) *(GAS unsigned*)(row + (kt_) * 32 + r) = c0 | (pa << 16); \
            else *(GAS unsigned*)(row + ((kt_) + 1) * 32 + r - 1) = pb | (c1 << 16); \
            } } while (0)
    bf16x8 B0[2][4], B1[2][4];
    IDX_LOADB(B0, 0);
#pragma unroll 1
    for (int p = 0; p < npair; p += 2) {
        if (p + 1 < npair) IDX_LOADB(B1, 2 * (p + 1));
        IDX_STEP(B0, 2 * p);
        if (p + 1 < npair) {
            if (p + 2 < npair) IDX_LOADB(B0, 2 * (p + 2));
            IDX_STEP(B1, 2 * (p + 1));
        }
    }
#undef IDX_LOADB
#undef IDX_STEP
}
__device__ __forceinline__ void idx_select_row(int lane, const unsigned short* row, int n, LAS unsigned char* bmrow, LAS unsigned* bins  ) {
    const int nch = n / 8;
    if (n <= 256) {
#pragma unroll
        for (int s = 0; s < 16; ++s) { const int j = lane + 64 * s; bmrow[j] = (j < nch) ? 0xffu : 0u; }
        return;
    }
    v4u cw[16];
#pragma unroll
    for (int s = 0; s < 16; ++s) { const int j = lane + 64 * s; const unsigned m = (unsigned)((j - nch) >> 31);
        const int jc = j < nch ? j : nch - 1; const v4u t = *(const v4u*)(row + (size_t)jc * 8); cw[s] = (v4u){t.x & m, t.y & m, t.z & m, t.w & m}; }
    const int ns = (nch + 63) / 64;
#define WSCAN(v) do { _Pragma("unroll") for (int o_ = 1; o_ < 64; o_ <<= 1) { const int t_ = __builtin_amdgcn_ds_bpermute((lane - o_) << 2, (v)); if (lane >= o_) (v) += t_; } } while (0)
#pragma unroll
    for (int i = 0; i < 8; ++i) *(LAS v4u*)(bins + (i * 64 + lane) * 4) = (v4u){0u, 0u, 0u, 0u};
    LDS_WAIT();
#pragma unroll
    for (int s = 0; s < 16; ++s) if (s < ns) {
#pragma unroll
        for (int e = 0; e < 4; ++e) { const unsigned w = cw[s][e];
            __hip_atomic_fetch_add(bins + ((w & 0xffffu) >> 5), 1u, __ATOMIC_RELAXED, __HIP_MEMORY_SCOPE_WORKGROUP);
            __hip_atomic_fetch_add(bins + (w >> 21), 1u, __ATOMIC_RELAXED, __HIP_MEMORY_SCOPE_WORKGROUP); } }
    LDS_WAIT();
    int B, above;
    { unsigned bv[32]; int sl = 0;
#pragma unroll
      for (int i = 0; i < 8; ++i) { const v4u t = *(const LAS v4u*)(bins + lane * 32 + 4 * i); bv[4 * i] = t.x; bv[4 * i + 1] = t.y; bv[4 * i + 2] = t.z; bv[4 * i + 3] = t.w; sl += (int)(t.x + t.y + t.z + t.w); }
      int incl = sl; WSCAN(incl);
      const int tot = __builtin_amdgcn_readlane(incl, 63);
      int run = tot - incl;
      const bool mine = run < 256 && run + sl >= 256;
      int bl = 0, al = 0; bool found = false;
#pragma unroll
      for (int k = 31; k >= 0; --k) { const int cbin = (int)bv[k]; if (!found && run + cbin >= 256) { bl = 32 * lane + k; al = run; found = true; } run += cbin; }
      const unsigned long long mk = __builtin_amdgcn_ballot_w64(mine); const int src = (int)__builtin_ctzll(mk);
      B = __builtin_amdgcn_readlane(bl, src); above = __builtin_amdgcn_readlane(al, src); }
    LDS_WAIT();
    if (lane < 8) *(LAS v4u*)(bins + lane * 4) = (v4u){0u, 0u, 0u, 0u};
    LDS_WAIT();
#pragma unroll
    for (int s = 0; s < 16; ++s) if (s < ns) {
#pragma unroll
        for (int e = 0; e < 4; ++e) { const unsigned w = cw[s][e]; const unsigned lo = w & 0xffffu, hi = w >> 16;
            if ((int)(lo >> 5) == B) __hip_atomic_fetch_add(bins + (lo & 31u), 1u, __ATOMIC_RELAXED, __HIP_MEMORY_SCOPE_WORKGROUP);
            if ((int)(hi >> 5) == B) __hip_atomic_fetch_add(bins + (hi & 31u), 1u, __ATOMIC_RELAXED, __HIP_MEMORY_SCOPE_WORKGROUP); } }
    LDS_WAIT();
    unsigned thr; int cgt, ceq;
    { const int cl = lane < 32 ? (int)bins[lane] : 0; int incl = cl; WSCAN(incl);
      const int tot = __builtin_amdgcn_readlane(incl, 63);
      const int run = above + tot - incl;
      const bool mine = lane < 32 && run < 256 && run + cl >= 256;
      const unsigned long long mk = __builtin_amdgcn_ballot_w64(mine); const int src = (int)__builtin_ctzll(mk);
      thr = ((unsigned)B << 5) | (unsigned)src; cgt = __builtin_amdgcn_readlane(run, src); ceq = __builtin_amdgcn_readlane(cl, src); }
    LDS_WAIT();
#undef WSCAN
    const int need = 256 - cgt;
    const bool fast = (ceq == need);
    int run = 0;
#pragma unroll
    for (int s = 0; s < 16; ++s) {
        const int j = lane + 64 * s;
        unsigned gm = 0u, tm = 0u;
        if (s < ns) {
#pragma unroll
            for (int e = 0; e < 4; ++e) { const unsigned w = cw[s][e]; const unsigned lo = w & 0xffffu, hi = w >> 16;
                gm |= ((thr - lo) >> 31) << (2 * e); gm |= ((thr - hi) >> 31) << (2 * e + 1);
                tm |= (((lo ^ thr) - 1u) >> 31) << (2 * e); tm |= (((hi ^ thr) - 1u) >> 31) << (2 * e + 1); }
            if (fast) gm |= tm;
            else {
                const int tc = __builtin_popcount(tm); int incl = tc;
#pragma unroll
                for (int o = 1; o < 64; o <<= 1) { const int t = __builtin_amdgcn_ds_bpermute((lane - o) << 2, incl); if (lane >= o) incl += t; }
                int rank = run + incl - tc;
#pragma unroll
                for (int e = 0; e < 8; ++e) if ((tm >> e) & 1u) { if (rank < need) gm |= 1u << e; ++rank; }
                run += __builtin_amdgcn_readlane(incl, 63);
            }
        }
        bmrow[j] = (unsigned char)gm;
    }
}


__device__ __forceinline__ void bt_emit_tile(int lane, const LAS unsigned char* rows, unsigned* BT, int b, int c, int tile, bool zero) {
    unsigned long long w = 0ull;
    if (!zero) w = *(const LAS unsigned long long*)(rows + lane * 1024 + tile * 8);
    unsigned va = 0u, vb = 0u;
#pragma unroll
    for (int pos = 0; pos < 64; ++pos) { const int rr = (pos >> 1) & 15, p = pos >> 5, h = pos & 1, key = 32 * p + (rr & 3) + 8 * (rr >> 2) + 4 * h;
        const unsigned long long m = __builtin_amdgcn_ballot_w64(((w >> key) & 1ull) != 0ull);
        asm volatile("s_nop 1\n\tv_writelane_b32 %0, %1, %2" : "+v"(va) : "s"((unsigned)m), "n"(pos)); asm volatile("v_writelane_b32 %0, %1, %2" : "+v"(vb) : "s"((unsigned)(m >> 32)), "n"(pos)); }
    const size_t g0 = ((size_t)(b * 256 + 2 * c) * 128 + tile) * 64;
    BT[g0 + lane] = va; BT[g0 + 128 * 64 + lane] = vb;
}

namespace att {
constexpr int AD = 128, NW = 8, QBLK = 32, KVBLK = 64, QB = NW * QBLK;
constexpr int SHM_V = KVBLK * AD * 2, SHM_K = KVBLK * AD * 2;
constexpr int LI_OFF = 2 * SHM_V + 2 * SHM_K;
constexpr int LUT_OFF = LI_OFF + NW * 64 * 4;
constexpr int NM_OFF = LUT_OFF + 8 * 256 * 4;
constexpr int QI_OFF = NM_OFF + 32;
constexpr int ATT_LDS = NM_OFF + 64;
typedef unsigned u32x16 __attribute__((ext_vector_type(16)));
#define AS4C __attribute__((address_space(4)))
#define KSWZ(row, colB) ((row) * 256 + ((colB) ^ (((row) & 7) << 4)))
#define SBAR() __builtin_amdgcn_sched_barrier(0)
__device__ __forceinline__ int v_st(int k, int c) { const int kk = (k & ~0xC) | ((k & 4) << 1) | ((k & 8) >> 1); return ((kk >> 3) * 4 + (c >> 5)) * 512 + ((kk & 7) * 32 + (c & 31)) * 2; }
__device__ __forceinline__ int v_rd_base(int lane) { return ((lane & 3) << 3) | (((lane >> 2) & 3) << 6) | (((lane >> 4) & 1) << 5) | (((lane >> 5) & 1) << 8); }
constexpr int v_rd_off(int d0, int ks, int half) { return d0 * 512 + ks * 4096 + half * 2048; }
__device__ __forceinline__ unsigned cvtpk(float lo, float hi) { unsigned r; asm volatile("v_cvt_pk_bf16_f32 %0, %1, %2" : "=v"(r) : "v"(lo), "v"(hi)); return r; }
__device__ __forceinline__ bf16x8 load8(const bf16* p) { return *reinterpret_cast<const bf16x8*>(p); }
__device__ __forceinline__ void mask16(f32x16& p, const u32x16& ma, const u32x16& mb, float neg) {
#pragma unroll
    for (int r = 0; r < 16; ++r) { const unsigned lo = r < 8 ? ma[2 * r] : mb[2 * r - 16], hi = r < 8 ? ma[2 * r + 1] : mb[2 * r - 15];
        const unsigned long long mm = ((unsigned long long)hi << 32) | lo; float o;
        asm volatile("v_cndmask_b32_e64 %0, %1, %2, %3" : "=v"(o) : "v"(neg), "v"(p[r]), "s"(mm)); p[r] = o; }
}
#define MFMA_PAD(a, b) asm volatile("s_nop 15\n\ts_nop 7" : "+v"(a), "+v"(b))
__device__ __forceinline__ void bias_tile(f32x16& p0, f32x16& p1, const LAS float* lut) {
#pragma unroll
    for (int r = 0; r < 16; ++r) { const int c = (r & 3) + 8 * (r >> 2); p0[r] += lut[c]; p1[r] += lut[c + 32]; }
}
__device__ __forceinline__ void exp16(f32x16& p) {
#pragma unroll
    for (int r = 0; r < 16; ++r) p[r] = __builtin_amdgcn_exp2f(p[r]);
}
__device__ __forceinline__ void finishSM(f32x16& p0, f32x16& p1, float& l_reg, bf16x8& pa0, bf16x8& pa1, bf16x8& pa2, bf16x8& pa3) {
    exp16(p1);
    float ps = 0;
#pragma unroll
    for (int r = 0; r < 16; ++r) ps += p0[r];
#pragma unroll
    for (int r = 0; r < 16; ++r) ps += p1[r];
    l_reg += ps;
#define PK4(P, B_, OUT) do { unsigned a0 = cvtpk(P[B_+0], P[B_+1]), a1 = cvtpk(P[B_+2], P[B_+3]);                          \
        unsigned b0 = cvtpk(P[B_+4], P[B_+5]), b1 = cvtpk(P[B_+6], P[B_+7]);                                             \
        auto r0 = __builtin_amdgcn_permlane32_swap(a0, b0, false, false); auto r1 = __builtin_amdgcn_permlane32_swap(a1, b1, false, false); \
        v4u w = {r0[0], r1[0], r0[1], r1[1]}; OUT = *reinterpret_cast<bf16x8*>(&w); } while (0)
    PK4(p0, 0, pa0); PK4(p0, 8, pa1); PK4(p1, 0, pa2); PK4(p1, 8, pa3);
#undef PK4
}
template <int KB>
__device__ __forceinline__ void qkt(f32x16& p0, f32x16& p1, const char* K_lds, int r32, int hi, const bf16x8* qr, float init) {
#pragma unroll
    for (int r = 0; r < 16; ++r) { float i0 = init, i1 = init; asm volatile("" : "+v"(i0), "+v"(i1)); p0[r] = i0; p1[r] = i1; }
    const char* kb[4];
#pragma unroll
    for (int dd = 0; dd < 4; ++dd) kb[dd] = K_lds + KB * SHM_K + KSWZ(r32, (dd * 16 + hi * 8) * 2);
#pragma unroll
    for (int d0 = 0; d0 < 8; ++d0) { const char* a = kb[d0 & 3] + (d0 >> 2) * 128;
        bf16x8 b0 = *reinterpret_cast<const bf16x8*>(a);
        bf16x8 b1 = *reinterpret_cast<const bf16x8*>(a + 32 * 256);
        p0 = __builtin_amdgcn_mfma_f32_32x32x16_bf16(b0, qr[d0], p0, 0, 0, 0);
        p1 = __builtin_amdgcn_mfma_f32_32x32x16_bf16(b1, qr[d0], p1, 0, 0, 0); }
}
template <int VB>
__device__ __forceinline__ void pv_tile(f32x16* o, int vb0, bf16x8 pa0, bf16x8 pa1, bf16x8 pa2, bf16x8 pa3) {
#define TRRD(dst, off) asm volatile("ds_read_b64_tr_b16 %0, %1 offset:%2" : "=&v"(dst) : "v"(vb0), "i"(off) : "memory")
#define PV_D0(d0) do { s16x4 l0, l1, l2, l3, h0, h1, h2, h3; constexpr int b_ = VB * SHM_V + v_rd_off(d0, 0, 0); \
        TRRD(l0, b_); TRRD(h0, b_ + 2048); TRRD(l1, b_ + 4096); TRRD(h1, b_ + 6144); TRRD(l2, b_ + 8192); TRRD(h2, b_ + 10240); TRRD(l3, b_ + 12288); TRRD(h3, b_ + 14336); \
        asm volatile("s_waitcnt lgkmcnt(0)" ::: "memory"); SBAR();   \
        o[d0] = __builtin_amdgcn_mfma_f32_32x32x16_bf16(pa0, (bf16x8){l0[0], l0[1], l0[2], l0[3], h0[0], h0[1], h0[2], h0[3]}, o[d0], 0, 0, 0);   \
        o[d0] = __builtin_amdgcn_mfma_f32_32x32x16_bf16(pa1, (bf16x8){l1[0], l1[1], l1[2], l1[3], h1[0], h1[1], h1[2], h1[3]}, o[d0], 0, 0, 0);   \
        o[d0] = __builtin_amdgcn_mfma_f32_32x32x16_bf16(pa2, (bf16x8){l2[0], l2[1], l2[2], l2[3], h2[0], h2[1], h2[2], h2[3]}, o[d0], 0, 0, 0);   \
        o[d0] = __builtin_amdgcn_mfma_f32_32x32x16_bf16(pa3, (bf16x8){l3[0], l3[1], l3[2], l3[3], h3[0], h3[1], h3[2], h3[3]}, o[d0], 0, 0, 0); } while (0)
    PV_D0(0); PV_D0(1); PV_D0(2); PV_D0(3);
#undef PV_D0
#undef TRRD
}
struct BlockRef { const bf16* Q; const bf16* K; unsigned char* O; const unsigned* bt; int P0; int h; };
struct Seam { bf16x8 qr[8]; bf16x8 st_v0, st_v1, st_k0, st_k1; };
#define ROW(p, k0, rr) ((p) + (size_t)((k0) + (rr)) * ZP + sc)
#define VMW() asm volatile("s_waitcnt vmcnt(0)" ::: "memory")
#define VMWN(n) asm volatile("s_waitcnt vmcnt(%0)" :: "i"(n) : "memory")
#define SLOAD_H(Kp, k0) do { const bf16* r0_ = ROW(Kp, k0, sr); const bf16* r1_ = ROW(Kp, k0, 32 + sr);   \
                         S.st_v0 = load8(r0_ + (ZC_DV - ZC_DK)); S.st_v1 = load8(r1_ + (ZC_DV - ZC_DK)); S.st_k0 = load8(r0_); S.st_k1 = load8(r1_); } while (0)
#define SWRITE_HK(bf) do { *(bf16x8*)(K_lds + (bf) * SHM_K + kws) = S.st_k0; *(bf16x8*)(K_lds + (bf) * SHM_K + kws + 32 * 256) = S.st_k1; } while (0)
#define SWRITE_HV(bf) do { *(bf16x8*)(V_lds + (bf) * SHM_V + vst0) = S.st_v0; *(bf16x8*)(V_lds + (bf) * SHM_V + vst1) = S.st_v1; } while (0)
#define SWRITE_H(bf) do { SWRITE_HV(bf); SWRITE_HK(bf); } while (0)
#define MLOAD(dst0, dst1, ptr, byteoff) do { const AS4C u32x16* q_ = (const AS4C u32x16*)(const AS4C void*)(ptr); dst0 = q_[(byteoff) / 64]; dst1 = q_[(byteoff) / 64 + 1]; } while (0)
__device__ __forceinline__ void prime(const BlockRef& cur, char* lds, Seam& S) {
    const int tid = opaque_tid(), wid = __builtin_amdgcn_readfirstlane(tid >> 6), lane = tid & 63, r32 = lane & 31, hi = lane >> 5;
    const int sr = tid >> 4, sc = (tid & 15) * 8, kws = KSWZ(sr, sc * 2); char* K_lds = lds + 2 * SHM_V;
#pragma unroll
    for (int d0 = 0; d0 < 8; ++d0) S.qr[d0] = load8(cur.Q + (size_t)(wid * QBLK + r32) * ZP + d0 * 16 + hi * 8);
    SLOAD_H(cur.K, 0); VMW(); SWRITE_HK(0);
    __syncthreads();
}
__device__ __forceinline__ void block(const BlockRef& cur, const BlockRef& nxt, char* lds, Seam& S) {
    const int tid = opaque_tid(), wid = __builtin_amdgcn_readfirstlane(tid >> 6), lane = tid & 63, r32 = lane & 31, hi = lane >> 5;
    const int NT = cur.P0 / KVBLK + 4;
    const int qlo = cur.P0 + wid * QBLK, qch = qlo >> 6;
    char* V_lds = lds; char* K_lds = lds + 2 * SHM_V;
    float* li_l = (float*)(lds + LI_OFF) + wid * 64;
    const float ninit = *(const float*)(lds + NM_OFF + 4 * cur.h);
    const float NEG = -__builtin_inff();
    const unsigned* btw = cur.bt + (size_t)wid * (128 * 64);
    float l_reg = 0; f32x16 o[4];
#pragma unroll
    for (int d = 0; d < 4; ++d)
#pragma unroll
        for (int r = 0; r < 16; ++r) o[d][r] = 0.f;
    const int sr = tid >> 4, sc = (tid & 15) * 8, vst0 = v_st(sr, sc), vst1 = v_st(32 + sr, sc), kws = KSWZ(sr, sc * 2);
    const int vb0 = (int)(uintptr_t)V_lds + v_rd_base(lane);
    const bf16* Kh = cur.K;
#define KBASE(t) ((t) * KVBLK)
#define LUTB(t) (LUT_OFF + 4 * (cur.h * 256 + 191 + 4 * hi - qlo - r32 + (t) * KVBLK))
#define MASKT(P0_, P1_, t) do { if ((t) >= qch - 2 && (t) <= qch) bias_tile(P0_, P1_, (const LAS float*)(unsigned)LUTB(t)); \
        mask16(P0_, m0, m1, NEG); { const unsigned* mp_ = btw + (size_t)(t) * 64; MLOAD(m0, m1, mp_, 128); } \
        if (__builtin_expect(__all(ninit <= 0.f), 1)) { exp16(P0_); } else { l_reg = 0.f; }     \
        mask16(P1_, m0, m1, NEG); } while (0)
#define MREQ(t) do { const unsigned* mp_ = btw + (size_t)(t) * 64; MLOAD(m0, m1, mp_, 0); } while (0)
    constexpr int NQL = 8;
#define SEAM_K0() do { VMWN(NQL); SWRITE_HK(0); SBAR(); } while (0)
    f32x16 pA0, pA1, pB0, pB1; bf16x8 pa0, pa1, pa2, pa3; u32x16 m0, m1;
    SWRITE_HV(0); SBAR();
    MREQ(0);
    if (NT > 1) SLOAD_H(Kh, KBASE(1));
    SBAR(); qkt<0>(pA0, pA1, K_lds, r32, hi, S.qr, ninit);
    MFMA_PAD(pA0, pA1); MASKT(pA0, pA1, 0);
    if (NT > 1) { VMW(); SWRITE_H(1); }
    __syncthreads();
#define HALF_STEP(PX0, PX1, PY0, PY1, t, KB, VB, SB) do {                                                      \
        SBAR(); MREQ(t); qkt<KB>(PX0, PX1, K_lds, r32, hi, S.qr, ninit);                                             \
        finishSM(PY0, PY1, l_reg, pa0, pa1, pa2, pa3); SBAR();                                                           \
        if ((t) + 1 < NT) { SLOAD_H(Kh, KBASE((t) + 1)); SBAR(); }                                               \
        pv_tile<VB>(o, vb0, pa0, pa1, pa2, pa3); MASKT(PX0, PX1, (t));                                        \
        __syncthreads();                                                                                                      \
        if ((t) + 1 < NT) { VMW(); SWRITE_H(SB); }                                                                          \
        __syncthreads(); } while (0)
    for (int t = 1; t + 1 < NT; t += 2) {
        HALF_STEP(pB0, pB1, pA0, pA1, t, 1, 0, 0);
        HALF_STEP(pA0, pA1, pB0, pB1, t + 1, 0, 1, 1);
    }
    MREQ(NT - 1);
    SBAR(); qkt<1>(pB0, pB1, K_lds, r32, hi, S.qr, ninit); SBAR();
    SLOAD_H(nxt.K, 0); SBAR();
#pragma unroll
    for (int d0 = 0; d0 < 8; ++d0) S.qr[d0] = load8(nxt.Q + (size_t)(wid * QBLK + r32) * ZP + d0 * 16 + hi * 8);
    SBAR();
    finishSM(pA0, pA1, l_reg, pa0, pa1, pa2, pa3); SBAR();
    pv_tile<0>(o, vb0, pa0, pa1, pa2, pa3);
    MASKT(pB0, pB1, NT - 1); __syncthreads();
    finishSM(pB0, pB1, l_reg, pa0, pa1, pa2, pa3); SBAR(); pv_tile<1>(o, vb0, pa0, pa1, pa2, pa3);
    SBAR(); SEAM_K0();
    { auto rr = __builtin_amdgcn_permlane32_swap(__float_as_uint(l_reg), __float_as_uint(l_reg), false, false); l_reg = __uint_as_float(rr[0]) + __uint_as_float(rr[1]); }
    if (hi == 0) li_l[r32] = l_reg; asm volatile("s_waitcnt lgkmcnt(0)" ::: "memory");
    float rli[16];
#pragma unroll
    for (int r = 0; r < 16; ++r) rli[r] = __builtin_amdgcn_rcpf(fmaxf(li_l[crow(r, hi)], 1e-37f));
    unsigned char* Ow = cur.O + (size_t)(wid * QBLK) * 1024;
#pragma unroll
    for (int r = 0; r < 16; ++r) { const int orow = crow(r, hi);
#pragma unroll
        for (int d0 = 0; d0 < 4; ++d0) { const float v = o[d0][r] * rli[r] * 16.0f;
            const float v1 = DPP_F(v, 0x55), v2 = DPP_F(v, 0xAA), v3 = DPP_F(v, 0xFF);
            if ((r32 & 3) == 0) *(unsigned*)(Ow + (size_t)orow * 1024 + d0 * 32 + r32) = pk4_fp8(v, v1, v2, v3); } }
    __syncthreads();
#undef KBASE
#undef LUTB
#undef MASKT
#undef MREQ
#undef SEAM_K0
#undef HALF_STEP
}
#undef ROW
#undef VMW
#undef VMWN
#undef SLOAD_H
#undef SWRITE_HK
#undef SWRITE_HV
#undef SWRITE_H
#undef MLOAD
__device__ __forceinline__ BlockRef make_ref(int L, int pass, const bf16* Z, unsigned char* OB, const unsigned* BT) {
    const int bh = L >> 4, x = L & 15, b = bh >> 3, h = bh & 7, qb = pass ? 31 - x : x;
    BlockRef r; const size_t row0 = (size_t)b * SEQ + (size_t)qb * QB;
    r.Q = Z + row0 * ZP + ZC_DQ + h * AD; r.K = Z + (size_t)b * SEQ * ZP + ZC_DK + h * AD;
    r.O = OB + row0 * 1024 + h * AD; r.bt = BT + (size_t)(b * 256 + qb * 8) * (128 * 64); r.P0 = qb * QB; r.h = h; return r;
}
__device__ __forceinline__ int t5_bucket(int rel) {
    const int n = rel < 0 ? -rel : rel; int bk;
    if (n < 8) bk = n; else if (n < 12) bk = 8; else if (n < 16) bk = 9; else if (n < 23) bk = 10; else if (n < 32) bk = 11; else if (n < 46) bk = 12; else if (n < 64) bk = 13; else if (n < 91) bk = 14; else bk = 15;
    return (rel > 0 ? 16 : 0) + bk;
}
__device__ __forceinline__ BlockRef make_ref_blk(int i, const bf16* Z, unsigned char* OB, const unsigned* BT) {
    const int bh = i & 31, b = bh >> 3, h = bh & 7, qb = 31 - (i >> 5);
    BlockRef r; const size_t row0 = (size_t)b * SEQ + (size_t)qb * QB;
    r.Q = Z + row0 * ZP + ZC_DQ + h * AD; r.K = Z + (size_t)b * SEQ * ZP + ZC_DK + h * AD;
    r.O = OB + row0 * 1024 + h * AD; r.bt = BT + (size_t)(b * 256 + qb * 8) * (128 * 64); r.P0 = qb * QB; r.h = h; return r;
}
__device__ __forceinline__ int q_fetch(char* lds, gu32* qhead, int slot) {
    if (opaque_tid() == 0) { const unsigned v = __hip_atomic_fetch_add(qhead, 1u, RLX_AGENT); ((volatile unsigned*)(lds + QI_OFF))[slot] = v; }
    __syncthreads();
    return __builtin_amdgcn_readfirstlane((int)((volatile unsigned*)(lds + QI_OFF))[slot]);
}
__device__ __forceinline__ void attn_phase(char* lds, const bf16* Z, unsigned char* OB, const unsigned* BT, const float* rel_bias, const float* qg, const float* kg, gu32* qhead) {
    constexpr float L2E = 1.4426950408889634f;
    { float* lut = (float*)(lds + LUT_OFF);
      const int tid = opaque_tid();
      for (int i = tid; i < 8 * 256; i += 512) { const int h = i >> 8, rel = (i & 255) - 191; lut[i] = (rel_bias[t5_bucket(rel) * 8 + h] - rel_bias[15 * 8 + h]) * L2E; }
      if (tid < 64) { const int l = tid;
          float mq = fmaxf(fabsf(qg[l]), fabsf(qg[l + 64])), mk = fmaxf(fabsf(kg[l]), fabsf(kg[l + 64]));
          mq = wave_max(mq); mk = wave_max(mk);
          if (l < 8) { float mb = 0.f; for (int bk = 0; bk < 32; ++bk) mb = fmaxf(mb, rel_bias[bk * 8 + l] - rel_bias[15 * 8 + l]);
              ((float*)(lds + NM_OFF))[l] = -(11.313708498984761f * mq * mk + mb) * L2E; } } }
    asm volatile("" : "+s"(BT));
    __syncthreads();
    constexpr int total = NB * 8 * 32;
    const int i0 = q_fetch(lds, qhead, 0); if (i0 >= total) return;
    int i1 = q_fetch(lds, qhead, 1), slot = 0;
    BlockRef cur = make_ref_blk(i0, Z, OB, BT);
    Seam S;
    prime(cur, lds, S);
    for (;;) {
        const bool last = i1 >= total;
        const BlockRef nxt = last ? cur : make_ref_blk(i1, Z, OB, BT);
        block(cur, nxt, lds, S);
        if (last) break;
        cur = nxt; i1 = q_fetch(lds, qhead, slot); slot ^= 1;
    }
}
}

constexpr int RING_OFF = 0, RING_BYTES = 131072;
constexpr int LDSCTL_OFF = RING_BYTES, MISC_OFF = LDSCTL_OFF + 320;
constexpr int LDS_BYTES = 147456;

struct Frame {
    LAS unsigned char* lds;
    volatile LAS unsigned* MISC;
    gu32* ctl;
    int tid, lane, wave, vcu, G;
};

template <int MAP> __device__ __forceinline__ int rowmap(int n) {
    if (MAP == 0) return n;
    if (MAP == 1) {
        if (n < 1024) return n;
        if (n < 3072) return -1;
        if (n < 3088) return ZC_GLR - 2048 + (n - 3072);
        if (n < 6160) return -1;
        if (n < 7184) return ZC_IQ - 2048 + (n - 6160);
        if (n < 7248) return ZC_IK - 2048 + (n - 7184);
        return ZC_IW - 2048 + (n - 7248);
    }
    if (MAP == 4) return (n >= 1024 && n < 3072) ? n - 1024 : (n >= 3088 && n < 6160) ? n - 3088 + 2048 : -1;
    if (MAP == 2) { const int half = n >> 11, c = n & 2047; return (c >> 7) * 256 + half * 128 + (c & 127); }
    if (MAP == 3) return (n >> 7) * 256 + (n & 127);
    return n;
}
template <int MAP>
__device__ __forceinline__ void p0_transpose_item(const float* W, int K, int N, bf16* WT, int row_off, LAS float* scr, int item, int lane) {
    const int nblk = N / 32, kb = item / nblk, nb = item % nblk, k0 = 64 * kb, n0 = 32 * nb;
#pragma unroll 8
    for (int i = 0; i < 32; ++i) { const int kk = 2 * i + (lane >> 5); scr[kk * 33 + (lane & 31)] = W[(size_t)(k0 + kk) * N + n0 + (lane & 31)]; }
    LDS_WAIT(); asm volatile("" ::: "memory");
    const int c = lane & 7;
#pragma unroll
    for (int j = 0; j < 4; ++j) { const int n = (lane >> 3) + 8 * j; const LAS float* s = scr + (8 * c) * 33 + n;
        v4u o; o.x = pk2(s[0 * 33], s[1 * 33]); o.y = pk2(s[2 * 33], s[3 * 33]); o.z = pk2(s[4 * 33], s[5 * 33]); o.w = pk2(s[6 * 33], s[7 * 33]);
        const int rm = rowmap<MAP>(n0 + n); if (rm >= 0) *(GAS v4u*)(WT + (size_t)(row_off + rm) * K + k0 + 8 * c) = o; }
    LDS_WAIT(); asm volatile("" ::: "memory");
}
template <int MAP>
__device__ __forceinline__ void p0_transpose_item8(const float* W, int K, int N, unsigned char* WT, int row_off, LAS float* scr, int item, int lane, float scale) {
    const int nblk = N / 32, kb = item / nblk, nb = item % nblk, k0 = 64 * kb, n0 = 32 * nb;
#pragma unroll 8
    for (int i = 0; i < 32; ++i) { const int kk = 2 * i + (lane >> 5); scr[kk * 33 + (lane & 31)] = W[(size_t)(k0 + kk) * N + n0 + (lane & 31)] * scale; }
    LDS_WAIT(); asm volatile("" ::: "memory");
    const int c = lane & 3;
#pragma unroll
    for (int j = 0; j < 2; ++j) { const int n = (lane >> 2) + 16 * j; const LAS float* sp = scr + (16 * c) * 33 + n;
        v4u o; o.x = pk4_fp8(sp[0 * 33], sp[1 * 33], sp[2 * 33], sp[3 * 33]); o.y = pk4_fp8(sp[4 * 33], sp[5 * 33], sp[6 * 33], sp[7 * 33]);
        o.z = pk4_fp8(sp[8 * 33], sp[9 * 33], sp[10 * 33], sp[11 * 33]); o.w = pk4_fp8(sp[12 * 33], sp[13 * 33], sp[14 * 33], sp[15 * 33]);
        const int rm = rowmap<MAP>(n0 + n); if (rm >= 0) *(GAS v4u*)(WT + (size_t)(row_off + rm) * K + k0 + 16 * c) = o; }
    LDS_WAIT(); asm volatile("" ::: "memory");
}
constexpr int CONV_MOD = 6, CONV_DEPTH = 3;
template <int MAP>
__device__ __forceinline__ void conv_stream8(const float* W, int K, int N, unsigned char* WT, int erows, int row_add, LAS float* scr, int lane, int cw, int NCW) {
    const int nblk = N / 32, per_e = (K / 64) * nblk, total = NEXP * per_e;
    const int lr = lane >> 3, lc = (lane & 7) * 4;
    if (cw >= total) return;
    const int n_my = (total - cw + NCW - 1) / NCW, it_last = cw + (n_my - 1) * NCW;
    f32x4 v[CONV_DEPTH][8];
#define CONV_IT(j_) min(cw + (j_) * NCW, it_last)
#define CONV_LOAD(d_, it_) do { const int e_ = (it_) / per_e, r_ = (it_) - e_ * per_e, kb_ = r_ / nblk, nb_ = r_ - kb_ * nblk; \
        const float* s_ = W + (size_t)e_ * K * N + (size_t)(64 * kb_ + lr) * N + 32 * nb_ + lc; \
        _Pragma("unroll") for (int i = 0; i < 8; ++i) v[d_][i] = __builtin_nontemporal_load((const f32x4*)(s_ + (size_t)(8 * i) * N)); } while (0)
#pragma unroll
    for (int d = 0; d < CONV_DEPTH; ++d) { CONV_LOAD(d, CONV_IT(d)); asm volatile("" ::: "memory"); __builtin_amdgcn_sched_barrier(0); }
    for (int j0 = 0; j0 < n_my; j0 += CONV_DEPTH) {
#pragma unroll
        for (int d = 0; d < CONV_DEPTH; ++d) {
            const int it = CONV_IT(j0 + d);
            const int e = it / per_e, r = it - e * per_e, kb = r / nblk, nb = r - kb * nblk, k0 = 64 * kb, n0 = 32 * nb;
#pragma unroll
            for (int i = 0; i < 8; ++i) { LAS float* dd = scr + (8 * i + lr) * 33 + lc; dd[0] = v[d][i].x; dd[1] = v[d][i].y; dd[2] = v[d][i].z; dd[3] = v[d][i].w; }
            CONV_LOAD(d, CONV_IT(j0 + d + CONV_DEPTH));
            LDS_WAIT(); asm volatile("" ::: "memory");
            const int c = lane & 3;
#pragma unroll
            for (int j = 0; j < 2; ++j) { const int n = (lane >> 2) + 16 * j; const LAS float* sp = scr + (16 * c) * 33 + n;
                v4u o; o.x = pk4_fp8(32.f * sp[0 * 33], 32.f * sp[1 * 33], 32.f * sp[2 * 33], 32.f * sp[3 * 33]); o.y = pk4_fp8(32.f * sp[4 * 33], 32.f * sp[5 * 33], 32.f * sp[6 * 33], 32.f * sp[7 * 33]);
                o.z = pk4_fp8(32.f * sp[8 * 33], 32.f * sp[9 * 33], 32.f * sp[10 * 33], 32.f * sp[11 * 33]); o.w = pk4_fp8(32.f * sp[12 * 33], 32.f * sp[13 * 33], 32.f * sp[14 * 33], 32.f * sp[15 * 33]);
                __builtin_nontemporal_store(o, (GAS v4u*)(WT + (size_t)(e * erows + row_add + rowmap<MAP>(n0 + n)) * K + k0 + 16 * c)); }
            LDS_WAIT(); asm volatile("" ::: "memory");
        }
    }
#undef CONV_LOAD
#undef CONV_IT
}
__device__ __forceinline__ void p0_transpose_item_win(const float* W, bf16* WT, unsigned char* WT8, LAS float* scr, int item, int lane) {
    constexpr int K = D, N = 7264;
    const int nblk = N / 32, kb = item / nblk, nb = item % nblk, k0 = 64 * kb, n0 = 32 * nb;
#pragma unroll 8
    for (int i = 0; i < 32; ++i) { const int kk = 2 * i + (lane >> 5); scr[kk * 33 + (lane & 31)] = W[(size_t)(k0 + kk) * N + n0 + (lane & 31)]; }
    LDS_WAIT(); asm volatile("" ::: "memory");
    { const int c = lane & 7;
#pragma unroll
      for (int j = 0; j < 4; ++j) { const int n = (lane >> 3) + 8 * j; const LAS float* sp = scr + (8 * c) * 33 + n; const int rm = rowmap<1>(n0 + n);
        if (rm >= 0) { v4u o; o.x = pk2(sp[0 * 33], sp[1 * 33]); o.y = pk2(sp[2 * 33], sp[3 * 33]); o.z = pk2(sp[4 * 33], sp[5 * 33]); o.w = pk2(sp[6 * 33], sp[7 * 33]);
            *(GAS v4u*)(WT + (size_t)rm * K + k0 + 8 * c) = o; } } }
    { const int c = lane & 3;
#pragma unroll
      for (int j = 0; j < 2; ++j) { const int n = (lane >> 2) + 16 * j; const LAS float* sp = scr + (16 * c) * 33 + n; const int rm = rowmap<4>(n0 + n);
        if (rm >= 0) { v4u o; o.x = pk4_fp8(32.f * sp[0 * 33], 32.f * sp[1 * 33], 32.f * sp[2 * 33], 32.f * sp[3 * 33]); o.y = pk4_fp8(32.f * sp[4 * 33], 32.f * sp[5 * 33], 32.f * sp[6 * 33], 32.f * sp[7 * 33]);
            o.z = pk4_fp8(32.f * sp[8 * 33], 32.f * sp[9 * 33], 32.f * sp[10 * 33], 32.f * sp[11 * 33]); o.w = pk4_fp8(32.f * sp[12 * 33], 32.f * sp[13 * 33], 32.f * sp[14 * 33], 32.f * sp[15 * 33]);
            *(GAS v4u*)(WT8 + (size_t)rm * K + k0 + 16 * c) = o; } } }
    LDS_WAIT(); asm volatile("" ::: "memory");
}
__device__ __forceinline__ void rms_row_to_bf16(int lane, const float* xrow, const float* g, bf16* orow, unsigned char* orow8 = nullptr) {
    const GAS f32x4* xr = (const GAS f32x4*)xrow + lane;
    f32x4 v[8]; float s = 0.f;
#pragma unroll
    for (int j = 0; j < 8; ++j) { v[j] = xr[64 * j]; s += (v[j].x * v[j].x + v[j].y * v[j].y) + (v[j].z * v[j].z + v[j].w * v[j].w); }
    const float rstd = 1.0f / sqrtf(wave_sum(s) * (1.f / D) + EPS);
    GAS unsigned long long* o8 = (GAS unsigned long long*)orow + lane;
#pragma unroll
    for (int j = 0; j < 8; ++j) { const f32x4 gg = ((const GAS f32x4*)g)[64 * j + lane];
        o8[64 * j] = (unsigned long long)pk2(v[j].x * rstd * gg.x, v[j].y * rstd * gg.y) | ((unsigned long long)pk2(v[j].z * rstd * gg.z, v[j].w * rstd * gg.w) << 32);
        if (orow8) ((GAS unsigned*)orow8)[64 * j + lane] = pk4_fp8(v[j].x * rstd * gg.x, v[j].y * rstd * gg.y, v[j].z * rstd * gg.z, v[j].w * rstd * gg.w); }
}

#ifndef MK_DSA
#define MK_DSA 1
#endif
#ifndef MK_MOE
#define MK_MOE 1
#endif
#ifndef MK_GLA
#define MK_GLA 1
#endif
constexpr int PREF_OFF = LDSCTL_OFF, CNTL_OFF = MISC_OFF + 128;
__device__ __forceinline__ void rms_row_bf(int lane, const bf16* xrow, const float* g, bf16* orow, unsigned char* orow8) {
    const GAS v4u* xr = (const GAS v4u*)xrow + lane;
    v4u w[4]; float s = 0.f;
#pragma unroll
    for (int j = 0; j < 4; ++j) { w[j] = xr[64 * j];
        const float a0 = bflo(w[j].x), a1 = bfhi(w[j].x), a2 = bflo(w[j].y), a3 = bfhi(w[j].y), a4 = bflo(w[j].z), a5 = bfhi(w[j].z), a6 = bflo(w[j].w), a7 = bfhi(w[j].w);
        s += ((a0 * a0 + a1 * a1) + (a2 * a2 + a3 * a3)) + ((a4 * a4 + a5 * a5) + (a6 * a6 + a7 * a7)); }
    const float rstd = 1.0f / sqrtf(wave_sum(s) * (1.f / D) + EPS);
#pragma unroll
    for (int j = 0; j < 4; ++j) { const f32x4 g0 = ((const GAS f32x4*)g)[2 * (64 * j + lane)], g1 = ((const GAS f32x4*)g)[2 * (64 * j + lane) + 1];
        const float a0 = bflo(w[j].x) * rstd * g0.x, a1 = bfhi(w[j].x) * rstd * g0.y, a2 = bflo(w[j].y) * rstd * g0.z, a3 = bfhi(w[j].y) * rstd * g0.w;
        const float a4 = bflo(w[j].z) * rstd * g1.x, a5 = bfhi(w[j].z) * rstd * g1.y, a6 = bflo(w[j].w) * rstd * g1.z, a7 = bfhi(w[j].w) * rstd * g1.w;
        v4u o; o.x = pk2(a0, a1); o.y = pk2(a2, a3); o.z = pk2(a4, a5); o.w = pk2(a6, a7);
        ((GAS v4u*)orow)[64 * j + lane] = o;
        v2u o8; o8.x = pk4_fp8(a0, a1, a2, a3); o8.y = pk4_fp8(a4, a5, a6, a7);
        ((GAS v2u*)orow8)[64 * j + lane] = o8; }
}
__device__ __forceinline__ void combine_row_bf(int lane, const bf16* x1, const bf16* y0, const bf16* y1, const float* g, bf16* x2, unsigned char* orow8) {
    float v[4][8]; float s = 0.f;
#pragma unroll
    for (int j = 0; j < 4; ++j) { const v4u w = ((const GAS v4u*)x1)[64 * j + lane];
        v[j][0] = bflo(w.x); v[j][1] = bfhi(w.x); v[j][2] = bflo(w.y); v[j][3] = bfhi(w.y); v[j][4] = bflo(w.z); v[j][5] = bfhi(w.z); v[j][6] = bflo(w.w); v[j][7] = bfhi(w.w);
#if MK_MOE
        const v4u a = ((const GAS v4u*)y0)[64 * j + lane], b = ((const GAS v4u*)y1)[64 * j + lane];
        v[j][0] += bflo(a.x) + bflo(b.x); v[j][1] += bfhi(a.x) + bfhi(b.x); v[j][2] += bflo(a.y) + bflo(b.y); v[j][3] += bfhi(a.y) + bfhi(b.y);
        v[j][4] += bflo(a.z) + bflo(b.z); v[j][5] += bfhi(a.z) + bfhi(b.z); v[j][6] += bflo(a.w) + bflo(b.w); v[j][7] += bfhi(a.w) + bfhi(b.w);
#endif
        v4u o; o.x = pk2(v[j][0], v[j][1]); o.y = pk2(v[j][2], v[j][3]); o.z = pk2(v[j][4], v[j][5]); o.w = pk2(v[j][6], v[j][7]);
        ((GAS v4u*)x2)[64 * j + lane] = o;
        v[j][0] = bflo(o.x); v[j][1] = bfhi(o.x); v[j][2] = bflo(o.y); v[j][3] = bfhi(o.y); v[j][4] = bflo(o.z); v[j][5] = bfhi(o.z); v[j][6] = bflo(o.w); v[j][7] = bfhi(o.w);
#pragma unroll
        for (int q = 0; q < 8; ++q) s += v[j][q] * v[j][q]; }
    const float rstd = 1.0f / sqrtf(wave_sum(s) * (1.f / D) + EPS);
#pragma unroll
    for (int j = 0; j < 4; ++j) { const f32x4 g0 = ((const GAS f32x4*)g)[2 * (64 * j + lane)], g1 = ((const GAS f32x4*)g)[2 * (64 * j + lane) + 1];
        v2u o8; o8.x = pk4_fp8(v[j][0] * rstd * g0.x, v[j][1] * rstd * g0.y, v[j][2] * rstd * g0.z, v[j][3] * rstd * g0.w);
        o8.y = pk4_fp8(v[j][4] * rstd * g1.x, v[j][5] * rstd * g1.y, v[j][6] * rstd * g1.z, v[j][7] * rstd * g1.w);
        ((GAS v2u*)orow8)[64 * j + lane] = o8; }
}
__device__ __forceinline__ void combine_row(int lane, float* xio, const bf16* y0, const bf16* y1, const float* g, unsigned char* orow8) {
    GAS f32x4* xr = (GAS f32x4*)xio + lane;
    f32x4 v[8]; float s = 0.f;
#pragma unroll
    for (int j = 0; j < 8; ++j) { v[j] = xr[64 * j];
#if MK_MOE
        const v2u a = ((const GAS v2u*)y0)[64 * j + lane], b = ((const GAS v2u*)y1)[64 * j + lane];
        v[j].x += bflo(a.x) + bflo(b.x); v[j].y += bfhi(a.x) + bfhi(b.x); v[j].z += bflo(a.y) + bflo(b.y); v[j].w += bfhi(a.y) + bfhi(b.y);
#endif
        s += (v[j].x * v[j].x + v[j].y * v[j].y) + (v[j].z * v[j].z + v[j].w * v[j].w); }
    const float rstd = 1.0f / sqrtf(wave_sum(s) * (1.f / D) + EPS);
#pragma unroll
    for (int j = 0; j < 8; ++j) { const f32x4 gg = ((const GAS f32x4*)g)[64 * j + lane];
        xr[64 * j] = v[j];
        ((GAS unsigned*)orow8)[64 * j + lane] = pk4_fp8(v[j].x * rstd * gg.x, v[j].y * rstd * gg.y, v[j].z * rstd * gg.z, v[j].w * rstd * gg.w); }
}

struct Args { const float* in[27]; float* out; unsigned char* ws; int ph_lo, ph_hi; };
#define AS4 __attribute__((address_space(4)))

constexpr int P0_I_IN = (D / 64) * (7264 / 32), P0_I_BG = (D / 64) * (4096 / 32), P0_I_OG = (1024 / 64) * (D / 32), P0_I_O = (D / 64) * (D / 32), P0_I_PP = (PLE / 64) * (D / 32);
constexpr int P0_NITEMS = P0_I_IN + P0_I_BG + 2 * P0_I_OG + 2 * P0_I_O + P0_I_PP, P0_DEPTH = 3;
struct P0Item { const float* src; int N, kind, K, k0, n0; unsigned char* dst; };
__device__ __forceinline__ P0Item p0_decode(int r, const AS4 Args* ap, unsigned char* ws) {
    P0Item t; const float* W; int nblk;
    if (r < P0_I_IN) { W = ap->in[3]; t.N = 7264; t.K = D; t.kind = 0; t.dst = ws + WS_WIN; }
    else if ((r -= P0_I_IN) < P0_I_BG) { W = ap->in[12]; t.N = 4096; t.K = D; t.kind = 3; t.dst = ws + WS_WBG8; }
    else if ((r -= P0_I_BG) < P0_I_OG) { W = ap->in[7]; t.N = D; t.K = 1024; t.kind = 1; t.dst = ws + WS_WOG; }
    else if ((r -= P0_I_OG) < P0_I_OG) { W = ap->in[11]; t.N = D; t.K = 1024; t.kind = 2; t.dst = ws + WS_WOD8; }
    else if ((r -= P0_I_OG) < P0_I_O) { W = ap->in[14]; t.N = D; t.K = D; t.kind = 2; t.dst = ws + WS_WO8; }
    else if ((r -= P0_I_O) < P0_I_O) { W = ap->in[24]; t.N = D; t.K = D; t.kind = 2; t.dst = ws + WS_WPG8; }
    else { r -= P0_I_O; W = ap->in[26]; t.N = D; t.K = PLE; t.kind = 1; t.dst = ws + WS_WPP; }
    nblk = t.N / 32; const int kb = r / nblk, nb = r - kb * nblk; t.k0 = 64 * kb; t.n0 = 32 * nb;
    t.src = W + (size_t)t.k0 * t.N + t.n0; return t;
}
__device__ __forceinline__ void p0_emit(const P0Item& t, LAS float* scr, int lane) {
    if (t.kind == 1 || t.kind == 0) { const int c = lane & 7; bf16* WT = (bf16*)t.dst;
#pragma unroll
        for (int j = 0; j < 4; ++j) { const int n = (lane >> 3) + 8 * j; const LAS float* sp = scr + (8 * c) * 33 + n; const int rm = t.kind == 0 ? rowmap<1>(t.n0 + n) : t.n0 + n;
            if (rm >= 0) { v4u o; o.x = pk2(sp[0 * 33], sp[1 * 33]); o.y = pk2(sp[2 * 33], sp[3 * 33]); o.z = pk2(sp[4 * 33], sp[5 * 33]); o.w = pk2(sp[6 * 33], sp[7 * 33]);
                *(GAS v4u*)(WT + (size_t)rm * t.K + t.k0 + 8 * c) = o; } } }
    if (t.kind != 1) { const int c = lane & 3; unsigned char* WT8 = t.kind == 0 ? t.dst + (WS_WIN8 - WS_WIN) : t.dst;
#pragma unroll
        for (int j = 0; j < 2; ++j) { const int n = (lane >> 2) + 16 * j; const LAS float* sp = scr + (16 * c) * 33 + n;
            const int rm = t.kind == 0 ? rowmap<4>(t.n0 + n) : t.kind == 3 ? rowmap<2>(t.n0 + n) : t.n0 + n;
            if (rm >= 0) { v4u o; o.x = pk4_fp8(32.f * sp[0 * 33], 32.f * sp[1 * 33], 32.f * sp[2 * 33], 32.f * sp[3 * 33]); o.y = pk4_fp8(32.f * sp[4 * 33], 32.f * sp[5 * 33], 32.f * sp[6 * 33], 32.f * sp[7 * 33]);
                o.z = pk4_fp8(32.f * sp[8 * 33], 32.f * sp[9 * 33], 32.f * sp[10 * 33], 32.f * sp[11 * 33]); o.w = pk4_fp8(32.f * sp[12 * 33], 32.f * sp[13 * 33], 32.f * sp[14 * 33], 32.f * sp[15 * 33]);
                *(GAS v4u*)(WT8 + (size_t)rm * t.K + t.k0 + 16 * c) = o; } } }
}
__device__ __forceinline__ void p0_weight_stream(const AS4 Args* ap, unsigned char* ws, LAS float* scr, int lane, int gw, int NGW) {
    if (gw >= P0_NITEMS) return;
    const int n_my = (P0_NITEMS - gw + NGW - 1) / NGW, it_last = gw + (n_my - 1) * NGW;
    const int lr = lane >> 3, lc = (lane & 7) * 4;
    f32x4 v[P0_DEPTH][8];
#define P0_IT(j_) min(gw + (j_) * NGW, it_last)
#define P0_LOAD(d_, it_) do { const P0Item q_ = p0_decode((it_), ap, ws); const float* s_ = q_.src + (size_t)lr * q_.N + lc; \
        _Pragma("unroll") for (int i = 0; i < 8; ++i) v[d_][i] = *(const f32x4*)(s_ + (size_t)(8 * i) * q_.N); } while (0)
#pragma unroll
    for (int d = 0; d < P0_DEPTH; ++d) { P0_LOAD(d, P0_IT(d)); asm volatile("" ::: "memory"); __builtin_amdgcn_sched_barrier(0); }
    for (int j0 = 0; j0 < n_my; j0 += P0_DEPTH) {
#pragma unroll
        for (int d = 0; d < P0_DEPTH; ++d) {
            const P0Item t = p0_decode(P0_IT(j0 + d), ap, ws);
#pragma unroll
            for (int i = 0; i < 8; ++i) { LAS float* dd = scr + (8 * i + lr) * 33 + lc; dd[0] = v[d][i].x; dd[1] = v[d][i].y; dd[2] = v[d][i].z; dd[3] = v[d][i].w; }
            P0_LOAD(d, P0_IT(j0 + d + P0_DEPTH));
            LDS_WAIT(); asm volatile("" ::: "memory");
            p0_emit(t, scr, lane);
            LDS_WAIT(); asm volatile("" ::: "memory");
        }
    }
#undef P0_LOAD
#undef P0_IT
}

#define PHASE_LOCALS \
    const AS4 Args* ap = (const AS4 Args*)__builtin_amdgcn_kernarg_segment_ptr(); asm volatile("" : "+s"(ap)); \
    unsigned char* const ws = ap->ws; int tid_o = threadIdx.x; asm volatile("" : "+v"(tid_o)); \
    Frame F; F.lds = (LAS unsigned char*)lds_raw; F.MISC = (volatile LAS unsigned*)(F.lds + MISC_OFF); F.ctl = (gu32*)(ws + WS_CTL); \
    F.tid = tid_o; F.lane = tid_o & 63; F.wave = __builtin_amdgcn_readfirstlane(tid_o >> 6); F.G = gridDim.x; \
    { const int bx = blockIdx.x; F.vcu = (F.G % 8 == 0) ? (bx % 8) * (F.G / 8) + bx / 8 : bx; } \
    const int gw = F.vcu * NWAVES + F.wave, NGW = F.G * NWAVES; const int gt = blockIdx.x * 512 + F.tid, NGT = F.G * 512; \
    bf16* const HB = (bf16*)(ws + WS_HB); bf16* const ZB = (bf16*)(ws + WS_ZB); \
    LAS unsigned char* const wl = F.lds + RING_OFF + F.wave * 16384; \
    (void)gw; (void)NGW; (void)gt; (void)NGT; (void)HB; (void)ZB; (void)wl;
#ifndef MK_DBL
#define MK_DBL 0
#endif
#define REP2 for (int rep_ = 0; rep_ < 2; ++rep_)
#if (MK_DBL >> 0) & 1
#define REP_0 REP2
#else
#define REP_0
#endif
#if (MK_DBL >> 1) & 1
#define REP_1 REP2
#else
#define REP_1
#endif
#if (MK_DBL >> 2) & 1
#define REP_2 REP2
#else
#define REP_2
#endif
#if (MK_DBL >> 3) & 1
#define REP_3 REP2
#else
#define REP_3
#endif
#if (MK_DBL >> 4) & 1
#define REP_4 REP2
#else
#define REP_4
#endif
#if (MK_DBL >> 5) & 1
#define REP_5 REP2
#else
#define REP_5
#endif
#if (MK_DBL >> 6) & 1
#define REP_6 REP2
#else
#define REP_6
#endif
#if (MK_DBL >> 7) & 1
#define REP_7 REP2
#else
#define REP_7
#endif
#if (MK_DBL >> 8) & 1
#define REP_8 REP2
#else
#define REP_8
#endif
#if (MK_DBL >> 9) & 1
#define REP_9 REP2
#else
#define REP_9
#endif
#if (MK_DBL >> 10) & 1
#define REP_10 REP2
#else
#define REP_10
#endif
#if (MK_DBL >> 11) & 1
#define REP_11 REP2
#else
#define REP_11
#endif
#if (MK_DBL >> 12) & 1
#define REP_12 REP2
#else
#define REP_12
#endif
#if (MK_DBL >> 13) & 1
#define REP_13 REP2
#else
#define REP_13
#endif
#if (MK_DBL >> 14) & 1
#define REP_14 REP2
#else
#define REP_14
#endif
#define REP(k) REP_##k
#define IN(k) (ap->in[k])
#define GRID_BAR() do { XcdBarrier bb_; bb_.bar = (unsigned*)(F.ctl + CW_BAR); bb_.x = xb_xcc_id(); bb_.st = F.MISC + 8; xcd_barrier(bb_); } while (0)

__global__ void __launch_bounds__(NWAVES * 64, 2) mk_fwd(Args args) {
    extern __shared__ __attribute__((aligned(16))) unsigned char lds_raw[];
    (void)args;
    {
        PHASE_LOCALS
        for (int u = F.tid; u < (LDS_BYTES - LDSCTL_OFF) / 4; u += NWAVES * 64) ((LAS unsigned*)(F.lds + LDSCTL_OFF))[u] = 0u;
        __syncthreads();
        (void)xcd_barrier_post((unsigned*)(F.ctl + CW_BAR), F.MISC + 8);
    }
    REP(0)
    {
        PHASE_LOCALS
        LAS float* scr = (LAS float*)wl;
        constexpr int I_IN = (D / 64) * (7264 / 32), I_BG = (D / 64) * (4096 / 32), I_OG = (1024 / 64) * (D / 32), I_O = (D / 64) * (D / 32), I_PP = (PLE / 64) * (D / 32);
        constexpr int NITEMS = I_IN + I_BG + 2 * I_OG + 2 * I_O + I_PP;
        for (int it = gw; it < I_IN; it += NGW) p0_transpose_item_win(IN(3), (bf16*)(ws + WS_WIN), ws + WS_WIN8, scr, it, F.lane);
        { GAS v4u* z = (GAS v4u*)((bf16*)(ws + WS_WIN) + (size_t)(ZC_IW + 16 - 2048) * D);
          for (int i = gt; i < 160 * D * 2 / 16; i += NGT) z[i] = (v4u){0u, 0u, 0u, 0u}; }
        { bf16* wr = (bf16*)(ws + WS_WR); const float* wg = IN(16); const float* we = IN(18);
          for (int i = gt; i < 256 * D; i += NGT) { const int n = i >> 11, k = i & 2047; const float v = n < 8 ? wg[k * 8 + n] : (n < 72 ? we[k * 64 + (n - 8)] : 0.f); wr[i] = (bf16)f2bf(v); } }
        for (int m = gw; m < T; m += NGW) rms_row_to_bf16(F.lane, IN(0) + (size_t)m * D, IN(2), HB + (size_t)m * D, (unsigned char*)ap->out + (size_t)m * D);
        GRID_BAR();
    }
    REP(1)
    {
        PHASE_LOCALS
        { pg8::StaticOrder S; S.init(T, ZN_A - 2048, F.G, (int)blockIdx.x);
          pg8::Gemm g{HB, (const bf16*)(ws + WS_WIN), D};
          pg8::EpiBf16Skip E{ZB, ZP, 4, 2048};
          pg8::gemm_phase<pg8::EpiBf16Skip, pg8::StaticOrder>(F.lds + RING_OFF, g, S, E); }
        { pg8::StaticOrder S; S.init(T, 5120, F.G, (int)blockIdx.x);
          pg8::Gemm8 g{(const unsigned char*)ap->out, ws + WS_WIN8, D / 2, 0x7f7f7f7f, 0x7a7a7a7a};
          pg8::EpiBf16Skip E{ZB + 1024, ZP, 8, ZN_A - 3072};
          pg8::gemm_phase8<pg8::EpiBf16Skip, pg8::StaticOrder>(F.lds + RING_OFF, g, S, E); }
        GRID_BAR();
    }
    REP(2)
    {
        PHASE_LOCALS
#if MK_GLA
        for (int task = blockIdx.x; task < NB * 128; task += F.G) {
            gla_prep_task(F.lds, ZB, IN(4), IN(5), (float*)(ws + WS_DEC), task);
            gla_local_unit(F.lds, F.wave, F.lane, ZB, (const float*)(ws + WS_DEC), (float*)(ws + WS_SLOC), task * 8 + F.wave);
            __syncthreads();
        }
#endif
        for (int m = gw; m < T; m += NGW) dsa_prep_row(F.lane, ZB, (size_t)m, IN(8), IN(9), (bf16*)(ws + WS_IKC), (float*)(ws + WS_UW));
        GRID_BAR();
    }
    REP(3)
    {
        PHASE_LOCALS
#if MK_GLA
        gla_scan((const float*)(ws + WS_SLOC), (const float*)(ws + WS_DEC), (bf16*)(ws + WS_STT), gt, NGT);
#endif
#if MK_DSA
        for (int task = blockIdx.x; task < NB * 64; task += F.G) {
            const int b = task >> 6, xq = task & 63;
#pragma unroll 1
            for (int half = 0; half < 2; ++half) {
                const int c = half ? 127 - xq : xq, n = 64 * (c + 1);
                unsigned char* wsl = ws; int lane_l = F.lane; asm volatile("" : "+s"(wsl), "+v"(lane_l));
                idx_scores_oct(wl, lane_l, (const bf16*)(wsl + WS_ZB), (const bf16*)(wsl + WS_IKC), (const float*)(wsl + WS_UW), (unsigned short*)(wsl + WS_SC), b, c, F.wave);
                VM_WAIT(); __syncthreads();
                asm volatile("" : "+s"(wsl), "+v"(lane_l));
#pragma unroll 1
                for (int q = 0; q < 8; ++q) { const int ql = F.wave * 8 + q;
                    idx_select_row(lane_l, (const unsigned short*)(wsl + WS_SC) + sc_off(b, c) + (size_t)ql * n, n, F.lds + RING_OFF + ql * 1024, (LAS unsigned*)(F.lds + RING_OFF + 65536 + F.wave * 8192)); }
                LDS_WAIT(); __syncthreads();
                asm volatile("" : "+s"(wsl), "+v"(lane_l));
                const int tend = (c | 3) + 1;
#pragma unroll 1
                for (int tile = F.wave; tile < tend; tile += NWAVES) bt_emit_tile(lane_l, F.lds + RING_OFF, (unsigned*)(wsl + WS_BM), b, c, tile, tile > c);
                __syncthreads();
            }
        }
#endif
        GRID_BAR();
    }
    REP(4)
    {
        PHASE_LOCALS
#if MK_GLA
        for (int u = gw; u < 4096; u += NGW) gla_out_unit(wl, F.lane, ZB, (const bf16*)(ws + WS_STT), IN(6), (bf16*)(ws + WS_OA), u);
        __syncthreads();
#endif
#if MK_MOE
        if (F.vcu % CONV_MOD == 0) {
            const int cw = (F.vcu / CONV_MOD) * NWAVES + F.wave, NCW = ((F.G + CONV_MOD - 1) / CONV_MOD) * NWAVES;
            LAS float* scr = (LAS float*)wl; const int lane_c = opaque_tid() & 63;
            conv_stream8<3>(IN(20), D, EFF, ws + WS_WGU8, 1024, 0, scr, lane_c, cw, NCW);
            conv_stream8<3>(IN(21), D, EFF, ws + WS_WGU8, 1024, 128, scr, lane_c, cw, NCW);
            conv_stream8<0>(IN(22), EFF, D, ws + WS_WDN8, D, 0, scr, lane_c, cw, NCW);
            p0_weight_stream(ap, ws, scr, lane_c, P0_I_IN + cw, NCW);
            __syncthreads();
        }
#endif
#if MK_DSA
        att::attn_phase((char*)lds_raw, ZB, ws + WS_OB, (const unsigned*)(ws + WS_BM), IN(10), IN(8), IN(9), F.ctl + CW_ATTQ);
#endif
        GRID_BAR();
    }
    REP(5)
    {
        PHASE_LOCALS
        pg8::StaticOrder S; S.init(T, D, F.G, (int)blockIdx.x);
        { pg8::Gemm g{(const bf16*)(ws + WS_OA), (const bf16*)(ws + WS_WOG), 1024}; pg8::EpiFp8 E{ws + WS_YA, D};
          pg8::gemm_phase<pg8::EpiFp8, pg8::StaticOrder>(F.lds + RING_OFF, g, S, E); }
        { pg8::Gemm8 g{ws + WS_OB, ws + WS_WOD8, 1024 / 2, 0x7b7b7b7b, 0x7a7a7a7a}; pg8::EpiFp8 E{ws + WS_YB, D};
          pg8::gemm_phase8<pg8::EpiFp8, pg8::StaticOrder>(F.lds + RING_OFF, g, S, E); }
        GRID_BAR();
    }
    REP(6)
    {
        PHASE_LOCALS
        pg8::StaticOrder S; S.init(T, 4096, F.G, (int)blockIdx.x);
        pg8::Gemm8 g{(const unsigned char*)ap->out, ws + WS_WBG8, D / 2, 0x7f7f7f7f, 0x7a7a7a7a};
        pg8::EpiGateMix E{ws + WS_YA, ws + WS_YB, ws + WS_U, IN(13)};
        pg8::gemm_phase8<pg8::EpiGateMix, pg8::StaticOrder>(F.lds + RING_OFF, g, S, E);
        GRID_BAR();
    }
    REP(7)
    {
        PHASE_LOCALS
        pg8::StaticOrder S; S.init(T, D, F.G, (int)blockIdx.x);
        pg8::Gemm8 g{ws + WS_U, ws + WS_WO8, D / 2, 0x7c7c7c7c, 0x7a7a7a7a};
        pg8::EpiResBf16P E{IN(0), (bf16*)ap->out, D};
        pg8::gemm_phase8<pg8::EpiResBf16P, pg8::StaticOrder>(F.lds + RING_OFF, g, S, E);
        GRID_BAR();
    }
    REP(8)
    {
        PHASE_LOCALS
        for (int m = gw; m < T; m += NGW) rms_row_bf(F.lane, (const bf16*)ap->out + (size_t)m * D, IN(15), (bf16*)(ws + WS_H2B) + (size_t)m * D, ws + WS_H8 + (size_t)m * D);
        { const GAS f32x4* p4 = (const GAS f32x4*)IN(1); GAS v2u* o = (GAS v2u*)(ws + WS_PBF);
          for (size_t i = (size_t)gt; i < (size_t)T * PLE / 4; i += (size_t)NGT) { const f32x4 v = p4[i]; v2u w; w.x = pk2(v.x, v.y); w.y = pk2(v.z, v.w); o[i] = w; } }
        GRID_BAR();
    }
#if MK_MOE
    REP(9)
    {
        PHASE_LOCALS
        pg8::StaticOrder S; S.init(T, 256, F.G, (int)blockIdx.x);
        pg8::Gemm g{(const bf16*)(ws + WS_H2B), (const bf16*)(ws + WS_WR), D};
        pg8::EpiF32 E{(float*)(ws + WS_LOGIT), 256};
        pg8::gemm_phase<pg8::EpiF32, pg8::StaticOrder>(F.lds + RING_OFF, g, S, E);
        VM_WAIT(); __syncthreads();
        { pg8::Unit ur;
          const int nu = (128 - (int)blockIdx.x + F.G - 1) / F.G;
#pragma unroll 1
          for (int iu = 0; iu < nu; ++iu) { S.next(iu, ur); const int t_lo = ur.pm * 256, t_hi = t_lo + 256;
        const float* LG = (const float*)(ws + WS_LOGIT); const float* bg = IN(17); const float* be = IN(19);
          unsigned* cnt = (unsigned*)(F.ctl + CW_CNT); int* tokrow = (int*)(ws + WS_TOKROW); float* tokw = (float*)(ws + WS_TOKW);
          for (int t = t_lo + F.tid; t < t_hi; t += NWAVES * 64) {
              const f32x4 a = *(const f32x4*)(LG + (size_t)t * 256), b2 = *(const f32x4*)(LG + (size_t)t * 256 + 4);
              float l[8] = {a.x + bg[0], a.y + bg[1], a.z + bg[2], a.w + bg[3], b2.x + bg[4], b2.y + bg[5], b2.z + bg[6], b2.w + bg[7]};
              int gi = 0; float gm = l[0];
#pragma unroll
              for (int i = 1; i < 8; ++i) if (l[i] > gm) { gm = l[i]; gi = i; }
              float se = 0.f;
#pragma unroll
              for (int i = 0; i < 8; ++i) se += __expf(l[i] - gm);
              const float grp_w = 1.0f / se;
              const f32x4 c0 = *(const f32x4*)(LG + (size_t)t * 256 + 8 + gi * 8), c1 = *(const f32x4*)(LG + (size_t)t * 256 + 12 + gi * 8);
              const float* bb = be + gi * 8;
              float ev[8] = {c0.x + bb[0], c0.y + bb[1], c0.z + bb[2], c0.w + bb[3], c1.x + bb[4], c1.y + bb[5], c1.z + bb[6], c1.w + bb[7]};
              int i0 = 0; float v0 = ev[0];
#pragma unroll
              for (int i = 1; i < 8; ++i) if (ev[i] > v0) { v0 = ev[i]; i0 = i; }
              int i1 = -1; float v1 = -__builtin_inff();
#pragma unroll
              for (int i = 0; i < 8; ++i) if (i != i0 && ev[i] > v1) { v1 = ev[i]; i1 = i; }
              const float w0 = 1.0f / (1.0f + __expf(v1 - v0)), w1 = 1.0f - w0;
              const int e0 = gi * 8 + i0, e1 = gi * 8 + i1;
              const unsigned p0 = atomicAdd(&cnt[e0], 1u), p1 = atomicAdd(&cnt[e1], 1u);
              tokrow[(size_t)e0 * ECAP + p0] = t * 2; tokw[(size_t)e0 * ECAP + p0] = grp_w * w0;
              tokrow[(size_t)e1 * ECAP + p1] = t * 2 + 1; tokw[(size_t)e1 * ECAP + p1] = grp_w * w1;
          }
          } }
        { pg8::PleOrder SP{F.G, (int)blockIdx.x};
          pg8::Gemm gp{(const bf16*)(ws + WS_PBF), (const bf16*)(ws + WS_WPP), PLE};
          pg8::EpiBf16 EP{(bf16*)(ws + WS_PLEB), D};
          pg8::gemm_phase<pg8::EpiBf16, pg8::PleOrder>(F.lds + RING_OFF, gp, SP, EP); }
        GRID_BAR();
    }
    REP(11)
    {
        PHASE_LOCALS
        LAS int* pref = (LAS int*)(F.lds + PREF_OFF); LAS int* cntl = (LAS int*)(F.lds + CNTL_OFF);
        if (F.tid < 64) cntl[F.tid] = (int)__hip_atomic_load((unsigned*)(F.ctl + CW_CNT) + F.tid, RLX_AGENT);
        __syncthreads();
        if (F.tid == 0) { int acc = 0; for (int e = 0; e < 64; ++e) { pref[e] = acc; acc += (cntl[e] + 255) >> 8; } pref[64] = acc; }
        __syncthreads();
        pg8::MoeOrder S{pref, cntl, (const int*)(ws + WS_TOKROW), 4, F.G, F.vcu, D / 2};
        pg8::Gemm8 g{ws + WS_H8, ws + WS_WGU8, D / 2, 0x7f7f7f7f, 0x7a7a7a7a};
        pg8::EpiMoe1 E{ws + WS_ACT};
        pg8::gemm_phase8<pg8::EpiMoe1, pg8::MoeOrder, true>(F.lds + RING_OFF, g, S, E);
        GRID_BAR();
    }
    REP(12)
    {
        PHASE_LOCALS
        LAS int* pref = (LAS int*)(F.lds + PREF_OFF); LAS int* cntl = (LAS int*)(F.lds + CNTL_OFF);
        pg8::MoeOrder S{pref, cntl, (const int*)(ws + WS_TOKROW), 8, F.G, F.vcu, EFF / 2};
        pg8::Gemm8 g{ws + WS_ACT, ws + WS_WDN8, EFF / 2, 0x7d7d7d7d, 0x7a7a7a7a};
        pg8::EpiMoe2 E{(bf16*)(ws + WS_Y0), (long long)(HB - (bf16*)(ws + WS_Y0)), (const int*)(ws + WS_TOKROW), (const float*)(ws + WS_TOKW), cntl};
        pg8::gemm_phase8<pg8::EpiMoe2, pg8::MoeOrder, false>(F.lds + RING_OFF, g, S, E);
        GRID_BAR();
    }
#endif
    REP(13)
    {
        PHASE_LOCALS
        for (int m = gw; m < T; m += NGW) combine_row_bf(F.lane, (const bf16*)ap->out + (size_t)m * D, (const bf16*)(ws + WS_Y0) + (size_t)m * D, HB + (size_t)m * D, IN(23), (bf16*)(ws + WS_X2B) + (size_t)m * D, ws + WS_H8 + (size_t)m * D);
        GRID_BAR();
    }
    REP(14)
    {
        PHASE_LOCALS
        pg8::StaticOrder S; S.init(T, D, F.G, (int)blockIdx.x);
        { pg8::Gemm8 g{ws + WS_H8, ws + WS_WPG8, D / 2, 0x7f7f7f7f, 0x7a7a7a7a};
          pg8::EpiPleFinal E{(const bf16*)(ws + WS_X2B), (const bf16*)(ws + WS_PLEB), ap->out, IN(25)};
          pg8::gemm_phase8<pg8::EpiPleFinal, pg8::StaticOrder>(F.lds + RING_OFF, g, S, E); }
    }
}

extern "C" void kernel_launch(void* const* d_in, const int* in_sizes, int n_in, void* d_out, int out_size, void* d_ws, size_t ws_size, hipStream_t stream) {
    static int grid = 0;
    if (grid == 0) {
        if (n_in != 27 || out_size != T * D || ws_size < WS_END) { fprintf(stderr, "kernel_launch: unexpected shapes (n_in %d out %d ws %zu, need %zu)\n", n_in, out_size, ws_size, (size_t)WS_END); grid = -1; return; }
        int dev = 0, cus = 0, per_cu = 0;
        if (hipGetDevice(&dev) != hipSuccess || hipDeviceGetAttribute(&cus, hipDeviceAttributeMultiprocessorCount, dev) != hipSuccess) { grid = -1; return; }
        if (hipFuncSetAttribute((const void*)mk_fwd, hipFuncAttributeMaxDynamicSharedMemorySize, LDS_BYTES) != hipSuccess) { fprintf(stderr, "kernel_launch: hipFuncSetAttribute failed\n"); grid = -1; return; }
        if (hipOccupancyMaxActiveBlocksPerMultiprocessor(&per_cu, (const void*)mk_fwd, NWAVES * 64, LDS_BYTES) != hipSuccess || per_cu < 1) { fprintf(stderr, "kernel_launch: occupancy query says %d\n", per_cu); }
        (void)hipGetLastError();
        grid = cus;
    }
    if (grid < 0) return;
    if (hipMemsetAsync((char*)d_ws + WS_CTL, 0, CTL_ZERO_BYTES, stream) != hipSuccess) return;
    Args a{};
    for (int i = 0; i < 27; ++i) a.in[i] = (const float*)d_in[i];
    a.out = (float*)d_out; a.ws = (unsigned char*)d_ws; a.ph_lo = 0; a.ph_hi = 99;
    hipLaunchKernelGGL(mk_fwd, dim3(grid), dim3(NWAVES * 64), LDS_BYTES, stream, a);
}
```

```cpp
#include <hip/hip_runtime.h>
#include <cstdio>
#include <cstdint>

#ifndef MK_STAGE
#define MK_STAGE 1
#endif

#define GAS __attribute__((address_space(1)))
#define LAS __attribute__((address_space(3)))
typedef unsigned short bf16;
typedef unsigned v4u __attribute__((ext_vector_type(4)));
typedef unsigned v2u __attribute__((ext_vector_type(2)));
typedef float f32x4 __attribute__((ext_vector_type(4)));
typedef float f32x2 __attribute__((ext_vector_type(2)));
typedef float f32x16 __attribute__((ext_vector_type(16)));
typedef short bf16x8 __attribute__((ext_vector_type(8)));
typedef short s16x4 __attribute__((ext_vector_type(4)));
typedef GAS unsigned gu32;
#define RLX_AGENT __ATOMIC_RELAXED, __HIP_MEMORY_SCOPE_AGENT
#define LDS_WAIT() asm volatile("s_waitcnt lgkmcnt(0)" ::: "memory")
#define VM_WAIT() asm volatile("s_waitcnt vmcnt(0)" ::: "memory")

constexpr int NB = 4, SEQ = 8192, T = NB * SEQ, D = 2048, PLE = 256;
constexpr int ZP = 7424;
constexpr int ZC_GQ = 0, ZC_GK = 512, ZC_GV = 1024, ZC_GR = 2048, ZC_GLR = 3072, ZC_IK = 3088, ZC_IW = 3152, ZC_IQ = 3328, ZN_A = 4352  , ZC_DQ = 4352, ZC_DK = 5376, ZC_DV = 6400;
constexpr int NEXP = 64, EFF = 512, ECAP = 32768;
constexpr int ACT_ROWS = 81920;
constexpr float EPS = 1e-6f;
constexpr int NWAVES = 8;

constexpr size_t MiB = 1u << 20;
constexpr size_t al(size_t x) { return (x + 255) & ~(size_t)255; }
constexpr size_t WS_CTL = 0, CTL_ZERO_BYTES = 1 * MiB;
constexpr size_t WS_WIN = WS_CTL + CTL_ZERO_BYTES;
constexpr size_t WS_WBG = WS_WIN + al((size_t)ZP * D * 2);
constexpr size_t WS_WOG = WS_WBG + al((size_t)4096 * D * 2);
constexpr size_t WS_WOD = WS_WOG + al((size_t)D * 1024 * 2);
constexpr size_t WS_WO = WS_WOD + al((size_t)D * 1024 * 2);
constexpr size_t WS_WPG = WS_WO + al((size_t)D * D * 2);
constexpr size_t WS_WPP = WS_WPG + al((size_t)D * D * 2);
constexpr size_t WS_WR = WS_WPP + al((size_t)D * PLE * 2);
constexpr size_t WS_HB = WS_WR + al((size_t)256 * D * 2);
constexpr size_t WS_ZB = WS_HB + al((size_t)T * D * 2);
constexpr size_t ZB_BYTES = (size_t)T * ZP * 2;
constexpr size_t WS_SC = WS_ZB + al(ZB_BYTES);
constexpr size_t SC_PER_BATCH = (size_t)64 * 64 * (128 * 129 / 2);
constexpr size_t SC_BYTES = (size_t)NB * SC_PER_BATCH * 2;
constexpr size_t WS_BM = WS_SC + al(SC_BYTES);
constexpr size_t WS_SLOC = WS_BM + al((size_t)T * 1024);
constexpr size_t WS_STT = WS_SLOC + al((size_t)4096 * 8192 * 4);
constexpr size_t WS_DEC = WS_STT + al((size_t)4096 * 8192 * 2);
constexpr size_t WS_IKC = WS_DEC + al((size_t)4096 * 64 * 4);
constexpr size_t WS_UW = WS_IKC + al((size_t)T * 64 * 2);
constexpr size_t WS_WBG8 = WS_UW + al((size_t)T * 16 * 4);
constexpr size_t WS_WPG8 = WS_WBG8 + al((size_t)4096 * D);
constexpr size_t WS_WOD8 = WS_WPG8 + al((size_t)D * D);
constexpr size_t WS_WO8 = WS_WOD8 + al((size_t)D * 1024);
constexpr size_t WS_END = WS_WO8 + al((size_t)D * D);
constexpr size_t WS_WIN8 = WS_WIN + (size_t)ZN_A * D * 2;
static_assert(WS_WIN8 + (size_t)5120 * D <= WS_WBG, "w_in copies fit their region");
constexpr size_t WS_OA = WS_SC, WS_OB = WS_SC + (size_t)T * 1024 * 2;
constexpr size_t WS_YA = WS_ZB, WS_YB = WS_ZB + (size_t)T * D * 2, WS_U = WS_ZB + 2 * (size_t)T * D * 2;
constexpr size_t WS_WGU = WS_ZB;
constexpr size_t WS_WDN = WS_WGU + (size_t)NEXP * 1024 * D * 2;
constexpr size_t WS_ACT = WS_WDN + (size_t)NEXP * D * EFF * 2;
static_assert(WS_ACT + (size_t)ACT_ROWS * EFF * 2 <= WS_ZB + ZB_BYTES, "MoE overlay fits in Z");
constexpr size_t WS_LOGIT = WS_SC;
constexpr size_t WS_TOKROW = WS_LOGIT + (size_t)T * 256 * 4;
constexpr size_t WS_TOKW = WS_TOKROW + (size_t)NEXP * ECAP * 4;
constexpr size_t WS_PLEB = WS_TOKW + (size_t)NEXP * ECAP * 4;
constexpr size_t WS_PBF = WS_PLEB + (size_t)T * D * 2;
static_assert(WS_PBF + (size_t)T * PLE * 2 <= WS_SC + SC_BYTES, "late overlays fit in SC");
constexpr size_t WS_H8 = WS_STT;
constexpr size_t WS_WGU8 = WS_HB;
constexpr size_t WS_WDN8 = WS_SC + SC_BYTES - (size_t)NEXP * D * EFF;
static_assert(WS_PBF + (size_t)T * PLE * 2 <= WS_WDN8 && WS_OB + (size_t)T * 1024 * 2 <= WS_WDN8 && WS_WDN8 % 256 == 0, "expert down weights behind the SC overlays");
constexpr size_t WS_X2B = WS_ZB;
constexpr size_t WS_H2B = WS_ZB;
constexpr size_t WS_Y0 = WS_SLOC;
static_assert(WS_END <= (size_t)1253000000, "workspace map within the guaranteed minimum");
constexpr int CW_BAR = 4096;
constexpr int CW_CNT = 16384;
constexpr int CW_ATTQ = 20480;

__device__ __forceinline__ unsigned f2bf(float f) { unsigned u = __builtin_bit_cast(unsigned, f); return (u + 0x7fffu + ((u >> 16) & 1u)) >> 16; }
__device__ __forceinline__ unsigned pk2(float lo, float hi) { return f2bf(lo) | (f2bf(hi) << 16); }
__device__ __forceinline__ unsigned pk4_fp8(float a, float b, float c, float d) { int w = 0; w = __builtin_amdgcn_cvt_pk_fp8_f32(a, b, w, false); w = __builtin_amdgcn_cvt_pk_fp8_f32(c, d, w, true); return (unsigned)w; }
__device__ __forceinline__ float bf2f(unsigned short b) { return __builtin_bit_cast(float, (unsigned)b << 16); }
__device__ __forceinline__ float bflo(unsigned w) { return __builtin_bit_cast(float, w << 16); }
__device__ __forceinline__ float bfhi(unsigned w) { return __builtin_bit_cast(float, w & 0xffff0000u); }
__device__ __forceinline__ unsigned cvt_pk_bf16(float lo, float hi) { unsigned r; asm volatile("v_cvt_pk_bf16_f32 %0, %1, %2" : "=v"(r) : "v"(lo), "v"(hi)); return r; }
#define DPP_I(v, ctrl) __builtin_amdgcn_update_dpp((int)(v), (int)(v), (ctrl), 0xF, 0xF, true)
#define DPP_F(v, ctrl) __builtin_bit_cast(float, __builtin_amdgcn_update_dpp(__builtin_bit_cast(int, (float)(v)), __builtin_bit_cast(int, (float)(v)), (ctrl), 0xF, 0xF, true))
constexpr int DPP_X1 = 0xB1, DPP_X2 = 0x4E, DPP_HM = 0x141, DPP_RM = 0x140;
__device__ __forceinline__ float sum8(float v) { v += DPP_F(v, DPP_X1); v += DPP_F(v, DPP_X2); v += DPP_F(v, DPP_HM); return v; }
__device__ __forceinline__ float sum16(float v) { v = sum8(v); v += DPP_F(v, DPP_RM); return v; }
__device__ __forceinline__ float sum32(float v) { v = sum16(v); auto r = __builtin_amdgcn_permlane16_swap(__float_as_uint(v), __float_as_uint(v), false, false); return __uint_as_float(r[0]) + __uint_as_float(r[1]); }
__device__ __forceinline__ float wave_sum(float v) { v = sum32(v); auto r = __builtin_amdgcn_permlane32_swap(__float_as_uint(v), __float_as_uint(v), false, false); return __uint_as_float(r[0]) + __uint_as_float(r[1]); }
__device__ __forceinline__ float wave_max(float v) {
    v = fmaxf(v, DPP_F(v, DPP_X1)); v = fmaxf(v, DPP_F(v, DPP_X2)); v = fmaxf(v, DPP_F(v, DPP_HM)); v = fmaxf(v, DPP_F(v, DPP_RM));
    { auto r = __builtin_amdgcn_permlane16_swap(__float_as_uint(v), __float_as_uint(v), false, false); v = fmaxf(__uint_as_float(r[0]), __uint_as_float(r[1])); }
    { auto r = __builtin_amdgcn_permlane32_swap(__float_as_uint(v), __float_as_uint(v), false, false); v = fmaxf(__uint_as_float(r[0]), __uint_as_float(r[1])); }
    return v;
}
__device__ __forceinline__ int wave_sum_i(int v) {
    v += DPP_I(v, DPP_X1); v += DPP_I(v, DPP_X2); v += DPP_I(v, DPP_HM); v += DPP_I(v, DPP_RM);
    { auto r = __builtin_amdgcn_permlane16_swap((unsigned)v, (unsigned)v, false, false); v = (int)(r[0] + r[1]); }
    { auto r = __builtin_amdgcn_permlane32_swap((unsigned)v, (unsigned)v, false, false); v = (int)(r[0] + r[1]); }
    return v;
}
__device__ __forceinline__ int opaque_tid() { int t = threadIdx.x; asm volatile("" : "+v"(t)); return t; }
__device__ __forceinline__ float sigmoidf_(float x) { return __builtin_amdgcn_rcpf(1.0f + __builtin_amdgcn_exp2f(-1.4426950408889634f * x)); }

#define XB_TMO      128
#define XB_XCNT(j)  (256  + 64 * (j))
#define XB_XSUB(j)  (1280 + 64 * (j))
#define XB_XGEN(j)  (2304 + 64 * (j))
#define XB_TOP      3328
#define XB_TOPGEN   3392
#define XCD_BAR_WORDS 3456
#define XB_SPIN_CAP (1u << 18)
__device__ __forceinline__ unsigned xb_ld(unsigned* p)              { return __hip_atomic_load(p, __ATOMIC_RELAXED, __HIP_MEMORY_SCOPE_AGENT); }
__device__ __forceinline__ unsigned xb_add(unsigned* p, unsigned v) { return __hip_atomic_fetch_add(p, v, __ATOMIC_RELAXED, __HIP_MEMORY_SCOPE_AGENT); }
__device__ __forceinline__ unsigned xb_xcc_id() { return (unsigned)__builtin_amdgcn_s_getreg((3 << 11) | 20) & 0xFu; }
#define XB_SPIN(cond, bar) do { unsigned _sp = 0; while (cond) { __builtin_amdgcn_s_sleep(1); \
    if ((++_sp & 255u) == 0u) { if (xb_ld(&(bar)[XB_TMO])) break; if (_sp > XB_SPIN_CAP) { atomicAdd(&(bar)[XB_TMO], 1u); break; } } } } while (0)
struct XcdBarrier { unsigned* bar; unsigned x; volatile LAS unsigned* st; };
__device__ __forceinline__ XcdBarrier xcd_barrier_post(unsigned* bar, volatile LAS unsigned* st) {
    XcdBarrier b; b.bar = bar; b.x = xb_xcc_id(); b.st = st;
    if (threadIdx.x == 0) (void)xb_add(&bar[XB_XCNT(b.x)], 1u);
    return b;
}
__device__ __forceinline__ void xcd_barrier_complete(unsigned* bar, unsigned x, unsigned& nloc, unsigned& nx) {
    const unsigned G = gridDim.x * gridDim.y * gridDim.z;
    unsigned sum, cnt, mine, sp = 0u;
    for (;;) {
        sum = 0u; cnt = 0u; mine = 0u;
#pragma unroll
        for (unsigned j = 0; j < 16; ++j) { const unsigned c = xb_ld(&bar[XB_XCNT(j)]); sum += c; cnt += (c > 0u) ? 1u : 0u; mine = (j == x) ? c : mine; }
        if (sum == G) break;
        __builtin_amdgcn_s_sleep(1);
        if ((++sp & 255u) == 0u) { if (xb_ld(&bar[XB_TMO])) break; if (sp > XB_SPIN_CAP) { atomicAdd(&bar[XB_TMO], 1u); break; } }
    }
    nloc = mine > 0u ? mine : 1u; nx = cnt > 0u ? cnt : 1u;
}
__device__ __forceinline__ void xcd_barrier(const XcdBarrier& b) {
    asm volatile("s_waitcnt vmcnt(0)" ::: "memory");
    __syncthreads();
    if (threadIdx.x == 0) {
        unsigned* bar = b.bar;
        __builtin_amdgcn_s_waitcnt(0);
        unsigned nloc = b.st[0], nx = b.st[1];
        if (nloc == 0u) { xcd_barrier_complete(bar, b.x, nloc, nx); b.st[0] = nloc; b.st[1] = nx; }
        const unsigned old = xb_add(&bar[XB_XSUB(b.x)], 1u);
        const unsigned gen = old / nloc;
        if (old + 1u == (gen + 1u) * nloc) {
            __builtin_amdgcn_fence(__ATOMIC_RELEASE, "agent");
            asm volatile("s_waitcnt vmcnt(0)" ::: "memory");
            const unsigned og = xb_add(&bar[XB_TOP], 1u);
            const unsigned tg = og / nx;
            if (og + 1u == (tg + 1u) * nx) xb_add(&bar[XB_TOPGEN], 1u);
            else XB_SPIN(xb_ld(&bar[XB_TOPGEN]) == tg, bar);
            __builtin_amdgcn_fence(__ATOMIC_ACQUIRE, "agent");
            xb_add(&bar[XB_XGEN(b.x)], 1u);
            asm volatile("s_waitcnt vmcnt(0)" ::: "memory");
        } else {
            XB_SPIN(xb_ld(&bar[XB_XGEN(b.x)]) == gen, bar);
            __builtin_amdgcn_fence(__ATOMIC_ACQUIRE, "agent");
            asm volatile("s_waitcnt vmcnt(0)" ::: "memory");
        }
    }
    __syncthreads();
}

namespace pg8 {
constexpr int BM = 256, BK = 64, HALF = 128, HTB = HALF * BK * 2, STAGE_BYTES = 8 * HTB, NXCD = 8, WGM = 8;
__host__ __device__ __forceinline__ int lds_byte(int r, int c) { const int st = (r >> 4) * 2 + (c >> 5), rr = r & 15, cc = c & 31, ob = rr * 64 + cc * 2; return st * 1024 + (ob ^ (((ob >> 9) & 1) << 5)); }
__host__ __device__ __forceinline__ void stage_rc(int b, int& R, int& C) { const int st = b / 1024, sb = b % 1024, swz = sb ^ (((sb >> 9) & 1) << 5); R = (st >> 1) * 16 + swz / 64; C = (st & 1) * 32 + (swz % 64) / 2; }
__host__ __device__ __forceinline__ int perm32(int rho) { const int n = rho >> 4, i = rho & 15; return 8 * (i >> 2) + 4 * n + (i & 3); }

struct Unit { int pm, pn; int e, mt; };
struct Gemm { const bf16* A; const bf16* Bt; int K; };

typedef int v8i __attribute__((ext_vector_type(8)));
typedef int v4i __attribute__((ext_vector_type(4)));
struct Gemm8 { const unsigned char* A; const unsigned char* Bt; int K; int sa, sb; };
struct F2x { bf16x8 v[2]; __device__ __forceinline__ bf16x8& operator[](int i) { return v[i]; } __device__ __forceinline__ const bf16x8& operator[](int i) const { return v[i]; } };
__host__ __device__ __forceinline__ int lds_byte8(int r, int g) { const int st = (r >> 4) * 2 + (g >> 1), ob = (r & 15) * 64 + 32 * (g & 1); return st * 1024 + (ob ^ (((ob >> 9) & 1) << 5)); }
struct StaticOrder {
    int nM, nN, nwg, G, c;
    __device__ void init(int M, int N, int G_, int c_) { nM = M / BM; nN = N / BM; nwg = nM * nN; G = G_; c = c_; }
    __device__ __forceinline__ bool next(int i, Unit& u) const {
        const long L = (long)i * G + c; if (L >= nwg) return false;
        int wgid = (int)L; { const int q = nwg / NXCD, r = nwg % NXCD, xcd = wgid % NXCD, off = wgid / NXCD; wgid = (xcd < r ? xcd * (q + 1) : r * (q + 1) + (xcd - r) * q) + off; }
        const int nig = WGM * nN, gid = wgid / nig, fm = gid * WGM, gsz = (nM - fm) < WGM ? (nM - fm) : WGM;
        u.pm = fm + ((wgid % nig) % gsz); u.pn = (wgid % nig) / gsz; u.e = 0; u.mt = 0; return true;
    }
    __device__ __forceinline__ void rows(const Unit&, int, int, unsigned (&)[2][2]) const {}
};

template <class Epi, class Sched, bool GATHER = false>
__device__ __forceinline__ void gemm_phase(LAS unsigned char* lds, const Gemm g, const Sched& S, const Epi& E) {
    int tid_ = threadIdx.x; asm volatile("" : "+v"(tid_));
    const int tid = tid_, wid = __builtin_amdgcn_readfirstlane(tid >> 6), lane = tid & 63, wr = wid >> 2, wc = wid & 3, fr = lane & 15, fq = lane >> 4;
    const int K = g.K, nt = K / BK;
    unsigned voffA[2], voffB[2]; int RA[2], CA[2];
#pragma unroll
    for (int i = 0; i < 2; ++i) { int R, C; stage_rc(tid * 16 + i * 8192, R, C); const int Rb = Epi::PERM ? ((R & ~31) + perm32(R & 31)) : R;
        RA[i] = R; CA[i] = C; voffA[i] = (unsigned)(R * K + C) * 2u; voffB[i] = (unsigned)(Rb * K + C) * 2u; }
    const size_t kstep = (size_t)(BK * 2);
    const size_t hstep = (size_t)HALF * K * 2;
    const size_t tstep = 2 * hstep;
    const unsigned ldsw = (unsigned)wid * 1024u;
    const int aoff = lds_byte(wr * 64 + fr, fq * 8), boff = lds_byte(wc * 32 + fr, fq * 8);
#define PG8_SA(b, h) (((b) * 2 + (h)) * HTB)
#define PG8_SB(b, h) ((4 + (b) * 2 + (h)) * HTB)
#define PG8_STAGE(bufoff, gbase, voff) do { _Pragma("unroll") for (int _i = 0; _i < 2; ++_i) \
        __builtin_amdgcn_global_load_lds((const unsigned*)((const char*)(gbase) + (voff)[_i]), (LAS unsigned*)(lds + (bufoff) + ldsw + _i * 8192), 16, 0, 0); } while (0)
#define PG8_STAGE_A(bufoff, gbase, h, AO) do { if constexpr (GATHER) { PG8_STAGE(bufoff, gbase, AO[h]); } else { PG8_STAGE(bufoff, (gbase) + (h) * hstep, voffA); } } while (0)
#define PG8_LDA(dst, b, h) do { _Pragma("unroll") for (int m = 0; m < 4; ++m) _Pragma("unroll") for (int k = 0; k < 2; ++k) dst[m][k] = *(const LAS bf16x8*)(lds + PG8_SA(b, h) + aoff + m * 2048 + k * 1024); } while (0)
#define PG8_LDB(dst, b, h) do { _Pragma("unroll") for (int n = 0; n < 2; ++n) _Pragma("unroll") for (int k = 0; k < 2; ++k) dst[n][k] = *(const LAS bf16x8*)(lds + PG8_SB(b, h) + boff + n * 2048 + k * 1024); } while (0)
#define PG8_MMA(ai, bj, At, Bt) do { __builtin_amdgcn_s_setprio(1); _Pragma("unroll") for (int m = 0; m < 4; ++m) _Pragma("unroll") for (int n = 0; n < 2; ++n) _Pragma("unroll") for (int k = 0; k < 2; ++k) \
        acc[ai][bj][m][n] = __builtin_amdgcn_mfma_f32_16x16x32_bf16(Bt[n][k], At[m][k], acc[ai][bj][m][n], 0, 0, 0); __builtin_amdgcn_s_setprio(0); } while (0)
#define PG8_WAIT_V(n) asm volatile("s_waitcnt vmcnt(" #n ")" ::: "memory")
#define PG8_WAIT_L(n) asm volatile("s_waitcnt lgkmcnt(" #n ")" ::: "memory")
#define PG8_BAR __builtin_amdgcn_s_barrier()
#define PG8_SCHED __builtin_amdgcn_sched_barrier(0)
    Unit cur, nxt; int ui = 0;
    if (!S.next(0, cur)) return;
    f32x4 acc[2][2][4][2];
#pragma unroll
    for (int a = 0; a < 2; ++a)
#pragma unroll
        for (int b = 0; b < 2; ++b)
#pragma unroll
            for (int m = 0; m < 4; ++m)
#pragma unroll
                for (int n = 0; n < 2; ++n) acc[a][b][m][n] = (f32x4){0.f, 0.f, 0.f, 0.f};
    bf16x8 At[4][2], B0[2][2], B1[2][2];
    unsigned aoc[2][2], aon[2][2];
    const char* cA; const char* cB = (const char*)g.Bt + (size_t)cur.pn * tstep;
    if constexpr (GATHER) { cA = (const char*)g.A; S.rows(cur, RA[0], RA[1], aoc);
#pragma unroll
        for (int h = 0; h < 2; ++h)
#pragma unroll
            for (int i = 0; i < 2; ++i) aoc[h][i] += (unsigned)CA[i] * 2u; }
    else { cA = (const char*)g.A + (size_t)cur.pm * tstep;
#pragma unroll
        for (int i = 0; i < 2; ++i) { aoc[0][i] = 0u; aoc[1][i] = 0u; } }
    PG8_STAGE(PG8_SB(0, 0), cB, voffB); PG8_STAGE(PG8_SB(0, 1), cB + hstep, voffB); PG8_STAGE_A(PG8_SA(0, 0), cA, 0, aoc); PG8_STAGE_A(PG8_SA(0, 1), cA, 1, aoc);
    if (wr == 1) PG8_BAR;
    PG8_WAIT_V(2); PG8_BAR;
    PG8_STAGE(PG8_SB(1, 0), cB + kstep, voffB); PG8_STAGE_A(PG8_SA(1, 0), cA + kstep, 0, aoc); PG8_STAGE(PG8_SB(1, 1), cB + hstep + kstep, voffB);
    PG8_WAIT_V(6); PG8_BAR;
    for (;;) {
        const bool has_next = S.next(ui + 1, nxt);
        const char* nA; const char* nB = has_next ? (const char*)g.Bt + (size_t)nxt.pn * tstep : cB;
        if constexpr (GATHER) { nA = cA;
            if (has_next) { S.rows(nxt, RA[0], RA[1], aon);
#pragma unroll
                for (int h = 0; h < 2; ++h)
#pragma unroll
                    for (int i = 0; i < 2; ++i) aon[h][i] += (unsigned)CA[i] * 2u; }
            else {
#pragma unroll
                for (int h = 0; h < 2; ++h)
#pragma unroll
                    for (int i = 0; i < 2; ++i) aon[h][i] = aoc[h][i]; } }
        else { nA = has_next ? (const char*)g.A + (size_t)nxt.pm * tstep : cA;
#pragma unroll
            for (int h = 0; h < 2; ++h)
#pragma unroll
                for (int i = 0; i < 2; ++i) aon[h][i] = aoc[h][i]; }
#pragma nounroll
        for (int t = 0; t < nt; t += 2) {
            const bool last = (t == nt - 2);
            const char* a1 = cA + (size_t)(t + 1) * kstep;
            const char* a2 = last ? nA : cA + (size_t)(t + 2) * kstep; const char* b2 = last ? nB : cB + (size_t)(t + 2) * kstep;
            const char* a3 = a2 + kstep; const char* b3 = b2 + kstep;
            unsigned ao2[2][2];
#pragma unroll
            for (int h = 0; h < 2; ++h)
#pragma unroll
                for (int i = 0; i < 2; ++i) ao2[h][i] = (GATHER && last) ? aon[h][i] : aoc[h][i];
            PG8_LDB(B0, 0, 0); PG8_LDB(B1, 0, 1); PG8_SCHED; PG8_LDA(At, 0, 0); PG8_STAGE_A(PG8_SA(1, 1), a1, 1, aoc);
            PG8_WAIT_V(8); PG8_WAIT_L(0); PG8_BAR; PG8_MMA(0, 0, At, B0); PG8_MMA(0, 1, At, B1); PG8_BAR; PG8_SCHED;
            PG8_LDA(At, 0, 1); PG8_STAGE(PG8_SB(0, 0), b2, voffB); PG8_STAGE(PG8_SB(0, 1), b2 + hstep, voffB); PG8_STAGE_A(PG8_SA(0, 0), a2, 0, ao2);
            PG8_WAIT_V(8); PG8_WAIT_L(0); PG8_BAR; PG8_MMA(1, 0, At, B0); PG8_MMA(1, 1, At, B1); PG8_BAR; PG8_SCHED;
            PG8_LDB(B0, 1, 0); PG8_LDB(B1, 1, 1); PG8_SCHED; PG8_LDA(At, 1, 0); PG8_STAGE_A(PG8_SA(0, 1), a2, 1, ao2);
            PG8_WAIT_V(8); PG8_WAIT_L(0); PG8_BAR; PG8_MMA(0, 0, At, B0); PG8_MMA(0, 1, At, B1); PG8_BAR; PG8_SCHED;
            PG8_LDA(At, 1, 1); PG8_STAGE(PG8_SB(1, 0), b3, voffB); PG8_STAGE(PG8_SB(1, 1), b3 + hstep, voffB); PG8_STAGE_A(PG8_SA(1, 0), a3, 0, ao2);
            PG8_WAIT_V(8); PG8_WAIT_L(0); PG8_BAR; PG8_MMA(1, 0, At, B0); PG8_MMA(1, 1, At, B1); PG8_BAR; PG8_SCHED;
        }
        if (wr == 0) PG8_BAR;
        asm volatile("s_nop 15\n\ts_nop 7" ::: "memory");
        E(acc, cur, wr, wc, fr, fq);
        if (!has_next) break;
#pragma unroll
        for (int a = 0; a < 2; ++a)
#pragma unroll
            for (int b = 0; b < 2; ++b)
#pragma unroll
                for (int m = 0; m < 4; ++m)
#pragma unroll
                    for (int n = 0; n < 2; ++n) acc[a][b][m][n] = (f32x4){0.f, 0.f, 0.f, 0.f};
        cur = nxt; cA = nA; cB = nB; ++ui;
#pragma unroll
        for (int h = 0; h < 2; ++h)
#pragma unroll
            for (int i = 0; i < 2; ++i) aoc[h][i] = aon[h][i];
        if (wr == 1) PG8_BAR;
    }
    PG8_WAIT_V(0);
    PG8_BAR;
#undef PG8_SA
#undef PG8_SB
#undef PG8_STAGE
#undef PG8_STAGE_A
#undef PG8_LDA
#undef PG8_LDB
#undef PG8_MMA
#undef PG8_WAIT_V
#undef PG8_WAIT_L
#undef PG8_BAR
#undef PG8_SCHED
}

template <class Epi, class Sched, bool GATHER = false>
__device__ __forceinline__ void gemm_phase8(LAS unsigned char* lds, const Gemm8 g, const Sched& S, const Epi& E) {
    int tid_ = threadIdx.x; asm volatile("" : "+v"(tid_));
    const int tid = tid_, wid = __builtin_amdgcn_readfirstlane(tid >> 6), lane = tid & 63, wr = wid >> 2, wc = wid & 3, fr = lane & 15, fq = lane >> 4;
    const int K = g.K, nt = K / BK;
    unsigned voffA[2], voffB[2]; int RA[2], CA[2];
#pragma unroll
    for (int i = 0; i < 2; ++i) { int R, C; stage_rc(tid * 16 + i * 8192, R, C); const int Rb = Epi::PERM ? ((R & ~31) + perm32(R & 31)) : R;
        RA[i] = R; CA[i] = C; voffA[i] = (unsigned)(R * K + C) * 2u; voffB[i] = (unsigned)(Rb * K + C) * 2u; }
    const size_t kstep = (size_t)(BK * 2);
    const size_t hstep = (size_t)HALF * K * 2;
    const size_t tstep = 2 * hstep;
    const unsigned ldsw = (unsigned)wid * 1024u;
    const int aoff = lds_byte8(wr * 64 + fr, fq), boff = lds_byte8(wc * 32 + fr, fq);
#define PG8_SA(b, h) (((b) * 2 + (h)) * HTB)
#define PG8_SB(b, h) ((4 + (b) * 2 + (h)) * HTB)
#define PG8_STAGE(bufoff, gbase, voff) do { _Pragma("unroll") for (int _i = 0; _i < 2; ++_i) \
        __builtin_amdgcn_global_load_lds((const unsigned*)((const char*)(gbase) + (voff)[_i]), (LAS unsigned*)(lds + (bufoff) + ldsw + _i * 8192), 16, 0, 0); } while (0)
#define PG8_STAGE_A(bufoff, gbase, h, AO) do { if constexpr (GATHER) { PG8_STAGE(bufoff, gbase, AO[h]); } else { PG8_STAGE(bufoff, (gbase) + (h) * hstep, voffA); } } while (0)
#define PG8_LD32(p) __builtin_shufflevector(*(const LAS v4i*)(p), *(const LAS v4i*)((p) + 16), 0, 1, 2, 3, 4, 5, 6, 7)
#define PG8_LDA(dst, b, h) do { _Pragma("unroll") for (int m = 0; m < 4; ++m) dst[m] = PG8_LD32(lds + PG8_SA(b, h) + aoff + m * 2048); } while (0)
#define PG8_LDB(dst, b, h) do { _Pragma("unroll") for (int n = 0; n < 2; ++n) dst[n] = PG8_LD32(lds + PG8_SB(b, h) + boff + n * 2048); } while (0)
#define PG8_MMA(ai, bj, At, Bt) do { __builtin_amdgcn_s_setprio(1); _Pragma("unroll") for (int m = 0; m < 4; ++m) _Pragma("unroll") for (int n = 0; n < 2; ++n) \
        asm volatile("v_mfma_scale_f32_16x16x128_f8f6f4 %0, %1, %2, %0, %3, %4 op_sel_hi:[0,0,0]" : "+v"(acc[ai][bj][m][n]) : "v"(Bt[n]), "v"(At[m]), "v"(vsb), "v"(vsa)); __builtin_amdgcn_s_setprio(0); } while (0)
#define PG8_WAIT_V(n) asm volatile("s_waitcnt vmcnt(" #n ")" ::: "memory")
#define PG8_WAIT_L(n) asm volatile("s_waitcnt lgkmcnt(" #n ")" ::: "memory")
#define PG8_BAR __builtin_amdgcn_s_barrier()
#define PG8_SCHED __builtin_amdgcn_sched_barrier(0)
    Unit cur, nxt; int ui = 0;
    if (!S.next(0, cur)) return;
    f32x4 acc[2][2][4][2];
#pragma unroll
    for (int a = 0; a < 2; ++a)
#pragma unroll
        for (int b = 0; b < 2; ++b)
#pragma unroll
            for (int m = 0; m < 4; ++m)
#pragma unroll
                for (int n = 0; n < 2; ++n) acc[a][b][m][n] = (f32x4){0.f, 0.f, 0.f, 0.f};
    v8i At[4], B0[2], B1[2]; const int vsa = g.sa, vsb = g.sb;
    unsigned aoc[2][2], aon[2][2];
    const char* cA; const char* cB = (const char*)g.Bt + (size_t)cur.pn * tstep;
    if constexpr (GATHER) { cA = (const char*)g.A; S.rows(cur, RA[0], RA[1], aoc);
#pragma unroll
        for (int h = 0; h < 2; ++h)
#pragma unroll
            for (int i = 0; i < 2; ++i) aoc[h][i] += (unsigned)CA[i] * 2u; }
    else { cA = (const char*)g.A + (size_t)cur.pm * tstep;
#pragma unroll
        for (int i = 0; i < 2; ++i) { aoc[0][i] = 0u; aoc[1][i] = 0u; } }
    PG8_STAGE(PG8_SB(0, 0), cB, voffB); PG8_STAGE(PG8_SB(0, 1), cB + hstep, voffB); PG8_STAGE_A(PG8_SA(0, 0), cA, 0, aoc); PG8_STAGE_A(PG8_SA(0, 1), cA, 1, aoc);
    if (wr == 1) PG8_BAR;
    PG8_WAIT_V(2); PG8_BAR;
    PG8_STAGE(PG8_SB(1, 0), cB + kstep, voffB); PG8_STAGE_A(PG8_SA(1, 0), cA + kstep, 0, aoc); PG8_STAGE(PG8_SB(1, 1), cB + hstep + kstep, voffB);
    PG8_WAIT_V(6); PG8_BAR;
    for (;;) {
        const bool has_next = S.next(ui + 1, nxt);
        const char* nA; const char* nB = has_next ? (const char*)g.Bt + (size_t)nxt.pn * tstep : cB;
        if constexpr (GATHER) { nA = cA;
            if (has_next) { S.rows(nxt, RA[0], RA[1], aon);
#pragma unroll
                for (int h = 0; h < 2; ++h)
#pragma unroll
                    for (int i = 0; i < 2; ++i) aon[h][i] += (unsigned)CA[i] * 2u; }
            else {
#pragma unroll
                for (int h = 0; h < 2; ++h)
#pragma unroll
                    for (int i = 0; i < 2; ++i) aon[h][i] = aoc[h][i]; } }
        else { nA = has_next ? (const char*)g.A + (size_t)nxt.pm * tstep : cA;
#pragma unroll
            for (int h = 0; h < 2; ++h)
#pragma unroll
                for (int i = 0; i < 2; ++i) aon[h][i] = aoc[h][i]; }
#pragma nounroll
        for (int t = 0; t < nt; t += 2) {
            const bool last = (t == nt - 2);
            const char* a1 = cA + (size_t)(t + 1) * kstep;
            const char* a2 = last ? nA : cA + (size_t)(t + 2) * kstep; const char* b2 = last ? nB : cB + (size_t)(t + 2) * kstep;
            const char* a3 = a2 + kstep; const char* b3 = b2 + kstep;
            unsigned ao2[2][2];
#pragma unroll
            for (int h = 0; h < 2; ++h)
#pragma unroll
                for (int i = 0; i < 2; ++i) ao2[h][i] = (GATHER && last) ? aon[h][i] : aoc[h][i];
            PG8_LDB(B0, 0, 0); PG8_LDB(B1, 0, 1); PG8_SCHED; PG8_LDA(At, 0, 0); PG8_STAGE_A(PG8_SA(1, 1), a1, 1, aoc);
            PG8_WAIT_V(8); PG8_WAIT_L(0); PG8_BAR; PG8_MMA(0, 0, At, B0); PG8_MMA(0, 1, At, B1); PG8_BAR; PG8_SCHED;
            PG8_LDA(At, 0, 1); PG8_STAGE(PG8_SB(0, 0), b2, voffB); PG8_STAGE(PG8_SB(0, 1), b2 + hstep, voffB); PG8_STAGE_A(PG8_SA(0, 0), a2, 0, ao2);
            PG8_WAIT_V(8); PG8_WAIT_L(0); PG8_BAR; PG8_MMA(1, 0, At, B0); PG8_MMA(1, 1, At, B1); PG8_BAR; PG8_SCHED;
            PG8_LDB(B0, 1, 0); PG8_LDB(B1, 1, 1); PG8_SCHED; PG8_LDA(At, 1, 0); PG8_STAGE_A(PG8_SA(0, 1), a2, 1, ao2);
            PG8_WAIT_V(8); PG8_WAIT_L(0); PG8_BAR; PG8_MMA(0, 0, At, B0); PG8_MMA(0, 1, At, B1); PG8_BAR; PG8_SCHED;
            PG8_LDA(At, 1, 1); PG8_STAGE(PG8_SB(1, 0), b3, voffB); PG8_STAGE(PG8_SB(1, 1), b3 + hstep, voffB); PG8_STAGE_A(PG8_SA(1, 0), a3, 0, ao2);
            PG8_WAIT_V(8); PG8_WAIT_L(0); PG8_BAR; PG8_MMA(1, 0, At, B0); PG8_MMA(1, 1, At, B1); PG8_BAR; PG8_SCHED;
        }
        if (wr == 0) PG8_BAR;
        asm volatile("s_nop 15\n\ts_nop 15\n\ts_nop 15" ::: "memory");
        { const int t2 = opaque_tid(), w2 = __builtin_amdgcn_readfirstlane(t2 >> 6), l2 = t2 & 63;
          E(acc, cur, w2 >> 2, w2 & 3, l2 & 15, l2 >> 4); }
        if (!has_next) break;
#pragma unroll
        for (int a = 0; a < 2; ++a)
#pragma unroll
            for (int b = 0; b < 2; ++b)
#pragma unroll
                for (int m = 0; m < 4; ++m)
#pragma unroll
                    for (int n = 0; n < 2; ++n) acc[a][b][m][n] = (f32x4){0.f, 0.f, 0.f, 0.f};
        cur = nxt; cA = nA; cB = nB; ++ui;
#pragma unroll
        for (int h = 0; h < 2; ++h)
#pragma unroll
            for (int i = 0; i < 2; ++i) aoc[h][i] = aon[h][i];
        if (wr == 1) PG8_BAR;
    }
    PG8_WAIT_V(0);
    PG8_BAR;
#undef PG8_SA
#undef PG8_SB
#undef PG8_STAGE
#undef PG8_STAGE_A
#undef PG8_LDA
#undef PG8_LD32
#undef PG8_LDB
#undef PG8_MMA
#undef PG8_WAIT_V
#undef PG8_WAIT_L
#undef PG8_BAR
#undef PG8_SCHED
}

struct EpiBf16Skip {
    static constexpr bool PERM = true;
    bf16* O; int ldc, pn_skip, skip;
    __device__ __forceinline__ void operator()(const f32x4 (&acc)[2][2][4][2], const Unit& u, int wr, int wc, int fr, int fq) const {
        const int row0 = u.pm * BM + wr * 64 + fr, col0 = u.pn * BM + wc * 32 + 8 * fq + (u.pn >= pn_skip ? skip : 0);
#pragma unroll
        for (int ai = 0; ai < 2; ++ai)
#pragma unroll
            for (int m = 0; m < 4; ++m) { bf16* rowp = O + (size_t)(row0 + ai * HALF + m * 16) * ldc + col0;
#pragma unroll
                for (int bj = 0; bj < 2; ++bj) { const f32x4 v0 = acc[ai][bj][m][0], v1 = acc[ai][bj][m][1];
                    v4u w; w.x = cvt_pk_bf16(v0[0], v0[1]); w.y = cvt_pk_bf16(v0[2], v0[3]); w.z = cvt_pk_bf16(v1[0], v1[1]); w.w = cvt_pk_bf16(v1[2], v1[3]);
                    *(v4u*)(rowp + bj * HALF) = w; } }
    }
};
struct EpiFp8 {
    static constexpr bool PERM = true;
    unsigned char* O; int ldc;
    __device__ __forceinline__ void operator()(const f32x4 (&acc)[2][2][4][2], const Unit& u, int wr, int wc, int fr, int fq) const {
        const int row0 = u.pm * BM + wr * 64 + fr, col0 = u.pn * BM + wc * 32 + 8 * fq;
#pragma unroll
        for (int ai = 0; ai < 2; ++ai)
#pragma unroll
            for (int m = 0; m < 4; ++m) { unsigned char* rowp = O + (size_t)(row0 + ai * HALF + m * 16) * ldc + col0;
#pragma unroll
                for (int bj = 0; bj < 2; ++bj) { const f32x4 v0 = acc[ai][bj][m][0] * 8.0f, v1 = acc[ai][bj][m][1] * 8.0f;
                    v2u w; w.x = pk4_fp8(v0[0], v0[1], v0[2], v0[3]); w.y = pk4_fp8(v1[0], v1[1], v1[2], v1[3]);
                    *(v2u*)(rowp + bj * HALF) = w; } }
    }
};
struct EpiBf16 {
    static constexpr bool PERM = true;
    bf16* O; int ldc;
    __device__ __forceinline__ void operator()(const f32x4 (&acc)[2][2][4][2], const Unit& u, int wr, int wc, int fr, int fq) const {
        const int row0 = u.pm * BM + wr * 64 + fr, col0 = u.pn * BM + wc * 32 + 8 * fq;
#pragma unroll
        for (int ai = 0; ai < 2; ++ai)
#pragma unroll
            for (int m = 0; m < 4; ++m) { bf16* rowp = O + (size_t)(row0 + ai * HALF + m * 16) * ldc + col0;
#pragma unroll
                for (int bj = 0; bj < 2; ++bj) { const f32x4 v0 = acc[ai][bj][m][0], v1 = acc[ai][bj][m][1];
                    v4u w; w.x = cvt_pk_bf16(v0[0], v0[1]); w.y = cvt_pk_bf16(v0[2], v0[3]); w.z = cvt_pk_bf16(v1[0], v1[1]); w.w = cvt_pk_bf16(v1[2], v1[3]);
                    *(v4u*)(rowp + bj * HALF) = w; } }
    }
};
struct EpiF32 {
    static constexpr bool PERM = false;
    float* C; int ldc;
    __device__ __forceinline__ void operator()(const f32x4 (&acc)[2][2][4][2], const Unit& u, int wr, int wc, int fr, int fq) const {
        const int row0 = u.pm * BM + wr * 64 + fr, col0 = u.pn * BM + wc * 32 + 4 * fq;
#pragma unroll
        for (int ai = 0; ai < 2; ++ai)
#pragma unroll
            for (int m = 0; m < 4; ++m) { float* rowp = C + (size_t)(row0 + ai * HALF + m * 16) * ldc + col0;
#pragma unroll
                for (int bj = 0; bj < 2; ++bj)
#pragma unroll
                    for (int n = 0; n < 2; ++n) *(f32x4*)(rowp + bj * HALF + n * 16) = acc[ai][bj][m][n]; }
    }
};
struct EpiResF32 {
    static constexpr bool PERM = false;
    const float* base; float* out; int ldc;
    __device__ __forceinline__ void operator()(const f32x4 (&acc)[2][2][4][2], const Unit& u, int wr, int wc, int fr, int fq) const {
        const int row0 = u.pm * BM + wr * 64 + fr, col0 = u.pn * BM + wc * 32 + 4 * fq;
#pragma unroll
        for (int ai = 0; ai < 2; ++ai)
#pragma unroll
            for (int m = 0; m < 4; ++m) { const size_t off = (size_t)(row0 + ai * HALF + m * 16) * ldc + col0;
#pragma unroll
                for (int bj = 0; bj < 2; ++bj)
#pragma unroll
                    for (int n = 0; n < 2; ++n) { const f32x4 b = *(const f32x4*)(base + off + bj * HALF + n * 16); *(f32x4*)(out + off + bj * HALF + n * 16) = b + acc[ai][bj][m][n]; } }
    }
};
struct EpiResBf16P {
    static constexpr bool PERM = true;
    const float* base; bf16* out; int ldc;
    __device__ __forceinline__ void operator()(const f32x4 (&acc)[2][2][4][2], const Unit& u, int wr, int wc, int fr, int fq) const {
        const int row0 = u.pm * BM + wr * 64 + fr, col0 = u.pn * BM + wc * 32 + 8 * fq;
#pragma unroll
        for (int ai = 0; ai < 2; ++ai)
#pragma unroll
            for (int m = 0; m < 4; ++m) { const size_t off = (size_t)(row0 + ai * HALF + m * 16) * ldc + col0;
#pragma unroll
                for (int bj = 0; bj < 2; ++bj) { const f32x4 v0 = *(const f32x4*)(base + off + bj * HALF) + acc[ai][bj][m][0], v1 = *(const f32x4*)(base + off + bj * HALF + 4) + acc[ai][bj][m][1];
                    v4u w; w.x = cvt_pk_bf16(v0[0], v0[1]); w.y = cvt_pk_bf16(v0[2], v0[3]); w.z = cvt_pk_bf16(v1[0], v1[1]); w.w = cvt_pk_bf16(v1[2], v1[3]);
                    *(v4u*)(out + off + bj * HALF) = w; } }
    }
};
struct EpiResF32P {
    static constexpr bool PERM = true;
    const float* base; float* out; int ldc;
    __device__ __forceinline__ void operator()(const f32x4 (&acc)[2][2][4][2], const Unit& u, int wr, int wc, int fr, int fq) const {
        const int row0 = u.pm * BM + wr * 64 + fr, col0 = u.pn * BM + wc * 32 + 8 * fq;
#pragma unroll
        for (int ai = 0; ai < 2; ++ai)
#pragma unroll
            for (int m = 0; m < 4; ++m) { const size_t off = (size_t)(row0 + ai * HALF + m * 16) * ldc + col0;
#pragma unroll
                for (int bj = 0; bj < 2; ++bj)
#pragma unroll
                    for (int n = 0; n < 2; ++n) { const f32x4 b = *(const f32x4*)(base + off + bj * HALF + n * 4); *(f32x4*)(out + off + bj * HALF + n * 4) = b + acc[ai][bj][m][n]; } }
    }
};
struct EpiGateMix {
    static constexpr bool PERM = true;
    const unsigned char* YA; const unsigned char* YB; unsigned char* U; const float* bias;
    __device__ __forceinline__ void operator()(const f32x4 (&acc)[2][2][4][2], const Unit& u, int wr, int wc, int fr, int fq) const {
        const int row0 = u.pm * BM + wr * 64 + fr, col0 = u.pn * HALF + wc * 32 + 8 * fq;
        const f32x4 ba0 = *(const f32x4*)(bias + col0), ba1 = *(const f32x4*)(bias + col0 + 4), bb0 = *(const f32x4*)(bias + D + col0), bb1 = *(const f32x4*)(bias + D + col0 + 4);
#pragma unroll
        for (int ai = 0; ai < 2; ++ai)
#pragma unroll
            for (int m = 0; m < 4; ++m) { const size_t off = (size_t)(row0 + ai * HALF + m * 16) * D + col0;
                const v2u ya = *(const v2u*)(YA + off), yb = *(const v2u*)(YB + off);
                const f32x4 a0 = acc[ai][0][m][0] + ba0, a1 = acc[ai][0][m][1] + ba1, b0 = acc[ai][1][m][0] + bb0, b1 = acc[ai][1][m][1] + bb1;
                float o[8];
                float va[8], vb[8];
                { const auto p0 = __builtin_amdgcn_cvt_pk_f32_fp8((int)ya.x, false), p1 = __builtin_amdgcn_cvt_pk_f32_fp8((int)ya.x, true), p2 = __builtin_amdgcn_cvt_pk_f32_fp8((int)ya.y, false), p3 = __builtin_amdgcn_cvt_pk_f32_fp8((int)ya.y, true);
                  va[0] = p0[0]; va[1] = p0[1]; va[2] = p1[0]; va[3] = p1[1]; va[4] = p2[0]; va[5] = p2[1]; va[6] = p3[0]; va[7] = p3[1]; }
                { const auto p0 = __builtin_amdgcn_cvt_pk_f32_fp8((int)yb.x, false), p1 = __builtin_amdgcn_cvt_pk_f32_fp8((int)yb.x, true), p2 = __builtin_amdgcn_cvt_pk_f32_fp8((int)yb.y, false), p3 = __builtin_amdgcn_cvt_pk_f32_fp8((int)yb.y, true);
                  vb[0] = p0[0]; vb[1] = p0[1]; vb[2] = p1[0]; vb[3] = p1[1]; vb[4] = p2[0]; vb[5] = p2[1]; vb[6] = p3[0]; vb[7] = p3[1]; }
#pragma unroll
                for (int j = 0; j < 8; ++j) { const float ga = sigmoidf_(j < 4 ? a0[j & 3] : a1[j & 3]), gb = sigmoidf_(j < 4 ? b0[j & 3] : b1[j & 3]);
                    o[j] = ga * va[j] + gb * vb[j]; }
                v2u w; w.x = pk4_fp8(o[0], o[1], o[2], o[3]); w.y = pk4_fp8(o[4], o[5], o[6], o[7]);
                *(v2u*)(U + off) = w;
                asm volatile("" ::: "memory"); }
    }
};
struct EpiPleFinal {
    static constexpr bool PERM = true;
    const bf16* x2; const bf16* P; float* out; const float* bias;
    __device__ __forceinline__ void operator()(const f32x4 (&acc)[2][2][4][2], const Unit& u, int wr, int wc, int fr, int fq) const {
        const int row0 = u.pm * BM + wr * 64 + fr, col0 = u.pn * BM + wc * 32 + 8 * fq;
#pragma unroll
        for (int bj = 0; bj < 2; ++bj) { const f32x4 bv0 = *(const f32x4*)(bias + col0 + bj * HALF), bv1 = *(const f32x4*)(bias + col0 + bj * HALF + 4);
#pragma unroll
            for (int ai = 0; ai < 2; ++ai)
#pragma unroll
                for (int m = 0; m < 4; ++m) { const size_t off = (size_t)(row0 + ai * HALF + m * 16) * D + col0 + bj * HALF;
                    const v4u pw = *(const v4u*)(P + off), xw = *(const v4u*)(x2 + off);
                    const f32x4 x0 = {bflo(xw.x), bfhi(xw.x), bflo(xw.y), bfhi(xw.y)}, x1 = {bflo(xw.z), bfhi(xw.z), bflo(xw.w), bfhi(xw.w)};
                    const f32x4 a0 = acc[ai][bj][m][0] + bv0, a1 = acc[ai][bj][m][1] + bv1;
                    f32x4 o0, o1;
                    o0[0] = x0[0] + sigmoidf_(a0[0]) * bflo(pw.x); o0[1] = x0[1] + sigmoidf_(a0[1]) * bfhi(pw.x); o0[2] = x0[2] + sigmoidf_(a0[2]) * bflo(pw.y); o0[3] = x0[3] + sigmoidf_(a0[3]) * bfhi(pw.y);
                    o1[0] = x1[0] + sigmoidf_(a1[0]) * bflo(pw.z); o1[1] = x1[1] + sigmoidf_(a1[1]) * bfhi(pw.z); o1[2] = x1[2] + sigmoidf_(a1[2]) * bflo(pw.w); o1[3] = x1[3] + sigmoidf_(a1[3]) * bfhi(pw.w);
                    *(f32x4*)(out + off) = o0; *(f32x4*)(out + off + 4) = o1; } }
    }
};

struct PleOrder {
    int G, c;
    __device__ __forceinline__ bool next(int i, Unit& u) const {
        int L;
        if (G == 256) { if (c >= 128) { if (i >= 6) return false; L = (c - 128) * 6 + i; } else { if (i >= 2) return false; L = 768 + c * 2 + i; } }
        else { L = i * G + c; if (L >= 1024) return false; }
        u.pm = L >> 3; u.pn = L & 7; u.e = 0; u.mt = 0; return true;
    }
    __device__ __forceinline__ void rows(const Unit&, int, int, unsigned (&)[2][2]) const {}
};
struct MoeOrder {
    const LAS int* pref;
    const LAS int* cntl;
    const int* tokrow; int NT, G, c, K;
    __device__ __forceinline__ bool next(int i, Unit& u) const {
        const int L = i * G + c; if (L >= pref[64] * NT) return false;
        const int tt = L / NT, pnl = L - tt * NT; int lo = 0, hi = 64;
        while (hi - lo > 1) { const int mid = (lo + hi) >> 1; if (pref[mid] <= tt) lo = mid; else hi = mid; }
        u.e = lo; u.mt = tt - pref[lo]; u.pm = tt; u.pn = lo * NT + pnl; return true;
    }
    __device__ __forceinline__ void rows(const Unit& u, int R0, int R1, unsigned (&off)[2][2]) const {
        const int n = cntl[u.e];
#pragma unroll
        for (int h = 0; h < 2; ++h)
#pragma unroll
            for (int i = 0; i < 2; ++i) { const int j = u.mt * 256 + h * 128 + (i ? R1 : R0);
                const int tk = (j < n) ? (tokrow[(size_t)u.e * ECAP + j] >> 1) : 0; off[h][i] = (unsigned)tk * (unsigned)(K * 2); }
    }
};
struct EpiMoe1 {
    static constexpr bool PERM = true;
    unsigned char* ACT;
    __device__ __forceinline__ void operator()(const f32x4 (&acc)[2][2][4][2], const Unit& u, int wr, int wc, int fr, int fq) const {
        const int row0 = u.pm * BM + wr * 64 + fr, col0 = (u.pn & 3) * HALF + wc * 32 + 8 * fq;
#pragma unroll
        for (int ai = 0; ai < 2; ++ai)
#pragma unroll
            for (int m = 0; m < 4; ++m) { float o[8];
#pragma unroll
                for (int j = 0; j < 8; ++j) { const float g = acc[ai][0][m][j >> 2][j & 3], up = acc[ai][1][m][j >> 2][j & 3]; o[j] = 4.0f * g * sigmoidf_(g) * up; }
                v2u w; w.x = pk4_fp8(o[0], o[1], o[2], o[3]); w.y = pk4_fp8(o[4], o[5], o[6], o[7]);
                *(v2u*)(ACT + (size_t)(row0 + ai * HALF + m * 16) * EFF + col0) = w; }
    }
};
struct EpiMoe2 {
    static constexpr bool PERM = true;
    bf16* Y0; long long ydelta; const int* tokrow; const float* tokw; const LAS int* cntl;
    __device__ __forceinline__ void operator()(const f32x4 (&acc)[2][2][4][2], const Unit& u, int wr, int wc, int fr, int fq) const {
        const int n = cntl[u.e], col0 = (u.pn & 7) * BM + wc * 32 + 8 * fq;
        int infos[2][4]; float wts[2][4];
#pragma unroll
        for (int ai = 0; ai < 2; ++ai)
#pragma unroll
            for (int m = 0; m < 4; ++m) { const int j = u.mt * 256 + ai * HALF + wr * 64 + m * 16 + fr, jj = j < n ? j : 0;
                infos[ai][m] = tokrow[(size_t)u.e * ECAP + jj]; wts[ai][m] = tokw[(size_t)u.e * ECAP + jj]; }
#pragma unroll
        for (int ai = 0; ai < 2; ++ai)
#pragma unroll
            for (int m = 0; m < 4; ++m) { const int j = u.mt * 256 + ai * HALF + wr * 64 + m * 16 + fr;
                if (j < n) { const int info = infos[ai][m]; const float wt = wts[ai][m];
                    bf16* rowp = Y0 + (long long)(info & 1) * ydelta + (size_t)(info >> 1) * D + col0;
#pragma unroll
                    for (int bj = 0; bj < 2; ++bj) { const f32x4 v0 = acc[ai][bj][m][0] * wt, v1 = acc[ai][bj][m][1] * wt;
                        v4u w; w.x = cvt_pk_bf16(v0[0], v0[1]); w.y = cvt_pk_bf16(v0[2], v0[3]); w.z = cvt_pk_bf16(v1[0], v1[1]); w.w = cvt_pk_bf16(v1[2], v1[3]);
                        *(v4u*)(rowp + bj * HALF) = w; } } }
    }
};
}


#define MFMA32(a, b, c) __builtin_amdgcn_mfma_f32_32x32x16_bf16((a), (b), (c), 0, 0, 0)
__device__ __forceinline__ int crow(int r, int hi) { return (r & 3) + 8 * (r >> 2) + 4 * hi; }

constexpr int GLA_Q_OFF = 0, GLA_K_OFF = 65536, GLA_GLR_OFF = 132096;
__device__ __forceinline__ void gla_prep_task(LAS unsigned char* lds, bf16* Z, const float* w_alpha, const float* b_alpha, float* DEC, int task) {
    const int tid = opaque_tid(); const size_t t0 = (size_t)task * 64;
    LAS float* glr = (LAS float*)(lds + GLA_GLR_OFF);
    LAS unsigned short* qt = (LAS unsigned short*)(lds + GLA_Q_OFF); LAS unsigned short* kt = (LAS unsigned short*)(lds + GLA_K_OFF);
    __syncthreads();
#pragma unroll
    for (int i = 0; i < 8; ++i) { const int ch = tid + 512 * i, row = ch >> 6, c8 = (ch & 63) * 8;
        *(LAS v4u*)(qt + row * 512 + c8) = *(const GAS v4u*)(Z + (t0 + row) * ZP + ZC_GQ + c8);
        *(LAS v4u*)(kt + row * 512 + c8) = *(const GAS v4u*)(Z + (t0 + row) * ZP + ZC_GK + c8); }
    for (int i = tid; i < 1024; i += 512) glr[i] = bf2f(Z[(t0 + (i >> 4)) * ZP + ZC_GLR + (i & 15)]);
    float w[16];
#pragma unroll
    for (int i = 0; i < 16; ++i) w[i] = w_alpha[i * 512 + tid];
    const float bb = b_alpha[tid];
    __syncthreads();
    float G = 0.f;
#pragma unroll 4
    for (int r = 0; r < 64; ++r) {
        float pre = bb;
#pragma unroll
        for (int i = 0; i < 16; ++i) pre = fmaf(glr[r * 16 + i], w[i], pre);
        const float ls = fminf(pre, 0.f) - log1pf(__expf(-fabsf(pre)));
        G += ls * (1.0f / 16.0f);
        const float Gc = fmaxf(G, -80.f);
        const float eq = __expf(Gc), ek = __expf(-Gc);
        const float qv = bf2f(qt[r * 512 + tid]), kv = bf2f(kt[r * 512 + tid]);
        qt[r * 512 + tid] = (unsigned short)f2bf(qv * 0.125f * eq);
        kt[r * 512 + tid] = (unsigned short)f2bf(kv * ek);
    }
    DEC[(size_t)task * 512 + tid] = __expf(fmaxf(G, -80.f));
    __syncthreads();
#pragma unroll
    for (int i = 0; i < 8; ++i) { const int ch = tid + 512 * i, row = ch >> 6, c8 = (ch & 63) * 8;
        *(GAS v4u*)(Z + (t0 + row) * ZP + ZC_GQ + c8) = *(const LAS v4u*)(qt + row * 512 + c8);
        *(GAS v4u*)(Z + (t0 + row) * ZP + ZC_GK + c8) = *(const LAS v4u*)(kt + row * 512 + c8); }
    LDS_WAIT(); VM_WAIT(); __syncthreads();
}
__device__ __forceinline__ void dsa_prep_row(int lane, bf16* Z, size_t m, const float* qg, const float* kg, bf16* IKC, float* UW) {
#pragma unroll
    for (int which = 0; which < 2; ++which) {
        bf16* p = Z + m * ZP + (which ? ZC_DK : ZC_DQ) + lane * 16;
        const v4u a = *(const v4u*)p, b = *(const v4u*)(p + 8);
        float v[16]; const unsigned ww[8] = {a.x, a.y, a.z, a.w, b.x, b.y, b.z, b.w};
        float ss = 0.f;
#pragma unroll
        for (int i = 0; i < 8; ++i) { v[2 * i] = bflo(ww[i]); v[2 * i + 1] = bfhi(ww[i]); ss += v[2 * i] * v[2 * i] + v[2 * i + 1] * v[2 * i + 1]; }
        ss = sum8(ss);
        const float rstd = (1.0f / sqrtf(ss * (1.0f / 128.f) + EPS)) * (which ? 1.0f : 0.08838834764831845f * 1.4426950408889634f);
        const float* g = (which ? kg : qg) + (lane & 7) * 16;
        v4u o0, o1;
        o0.x = pk2(v[0] * rstd * g[0], v[1] * rstd * g[1]); o0.y = pk2(v[2] * rstd * g[2], v[3] * rstd * g[3]); o0.z = pk2(v[4] * rstd * g[4], v[5] * rstd * g[5]); o0.w = pk2(v[6] * rstd * g[6], v[7] * rstd * g[7]);
        o1.x = pk2(v[8] * rstd * g[8], v[9] * rstd * g[9]); o1.y = pk2(v[10] * rstd * g[10], v[11] * rstd * g[11]); o1.z = pk2(v[12] * rstd * g[12], v[13] * rstd * g[13]); o1.w = pk2(v[14] * rstd * g[14], v[15] * rstd * g[15]);
        *(v4u*)p = o0; *(v4u*)(p + 8) = o1;
    }
    if (lane < 8) *(v4u*)(IKC + m * 64 + lane * 8) = *(const v4u*)(Z + m * ZP + ZC_IK + lane * 8);
    if (lane < 16) UW[m * 16 + lane] = bf2f(Z[m * ZP + ZC_IW + lane]) * (0.5f / 32.0f);
}
#define FRAG_NAT(dst, tile, s, hg, col) do { _Pragma("unroll") for (int j_ = 0; j_ < 8; ++j_) dst[j_] = (short)(tile)[(16 * (s) + 8 * (hg) + j_) * 64 + (col)]; } while (0)
__device__ __forceinline__ void gla_local_unit(LAS unsigned char* lds, int wave, int lane, const bf16* Z, const float* DEC, float* SLOC, int u) {
    const int h = u & 7; const size_t t0 = (size_t)(u >> 3) * 64; const int r = lane & 31, hg = lane >> 5;
    const LAS unsigned short* kt = (const LAS unsigned short*)(lds + GLA_K_OFF) + h * 64;
    LAS unsigned short* vt = (LAS unsigned short*)(lds + GLA_Q_OFF + wave * 8192);
    const float d0 = DEC[(size_t)u * 64 + r], d1 = DEC[(size_t)u * 64 + 32 + r];
    bf16x8 Bk[2][4];
#pragma unroll
    for (int nt = 0; nt < 2; ++nt)
#pragma unroll
        for (int s = 0; s < 4; ++s) {
#pragma unroll
            for (int j = 0; j < 8; ++j) Bk[nt][s][j] = (short)kt[(16 * s + 8 * hg + j) * 512 + 32 * nt + r]; }
#pragma unroll 1
    for (int half = 0; half < 2; ++half) {
        LDS_WAIT();
#pragma unroll
        for (int i = 0; i < 8; ++i) { const int row = i * 8 + (lane >> 3), ch = lane & 7;
            *(LAS v4u*)(vt + row * 64 + ch * 8) = *(const v4u*)(Z + (t0 + row) * ZP + ZC_GV + h * 128 + half * 64 + ch * 8); }
        LDS_WAIT();
        f32x16 acc[2][2];
#pragma unroll
        for (int a = 0; a < 2; ++a)
#pragma unroll
            for (int b = 0; b < 2; ++b)
#pragma unroll
                for (int i = 0; i < 16; ++i) acc[a][b][i] = 0.f;
#pragma unroll
        for (int mt = 0; mt < 2; ++mt)
#pragma unroll
            for (int s = 0; s < 4; ++s) { bf16x8 Av; FRAG_NAT(Av, vt, s, hg, 32 * mt + r);
                acc[mt][0] = MFMA32(Av, Bk[0][s], acc[mt][0]); acc[mt][1] = MFMA32(Av, Bk[1][s], acc[mt][1]); }
        unsigned short* out = (unsigned short*)SLOC + (size_t)u * 8192;
#pragma unroll
        for (int mt = 0; mt < 2; ++mt)
#pragma unroll
            for (int i = 0; i < 16; ++i) { const int dv = half * 64 + 32 * mt + crow(i, hg);
                out[dv * 64 + r] = (unsigned short)f2bf(acc[mt][0][i] * d0); out[dv * 64 + 32 + r] = (unsigned short)f2bf(acc[mt][1][i] * d1); }
    }
}
__device__ __forceinline__ void gla_scan(const float* SLOC, const float* DEC, bf16* STT, int gt, int ngt) {
    for (int p = gt; p < 32 * 4096; p += ngt) {
        const int bh = p >> 12, ev = (p & 4095) * 2, b = bh >> 3, h = bh & 7, k = ev & 63;
        float s0 = 0.f, s1 = 0.f;
#pragma unroll 8
        for (int c = 0; c < 128; ++c) {
            const size_t u = ((size_t)(b * 128 + c) * 8 + h);
            const unsigned slw = *(const unsigned*)((const unsigned short*)SLOC + u * 8192 + ev); float2 sl; sl.x = bflo(slw); sl.y = bfhi(slw); const float2 dc = *(const float2*)(DEC + u * 64 + k);
            *(unsigned*)(STT + u * 8192 + ev) = pk2(s0, s1);
            s0 = fmaf(s0, dc.x, sl.x); s1 = fmaf(s1, dc.y, sl.y);
        }
    }
}
__device__ __forceinline__ void gla_out_unit(LAS unsigned char* wl, int lane, const bf16* Z, const bf16* STT, const float* gn, bf16* OA, int u) {
    const int h = u & 7; const size_t t0 = (size_t)(u >> 3) * 64; const int r = lane & 31, hg = lane >> 5;
    LAS unsigned short* vt = (LAS unsigned short*)wl;
    LDS_WAIT();
#pragma unroll
    for (int i = 0; i < 16; ++i) { const int row = i * 4 + (lane >> 4), ch = lane & 15;
        *(LAS v4u*)(vt + row * 128 + ch * 8) = *(const v4u*)(Z + (t0 + row) * ZP + ZC_GV + h * 128 + ch * 8); }
    bf16x8 Fq[2][4], Fk[2][4];
#pragma unroll
    for (int t = 0; t < 2; ++t)
#pragma unroll
        for (int s = 0; s < 4; ++s) {
            Fq[t][s] = *(const bf16x8*)(Z + (t0 + 32 * t + r) * ZP + ZC_GQ + h * 64 + 16 * s + 8 * hg);
            Fk[t][s] = *(const bf16x8*)(Z + (t0 + 32 * t + r) * ZP + ZC_GK + h * 64 + 16 * s + 8 * hg); }
    const bf16* st = STT + (size_t)u * 8192;
    LDS_WAIT();
#pragma unroll 1
    for (int it = 0; it < 2; ++it) {
        f32x16 o[4];
#pragma unroll
        for (int d = 0; d < 4; ++d)
#pragma unroll
            for (int i = 0; i < 16; ++i) o[d][i] = 0.f;
#pragma unroll
        for (int d = 0; d < 4; ++d)
#pragma unroll
            for (int s = 0; s < 4; ++s) { const bf16x8 Bs = *(const bf16x8*)(st + (32 * d + r) * 64 + 16 * s + 8 * hg); o[d] = MFMA32(Fq[it][s], Bs, o[d]); }
#pragma unroll
        for (int jt = 0; jt < 2; ++jt) {
            if (jt <= it) {
                f32x16 X;
#pragma unroll
                for (int i = 0; i < 16; ++i) X[i] = 0.f;
#pragma unroll
                for (int s = 0; s < 4; ++s) X = MFMA32(Fk[jt][s], Fq[it][s], X);
                asm volatile("s_nop 15\n\ts_nop 7" : "+v"(X));
                if (jt == it) {
#pragma unroll
                    for (int i = 0; i < 16; ++i) if (crow(i, hg) > r) X[i] = 0.f;
                }
#pragma unroll
                for (int s2 = 0; s2 < 2; ++s2) {
                    v4u pw; pw.x = cvt_pk_bf16(X[8 * s2 + 0], X[8 * s2 + 1]); pw.y = cvt_pk_bf16(X[8 * s2 + 2], X[8 * s2 + 3]); pw.z = cvt_pk_bf16(X[8 * s2 + 4], X[8 * s2 + 5]); pw.w = cvt_pk_bf16(X[8 * s2 + 6], X[8 * s2 + 7]);
                    const bf16x8 pa = __builtin_bit_cast(bf16x8, pw);
#pragma unroll
                    for (int d = 0; d < 4; ++d) { bf16x8 Bv;
#pragma unroll
                        for (int j = 0; j < 8; ++j) Bv[j] = (short)vt[(32 * jt + 16 * s2 + 8 * (j >> 2) + 4 * hg + (j & 3)) * 128 + 32 * d + r];
                        o[d] = MFMA32(pa, Bv, o[d]); }
                }
            }
        }
        float g4[4];
#pragma unroll
        for (int d = 0; d < 4; ++d) g4[d] = gn[32 * d + r];
#pragma unroll
        for (int i = 0; i < 16; ++i) {
            float ss = o[0][i] * o[0][i] + o[1][i] * o[1][i] + o[2][i] * o[2][i] + o[3][i] * o[3][i];
            ss = sum32(ss);
            const float rstd = 1.0f / sqrtf(ss * (1.0f / 128.f) + EPS);
            const size_t tok = t0 + 32 * it + crow(i, hg);
#pragma unroll
            for (int d = 0; d < 4; ++d) { const float gr = bf2f(Z[tok * ZP + ZC_GR + h * 128 + 32 * d + r]);
                const float val = o[d][i] * rstd * g4[d] * (gr * sigmoidf_(gr));
                OA[tok * 1024 + h * 128 + 32 * d + r] = (bf16)f2bf(val); }
        }
    }
}


__device__ __forceinline__ size_t sc_off(int b, int c) { return (size_t)b * SC_PER_BATCH + (size_t)4096 * ((size_t)c * (c + 1) / 2); }
__device__ __forceinline__ unsigned score_code(float sc) {
    const _Float16 hf = (_Float16)sc; const unsigned bits = (unsigned)__builtin_bit_cast(unsigned short, hf);
    return (bits & 0x8000u) ? (~bits & 0xffffu) : (bits | 0x8000u);
}
__device__ __forceinline__ void idx_scores_oct(LAS unsigned char* wl, int lane, const bf16* Z, const bf16* IKC, const float* UW, unsigned short* SC, int b, int c, int oct) {
    const int r = lane & 31, hg = lane >> 5, n = 64 * (c + 1);
    const size_t t0 = (size_t)b * SEQ + (size_t)c * 64 + 8 * oct;
    bf16x8 A[4][4];
    { const int q = (r >> 2) & 1, head = (r & 3) + 4 * (r >> 3);
#pragma unroll
      for (int a = 0; a < 4; ++a)
#pragma unroll
        for (int s = 0; s < 4; ++s) A[a][s] = *(const bf16x8*)(Z + (t0 + 2 * a + q) * ZP + ZC_IQ + head * 64 + 16 * s + 8 * hg); }
    LAS float* ul = (LAS float*)wl;
    LDS_WAIT();
    ul[lane] = UW[t0 * 16 + lane]; ul[64 + lane] = UW[t0 * 16 + 64 + lane];
    LDS_WAIT();
    GAS unsigned short* row0 = (GAS unsigned short*)SC + sc_off(b, c) + (size_t)(8 * oct + hg) * n;
    const GAS bf16* kb = (const GAS bf16*)IKC + ((size_t)b * SEQ + r) * 64 + 8 * hg;
    const int npair = n / 64;
#define IDX_LOADB(dst, kt_) do { _Pragma("unroll") for (int t = 0; t < 2; ++t) _Pragma("unroll") for (int s = 0; s < 4; ++s) dst[t][s] = *(const GAS bf16x8*)(kb + (size_t)((kt_) + t) * 32 * 64 + 16 * s); } while (0)
#define IDX_STEP(Bc, kt_) do { _Pragma("unroll") for (int a = 0; a < 4; ++a) { \
            f32x2 u2[8]; \
            _Pragma("unroll") for (int i = 0; i < 4; ++i) { const f32x4 t4 = *(const LAS f32x4*)(ul + (2 * a + hg) * 16 + 4 * i); u2[2 * i] = (f32x2){t4.x, t4.y}; u2[2 * i + 1] = (f32x2){t4.z, t4.w}; } \
            f32x16 acc0, acc1; \
            _Pragma("unroll") for (int i = 0; i < 16; ++i) { acc0[i] = 0.f; acc1[i] = 0.f; } \
            _Pragma("unroll") for (int s = 0; s < 4; ++s) { acc0 = MFMA32(A[a][s], Bc[0][s], acc0); acc1 = MFMA32(A[a][s], Bc[1][s], acc1); } \
            f32x2 l0 = {0.f, 0.f}, l1 = {0.f, 0.f}; \
            _Pragma("unroll") for (int j = 0; j < 8; ++j) { l0 = (f32x2){acc0[2 * j], acc0[2 * j + 1]} * u2[j] + l0; l1 = (f32x2){acc1[2 * j], acc1[2 * j + 1]} * u2[j] + l1; } \
            float s0 = l0.x + l0.y, s1 = l1.x + l1.y; \
            _Pragma("unroll") for (int j = 0; j < 8; ++j) { \
                asm("v_fma_f32 %0, |%1|, %2, %0" : "+v"(s0) : "v"(acc0[2 * j]), "v"(u2[j].x)); asm("v_fma_f32 %0, |%1|, %2, %0" : "+v"(s1) : "v"(acc1[2 * j]), "v"(u2[j].x)); \
                asm("v_fma_f32 %0, |%1|, %2, %0" : "+v"(s0) : "v"(acc0[2 * j + 1]), "v"(u2[j].y)); asm("v_fma_f32 %0, |%1|, %2, %0" : "+v"(s1) : "v"(acc1[2 * j + 1]), "v"(u2[j].y)); } \
            const unsigned c0 = score_code(s0), c1 = score_code(s1); \
            const unsigned pa = (unsigned)DPP_I(c0, DPP_X1), pb = (unsigned)DPP_I(c1, DPP_X1); \
            GAS unsigned short* row = row0 + (size_t)(2 * a) * n; \
            if ((r & 1) == 0) *(GAS unsigned*)(row + (kt_) * 32 + r) = c0 | (pa << 16); \
            else *(GAS unsigned*)(row + ((kt_) + 1) * 32 + r - 1) = pb | (c1 << 16); \
            } } while (0)
    bf16x8 B0[2][4], B1[2][4];
    IDX_LOADB(B0, 0);
#pragma unroll 1
    for (int p = 0; p < npair; p += 2) {
        if (p + 1 < npair) IDX_LOADB(B1, 2 * (p + 1));
        IDX_STEP(B0, 2 * p);
        if (p + 1 < npair) {
            if (p + 2 < npair) IDX_LOADB(B0, 2 * (p + 2));
            IDX_STEP(B1, 2 * (p + 1));
        }
    }
#undef IDX_LOADB
#undef IDX_STEP
}
__device__ __forceinline__ void idx_select_row(int lane, const unsigned short* row, int n, LAS unsigned char* bmrow, LAS unsigned* bins  ) {
    const int nch = n / 8;
    if (n <= 256) {
#pragma unroll
        for (int s = 0; s < 16; ++s) { const int j = lane + 64 * s; bmrow[j] = (j < nch) ? 0xffu : 0u; }
        return;
    }
    v4u cw[16];
#pragma unroll
    for (int s = 0; s < 16; ++s) { const int j = lane + 64 * s; const unsigned m = (unsigned)((j - nch) >> 31);
        const int jc = j < nch ? j : nch - 1; const v4u t = *(const v4u*)(row + (size_t)jc * 8); cw[s] = (v4u){t.x & m, t.y & m, t.z & m, t.w & m}; }
    const int ns = (nch + 63) / 64;
#define WSCAN(v) do { _Pragma("unroll") for (int o_ = 1; o_ < 64; o_ <<= 1) { const int t_ = __builtin_amdgcn_ds_bpermute((lane - o_) << 2, (v)); if (lane >= o_) (v) += t_; } } while (0)
#pragma unroll
    for (int i = 0; i < 8; ++i) *(LAS v4u*)(bins + (i * 64 + lane) * 4) = (v4u){0u, 0u, 0u, 0u};
    LDS_WAIT();
#pragma unroll
    for (int s = 0; s < 16; ++s) if (s < ns) {
#pragma unroll
        for (int e = 0; e < 4; ++e) { const unsigned w = cw[s][e];
            __hip_atomic_fetch_add(bins + ((w & 0xffffu) >> 5), 1u, __ATOMIC_RELAXED, __HIP_MEMORY_SCOPE_WORKGROUP);
            __hip_atomic_fetch_add(bins + (w >> 21), 1u, __ATOMIC_RELAXED, __HIP_MEMORY_SCOPE_WORKGROUP); } }
    LDS_WAIT();
    int B, above;
    { unsigned bv[32]; int sl = 0;
#pragma unroll
      for (int i = 0; i < 8; ++i) { const v4u t = *(const LAS v4u*)(bins + lane * 32 + 4 * i); bv[4 * i] = t.x; bv[4 * i + 1] = t.y; bv[4 * i + 2] = t.z; bv[4 * i + 3] = t.w; sl += (int)(t.x + t.y + t.z + t.w); }
      int incl = sl; WSCAN(incl);
      const int tot = __builtin_amdgcn_readlane(incl, 63);
      int run = tot - incl;
      const bool mine = run < 256 && run + sl >= 256;
      int bl = 0, al = 0; bool found = false;
#pragma unroll
      for (int k = 31; k >= 0; --k) { const int cbin = (int)bv[k]; if (!found && run + cbin >= 256) { bl = 32 * lane + k; al = run; found = true; } run += cbin; }
      const unsigned long long mk = __builtin_amdgcn_ballot_w64(mine); const int src = (int)__builtin_ctzll(mk);
      B = __builtin_amdgcn_readlane(bl, src); above = __builtin_amdgcn_readlane(al, src); }
    LDS_WAIT();
    if (lane < 8) *(LAS v4u*)(bins + lane * 4) = (v4u){0u, 0u, 0u, 0u};
    LDS_WAIT();
#pragma unroll
    for (int s = 0; s < 16; ++s) if (s < ns) {
#pragma unroll
        for (int e = 0; e < 4; ++e) { const unsigned w = cw[s][e]; const unsigned lo = w & 0xffffu, hi = w >> 16;
            if ((int)(lo >> 5) == B) __hip_atomic_fetch_add(bins + (lo & 31u), 1u, __ATOMIC_RELAXED, __HIP_MEMORY_SCOPE_WORKGROUP);
            if ((int)(hi >> 5) == B) __hip_atomic_fetch_add(bins + (hi & 31u), 1u, __ATOMIC_RELAXED, __HIP_MEMORY_SCOPE_WORKGROUP); } }
    LDS_WAIT();
    unsigned thr; int cgt, ceq;
    { const int cl = lane < 32 ? (int)bins[lane] : 0; int incl = cl; WSCAN(incl);
      const int tot = __builtin_amdgcn_readlane(incl, 63);
      const int run = above + tot - incl;
      const bool mine = lane < 32 && run < 256 && run + cl >= 256;
      const unsigned long long mk = __builtin_amdgcn_ballot_w64(mine); const int src = (int)__builtin_ctzll(mk);
      thr = ((unsigned)B << 5) | (unsigned)src; cgt = __builtin_amdgcn_readlane(run, src); ceq = __builtin_amdgcn_readlane(cl, src); }
    LDS_WAIT();
#undef WSCAN
    const int need = 256 - cgt;
    const bool fast = (ceq == need);
    int run = 0;
#pragma unroll
    for (int s = 0; s < 16; ++s) {
        const int j = lane + 64 * s;
        unsigned gm = 0u, tm = 0u;
        if (s < ns) {
#pragma unroll
            for (int e = 0; e < 4; ++e) { const unsigned w = cw[s][e]; const unsigned lo = w & 0xffffu, hi = w >> 16;
                gm |= ((thr - lo) >> 31) << (2 * e); gm |= ((thr - hi) >> 31) << (2 * e + 1);
                tm |= (((lo ^ thr) - 1u) >> 31) << (2 * e); tm |= (((hi ^ thr) - 1u) >> 31) << (2 * e + 1); }
            if (fast) gm |= tm;
            else {
                const int tc = __builtin_popcount(tm); int incl = tc;
#pragma unroll
                for (int o = 1; o < 64; o <<= 1) { const int t = __builtin_amdgcn_ds_bpermute((lane - o) << 2, incl); if (lane >= o) incl += t; }
                int rank = run + incl - tc;
#pragma unroll
                for (int e = 0; e < 8; ++e) if ((tm >> e) & 1u) { if (rank < need) gm |= 1u << e; ++rank; }
                run += __builtin_amdgcn_readlane(incl, 63);
            }
        }
        bmrow[j] = (unsigned char)gm;
    }
}


__device__ __forceinline__ void bt_emit_tile(int lane, const LAS unsigned char* rows, unsigned* BT, int b, int c, int tile, bool zero) {
    unsigned long long w = 0ull;
    if (!zero) w = *(const LAS unsigned long long*)(rows + lane * 1024 + tile * 8);
    unsigned va = 0u, vb = 0u;
#pragma unroll
    for (int pos = 0; pos < 64; ++pos) { const int rr = (pos >> 1) & 15, p = pos >> 5, h = pos & 1, key = 32 * p + (rr & 3) + 8 * (rr >> 2) + 4 * h;
        const unsigned long long m = __builtin_amdgcn_ballot_w64(((w >> key) & 1ull) != 0ull);
        asm volatile("s_nop 1\n\tv_writelane_b32 %0, %1, %2" : "+v"(va) : "s"((unsigned)m), "n"(pos)); asm volatile("v_writelane_b32 %0, %1, %2" : "+v"(vb) : "s"((unsigned)(m >> 32)), "n"(pos)); }
    const size_t g0 = ((size_t)(b * 256 + 2 * c) * 128 + tile) * 64;
    BT[g0 + lane] = va; BT[g0 + 128 * 64 + lane] = vb;
}

namespace att {
constexpr int AD = 128, NW = 8, QBLK = 32, KVBLK = 64, QB = NW * QBLK;
constexpr int SHM_V = KVBLK * AD * 2, SHM_K = KVBLK * AD * 2;
constexpr int LI_OFF = 2 * SHM_V + 2 * SHM_K;
constexpr int LUT_OFF = LI_OFF + NW * 64 * 4;
constexpr int NM_OFF = LUT_OFF + 8 * 256 * 4;
constexpr int QI_OFF = NM_OFF + 32;
constexpr int ATT_LDS = NM_OFF + 64;
typedef unsigned u32x16 __attribute__((ext_vector_type(16)));
#define AS4C __attribute__((address_space(4)))
#define KSWZ(row, colB) ((row) * 256 + ((colB) ^ (((row) & 7) << 4)))
#define SBAR() __builtin_amdgcn_sched_barrier(0)
__device__ __forceinline__ int v_st(int k, int c) { const int kk = (k & ~0xC) | ((k & 4) << 1) | ((k & 8) >> 1); return ((kk >> 3) * 4 + (c >> 5)) * 512 + ((kk & 7) * 32 + (c & 31)) * 2; }
__device__ __forceinline__ int v_rd_base(int lane) { return ((lane & 3) << 3) | (((lane >> 2) & 3) << 6) | (((lane >> 4) & 1) << 5) | (((lane >> 5) & 1) << 8); }
constexpr int v_rd_off(int d0, int ks, int half) { return d0 * 512 + ks * 4096 + half * 2048; }
__device__ __forceinline__ unsigned cvtpk(float lo, float hi) { unsigned r; asm volatile("v_cvt_pk_bf16_f32 %0, %1, %2" : "=v"(r) : "v"(lo), "v"(hi)); return r; }
__device__ __forceinline__ bf16x8 load8(const bf16* p) { return *reinterpret_cast<const bf16x8*>(p); }
__device__ __forceinline__ void mask16(f32x16& p, const u32x16& ma, const u32x16& mb, float neg) {
#pragma unroll
    for (int r = 0; r < 16; ++r) { const unsigned lo = r < 8 ? ma[2 * r] : mb[2 * r - 16], hi = r < 8 ? ma[2 * r + 1] : mb[2 * r - 15];
        const unsigned long long mm = ((unsigned long long)hi << 32) | lo; float o;
        asm volatile("v_cndmask_b32_e64 %0, %1, %2, %3" : "=v"(o) : "v"(neg), "v"(p[r]), "s"(mm)); p[r] = o; }
}
#define MFMA_PAD(a, b) asm volatile("s_nop 15\n\ts_nop 7" : "+v"(a), "+v"(b))
__device__ __forceinline__ void bias_tile(f32x16& p0, f32x16& p1, const LAS float* lut) {
#pragma unroll
    for (int r = 0; r < 16; ++r) { const int c = (r & 3) + 8 * (r >> 2); p0[r] += lut[c]; p1[r] += lut[c + 32]; }
}
__device__ __forceinline__ void exp16(f32x16& p) {
#pragma unroll
    for (int r = 0; r < 16; ++r) p[r] = __builtin_amdgcn_exp2f(p[r]);
}
__device__ __forceinline__ void finishSM(f32x16& p0, f32x16& p1, float& l_reg, bf16x8& pa0, bf16x8& pa1, bf16x8& pa2, bf16x8& pa3) {
    exp16(p1);
    float ps = 0;
#pragma unroll
    for (int r = 0; r < 16; ++r) ps += p0[r];
#pragma unroll
    for (int r = 0; r < 16; ++r) ps += p1[r];
    l_reg += ps;
#define PK4(P, B_, OUT) do { unsigned a0 = cvtpk(P[B_+0], P[B_+1]), a1 = cvtpk(P[B_+2], P[B_+3]);                          \
        unsigned b0 = cvtpk(P[B_+4], P[B_+5]), b1 = cvtpk(P[B_+6], P[B_+7]);                                             \
        auto r0 = __builtin_amdgcn_permlane32_swap(a0, b0, false, false); auto r1 = __builtin_amdgcn_permlane32_swap(a1, b1, false, false); \
        v4u w = {r0[0], r1[0], r0[1], r1[1]}; OUT = *reinterpret_cast<bf16x8*>(&w); } while (0)
    PK4(p0, 0, pa0); PK4(p0, 8, pa1); PK4(p1, 0, pa2); PK4(p1, 8, pa3);
#undef PK4
}
template <int KB>
__device__ __forceinline__ void qkt(f32x16& p0, f32x16& p1, const char* K_lds, int r32, int hi, const bf16x8* qr, float init) {
#pragma unroll
    for (int r = 0; r < 16; ++r) { float i0 = init, i1 = init; asm volatile("" : "+v"(i0), "+v"(i1)); p0[r] = i0; p1[r] = i1; }
    const char* kb[4];
#pragma unroll
    for (int dd = 0; dd < 4; ++dd) kb[dd] = K_lds + KB * SHM_K + KSWZ(r32, (dd * 16 + hi * 8) * 2);
#pragma unroll
    for (int d0 = 0; d0 < 8; ++d0) { const char* a = kb[d0 & 3] + (d0 >> 2) * 128;
        bf16x8 b0 = *reinterpret_cast<const bf16x8*>(a);
        bf16x8 b1 = *reinterpret_cast<const bf16x8*>(a + 32 * 256);
        p0 = __builtin_amdgcn_mfma_f32_32x32x16_bf16(b0, qr[d0], p0, 0, 0, 0);
        p1 = __builtin_amdgcn_mfma_f32_32x32x16_bf16(b1, qr[d0], p1, 0, 0, 0); }
}
template <int VB>
__device__ __forceinline__ void pv_tile(f32x16* o, int vb0, bf16x8 pa0, bf16x8 pa1, bf16x8 pa2, bf16x8 pa3) {
#define TRRD(dst, off) asm volatile("ds_read_b64_tr_b16 %0, %1 offset:%2" : "=&v"(dst) : "v"(vb0), "i"(off) : "memory")
#define PV_D0(d0) do { s16x4 l0, l1, l2, l3, h0, h1, h2, h3; constexpr int b_ = VB * SHM_V + v_rd_off(d0, 0, 0); \
        TRRD(l0, b_); TRRD(h0, b_ + 2048); TRRD(l1, b_ + 4096); TRRD(h1, b_ + 6144); TRRD(l2, b_ + 8192); TRRD(h2, b_ + 10240); TRRD(l3, b_ + 12288); TRRD(h3, b_ + 14336); \
        asm volatile("s_waitcnt lgkmcnt(0)" ::: "memory"); SBAR();   \
        o[d0] = __builtin_amdgcn_mfma_f32_32x32x16_bf16(pa0, (bf16x8){l0[0], l0[1], l0[2], l0[3], h0[0], h0[1], h0[2], h0[3]}, o[d0], 0, 0, 0);   \
        o[d0] = __builtin_amdgcn_mfma_f32_32x32x16_bf16(pa1, (bf16x8){l1[0], l1[1], l1[2], l1[3], h1[0], h1[1], h1[2], h1[3]}, o[d0], 0, 0, 0);   \
        o[d0] = __builtin_amdgcn_mfma_f32_32x32x16_bf16(pa2, (bf16x8){l2[0], l2[1], l2[2], l2[3], h2[0], h2[1], h2[2], h2[3]}, o[d0], 0, 0, 0);   \
        o[d0] = __builtin_amdgcn_mfma_f32_32x32x16_bf16(pa3, (bf16x8){l3[0], l3[1], l3[2], l3[3], h3[0], h3[1], h3[2], h3[3]}, o[d0], 0, 0, 0); } while (0)
    PV_D0(0); PV_D0(1); PV_D0(2); PV_D0(3);
#undef PV_D0
#undef TRRD
}
struct BlockRef { const bf16* Q; const bf16* K; unsigned char* O; const unsigned* bt; int P0; int h; };
struct Seam { bf16x8 qr[8]; bf16x8 st_v0, st_v1, st_k0, st_k1; };
#define ROW(p, k0, rr) ((p) + (size_t)((k0) + (rr)) * ZP + sc)
#define VMW() asm volatile("s_waitcnt vmcnt(0)" ::: "memory")
#define VMWN(n) asm volatile("s_waitcnt vmcnt(%0)" :: "i"(n) : "memory")
#define SLOAD_H(Kp, k0) do { const bf16* r0_ = ROW(Kp, k0, sr); const bf16* r1_ = ROW(Kp, k0, 32 + sr);   \
                         S.st_v0 = load8(r0_ + (ZC_DV - ZC_DK)); S.st_v1 = load8(r1_ + (ZC_DV - ZC_DK)); S.st_k0 = load8(r0_); S.st_k1 = load8(r1_); } while (0)
#define SWRITE_HK(bf) do { *(bf16x8*)(K_lds + (bf) * SHM_K + kws) = S.st_k0; *(bf16x8*)(K_lds + (bf) * SHM_K + kws + 32 * 256) = S.st_k1; } while (0)
#define SWRITE_HV(bf) do { *(bf16x8*)(V_lds + (bf) * SHM_V + vst0) = S.st_v0; *(bf16x8*)(V_lds + (bf) * SHM_V + vst1) = S.st_v1; } while (0)
#define SWRITE_H(bf) do { SWRITE_HV(bf); SWRITE_HK(bf); } while (0)
#define MLOAD(dst0, dst1, ptr, byteoff) do { const AS4C u32x16* q_ = (const AS4C u32x16*)(const AS4C void*)(ptr); dst0 = q_[(byteoff) / 64]; dst1 = q_[(byteoff) / 64 + 1]; } while (0)
__device__ __forceinline__ void prime(const BlockRef& cur, char* lds, Seam& S) {
    const int tid = opaque_tid(), wid = __builtin_amdgcn_readfirstlane(tid >> 6), lane = tid & 63, r32 = lane & 31, hi = lane >> 5;
    const int sr = tid >> 4, sc = (tid & 15) * 8, kws = KSWZ(sr, sc * 2); char* K_lds = lds + 2 * SHM_V;
#pragma unroll
    for (int d0 = 0; d0 < 8; ++d0) S.qr[d0] = load8(cur.Q + (size_t)(wid * QBLK + r32) * ZP + d0 * 16 + hi * 8);
    SLOAD_H(cur.K, 0); VMW(); SWRITE_HK(0);
    __syncthreads();
}
__device__ __forceinline__ void block(const BlockRef& cur, const BlockRef& nxt, char* lds, Seam& S) {
    const int tid = opaque_tid(), wid = __builtin_amdgcn_readfirstlane(tid >> 6), lane = tid & 63, r32 = lane & 31, hi = lane >> 5;
    const int NT = cur.P0 / KVBLK + 4;
    const int qlo = cur.P0 + wid * QBLK, qch = qlo >> 6;
    char* V_lds = lds; char* K_lds = lds + 2 * SHM_V;
    float* li_l = (float*)(lds + LI_OFF) + wid * 64;
    const float ninit = *(const float*)(lds + NM_OFF + 4 * cur.h);
    const float NEG = -__builtin_inff();
    const unsigned* btw = cur.bt + (size_t)wid * (128 * 64);
    float l_reg = 0; f32x16 o[4];
#pragma unroll
    for (int d = 0; d < 4; ++d)
#pragma unroll
        for (int r = 0; r < 16; ++r) o[d][r] = 0.f;
    const int sr = tid >> 4, sc = (tid & 15) * 8, vst0 = v_st(sr, sc), vst1 = v_st(32 + sr, sc), kws = KSWZ(sr, sc * 2);
    const int vb0 = (int)(uintptr_t)V_lds + v_rd_base(lane);
    const bf16* Kh = cur.K;
#define KBASE(t) ((t) * KVBLK)
#define LUTB(t) (LUT_OFF + 4 * (cur.h * 256 + 191 + 4 * hi - qlo - r32 + (t) * KVBLK))
#define MASKT(P0_, P1_, t) do { if ((t) >= qch - 2 && (t) <= qch) bias_tile(P0_, P1_, (const LAS float*)(unsigned)LUTB(t)); \
        mask16(P0_, m0, m1, NEG); { const unsigned* mp_ = btw + (size_t)(t) * 64; MLOAD(m0, m1, mp_, 128); } \
        if (__builtin_expect(__all(ninit <= 0.f), 1)) { exp16(P0_); } else { l_reg = 0.f; }     \
        mask16(P1_, m0, m1, NEG); } while (0)
#define MREQ(t) do { const unsigned* mp_ = btw + (size_t)(t) * 64; MLOAD(m0, m1, mp_, 0); } while (0)
    constexpr int NQL = 8;
#define SEAM_K0() do { VMWN(NQL); SWRITE_HK(0); SBAR(); } while (0)
    f32x16 pA0, pA1, pB0, pB1; bf16x8 pa0, pa1, pa2, pa3; u32x16 m0, m1;
    SWRITE_HV(0); SBAR();
    MREQ(0);
    if (NT > 1) SLOAD_H(Kh, KBASE(1));
    SBAR(); qkt<0>(pA0, pA1, K_lds, r32, hi, S.qr, ninit);
    MFMA_PAD(pA0, pA1); MASKT(pA0, pA1, 0);
    if (NT > 1) { VMW(); SWRITE_H(1); }
    __syncthreads();
#define HALF_STEP(PX0, PX1, PY0, PY1, t, KB, VB, SB) do {                                                      \
        SBAR(); MREQ(t); qkt<KB>(PX0, PX1, K_lds, r32, hi, S.qr, ninit);                                             \
        finishSM(PY0, PY1, l_reg, pa0, pa1, pa2, pa3); SBAR();                                                           \
        if ((t) + 1 < NT) { SLOAD_H(Kh, KBASE((t) + 1)); SBAR(); }                                               \
        pv_tile<VB>(o, vb0, pa0, pa1, pa2, pa3); MASKT(PX0, PX1, (t));                                        \
        __syncthreads();                                                                                                      \
        if ((t) + 1 < NT) { VMW(); SWRITE_H(SB); }                                                                          \
        __syncthreads(); } while (0)
    for (int t = 1; t + 1 < NT; t += 2) {
        HALF_STEP(pB0, pB1, pA0, pA1, t, 1, 0, 0);
        HALF_STEP(pA0, pA1, pB0, pB1, t + 1, 0, 1, 1);
    }
    MREQ(NT - 1);
    SBAR(); qkt<1>(pB0, pB1, K_lds, r32, hi, S.qr, ninit); SBAR();
    SLOAD_H(nxt.K, 0); SBAR();
#pragma unroll
    for (int d0 = 0; d0 < 8; ++d0) S.qr[d0] = load8(nxt.Q + (size_t)(wid * QBLK + r32) * ZP + d0 * 16 + hi * 8);
    SBAR();
    finishSM(pA0, pA1, l_reg, pa0, pa1, pa2, pa3); SBAR();
    pv_tile<0>(o, vb0, pa0, pa1, pa2, pa3);
    MASKT(pB0, pB1, NT - 1); __syncthreads();
    finishSM(pB0, pB1, l_reg, pa0, pa1, pa2, pa3); SBAR(); pv_tile<1>(o, vb0, pa0, pa1, pa2, pa3);
    SBAR(); SEAM_K0();
    { auto rr = __builtin_amdgcn_permlane32_swap(__float_as_uint(l_reg), __float_as_uint(l_reg), false, false); l_reg = __uint_as_float(rr[0]) + __uint_as_float(rr[1]); }
    if (hi == 0) li_l[r32] = l_reg; asm volatile("s_waitcnt lgkmcnt(0)" ::: "memory");
    float rli[16];
#pragma unroll
    for (int r = 0; r < 16; ++r) rli[r] = __builtin_amdgcn_rcpf(fmaxf(li_l[crow(r, hi)], 1e-37f));
    unsigned char* Ow = cur.O + (size_t)(wid * QBLK) * 1024;
#pragma unroll
    for (int r = 0; r < 16; ++r) { const int orow = crow(r, hi);
#pragma unroll
        for (int d0 = 0; d0 < 4; ++d0) { const float v = o[d0][r] * rli[r] * 16.0f;
            const float v1 = DPP_F(v, 0x55), v2 = DPP_F(v, 0xAA), v3 = DPP_F(v, 0xFF);
            if ((r32 & 3) == 0) *(unsigned*)(Ow + (size_t)orow * 1024 + d0 * 32 + r32) = pk4_fp8(v, v1, v2, v3); } }
    __syncthreads();
#undef KBASE
#undef LUTB
#undef MASKT
#undef MREQ
#undef SEAM_K0
#undef HALF_STEP
}
#undef ROW
#undef VMW
#undef VMWN
#undef SLOAD_H
#undef SWRITE_HK
#undef SWRITE_HV
#undef SWRITE_H
#undef MLOAD
__device__ __forceinline__ BlockRef make_ref(int L, int pass, const bf16* Z, unsigned char* OB, const unsigned* BT) {
    const int bh = L >> 4, x = L & 15, b = bh >> 3, h = bh & 7, qb = pass ? 31 - x : x;
    BlockRef r; const size_t row0 = (size_t)b * SEQ + (size_t)qb * QB;
    r.Q = Z + row0 * ZP + ZC_DQ + h * AD; r.K = Z + (size_t)b * SEQ * ZP + ZC_DK + h * AD;
    r.O = OB + row0 * 1024 + h * AD; r.bt = BT + (size_t)(b * 256 + qb * 8) * (128 * 64); r.P0 = qb * QB; r.h = h; return r;
}
__device__ __forceinline__ int t5_bucket(int rel) {
    const int n = rel < 0 ? -rel : rel; int bk;
    if (n < 8) bk = n; else if (n < 12) bk = 8; else if (n < 16) bk = 9; else if (n < 23) bk = 10; else if (n < 32) bk = 11; else if (n < 46) bk = 12; else if (n < 64) bk = 13; else if (n < 91) bk = 14; else bk = 15;
    return (rel > 0 ? 16 : 0) + bk;
}
__device__ __forceinline__ BlockRef make_ref_blk(int i, const bf16* Z, unsigned char* OB, const unsigned* BT) {
    const int bh = i & 31, b = bh >> 3, h = bh & 7, qb = 31 - (i >> 5);
    BlockRef r; const size_t row0 = (size_t)b * SEQ + (size_t)qb * QB;
    r.Q = Z + row0 * ZP + ZC_DQ + h * AD; r.K = Z + (size_t)b * SEQ * ZP + ZC_DK + h * AD;
    r.O = OB + row0 * 1024 + h * AD; r.bt = BT + (size_t)(b * 256 + qb * 8) * (128 * 64); r.P0 = qb * QB; r.h = h; return r;
}
__device__ __forceinline__ int q_fetch(char* lds, gu32* qhead, int slot) {
    if (opaque_tid() == 0) { const unsigned v = __hip_atomic_fetch_add(qhead, 1u, RLX_AGENT); ((volatile unsigned*)(lds + QI_OFF))[slot] = v; }
    __syncthreads();
    return __builtin_amdgcn_readfirstlane((int)((volatile unsigned*)(lds + QI_OFF))[slot]);
}
__device__ __forceinline__ void attn_phase(char* lds, const bf16* Z, unsigned char* OB, const unsigned* BT, const float* rel_bias, const float* qg, const float* kg, gu32* qhead) {
    constexpr float L2E = 1.4426950408889634f;
    { float* lut = (float*)(lds + LUT_OFF);
      const int tid = opaque_tid();
      for (int i = tid; i < 8 * 256; i += 512) { const int h = i >> 8, rel = (i & 255) - 191; lut[i] = (rel_bias[t5_bucket(rel) * 8 + h] - rel_bias[15 * 8 + h]) * L2E; }
      if (tid < 64) { const int l = tid;
          float mq = fmaxf(fabsf(qg[l]), fabsf(qg[l + 64])), mk = fmaxf(fabsf(kg[l]), fabsf(kg[l + 64]));
          mq = wave_max(mq); mk = wave_max(mk);
          if (l < 8) { float mb = 0.f; for (int bk = 0; bk < 32; ++bk) mb = fmaxf(mb, rel_bias[bk * 8 + l] - rel_bias[15 * 8 + l]);
              ((float*)(lds + NM_OFF))[l] = -(11.313708498984761f * mq * mk + mb) * L2E; } } }
    asm volatile("" : "+s"(BT));
    __syncthreads();
    constexpr int total = NB * 8 * 32;
    const int i0 = q_fetch(lds, qhead, 0); if (i0 >= total) return;
    int i1 = q_fetch(lds, qhead, 1), slot = 0;
    BlockRef cur = make_ref_blk(i0, Z, OB, BT);
    Seam S;
    prime(cur, lds, S);
    for (;;) {
        const bool last = i1 >= total;
        const BlockRef nxt = last ? cur : make_ref_blk(i1, Z, OB, BT);
        block(cur, nxt, lds, S);
        if (last) break;
        cur = nxt; i1 = q_fetch(lds, qhead, slot); slot ^= 1;
    }
}
}

constexpr int RING_OFF = 0, RING_BYTES = 131072;
constexpr int LDSCTL_OFF = RING_BYTES, MISC_OFF = LDSCTL_OFF + 320;
constexpr int LDS_BYTES = 147456;

struct Frame {
    LAS unsigned char* lds;
    volatile LAS unsigned* MISC;
    gu32* ctl;
    int tid, lane, wave, vcu, G;
};

template <int MAP> __device__ __forceinline__ int rowmap(int n) {
    if (MAP == 0) return n;
    if (MAP == 1) {
        if (n < 1024) return n;
        if (n < 3072) return -1;
        if (n < 3088) return ZC_GLR - 2048 + (n - 3072);
        if (n < 6160) return -1;
        if (n < 7184) return ZC_IQ - 2048 + (n - 6160);
        if (n < 7248) return ZC_IK - 2048 + (n - 7184);
        return ZC_IW - 2048 + (n - 7248);
    }
    if (MAP == 4) return (n >= 1024 && n < 3072) ? n - 1024 : (n >= 3088 && n < 6160) ? n - 3088 + 2048 : -1;
    if (MAP == 2) { const int half = n >> 11, c = n & 2047; return (c >> 7) * 256 + half * 128 + (c & 127); }
    if (MAP == 3) return (n >> 7) * 256 + (n & 127);
    return n;
}
template <int MAP>
__device__ __forceinline__ void p0_transpose_item(const float* W, int K, int N, bf16* WT, int row_off, LAS float* scr, int item, int lane) {
    const int nblk = N / 32, kb = item / nblk, nb = item % nblk, k0 = 64 * kb, n0 = 32 * nb;
#pragma unroll 8
    for (int i = 0; i < 32; ++i) { const int kk = 2 * i + (lane >> 5); scr[kk * 33 + (lane & 31)] = W[(size_t)(k0 + kk) * N + n0 + (lane & 31)]; }
    LDS_WAIT(); asm volatile("" ::: "memory");
    const int c = lane & 7;
#pragma unroll
    for (int j = 0; j < 4; ++j) { const int n = (lane >> 3) + 8 * j; const LAS float* s = scr + (8 * c) * 33 + n;
        v4u o; o.x = pk2(s[0 * 33], s[1 * 33]); o.y = pk2(s[2 * 33], s[3 * 33]); o.z = pk2(s[4 * 33], s[5 * 33]); o.w = pk2(s[6 * 33], s[7 * 33]);
        const int rm = rowmap<MAP>(n0 + n); if (rm >= 0) *(GAS v4u*)(WT + (size_t)(row_off + rm) * K + k0 + 8 * c) = o; }
    LDS_WAIT(); asm volatile("" ::: "memory");
}
template <int MAP>
__device__ __forceinline__ void p0_transpose_item8(const float* W, int K, int N, unsigned char* WT, int row_off, LAS float* scr, int item, int lane, float scale) {
    const int nblk = N / 32, kb = item / nblk, nb = item % nblk, k0 = 64 * kb, n0 = 32 * nb;
#pragma unroll 8
    for (int i = 0; i < 32; ++i) { const int kk = 2 * i + (lane >> 5); scr[kk * 33 + (lane & 31)] = W[(size_t)(k0 + kk) * N + n0 + (lane & 31)] * scale; }
    LDS_WAIT(); asm volatile("" ::: "memory");
    const int c = lane & 3;
#pragma unroll
    for (int j = 0; j < 2; ++j) { const int n = (lane >> 2) + 16 * j; const LAS float* sp = scr + (16 * c) * 33 + n;
        v4u o; o.x = pk4_fp8(sp[0 * 33], sp[1 * 33], sp[2 * 33], sp[3 * 33]); o.y = pk4_fp8(sp[4 * 33], sp[5 * 33], sp[6 * 33], sp[7 * 33]);
        o.z = pk4_fp8(sp[8 * 33], sp[9 * 33], sp[10 * 33], sp[11 * 33]); o.w = pk4_fp8(sp[12 * 33], sp[13 * 33], sp[14 * 33], sp[15 * 33]);
        const int rm = rowmap<MAP>(n0 + n); if (rm >= 0) *(GAS v4u*)(WT + (size_t)(row_off + rm) * K + k0 + 16 * c) = o; }
    LDS_WAIT(); asm volatile("" ::: "memory");
}
constexpr int CONV_MOD = 6, CONV_DEPTH = 3;
template <int MAP>
__device__ __forceinline__ void conv_stream8(const float* W, int K, int N, unsigned char* WT, int erows, int row_add, LAS float* scr, int lane, int cw, int NCW) {
    const int nblk = N / 32, per_e = (K / 64) * nblk, total = NEXP * per_e;
    const int lr = lane >> 3, lc = (lane & 7) * 4;
    if (cw >= total) return;
    const int n_my = (total - cw + NCW - 1) / NCW, it_last = cw + (n_my - 1) * NCW;
    f32x4 v[CONV_DEPTH][8];
#define CONV_IT(j_) min(cw + (j_) * NCW, it_last)
#define CONV_LOAD(d_, it_) do { const int e_ = (it_) / per_e, r_ = (it_) - e_ * per_e, kb_ = r_ / nblk, nb_ = r_ - kb_ * nblk; \
        const float* s_ = W + (size_t)e_ * K * N + (size_t)(64 * kb_ + lr) * N + 32 * nb_ + lc; \
        _Pragma("unroll") for (int i = 0; i < 8; ++i) v[d_][i] = __builtin_nontemporal_load((const f32x4*)(s_ + (size_t)(8 * i) * N)); } while (0)
#pragma unroll
    for (int d = 0; d < CONV_DEPTH; ++d) { CONV_LOAD(d, CONV_IT(d)); asm volatile("" ::: "memory"); __builtin_amdgcn_sched_barrier(0); }
    for (int j0 = 0; j0 < n_my; j0 += CONV_DEPTH) {
#pragma unroll
        for (int d = 0; d < CONV_DEPTH; ++d) {
            const int it = CONV_IT(j0 + d);
            const int e = it / per_e, r = it - e * per_e, kb = r / nblk, nb = r - kb * nblk, k0 = 64 * kb, n0 = 32 * nb;
#pragma unroll
            for (int i = 0; i < 8; ++i) { LAS float* dd = scr + (8 * i + lr) * 33 + lc; dd[0] = v[d][i].x; dd[1] = v[d][i].y; dd[2] = v[d][i].z; dd[3] = v[d][i].w; }
            CONV_LOAD(d, CONV_IT(j0 + d + CONV_DEPTH));
            LDS_WAIT(); asm volatile("" ::: "memory");
            const int c = lane & 3;
#pragma unroll
            for (int j = 0; j < 2; ++j) { const int n = (lane >> 2) + 16 * j; const LAS float* sp = scr + (16 * c) * 33 + n;
                v4u o; o.x = pk4_fp8(32.f * sp[0 * 33], 32.f * sp[1 * 33], 32.f * sp[2 * 33], 32.f * sp[3 * 33]); o.y = pk4_fp8(32.f * sp[4 * 33], 32.f * sp[5 * 33], 32.f * sp[6 * 33], 32.f * sp[7 * 33]);
                o.z = pk4_fp8(32.f * sp[8 * 33], 32.f * sp[9 * 33], 32.f * sp[10 * 33], 32.f * sp[11 * 33]); o.w = pk4_fp8(32.f * sp[12 * 33], 32.f * sp[13 * 33], 32.f * sp[14 * 33], 32.f * sp[15 * 33]);
                __builtin_nontemporal_store(o, (GAS v4u*)(WT + (size_t)(e * erows + row_add + rowmap<MAP>(n0 + n)) * K + k0 + 16 * c)); }
            LDS_WAIT(); asm volatile("" ::: "memory");
        }
    }
#undef CONV_LOAD
#undef CONV_IT
}
__device__ __forceinline__ void p0_transpose_item_win(const float* W, bf16* WT, unsigned char* WT8, LAS float* scr, int item, int lane) {
    constexpr int K = D, N = 7264;
    const int nblk = N / 32, kb = item / nblk, nb = item % nblk, k0 = 64 * kb, n0 = 32 * nb;
#pragma unroll 8
    for (int i = 0; i < 32; ++i) { const int kk = 2 * i + (lane >> 5); scr[kk * 33 + (lane & 31)] = W[(size_t)(k0 + kk) * N + n0 + (lane & 31)]; }
    LDS_WAIT(); asm volatile("" ::: "memory");
    { const int c = lane & 7;
#pragma unroll
      for (int j = 0; j < 4; ++j) { const int n = (lane >> 3) + 8 * j; const LAS float* sp = scr + (8 * c) * 33 + n; const int rm = rowmap<1>(n0 + n);
        if (rm >= 0) { v4u o; o.x = pk2(sp[0 * 33], sp[1 * 33]); o.y = pk2(sp[2 * 33], sp[3 * 33]); o.z = pk2(sp[4 * 33], sp[5 * 33]); o.w = pk2(sp[6 * 33], sp[7 * 33]);
            *(GAS v4u*)(WT + (size_t)rm * K + k0 + 8 * c) = o; } } }
    { const int c = lane & 3;
#pragma unroll
      for (int j = 0; j < 2; ++j) { const int n = (lane >> 2) + 16 * j; const LAS float* sp = scr + (16 * c) * 33 + n; const int rm = rowmap<4>(n0 + n);
        if (rm >= 0) { v4u o; o.x = pk4_fp8(32.f * sp[0 * 33], 32.f * sp[1 * 33], 32.f * sp[2 * 33], 32.f * sp[3 * 33]); o.y = pk4_fp8(32.f * sp[4 * 33], 32.f * sp[5 * 33], 32.f * sp[6 * 33], 32.f * sp[7 * 33]);
            o.z = pk4_fp8(32.f * sp[8 * 33], 32.f * sp[9 * 33], 32.f * sp[10 * 33], 32.f * sp[11 * 33]); o.w = pk4_fp8(32.f * sp[12 * 33], 32.f * sp[13 * 33], 32.f * sp[14 * 33], 32.f * sp[15 * 33]);
            *(GAS v4u*)(WT8 + (size_t)rm * K + k0 + 16 * c) = o; } } }
    LDS_WAIT(); asm volatile("" ::: "memory");
}
__device__ __forceinline__ void rms_row_to_bf16(int lane, const float* xrow, const float* g, bf16* orow, unsigned char* orow8 = nullptr) {
    const GAS f32x4* xr = (const GAS f32x4*)xrow + lane;
    f32x4 v[8]; float s = 0.f;
#pragma unroll
    for (int j = 0; j < 8; ++j) { v[j] = xr[64 * j]; s += (v[j].x * v[j].x + v[j].y * v[j].y) + (v[j].z * v[j].z + v[j].w * v[j].w); }
    const float rstd = 1.0f / sqrtf(wave_sum(s) * (1.f / D) + EPS);
    GAS unsigned long long* o8 = (GAS unsigned long long*)orow + lane;
#pragma unroll
    for (int j = 0; j < 8; ++j) { const f32x4 gg = ((const GAS f32x4*)g)[64 * j + lane];
        o8[64 * j] = (unsigned long long)pk2(v[j].x * rstd * gg.x, v[j].y * rstd * gg.y) | ((unsigned long long)pk2(v[j].z * rstd * gg.z, v[j].w * rstd * gg.w) << 32);
        if (orow8) ((GAS unsigned*)orow8)[64 * j + lane] = pk4_fp8(v[j].x * rstd * gg.x, v[j].y * rstd * gg.y, v[j].z * rstd * gg.z, v[j].w * rstd * gg.w); }
}

#ifndef MK_DSA
#define MK_DSA 1
#endif
#ifndef MK_MOE
#define MK_MOE 1
#endif
#ifndef MK_GLA
#define MK_GLA 1
#endif
constexpr int PREF_OFF = LDSCTL_OFF, CNTL_OFF = MISC_OFF + 128;
__device__ __forceinline__ void rms_row_bf(int lane, const bf16* xrow, const float* g, bf16* orow, unsigned char* orow8) {
    const GAS v4u* xr = (const GAS v4u*)xrow + lane;
    v4u w[4]; float s = 0.f;
#pragma unroll
    for (int j = 0; j < 4; ++j) { w[j] = xr[64 * j];
        const float a0 = bflo(w[j].x), a1 = bfhi(w[j].x), a2 = bflo(w[j].y), a3 = bfhi(w[j].y), a4 = bflo(w[j].z), a5 = bfhi(w[j].z), a6 = bflo(w[j].w), a7 = bfhi(w[j].w);
        s += ((a0 * a0 + a1 * a1) + (a2 * a2 + a3 * a3)) + ((a4 * a4 + a5 * a5) + (a6 * a6 + a7 * a7)); }
    const float rstd = 1.0f / sqrtf(wave_sum(s) * (1.f / D) + EPS);
#pragma unroll
    for (int j = 0; j < 4; ++j) { const f32x4 g0 = ((const GAS f32x4*)g)[2 * (64 * j + lane)], g1 = ((const GAS f32x4*)g)[2 * (64 * j + lane) + 1];
        const float a0 = bflo(w[j].x) * rstd * g0.x, a1 = bfhi(w[j].x) * rstd * g0.y, a2 = bflo(w[j].y) * rstd * g0.z, a3 = bfhi(w[j].y) * rstd * g0.w;
        const float a4 = bflo(w[j].z) * rstd * g1.x, a5 = bfhi(w[j].z) * rstd * g1.y, a6 = bflo(w[j].w) * rstd * g1.z, a7 = bfhi(w[j].w) * rstd * g1.w;
        v4u o; o.x = pk2(a0, a1); o.y = pk2(a2, a3); o.z = pk2(a4, a5); o.w = pk2(a6, a7);
        ((GAS v4u*)orow)[64 * j + lane] = o;
        v2u o8; o8.x = pk4_fp8(a0, a1, a2, a3); o8.y = pk4_fp8(a4, a5, a6, a7);
        ((GAS v2u*)orow8)[64 * j + lane] = o8; }
}
__device__ __forceinline__ void combine_row_bf(int lane, const bf16* x1, const bf16* y0, const bf16* y1, const float* g, bf16* x2, unsigned char* orow8) {
    float v[4][8]; float s = 0.f;
#pragma unroll
    for (int j = 0; j < 4; ++j) { const v4u w = ((const GAS v4u*)x1)[64 * j + lane];
        v[j][0] = bflo(w.x); v[j][1] = bfhi(w.x); v[j][2] = bflo(w.y); v[j][3] = bfhi(w.y); v[j][4] = bflo(w.z); v[j][5] = bfhi(w.z); v[j][6] = bflo(w.w); v[j][7] = bfhi(w.w);
#if MK_MOE
        const v4u a = ((const GAS v4u*)y0)[64 * j + lane], b = ((const GAS v4u*)y1)[64 * j + lane];
        v[j][0] += bflo(a.x) + bflo(b.x); v[j][1] += bfhi(a.x) + bfhi(b.x); v[j][2] += bflo(a.y) + bflo(b.y); v[j][3] += bfhi(a.y) + bfhi(b.y);
        v[j][4] += bflo(a.z) + bflo(b.z); v[j][5] += bfhi(a.z) + bfhi(b.z); v[j][6] += bflo(a.w) + bflo(b.w); v[j][7] += bfhi(a.w) + bfhi(b.w);
#endif
        v4u o; o.x = pk2(v[j][0], v[j][1]); o.y = pk2(v[j][2], v[j][3]); o.z = pk2(v[j][4], v[j][5]); o.w = pk2(v[j][6], v[j][7]);
        ((GAS v4u*)x2)[64 * j + lane] = o;
        v[j][0] = bflo(o.x); v[j][1] = bfhi(o.x); v[j][2] = bflo(o.y); v[j][3] = bfhi(o.y); v[j][4] = bflo(o.z); v[j][5] = bfhi(o.z); v[j][6] = bflo(o.w); v[j][7] = bfhi(o.w);
#pragma unroll
        for (int q = 0; q < 8; ++q) s += v[j][q] * v[j][q]; }
    const float rstd = 1.0f / sqrtf(wave_sum(s) * (1.f / D) + EPS);
#pragma unroll
    for (int j = 0; j < 4; ++j) { const f32x4 g0 = ((const GAS f32x4*)g)[2 * (64 * j + lane)], g1 = ((const GAS f32x4*)g)[2 * (64 * j + lane) + 1];
        v2u o8; o8.x = pk4_fp8(v[j][0] * rstd * g0.x, v[j][1] * rstd * g0.y, v[j][2] * rstd * g0.z, v[j][3] * rstd * g0.w);
        o8.y = pk4_fp8(v[j][4] * rstd * g1.x, v[j][5] * rstd * g1.y, v[j][6] * rstd * g1.z, v[j][7] * rstd * g1.w);
        ((GAS v2u*)orow8)[64 * j + lane] = o8; }
}
__device__ __forceinline__ void combine_row(int lane, float* xio, const bf16* y0, const bf16* y1, const float* g, unsigned char* orow8) {
    GAS f32x4* xr = (GAS f32x4*)xio + lane;
    f32x4 v[8]; float s = 0.f;
#pragma unroll
    for (int j = 0; j < 8; ++j) { v[j] = xr[64 * j];
#if MK_MOE
        const v2u a = ((const GAS v2u*)y0)[64 * j + lane], b = ((const GAS v2u*)y1)[64 * j + lane];
        v[j].x += bflo(a.x) + bflo(b.x); v[j].y += bfhi(a.x) + bfhi(b.x); v[j].z += bflo(a.y) + bflo(b.y); v[j].w += bfhi(a.y) + bfhi(b.y);
#endif
        s += (v[j].x * v[j].x + v[j].y * v[j].y) + (v[j].z * v[j].z + v[j].w * v[j].w); }
    const float rstd = 1.0f / sqrtf(wave_sum(s) * (1.f / D) + EPS);
#pragma unroll
    for (int j = 0; j < 8; ++j) { const f32x4 gg = ((const GAS f32x4*)g)[64 * j + lane];
        xr[64 * j] = v[j];
        ((GAS unsigned*)orow8)[64 * j + lane] = pk4_fp8(v[j].x * rstd * gg.x, v[j].y * rstd * gg.y, v[j].z * rstd * gg.z, v[j].w * rstd * gg.w); }
}

struct Args { const float* in[27]; float* out; unsigned char* ws; int ph_lo, ph_hi; };
#define AS4 __attribute__((address_space(4)))

constexpr int P0_I_IN = (D / 64) * (7264 / 32), P0_I_BG = (D / 64) * (4096 / 32), P0_I_OG = (1024 / 64) * (D / 32), P0_I_O = (D / 64) * (D / 32), P0_I_PP = (PLE / 64) * (D / 32);
constexpr int P0_NITEMS = P0_I_IN + P0_I_BG + 2 * P0_I_OG + 2 * P0_I_O + P0_I_PP, P0_DEPTH = 3;
struct P0Item { const float* src; int N, kind, K, k0, n0; unsigned char* dst; };
__device__ __forceinline__ P0Item p0_decode(int r, const AS4 Args* ap, unsigned char* ws) {
    P0Item t; const float* W; int nblk;
    if (r < P0_I_IN) { W = ap->in[3]; t.N = 7264; t.K = D; t.kind = 0; t.dst = ws + WS_WIN; }
    else if ((r -= P0_I_IN) < P0_I_BG) { W = ap->in[12]; t.N = 4096; t.K = D; t.kind = 3; t.dst = ws + WS_WBG8; }
    else if ((r -= P0_I_BG) < P0_I_OG) { W = ap->in[7]; t.N = D; t.K = 1024; t.kind = 1; t.dst = ws + WS_WOG; }
    else if ((r -= P0_I_OG) < P0_I_OG) { W = ap->in[11]; t.N = D; t.K = 1024; t.kind = 2; t.dst = ws + WS_WOD8; }
    else if ((r -= P0_I_OG) < P0_I_O) { W = ap->in[14]; t.N = D; t.K = D; t.kind = 2; t.dst = ws + WS_WO8; }
    else if ((r -= P0_I_O) < P0_I_O) { W = ap->in[24]; t.N = D; t.K = D; t.kind = 2; t.dst = ws + WS_WPG8; }
    else { r -= P0_I_O; W = ap->in[26]; t.N = D; t.K = PLE; t.kind = 1; t.dst = ws + WS_WPP; }
    nblk = t.N / 32; const int kb = r / nblk, nb = r - kb * nblk; t.k0 = 64 * kb; t.n0 = 32 * nb;
    t.src = W + (size_t)t.k0 * t.N + t.n0; return t;
}
__device__ __forceinline__ void p0_emit(const P0Item& t, LAS float* scr, int lane) {
    if (t.kind == 1 || t.kind == 0) { const int c = lane & 7; bf16* WT = (bf16*)t.dst;
#pragma unroll
        for (int j = 0; j < 4; ++j) { const int n = (lane >> 3) + 8 * j; const LAS float* sp = scr + (8 * c) * 33 + n; const int rm = t.kind == 0 ? rowmap<1>(t.n0 + n) : t.n0 + n;
            if (rm >= 0) { v4u o; o.x = pk2(sp[0 * 33], sp[1 * 33]); o.y = pk2(sp[2 * 33], sp[3 * 33]); o.z = pk2(sp[4 * 33], sp[5 * 33]); o.w = pk2(sp[6 * 33], sp[7 * 33]);
                *(GAS v4u*)(WT + (size_t)rm * t.K + t.k0 + 8 * c) = o; } } }
    if (t.kind != 1) { const int c = lane & 3; unsigned char* WT8 = t.kind == 0 ? t.dst + (WS_WIN8 - WS_WIN) : t.dst;
#pragma unroll
        for (int j = 0; j < 2; ++j) { const int n = (lane >> 2) + 16 * j; const LAS float* sp = scr + (16 * c) * 33 + n;
            const int rm = t.kind == 0 ? rowmap<4>(t.n0 + n) : t.kind == 3 ? rowmap<2>(t.n0 + n) : t.n0 + n;
            if (rm >= 0) { v4u o; o.x = pk4_fp8(32.f * sp[0 * 33], 32.f * sp[1 * 33], 32.f * sp[2 * 33], 32.f * sp[3 * 33]); o.y = pk4_fp8(32.f * sp[4 * 33], 32.f * sp[5 * 33], 32.f * sp[6 * 33], 32.f * sp[7 * 33]);
                o.z = pk4_fp8(32.f * sp[8 * 33], 32.f * sp[9 * 33], 32.f * sp[10 * 33], 32.f * sp[11 * 33]); o.w = pk4_fp8(32.f * sp[12 * 33], 32.f * sp[13 * 33], 32.f * sp[14 * 33], 32.f * sp[15 * 33]);
                *(GAS v4u*)(WT8 + (size_t)rm * t.K + t.k0 + 16 * c) = o; } } }
}
__device__ __forceinline__ void p0_weight_stream(const AS4 Args* ap, unsigned char* ws, LAS float* scr, int lane, int gw, int NGW) {
    if (gw >= P0_NITEMS) return;
    const int n_my = (P0_NITEMS - gw + NGW - 1) / NGW, it_last = gw + (n_my - 1) * NGW;
    const int lr = lane >> 3, lc = (lane & 7) * 4;
    f32x4 v[P0_DEPTH][8];
#define P0_IT(j_) min(gw + (j_) * NGW, it_last)
#define P0_LOAD(d_, it_) do { const P0Item q_ = p0_decode((it_), ap, ws); const float* s_ = q_.src + (size_t)lr * q_.N + lc; \
        _Pragma("unroll") for (int i = 0; i < 8; ++i) v[d_][i] = *(const f32x4*)(s_ + (size_t)(8 * i) * q_.N); } while (0)
#pragma unroll
    for (int d = 0; d < P0_DEPTH; ++d) { P0_LOAD(d, P0_IT(d)); asm volatile("" ::: "memory"); __builtin_amdgcn_sched_barrier(0); }
    for (int j0 = 0; j0 < n_my; j0 += P0_DEPTH) {
#pragma unroll
        for (int d = 0; d < P0_DEPTH; ++d) {
            const P0Item t = p0_decode(P0_IT(j0 + d), ap, ws);
#pragma unroll
            for (int i = 0; i < 8; ++i) { LAS float* dd = scr + (8 * i + lr) * 33 + lc; dd[0] = v[d][i].x; dd[1] = v[d][i].y; dd[2] = v[d][i].z; dd[3] = v[d][i].w; }
            P0_LOAD(d, P0_IT(j0 + d + P0_DEPTH));
            LDS_WAIT(); asm volatile("" ::: "memory");
            p0_emit(t, scr, lane);
            LDS_WAIT(); asm volatile("" ::: "memory");
        }
    }
#undef P0_LOAD
#undef P0_IT
}

#define PHASE_LOCALS \
    const AS4 Args* ap = (const AS4 Args*)__builtin_amdgcn_kernarg_segment_ptr(); asm volatile("" : "+s"(ap)); \
    unsigned char* const ws = ap->ws; int tid_o = threadIdx.x; asm volatile("" : "+v"(tid_o)); \
    Frame F; F.lds = (LAS unsigned char*)lds_raw; F.MISC = (volatile LAS unsigned*)(F.lds + MISC_OFF); F.ctl = (gu32*)(ws + WS_CTL); \
    F.tid = tid_o; F.lane = tid_o & 63; F.wave = __builtin_amdgcn_readfirstlane(tid_o >> 6); F.G = gridDim.x; \
    { const int bx = blockIdx.x; F.vcu = (F.G % 8 == 0) ? (bx % 8) * (F.G / 8) + bx / 8 : bx; } \
    const int gw = F.vcu * NWAVES + F.wave, NGW = F.G * NWAVES; const int gt = blockIdx.x * 512 + F.tid, NGT = F.G * 512; \
    bf16* const HB = (bf16*)(ws + WS_HB); bf16* const ZB = (bf16*)(ws + WS_ZB); \
    LAS unsigned char* const wl = F.lds + RING_OFF + F.wave * 16384; \
    (void)gw; (void)NGW; (void)gt; (void)NGT; (void)HB; (void)ZB; (void)wl;
#ifndef MK_DBL
#define MK_DBL 0
#endif
#define REP2 for (int rep_ = 0; rep_ < 2; ++rep_)
#if (MK_DBL >> 0) & 1
#define REP_0 REP2
#else
#define REP_0
#endif
#if (MK_DBL >> 1) & 1
#define REP_1 REP2
#else
#define REP_1
#endif
#if (MK_DBL >> 2) & 1
#define REP_2 REP2
#else
#define REP_2
#endif
#if (MK_DBL >> 3) & 1
#define REP_3 REP2
#else
#define REP_3
#endif
#if (MK_DBL >> 4) & 1
#define REP_4 REP2
#else
#define REP_4
#endif
#if (MK_DBL >> 5) & 1
#define REP_5 REP2
#else
#define REP_5
#endif
#if (MK_DBL >> 6) & 1
#define REP_6 REP2
#else
#define REP_6
#endif
#if (MK_DBL >> 7) & 1
#define REP_7 REP2
#else
#define REP_7
#endif
#if (MK_DBL >> 8) & 1
#define REP_8 REP2
#else
#define REP_8
#endif
#if (MK_DBL >> 9) & 1
#define REP_9 REP2
#else
#define REP_9
#endif
#if (MK_DBL >> 10) & 1
#define REP_10 REP2
#else
#define REP_10
#endif
#if (MK_DBL >> 11) & 1
#define REP_11 REP2
#else
#define REP_11
#endif
#if (MK_DBL >> 12) & 1
#define REP_12 REP2
#else
#define REP_12
#endif
#if (MK_DBL >> 13) & 1
#define REP_13 REP2
#else
#define REP_13
#endif
#if (MK_DBL >> 14) & 1
#define REP_14 REP2
#else
#define REP_14
#endif
#define REP(k) REP_##k
#define IN(k) (ap->in[k])
#define GRID_BAR() do { XcdBarrier bb_; bb_.bar = (unsigned*)(F.ctl + CW_BAR); bb_.x = xb_xcc_id(); bb_.st = F.MISC + 8; xcd_barrier(bb_); } while (0)

__global__ void __launch_bounds__(NWAVES * 64, 2) mk_fwd(Args args) {
    extern __shared__ __attribute__((aligned(16))) unsigned char lds_raw[];
    (void)args;
    {
        PHASE_LOCALS
        for (int u = F.tid; u < (LDS_BYTES - LDSCTL_OFF) / 4; u += NWAVES * 64) ((LAS unsigned*)(F.lds + LDSCTL_OFF))[u] = 0u;
        __syncthreads();
        (void)xcd_barrier_post((unsigned*)(F.ctl + CW_BAR), F.MISC + 8);
    }
    REP(0)
    {
        PHASE_LOCALS
        LAS float* scr = (LAS float*)wl;
        constexpr int I_IN = (D / 64) * (7264 / 32), I_BG = (D / 64) * (4096 / 32), I_OG = (1024 / 64) * (D / 32), I_O = (D / 64) * (D / 32), I_PP = (PLE / 64) * (D / 32);
        constexpr int NITEMS = I_IN + I_BG + 2 * I_OG + 2 * I_O + I_PP;
        for (int it = gw; it < I_IN; it += NGW) p0_transpose_item_win(IN(3), (bf16*)(ws + WS_WIN), ws + WS_WIN8, scr, it, F.lane);
        { GAS v4u* z = (GAS v4u*)((bf16*)(ws + WS_WIN) + (size_t)(ZC_IW + 16 - 2048) * D);
          for (int i = gt; i < 160 * D * 2 / 16; i += NGT) z[i] = (v4u){0u, 0u, 0u, 0u}; }
        { bf16* wr = (bf16*)(ws + WS_WR); const float* wg = IN(16); const float* we = IN(18);
          for (int i = gt; i < 256 * D; i += NGT) { const int n = i >> 11, k = i & 2047; const float v = n < 8 ? wg[k * 8 + n] : (n < 72 ? we[k * 64 + (n - 8)] : 0.f); wr[i] = (bf16)f2bf(v); } }
        for (int m = gw; m < T; m += NGW) rms_row_to_bf16(F.lane, IN(0) + (size_t)m * D, IN(2), HB + (size_t)m * D, (unsigned char*)ap->out + (size_t)m * D);
        GRID_BAR();
    }
    REP(1)
    {
        PHASE_LOCALS
        { pg8::StaticOrder S; S.init(T, ZN_A - 2048, F.G, (int)blockIdx.x);
          pg8::Gemm g{HB, (const bf16*)(ws + WS_WIN), D};
          pg8::EpiBf16Skip E{ZB, ZP, 4, 2048};
          pg8::gemm_phase<pg8::EpiBf16Skip, pg8::StaticOrder>(F.lds + RING_OFF, g, S, E); }
        { pg8::StaticOrder S; S.init(T, 5120, F.G, (int)blockIdx.x);
          pg8::Gemm8 g{(const unsigned char*)ap->out, ws + WS_WIN8, D / 2, 0x7f7f7f7f, 0x7a7a7a7a};
          pg8::EpiBf16Skip E{ZB + 1024, ZP, 8, ZN_A - 3072};
          pg8::gemm_phase8<pg8::EpiBf16Skip, pg8::StaticOrder>(F.lds + RING_OFF, g, S, E); }
        GRID_BAR();
    }
    REP(2)
    {
        PHASE_LOCALS
#if MK_GLA
        for (int task = blockIdx.x; task < NB * 128; task += F.G) {
            gla_prep_task(F.lds, ZB, IN(4), IN(5), (float*)(ws + WS_DEC), task);
            gla_local_unit(F.lds, F.wave, F.lane, ZB, (const float*)(ws + WS_DEC), (float*)(ws + WS_SLOC), task * 8 + F.wave);
            __syncthreads();
        }
#endif
        for (int m = gw; m < T; m += NGW) dsa_prep_row(F.lane, ZB, (size_t)m, IN(8), IN(9), (bf16*)(ws + WS_IKC), (float*)(ws + WS_UW));
        GRID_BAR();
    }
    REP(3)
    {
        PHASE_LOCALS
#if MK_GLA
        gla_scan((const float*)(ws + WS_SLOC), (const float*)(ws + WS_DEC), (bf16*)(ws + WS_STT), gt, NGT);
#endif
#if MK_DSA
        for (int task = blockIdx.x; task < NB * 64; task += F.G) {
            const int b = task >> 6, xq = task & 63;
#pragma unroll 1
            for (int half = 0; half < 2; ++half) {
                const int c = half ? 127 - xq : xq, n = 64 * (c + 1);
                unsigned char* wsl = ws; int lane_l = F.lane; asm volatile("" : "+s"(wsl), "+v"(lane_l));
                idx_scores_oct(wl, lane_l, (const bf16*)(wsl + WS_ZB), (const bf16*)(wsl + WS_IKC), (const float*)(wsl + WS_UW), (unsigned short*)(wsl + WS_SC), b, c, F.wave);
                VM_WAIT(); __syncthreads();
                asm volatile("" : "+s"(wsl), "+v"(lane_l));
#pragma unroll 1
                for (int q = 0; q < 8; ++q) { const int ql = F.wave * 8 + q;
                    idx_select_row(lane_l, (const unsigned short*)(wsl + WS_SC) + sc_off(b, c) + (size_t)ql * n, n, F.lds + RING_OFF + ql * 1024, (LAS unsigned*)(F.lds + RING_OFF + 65536 + F.wave * 8192)); }
                LDS_WAIT(); __syncthreads();
                asm volatile("" : "+s"(wsl), "+v"(lane_l));
                const int tend = (c | 3) + 1;
#pragma unroll 1
                for (int tile = F.wave; tile < tend; tile += NWAVES) bt_emit_tile(lane_l, F.lds + RING_OFF, (unsigned*)(wsl + WS_BM), b, c, tile, tile > c);
                __syncthreads();
            }
        }
#endif
        GRID_BAR();
    }
    REP(4)
    {
        PHASE_LOCALS
#if MK_GLA
        for (int u = gw; u < 4096; u += NGW) gla_out_unit(wl, F.lane, ZB, (const bf16*)(ws + WS_STT), IN(6), (bf16*)(ws + WS_OA), u);
        __syncthreads();
#endif
#if MK_MOE
        if (F.vcu % CONV_MOD == 0) {
            const int cw = (F.vcu / CONV_MOD) * NWAVES + F.wave, NCW = ((F.G + CONV_MOD - 1) / CONV_MOD) * NWAVES;
            LAS float* scr = (LAS float*)wl; const int lane_c = opaque_tid() & 63;
            conv_stream8<3>(IN(20), D, EFF, ws + WS_WGU8, 1024, 0, scr, lane_c, cw, NCW);
            conv_stream8<3>(IN(21), D, EFF, ws + WS_WGU8, 1024, 128, scr, lane_c, cw, NCW);
            conv_stream8<0>(IN(22), EFF, D, ws + WS_WDN8, D, 0, scr, lane_c, cw, NCW);
            p0_weight_stream(ap, ws, scr, lane_c, P0_I_IN + cw, NCW);
            __syncthreads();
        }
#endif
#if MK_DSA
        att::attn_phase((char*)lds_raw, ZB, ws + WS_OB, (const unsigned*)(ws + WS_BM), IN(10), IN(8), IN(9), F.ctl + CW_ATTQ);
#endif
        GRID_BAR();
    }
    REP(5)
    {
        PHASE_LOCALS
        pg8::StaticOrder S; S.init(T, D, F.G, (int)blockIdx.x);
        { pg8::Gemm g{(const bf16*)(ws + WS_OA), (const bf16*)(ws + WS_WOG), 1024}; pg8::EpiFp8 E{ws + WS_YA, D};
          pg8::gemm_phase<pg8::EpiFp8, pg8::StaticOrder>(F.lds + RING_OFF, g, S, E); }
        { pg8::Gemm8 g{ws + WS_OB, ws + WS_WOD8, 1024 / 2, 0x7b7b7b7b, 0x7a7a7a7a}; pg8::EpiFp8 E{ws + WS_YB, D};
          pg8::gemm_phase8<pg8::EpiFp8, pg8::StaticOrder>(F.lds + RING_OFF, g, S, E); }
        GRID_BAR();
    }
    REP(6)
    {
        PHASE_LOCALS
        pg8::StaticOrder S; S.init(T, 4096, F.G, (int)blockIdx.x);
        pg8::Gemm8 g{(const unsigned char*)ap->out, ws + WS_WBG8, D / 2, 0x7f7f7f7f, 0x7a7a7a7a};
        pg8::EpiGateMix E{ws + WS_YA, ws + WS_YB, ws + WS_U, IN(13)};
        pg8::gemm_phase8<pg8::EpiGateMix, pg8::StaticOrder>(F.lds + RING_OFF, g, S, E);
        GRID_BAR();
    }
    REP(7)
    {
        PHASE_LOCALS
        pg8::StaticOrder S; S.init(T, D, F.G, (int)blockIdx.x);
        pg8::Gemm8 g{ws + WS_U, ws + WS_WO8, D / 2, 0x7c7c7c7c, 0x7a7a7a7a};
        pg8::EpiResBf16P E{IN(0), (bf16*)ap->out, D};
        pg8::gemm_phase8<pg8::EpiResBf16P, pg8::StaticOrder>(F.lds + RING_OFF, g, S, E);
        GRID_BAR();
    }
    REP(8)
    {
        PHASE_LOCALS
        for (int m = gw; m < T; m += NGW) rms_row_bf(F.lane, (const bf16*)ap->out + (size_t)m * D, IN(15), (bf16*)(ws + WS_H2B) + (size_t)m * D, ws + WS_H8 + (size_t)m * D);
        { const GAS f32x4* p4 = (const GAS f32x4*)IN(1); GAS v2u* o = (GAS v2u*)(ws + WS_PBF);
          for (size_t i = (size_t)gt; i < (size_t)T * PLE / 4; i += (size_t)NGT) { const f32x4 v = p4[i]; v2u w; w.x = pk2(v.x, v.y); w.y = pk2(v.z, v.w); o[i] = w; } }
        GRID_BAR();
    }
#if MK_MOE
    REP(9)
    {
        PHASE_LOCALS
        pg8::StaticOrder S; S.init(T, 256, F.G, (int)blockIdx.x);
        pg8::Gemm g{(const bf16*)(ws + WS_H2B), (const bf16*)(ws + WS_WR), D};
        pg8::EpiF32 E{(float*)(ws + WS_LOGIT), 256};
        pg8::gemm_phase<pg8::EpiF32, pg8::StaticOrder>(F.lds + RING_OFF, g, S, E);
        VM_WAIT(); __syncthreads();
        { pg8::Unit ur;
          const int nu = (128 - (int)blockIdx.x + F.G - 1) / F.G;
#pragma unroll 1
          for (int iu = 0; iu < nu; ++iu) { S.next(iu, ur); const int t_lo = ur.pm * 256, t_hi = t_lo + 256;
        const float* LG = (const float*)(ws + WS_LOGIT); const float* bg = IN(17); const float* be = IN(19);
          unsigned* cnt = (unsigned*)(F.ctl + CW_CNT); int* tokrow = (int*)(ws + WS_TOKROW); float* tokw = (float*)(ws + WS_TOKW);
          for (int t = t_lo + F.tid; t < t_hi; t += NWAVES * 64) {
              const f32x4 a = *(const f32x4*)(LG + (size_t)t * 256), b2 = *(const f32x4*)(LG + (size_t)t * 256 + 4);
              float l[8] = {a.x + bg[0], a.y + bg[1], a.z + bg[2], a.w + bg[3], b2.x + bg[4], b2.y + bg[5], b2.z + bg[6], b2.w + bg[7]};
              int gi = 0; float gm = l[0];
#pragma unroll
              for (int i = 1; i < 8; ++i) if (l[i] > gm) { gm = l[i]; gi = i; }
              float se = 0.f;
#pragma unroll
              for (int i = 0; i < 8; ++i) se += __expf(l[i] - gm);
              const float grp_w = 1.0f / se;
              const f32x4 c0 = *(const f32x4*)(LG + (size_t)t * 256 + 8 + gi * 8), c1 = *(const f32x4*)(LG + (size_t)t * 256 + 12 + gi * 8);
              const float* bb = be + gi * 8;
              float ev[8] = {c0.x + bb[0], c0.y + bb[1], c0.z + bb[2], c0.w + bb[3], c1.x + bb[4], c1.y + bb[5], c1.z + bb[6], c1.w + bb[7]};
              int i0 = 0; float v0 = ev[0];
#pragma unroll
              for (int i = 1; i < 8; ++i) if (ev[i] > v0) { v0 = ev[i]; i0 = i; }
              int i1 = -1; float v1 = -__builtin_inff();
#pragma unroll
              for (int i = 0; i < 8; ++i) if (i != i0 && ev[i] > v1) { v1 = ev[i]; i1 = i; }
              const float w0 = 1.0f / (1.0f + __expf(v1 - v0)), w1 = 1.0f - w0;
              const int e0 = gi * 8 + i0, e1 = gi * 8 + i1;
              const unsigned p0 = atomicAdd(&cnt[e0], 1u), p1 = atomicAdd(&cnt[e1], 1u);
              tokrow[(size_t)e0 * ECAP + p0] = t * 2; tokw[(size_t)e0 * ECAP + p0] = grp_w * w0;
              tokrow[(size_t)e1 * ECAP + p1] = t * 2 + 1; tokw[(size_t)e1 * ECAP + p1] = grp_w * w1;
          }
          } }
        { pg8::PleOrder SP{F.G, (int)blockIdx.x};
          pg8::Gemm gp{(const bf16*)(ws + WS_PBF), (const bf16*)(ws + WS_WPP), PLE};
          pg8::EpiBf16 EP{(bf16*)(ws + WS_PLEB), D};
          pg8::gemm_phase<pg8::EpiBf16, pg8::PleOrder>(F.lds + RING_OFF, gp, SP, EP); }
        GRID_BAR();
    }
    REP(11)
    {
        PHASE_LOCALS
        LAS int* pref = (LAS int*)(F.lds + PREF_OFF); LAS int* cntl = (LAS int*)(F.lds + CNTL_OFF);
        if (F.tid < 64) cntl[F.tid] = (int)__hip_atomic_load((unsigned*)(F.ctl + CW_CNT) + F.tid, RLX_AGENT);
        __syncthreads();
        if (F.tid == 0) { int acc = 0; for (int e = 0; e < 64; ++e) { pref[e] = acc; acc += (cntl[e] + 255) >> 8; } pref[64] = acc; }
        __syncthreads();
        pg8::MoeOrder S{pref, cntl, (const int*)(ws + WS_TOKROW), 4, F.G, F.vcu, D / 2};
        pg8::Gemm8 g{ws + WS_H8, ws + WS_WGU8, D / 2, 0x7f7f7f7f, 0x7a7a7a7a};
        pg8::EpiMoe1 E{ws + WS_ACT};
        pg8::gemm_phase8<pg8::EpiMoe1, pg8::MoeOrder, true>(F.lds + RING_OFF, g, S, E);
        GRID_BAR();
    }
    REP(12)
    {
        PHASE_LOCALS
        LAS int* pref = (LAS int*)(F.lds + PREF_OFF); LAS int* cntl = (LAS int*)(F.lds + CNTL_OFF);
        pg8::MoeOrder S{pref, cntl, (const int*)(ws + WS_TOKROW), 8, F.G, F.vcu, EFF / 2};
        pg8::Gemm8 g{ws + WS_ACT, ws + WS_WDN8, EFF / 2, 0x7d7d7d7d, 0x7a7a7a7a};
        pg8::EpiMoe2 E{(bf16*)(ws + WS_Y0), (long long)(HB - (bf16*)(ws + WS_Y0)), (const int*)(ws + WS_TOKROW), (const float*)(ws + WS_TOKW), cntl};
        pg8::gemm_phase8<pg8::EpiMoe2, pg8::MoeOrder, false>(F.lds + RING_OFF, g, S, E);
        GRID_BAR();
    }
#endif
    REP(13)
    {
        PHASE_LOCALS
        for (int m = gw; m < T; m += NGW) combine_row_bf(F.lane, (const bf16*)ap->out + (size_t)m * D, (const bf16*)(ws + WS_Y0) + (size_t)m * D, HB + (size_t)m * D, IN(23), (bf16*)(ws + WS_X2B) + (size_t)m * D, ws + WS_H8 + (size_t)m * D);
        GRID_BAR();
    }
    REP(14)
    {
        PHASE_LOCALS
        pg8::StaticOrder S; S.init(T, D, F.G, (int)blockIdx.x);
        { pg8::Gemm8 g{ws + WS_H8, ws + WS_WPG8, D / 2, 0x7f7f7f7f, 0x7a7a7a7a};
          pg8::EpiPleFinal E{(const bf16*)(ws + WS_X2B), (const bf16*)(ws + WS_PLEB), ap->out, IN(25)};
          pg8::gemm_phase8<pg8::EpiPleFinal, pg8::StaticOrder>(F.lds + RING_OFF, g, S, E); }
    }
}

extern "C" void kernel_launch(void* const* d_in, const int* in_sizes, int n_in, void* d_out, int out_size, void* d_ws, size_t ws_size, hipStream_t stream) {
    static int grid = 0;
    if (grid == 0) {
        if (n_in != 27 || out_size != T * D || ws_size < WS_END) { fprintf(stderr, "kernel_launch: unexpected shapes (n_in %d out %d ws %zu, need %zu)\n", n_in, out_size, ws_size, (size_t)WS_END); grid = -1; return; }
        int dev = 0, cus = 0, per_cu = 0;
        if (hipGetDevice(&dev) != hipSuccess || hipDeviceGetAttribute(&cus, hipDeviceAttributeMultiprocessorCount, dev) != hipSuccess) { grid = -1; return; }
        if (hipFuncSetAttribute((const void*)mk_fwd, hipFuncAttributeMaxDynamicSharedMemorySize, LDS_BYTES) != hipSuccess) { fprintf(stderr, "kernel_launch: hipFuncSetAttribute failed\n"); grid = -1; return; }
        if (hipOccupancyMaxActiveBlocksPerMultiprocessor(&per_cu, (const void*)mk_fwd, NWAVES * 64, LDS_BYTES) != hipSuccess || per_cu < 1) { fprintf(stderr, "kernel_launch: occupancy query says %d\n", per_cu); }
        (void)hipGetLastError();
        grid = cus;
    }
    if (grid < 0) return;
    if (hipMemsetAsync((char*)d_ws + WS_CTL, 0, CTL_ZERO_BYTES, stream) != hipSuccess) return;
    Args a{};
    for (int i = 0; i < 27; ++i) a.in[i] = (const float*)d_in[i];
    a.out = (float*)d_out; a.ws = (unsigned char*)d_ws; a.ph_lo = 0; a.ph_hi = 99;
    hipLaunchKernelGGL(mk_fwd, dim3(grid), dim3(NWAVES * 64), LDS_BYTES, stream, a);
}
```

```cpp
#include <hip/hip_runtime.h>
#include <cstdio>
#include <cstdint>

#ifndef MK_STAGE
#define MK_STAGE 1
#endif

#define GAS __attribute__((address_space(1)))
#define LAS __attribute__((address_space(3)))
typedef unsigned short bf16;
typedef unsigned v4u __attribute__((ext_vector_type(4)));
typedef unsigned v2u __attribute__((ext_vector_type(2)));
typedef float f32x4 __attribute__((ext_vector_type(4)));
typedef float f32x2 __attribute__((ext_vector_type(2)));
typedef float f32x16 __attribute__((ext_vector_type(16)));
typedef short bf16x8 __attribute__((ext_vector_type(8)));
typedef short s16x4 __attribute__((ext_vector_type(4)));
typedef GAS unsigned gu32;
#define RLX_AGENT __ATOMIC_RELAXED, __HIP_MEMORY_SCOPE_AGENT
#define LDS_WAIT() asm volatile("s_waitcnt lgkmcnt(0)" ::: "memory")
#define VM_WAIT() asm volatile("s_waitcnt vmcnt(0)" ::: "memory")

constexpr int NB = 4, SEQ = 8192, T = NB * SEQ, D = 2048, PLE = 256;
constexpr int ZP = 7424;
constexpr int ZC_GQ = 0, ZC_GK = 512, ZC_GV = 1024, ZC_GR = 2048, ZC_GLR = 3072, ZC_IK = 3088, ZC_IW = 3152, ZC_IQ = 3328, ZN_A = 4352  , ZC_DQ = 4352, ZC_DK = 5376, ZC_DV = 6400;
constexpr int NEXP = 64, EFF = 512, ECAP = 32768;
constexpr int ACT_ROWS = 81920;
constexpr float EPS = 1e-6f;
constexpr int NWAVES = 8;

constexpr size_t MiB = 1u << 20;
constexpr size_t al(size_t x) { return (x + 255) & ~(size_t)255; }
constexpr size_t WS_CTL = 0, CTL_ZERO_BYTES = 1 * MiB;
constexpr size_t WS_WIN = WS_CTL + CTL_ZERO_BYTES;
constexpr size_t WS_WBG = WS_WIN + al((size_t)ZP * D * 2);
constexpr size_t WS_WOG = WS_WBG + al((size_t)4096 * D * 2);
constexpr size_t WS_WOD = WS_WOG + al((size_t)D * 1024 * 2);
constexpr size_t WS_WO = WS_WOD + al((size_t)D * 1024 * 2);
constexpr size_t WS_WPG = WS_WO + al((size_t)D * D * 2);
constexpr size_t WS_WPP = WS_WPG + al((size_t)D * D * 2);
constexpr size_t WS_WR = WS_WPP + al((size_t)D * PLE * 2);
constexpr size_t WS_HB = WS_WR + al((size_t)256 * D * 2);
constexpr size_t WS_ZB = WS_HB + al((size_t)T * D * 2);
constexpr size_t ZB_BYTES = (size_t)T * ZP * 2;
constexpr size_t WS_SC = WS_ZB + al(ZB_BYTES);
constexpr size_t SC_PER_BATCH = (size_t)64 * 64 * (128 * 129 / 2);
constexpr size_t SC_BYTES = (size_t)NB * SC_PER_BATCH * 2;
constexpr size_t WS_BM = WS_SC + al(SC_BYTES);
constexpr size_t WS_SLOC = WS_BM + al((size_t)T * 1024);
constexpr size_t WS_STT = WS_SLOC + al((size_t)4096 * 8192 * 4);
constexpr size_t WS_DEC = WS_STT + al((size_t)4096 * 8192 * 2);
constexpr size_t WS_IKC = WS_DEC + al((size_t)4096 * 64 * 4);
constexpr size_t WS_UW = WS_IKC + al((size_t)T * 64 * 2);
constexpr size_t WS_WBG8 = WS_UW + al((size_t)T * 16 * 4);
constexpr size_t WS_WPG8 = WS_WBG8 + al((size_t)4096 * D);
constexpr size_t WS_WOD8 = WS_WPG8 + al((size_t)D * D);
constexpr size_t WS_WO8 = WS_WOD8 + al((size_t)D * 1024);
constexpr size_t WS_END = WS_WO8 + al((size_t)D * D);
constexpr size_t WS_WIN8 = WS_WIN + (size_t)ZN_A * D * 2;
static_assert(WS_WIN8 + (size_t)5120 * D <= WS_WBG, "w_in copies fit their region");
constexpr size_t WS_OA = WS_SC, WS_OB = WS_SC + (size_t)T * 1024 * 2;
constexpr size_t WS_YA = WS_ZB, WS_YB = WS_ZB + (size_t)T * D * 2, WS_U = WS_ZB + 2 * (size_t)T * D * 2;
constexpr size_t WS_WGU = WS_ZB;
constexpr size_t WS_WDN = WS_WGU + (size_t)NEXP * 1024 * D * 2;
constexpr size_t WS_ACT = WS_WDN + (size_t)NEXP * D * EFF * 2;
static_assert(WS_ACT + (size_t)ACT_ROWS * EFF * 2 <= WS_ZB + ZB_BYTES, "MoE overlay fits in Z");
constexpr size_t WS_LOGIT = WS_SC;
constexpr size_t WS_TOKROW = WS_LOGIT + (size_t)T * 256 * 4;
constexpr size_t WS_TOKW = WS_TOKROW + (size_t)NEXP * ECAP * 4;
constexpr size_t WS_PLEB = WS_TOKW + (size_t)NEXP * ECAP * 4;
constexpr size_t WS_PBF = WS_PLEB + (size_t)T * D * 2;
static_assert(WS_PBF + (size_t)T * PLE * 2 <= WS_SC + SC_BYTES, "late overlays fit in SC");
constexpr size_t WS_H8 = WS_STT;
constexpr size_t WS_WGU8 = WS_HB;
constexpr size_t WS_WDN8 = WS_SC + SC_BYTES - (size_t)NEXP * D * EFF;
static_assert(WS_PBF + (size_t)T * PLE * 2 <= WS_WDN8 && WS_OB + (size_t)T * 1024 * 2 <= WS_WDN8 && WS_WDN8 % 256 == 0, "expert down weights behind the SC overlays");
constexpr size_t WS_X2B = WS_ZB;
constexpr size_t WS_H2B = WS_ZB;
constexpr size_t WS_Y0 = WS_SLOC;
static_assert(WS_END <= (size_t)1253000000, "workspace map within the guaranteed minimum");
constexpr int CW_BAR = 4096;
constexpr int CW_CNT = 16384;
constexpr int CW_ATTQ = 20480;

__device__ __forceinline__ unsigned f2bf(float f) { unsigned u = __builtin_bit_cast(unsigned, f); return (u + 0x7fffu + ((u >> 16) & 1u)) >> 16; }
__device__ __forceinline__ unsigned pk2(float lo, float hi) { return f2bf(lo) | (f2bf(hi) << 16); }
__device__ __forceinline__ unsigned pk4_fp8(float a, float b, float c, float d) { int w = 0; w = __builtin_amdgcn_cvt_pk_fp8_f32(a, b, w, false); w = __builtin_amdgcn_cvt_pk_fp8_f32(c, d, w, true); return (unsigned)w; }
__device__ __forceinline__ float bf2f(unsigned short b) { return __builtin_bit_cast(float, (unsigned)b << 16); }
__device__ __forceinline__ float bflo(unsigned w) { return __builtin_bit_cast(float, w << 16); }
__device__ __forceinline__ float bfhi(unsigned w) { return __builtin_bit_cast(float, w & 0xffff0000u); }
__device__ __forceinline__ unsigned cvt_pk_bf16(float lo, float hi) { unsigned r; asm volatile("v_cvt_pk_bf16_f32 %0, %1, %2" : "=v"(r) : "v"(lo), "v"(hi)); return r; }
#define DPP_I(v, ctrl) __builtin_amdgcn_update_dpp((int)(v), (int)(v), (ctrl), 0xF, 0xF, true)
#define DPP_F(v, ctrl) __builtin_bit_cast(float, __builtin_amdgcn_update_dpp(__builtin_bit_cast(int, (float)(v)), __builtin_bit_cast(int, (float)(v)), (ctrl), 0xF, 0xF, true))
constexpr int DPP_X1 = 0xB1, DPP_X2 = 0x4E, DPP_HM = 0x141, DPP_RM = 0x140;
__device__ __forceinline__ float sum8(float v) { v += DPP_F(v, DPP_X1); v += DPP_F(v, DPP_X2); v += DPP_F(v, DPP_HM); return v; }
__device__ __forceinline__ float sum16(float v) { v = sum8(v); v += DPP_F(v, DPP_RM); return v; }
__device__ __forceinline__ float sum32(float v) { v = sum16(v); auto r = __builtin_amdgcn_permlane16_swap(__float_as_uint(v), __float_as_uint(v), false, false); return __uint_as_float(r[0]) + __uint_as_float(r[1]); }
__device__ __forceinline__ float wave_sum(float v) { v = sum32(v); auto r = __builtin_amdgcn_permlane32_swap(__float_as_uint(v), __float_as_uint(v), false, false); return __uint_as_float(r[0]) + __uint_as_float(r[1]); }
__device__ __forceinline__ float wave_max(float v) {
    v = fmaxf(v, DPP_F(v, DPP_X1)); v = fmaxf(v, DPP_F(v, DPP_X2)); v = fmaxf(v, DPP_F(v, DPP_HM)); v = fmaxf(v, DPP_F(v, DPP_RM));
    { auto r = __builtin_amdgcn_permlane16_swap(__float_as_uint(v), __float_as_uint(v), false, false); v = fmaxf(__uint_as_float(r[0]), __uint_as_float(r[1])); }
    { auto r = __builtin_amdgcn_permlane32_swap(__float_as_uint(v), __float_as_uint(v), false, false); v = fmaxf(__uint_as_float(r[0]), __uint_as_float(r[1])); }
    return v;
}
__device__ __forceinline__ int wave_sum_i(int v) {
    v += DPP_I(v, DPP_X1); v += DPP_I(v, DPP_X2); v += DPP_I(v, DPP_HM); v += DPP_I(v, DPP_RM);
    { auto r = __builtin_amdgcn_permlane16_swap((unsigned)v, (unsigned)v, false, false); v = (int)(r[0] + r[1]); }
    { auto r = __builtin_amdgcn_permlane32_swap((unsigned)v, (unsigned)v, false, false); v = (int)(r[0] + r[1]); }
    return v;
}
__device__ __forceinline__ int opaque_tid() { int t = threadIdx.x; asm volatile("" : "+v"(t)); return t; }
__device__ __forceinline__ float sigmoidf_(float x) { return __builtin_amdgcn_rcpf(1.0f + __builtin_amdgcn_exp2f(-1.4426950408889634f * x)); }

#define XB_TMO      128
#define XB_XCNT(j)  (256  + 64 * (j))
#define XB_XSUB(j)  (1280 + 64 * (j))
#define XB_XGEN(j)  (2304 + 64 * (j))
#define XB_TOP      3328
#define XB_TOPGEN   3392
#define XCD_BAR_WORDS 3456
#define XB_SPIN_CAP (1u << 18)
__device__ __forceinline__ unsigned xb_ld(unsigned* p)              { return __hip_atomic_load(p, __ATOMIC_RELAXED, __HIP_MEMORY_SCOPE_AGENT); }
__device__ __forceinline__ unsigned xb_add(unsigned* p, unsigned v) { return __hip_atomic_fetch_add(p, v, __ATOMIC_RELAXED, __HIP_MEMORY_SCOPE_AGENT); }
__device__ __forceinline__ unsigned xb_xcc_id() { return (unsigned)__builtin_amdgcn_s_getreg((3 << 11) | 20) & 0xFu; }
#define XB_SPIN(cond, bar) do { unsigned _sp = 0; while (cond) { __builtin_amdgcn_s_sleep(1); \
    if ((++_sp & 255u) == 0u) { if (xb_ld(&(bar)[XB_TMO])) break; if (_sp > XB_SPIN_CAP) { atomicAdd(&(bar)[XB_TMO], 1u); break; } } } } while (0)
struct XcdBarrier { unsigned* bar; unsigned x; volatile LAS unsigned* st; };
__device__ __forceinline__ XcdBarrier xcd_barrier_post(unsigned* bar, volatile LAS unsigned* st) {
    XcdBarrier b; b.bar = bar; b.x = xb_xcc_id(); b.st = st;
    if (threadIdx.x == 0) (void)xb_add(&bar[XB_XCNT(b.x)], 1u);
    return b;
}
__device__ __forceinline__ void xcd_barrier_complete(unsigned* bar, unsigned x, unsigned& nloc, unsigned& nx) {
    const unsigned G = gridDim.x * gridDim.y * gridDim.z;
    unsigned sum, cnt, mine, sp = 0u;
    for (;;) {
        sum = 0u; cnt = 0u; mine = 0u;
#pragma unroll
        for (unsigned j = 0; j < 16; ++j) { const unsigned c = xb_ld(&bar[XB_XCNT(j)]); sum += c; cnt += (c > 0u) ? 1u : 0u; mine = (j == x) ? c : mine; }
        if (sum == G) break;
        __builtin_amdgcn_s_sleep(1);
        if ((++sp & 255u) == 0u) { if (xb_ld(&bar[XB_TMO])) break; if (sp > XB_SPIN_CAP) { atomicAdd(&bar[XB_TMO], 1u); break; } }
    }
    nloc = mine > 0u ? mine : 1u; nx = cnt > 0u ? cnt : 1u;
}
__device__ __forceinline__ void xcd_barrier(const XcdBarrier& b) {
    asm volatile("s_waitcnt vmcnt(0)" ::: "memory");
    __syncthreads();
    if (threadIdx.x == 0) {
        unsigned* bar = b.bar;
        __builtin_amdgcn_s_waitcnt(0);
        unsigned nloc = b.st[0], nx = b.st[1];
        if (nloc == 0u) { xcd_barrier_complete(bar, b.x, nloc, nx); b.st[0] = nloc; b.st[1] = nx; }
        const unsigned old = xb_add(&bar[XB_XSUB(b.x)], 1u);
        const unsigned gen = old / nloc;
        if (old + 1u == (gen + 1u) * nloc) {
            __builtin_amdgcn_fence(__ATOMIC_RELEASE, "agent");
            asm volatile("s_waitcnt vmcnt(0)" ::: "memory");
            const unsigned og = xb_add(&bar[XB_TOP], 1u);
            const unsigned tg = og / nx;
            if (og + 1u == (tg + 1u) * nx) xb_add(&bar[XB_TOPGEN], 1u);
            else XB_SPIN(xb_ld(&bar[XB_TOPGEN]) == tg, bar);
            __builtin_amdgcn_fence(__ATOMIC_ACQUIRE, "agent");
            xb_add(&bar[XB_XGEN(b.x)], 1u);
            asm volatile("s_waitcnt vmcnt(0)" ::: "memory");
        } else {
            XB_SPIN(xb_ld(&bar[XB_XGEN(b.x)]) == gen, bar);
            __builtin_amdgcn_fence(__ATOMIC_ACQUIRE, "agent");
            asm volatile("s_waitcnt vmcnt(0)" ::: "memory");
        }
    }
    __syncthreads();
}

namespace pg8 {
constexpr int BM = 256, BK = 64, HALF = 128, HTB = HALF * BK * 2, STAGE_BYTES = 8 * HTB, NXCD = 8, WGM = 8;
__host__ __device__ __forceinline__ int lds_byte(int r, int c) { const int st = (r >> 4) * 2 + (c >> 5), rr = r & 15, cc = c & 31, ob = rr * 64 + cc * 2; return st * 1024 + (ob ^ (((ob >> 9) & 1) << 5)); }
__host__ __device__ __forceinline__ void stage_rc(int b, int& R, int& C) { const int st = b / 1024, sb = b % 1024, swz = sb ^ (((sb >> 9) & 1) << 5); R = (st >> 1) * 16 + swz / 64; C = (st & 1) * 32 + (swz % 64) / 2; }
__host__ __device__ __forceinline__ int perm32(int rho) { const int n = rho >> 4, i = rho & 15; return 8 * (i >> 2) + 4 * n + (i & 3); }

struct Unit { int pm, pn; int e, mt; };
struct Gemm { const bf16* A; const bf16* Bt; int K; };

typedef int v8i __attribute__((ext_vector_type(8)));
typedef int v4i __attribute__((ext_vector_type(4)));
struct Gemm8 { const unsigned char* A; const unsigned char* Bt; int K; int sa, sb; };
struct F2x { bf16x8 v[2]; __device__ __forceinline__ bf16x8& operator[](int i) { return v[i]; } __device__ __forceinline__ const bf16x8& operator[](int i) const { return v[i]; } };
__host__ __device__ __forceinline__ int lds_byte8(int r, int g) { const int st = (r >> 4) * 2 + (g >> 1), ob = (r & 15) * 64 + 32 * (g & 1); return st * 1024 + (ob ^ (((ob >> 9) & 1) << 5)); }
struct StaticOrder {
    int nM, nN, nwg, G, c;
    __device__ void init(int M, int N, int G_, int c_) { nM = M / BM; nN = N / BM; nwg = nM * nN; G = G_; c = c_; }
    __device__ __forceinline__ bool next(int i, Unit& u) const {
        const long L = (long)i * G + c; if (L >= nwg) return false;
        int wgid = (int)L; { const int q = nwg / NXCD, r = nwg % NXCD, xcd = wgid % NXCD, off = wgid / NXCD; wgid = (xcd < r ? xcd * (q + 1) : r * (q + 1) + (xcd - r) * q) + off; }
        const int nig = WGM * nN, gid = wgid / nig, fm = gid * WGM, gsz = (nM - fm) < WGM ? (nM - fm) : WGM;
        u.pm = fm + ((wgid % nig) % gsz); u.pn = (wgid % nig) / gsz; u.e = 0; u.mt = 0; return true;
    }
    __device__ __forceinline__ void rows(const Unit&, int, int, unsigned (&)[2][2]) const {}
};

template <class Epi, class Sched, bool GATHER = false>
__device__ __forceinline__ void gemm_phase(LAS unsigned char* lds, const Gemm g, const Sched& S, const Epi& E) {
    int tid_ = threadIdx.x; asm volatile("" : "+v"(tid_));
    const int tid = tid_, wid = __builtin_amdgcn_readfirstlane(tid >> 6), lane = tid & 63, wr = wid >> 2, wc = wid & 3, fr = lane & 15, fq = lane >> 4;
    const int K = g.K, nt = K / BK;
    unsigned voffA[2], voffB[2]; int RA[2], CA[2];
#pragma unroll
    for (int i = 0; i < 2; ++i) { int R, C; stage_rc(tid * 16 + i * 8192, R, C); const int Rb = Epi::PERM ? ((R & ~31) + perm32(R & 31)) : R;
        RA[i] = R; CA[i] = C; voffA[i] = (unsigned)(R * K + C) * 2u; voffB[i] = (unsigned)(Rb * K + C) * 2u; }
    const size_t kstep = (size_t)(BK * 2);
    const size_t hstep = (size_t)HALF * K * 2;
    const size_t tstep = 2 * hstep;
    const unsigned ldsw = (unsigned)wid * 1024u;
    const int aoff = lds_byte(wr * 64 + fr, fq * 8), boff = lds_byte(wc * 32 + fr, fq * 8);
#define PG8_SA(b, h) (((b) * 2 + (h)) * HTB)
#define PG8_SB(b, h) ((4 + (b) * 2 + (h)) * HTB)
#define PG8_STAGE(bufoff, gbase, voff) do { _Pragma("unroll") for (int _i = 0; _i < 2; ++_i) \
        __builtin_amdgcn_global_load_lds((const unsigned*)((const char*)(gbase) + (voff)[_i]), (LAS unsigned*)(lds + (bufoff) + ldsw + _i * 8192), 16, 0, 0); } while (0)
#define PG8_STAGE_A(bufoff, gbase, h, AO) do { if constexpr (GATHER) { PG8_STAGE(bufoff, gbase, AO[h]); } else { PG8_STAGE(bufoff, (gbase) + (h) * hstep, voffA); } } while (0)
#define PG8_LDA(dst, b, h) do { _Pragma("unroll") for (int m = 0; m < 4; ++m) _Pragma("unroll") for (int k = 0; k < 2; ++k) dst[m][k] = *(const LAS bf16x8*)(lds + PG8_SA(b, h) + aoff + m * 2048 + k * 1024); } while (0)
#define PG8_LDB(dst, b, h) do { _Pragma("unroll") for (int n = 0; n < 2; ++n) _Pragma("unroll") for (int k = 0; k < 2; ++k) dst[n][k] = *(const LAS bf16x8*)(lds + PG8_SB(b, h) + boff + n * 2048 + k * 1024); } while (0)
#define PG8_MMA(ai, bj, At, Bt) do { __builtin_amdgcn_s_setprio(1); _Pragma("unroll") for (int m = 0; m < 4; ++m) _Pragma("unroll") for (int n = 0; n < 2; ++n) _Pragma("unroll") for (int k = 0; k < 2; ++k) \
        acc[ai][bj][m][n] = __builtin_amdgcn_mfma_f32_16x16x32_bf16(Bt[n][k], At[m][k], acc[ai][bj][m][n], 0, 0, 0); __builtin_amdgcn_s_setprio(0); } while (0)
#define PG8_WAIT_V(n) asm volatile("s_waitcnt vmcnt(" #n ")" ::: "memory")
#define PG8_WAIT_L(n) asm volatile("s_waitcnt lgkmcnt(" #n ")" ::: "memory")
#define PG8_BAR __builtin_amdgcn_s_barrier()
#define PG8_SCHED __builtin_amdgcn_sched_barrier(0)
    Unit cur, nxt; int ui = 0;
    if (!S.next(0, cur)) return;
    f32x4 acc[2][2][4][2];
#pragma unroll
    for (int a = 0; a < 2; ++a)
#pragma unroll
        for (int b = 0; b < 2; ++b)
#pragma unroll
            for (int m = 0; m < 4; ++m)
#pragma unroll
                for (int n = 0; n < 2; ++n) acc[a][b][m][n] = (f32x4){0.f, 0.f, 0.f, 0.f};
    bf16x8 At[4][2], B0[2][2], B1[2][2];
    unsigned aoc[2][2], aon[2][2];
    const char* cA; const char* cB = (const char*)g.Bt + (size_t)cur.pn * tstep;
    if constexpr (GATHER) { cA = (const char*)g.A; S.rows(cur, RA[0], RA[1], aoc);
#pragma unroll
        for (int h = 0; h < 2; ++h)
#pragma unroll
            for (int i = 0; i < 2; ++i) aoc[h][i] += (unsigned)CA[i] * 2u; }
    else { cA = (const char*)g.A + (size_t)cur.pm * tstep;
#pragma unroll
        for (int i = 0; i < 2; ++i) { aoc[0][i] = 0u; aoc[1][i] = 0u; } }
    PG8_STAGE(PG8_SB(0, 0), cB, voffB); PG8_STAGE(PG8_SB(0, 1), cB + hstep, voffB); PG8_STAGE_A(PG8_SA(0, 0), cA, 0, aoc); PG8_STAGE_A(PG8_SA(0, 1), cA, 1, aoc);
    if (wr == 1) PG8_BAR;
    PG8_WAIT_V(2); PG8_BAR;
    PG8_STAGE(PG8_SB(1, 0), cB + kstep, voffB); PG8_STAGE_A(PG8_SA(1, 0), cA + kstep, 0, aoc); PG8_STAGE(PG8_SB(1, 1), cB + hstep + kstep, voffB);
    PG8_WAIT_V(6); PG8_BAR;
    for (;;) {
        const bool has_next = S.next(ui + 1, nxt);
        const char* nA; const char* nB = has_next ? (const char*)g.Bt + (size_t)nxt.pn * tstep : cB;
        if constexpr (GATHER) { nA = cA;
            if (has_next) { S.rows(nxt, RA[0], RA[1], aon);
#pragma unroll
                for (int h = 0; h < 2; ++h)
#pragma unroll
                    for (int i = 0; i < 2; ++i) aon[h][i] += (unsigned)CA[i] * 2u; }
            else {
#pragma unroll
                for (int h = 0; h < 2; ++h)
#pragma unroll
                    for (int i = 0; i < 2; ++i) aon[h][i] = aoc[h][i]; } }
        else { nA = has_next ? (const char*)g.A + (size_t)nxt.pm * tstep : cA;
#pragma unroll
            for (int h = 0; h < 2; ++h)
#pragma unroll
                for (int i = 0; i < 2; ++i) aon[h][i] = aoc[h][i]; }
#pragma nounroll
        for (int t = 0; t < nt; t += 2) {
            const bool last = (t == nt - 2);
            const char* a1 = cA + (size_t)(t + 1) * kstep;
            const char* a2 = last ? nA : cA + (size_t)(t + 2) * kstep; const char* b2 = last ? nB : cB + (size_t)(t + 2) * kstep;
            const char* a3 = a2 + kstep; const char* b3 = b2 + kstep;
            unsigned ao2[2][2];
#pragma unroll
            for (int h = 0; h < 2; ++h)
#pragma unroll
                for (int i = 0; i < 2; ++i) ao2[h][i] = (GATHER && last) ? aon[h][i] : aoc[h][i];
            PG8_LDB(B0, 0, 0); PG8_LDB(B1, 0, 1); PG8_SCHED; PG8_LDA(At, 0, 0); PG8_STAGE_A(PG8_SA(1, 1), a1, 1, aoc);
            PG8_WAIT_V(8); PG8_WAIT_L(0); PG8_BAR; PG8_MMA(0, 0, At, B0); PG8_MMA(0, 1, At, B1); PG8_BAR; PG8_SCHED;
            PG8_LDA(At, 0, 1); PG8_STAGE(PG8_SB(0, 0), b2, voffB); PG8_STAGE(PG8_SB(0, 1), b2 + hstep, voffB); PG8_STAGE_A(PG8_SA(0, 0), a2, 0, ao2);
            PG8_WAIT_V(8); PG8_WAIT_L(0); PG8_BAR; PG8_MMA(1, 0, At, B0); PG8_MMA(1, 1, At, B1); PG8_BAR; PG8_SCHED;
            PG8_LDB(B0, 1, 0); PG8_LDB(B1, 1, 1); PG8_SCHED; PG8_LDA(At, 1, 0); PG8_STAGE_A(PG8_SA(0, 1), a2, 1, ao2);
            PG8_WAIT_V(8); PG8_WAIT_L(0); PG8_BAR; PG8_MMA(0, 0, At, B0); PG8_MMA(0, 1, At, B1); PG8_BAR; PG8_SCHED;
            PG8_LDA(At, 1, 1); PG8_STAGE(PG8_SB(1, 0), b3, voffB); PG8_STAGE(PG8_SB(1, 1), b3 + hstep, voffB); PG8_STAGE_A(PG8_SA(1, 0), a3, 0, ao2);
            PG8_WAIT_V(8); PG8_WAIT_L(0); PG8_BAR; PG8_MMA(1, 0, At, B0); PG8_MMA(1, 1, At, B1); PG8_BAR; PG8_SCHED;
        }
        if (wr == 0) PG8_BAR;
        asm volatile("s_nop 15\n\ts_nop 7" ::: "memory");
        E(acc, cur, wr, wc, fr, fq);
        if (!has_next) break;
#pragma unroll
        for (int a = 0; a < 2; ++a)
#pragma unroll
            for (int b = 0; b < 2; ++b)
#pragma unroll
                for (int m = 0; m < 4; ++m)
#pragma unroll
                    for (int n = 0; n < 2; ++n) acc[a][b][m][n] = (f32x4){0.f, 0.f, 0.f, 0.f};
        cur = nxt; cA = nA; cB = nB; ++ui;
#pragma unroll
        for (int h = 0; h < 2; ++h)
#pragma unroll
            for (int i = 0; i < 2; ++i) aoc[h][i] = aon[h][i];
        if (wr == 1) PG8_BAR;
    }
    PG8_WAIT_V(0);
    PG8_BAR;
#undef PG8_SA
#undef PG8_SB
#undef PG8_STAGE
#undef PG8_STAGE_A
#undef PG8_LDA
#undef PG8_LDB
#undef PG8_MMA
#undef PG8_WAIT_V
#undef PG8_WAIT_L
#undef PG8_BAR
#undef PG8_SCHED
}

template <class Epi, class Sched, bool GATHER = false>
__device__ __forceinline__ void gemm_phase8(LAS unsigned char* lds, const Gemm8 g, const Sched& S, const Epi& E) {
    int tid_ = threadIdx.x; asm volatile("" : "+v"(tid_));
    const int tid = tid_, wid = __builtin_amdgcn_readfirstlane(tid >> 6), lane = tid & 63, wr = wid >> 2, wc = wid & 3, fr = lane & 15, fq = lane >> 4;
    const int K = g.K, nt = K / BK;
    unsigned voffA[2], voffB[2]; int RA[2], CA[2];
#pragma unroll
    for (int i = 0; i < 2; ++i) { int R, C; stage_rc(tid * 16 + i * 8192, R, C); const int Rb = Epi::PERM ? ((R & ~31) + perm32(R & 31)) : R;
        RA[i] = R; CA[i] = C; voffA[i] = (unsigned)(R * K + C) * 2u; voffB[i] = (unsigned)(Rb * K + C) * 2u; }
    const size_t kstep = (size_t)(BK * 2);
    const size_t hstep = (size_t)HALF * K * 2;
    const size_t tstep = 2 * hstep;
    const unsigned ldsw = (unsigned)wid * 1024u;
    const int aoff = lds_byte8(wr * 64 + fr, fq), boff = lds_byte8(wc * 32 + fr, fq);
#define PG8_SA(b, h) (((b) * 2 + (h)) * HTB)
#define PG8_SB(b, h) ((4 + (b) * 2 + (h)) * HTB)
#define PG8_STAGE(bufoff, gbase, voff) do { _Pragma("unroll") for (int _i = 0; _i < 2; ++_i) \
        __builtin_amdgcn_global_load_lds((const unsigned*)((const char*)(gbase) + (voff)[_i]), (LAS unsigned*)(lds + (bufoff) + ldsw + _i * 8192), 16, 0, 0); } while (0)
#define PG8_STAGE_A(bufoff, gbase, h, AO) do { if constexpr (GATHER) { PG8_STAGE(bufoff, gbase, AO[h]); } else { PG8_STAGE(bufoff, (gbase) + (h) * hstep, voffA); } } while (0)
#define PG8_LD32(p) __builtin_shufflevector(*(const LAS v4i*)(p), *(const LAS v4i*)((p) + 16), 0, 1, 2, 3, 4, 5, 6, 7)
#define PG8_LDA(dst, b, h) do { _Pragma("unroll") for (int m = 0; m < 4; ++m) dst[m] = PG8_LD32(lds + PG8_SA(b, h) + aoff + m * 2048); } while (0)
#define PG8_LDB(dst, b, h) do { _Pragma("unroll") for (int n = 0; n < 2; ++n) dst[n] = PG8_LD32(lds + PG8_SB(b, h) + boff + n * 2048); } while (0)
#define PG8_MMA(ai, bj, At, Bt) do { __builtin_amdgcn_s_setprio(1); _Pragma("unroll") for (int m = 0; m < 4; ++m) _Pragma("unroll") for (int n = 0; n < 2; ++n) \
        asm volatile("v_mfma_scale_f32_16x16x128_f8f6f4 %0, %1, %2, %0, %3, %4 op_sel_hi:[0,0,0]" : "+v"(acc[ai][bj][m][n]) : "v"(Bt[n]), "v"(At[m]), "v"(vsb), "v"(vsa)); __builtin_amdgcn_s_setprio(0); } while (0)
#define PG8_WAIT_V(n) asm volatile("s_waitcnt vmcnt(" #n ")" ::: "memory")
#define PG8_WAIT_L(n) asm volatile("s_waitcnt lgkmcnt(" #n ")" ::: "memory")
#define PG8_BAR __builtin_amdgcn_s_barrier()
#define PG8_SCHED __builtin_amdgcn_sched_barrier(0)
    Unit cur, nxt; int ui = 0;
    if (!S.next(0, cur)) return;
    f32x4 acc[2][2][4][2];
#pragma unroll
    for (int a = 0; a < 2; ++a)
#pragma unroll
        for (int b = 0; b < 2; ++b)
#pragma unroll
            for (int m = 0; m < 4; ++m)
#pragma unroll
                for (int n = 0; n < 2; ++n) acc[a][b][m][n] = (f32x4){0.f, 0.f, 0.f, 0.f};
    v8i At[4], B0[2], B1[2]; const int vsa = g.sa, vsb = g.sb;
    unsigned aoc[2][2], aon[2][2];
    const char* cA; const char* cB = (const char*)g.Bt + (size_t)cur.pn * tstep;
    if constexpr (GATHER) { cA = (const char*)g.A; S.rows(cur, RA[0], RA[1], aoc);
#pragma unroll
        for (int h = 0; h < 2; ++h)
#pragma unroll
            for (int i = 0; i < 2; ++i) aoc[h][i] += (unsigned)CA[i] * 2u; }
    else { cA = (const char*)g.A + (size_t)cur.pm * tstep;
#pragma unroll
        for (int i = 0; i < 2; ++i) { aoc[0][i] = 0u; aoc[1][i] = 0u; } }
    PG8_STAGE(PG8_SB(0, 0), cB, voffB); PG8_STAGE(PG8_SB(0, 1), cB + hstep, voffB); PG8_STAGE_A(PG8_SA(0, 0), cA, 0, aoc); PG8_STAGE_A(PG8_SA(0, 1), cA, 1, aoc);
    if (wr == 1) PG8_BAR;
    PG8_WAIT_V(2); PG8_BAR;
    PG8_STAGE(PG8_SB(1, 0), cB + kstep, voffB); PG8_STAGE_A(PG8_SA(1, 0), cA + kstep, 0, aoc); PG8_STAGE(PG8_SB(1, 1), cB + hstep + kstep, voffB);
    PG8_WAIT_V(6); PG8_BAR;
    for (;;) {
        const bool has_next = S.next(ui + 1, nxt);
        const char* nA; const char* nB = has_next ? (const char*)g.Bt + (size_t)nxt.pn * tstep : cB;
        if constexpr (GATHER) { nA = cA;
            if (has_next) { S.rows(nxt, RA[0], RA[1], aon);
#pragma unroll
                for (int h = 0; h < 2; ++h)
#pragma unroll
                    for (int i = 0; i < 2; ++i) aon[h][i] += (unsigned)CA[i] * 2u; }
            else {
#pragma unroll
                for (int h = 0; h < 2; ++h)
#pragma unroll
                    for (int i = 0; i < 2; ++i) aon[h][i] = aoc[h][i]; } }
        else { nA = has_next ? (const char*)g.A + (size_t)nxt.pm * tstep : cA;
#pragma unroll
            for (int h = 0; h < 2; ++h)
#pragma unroll
                for (int i = 0; i < 2; ++i) aon[h][i] = aoc[h][i]; }
#pragma nounroll
        for (int t = 0; t < nt; t += 2) {
            const bool last = (t == nt - 2);
            const char* a1 = cA + (size_t)(t + 1) * kstep;
            const char* a2 = last ? nA : cA + (size_t)(t + 2) * kstep; const char* b2 = last ? nB : cB + (size_t)(t + 2) * kstep;
            const char* a3 = a2 + kstep; const char* b3 = b2 + kstep;
            unsigned ao2[2][2];
#pragma unroll
            for (int h = 0; h < 2; ++h)
#pragma unroll
                for (int i = 0; i < 2; ++i) ao2[h][i] = (GATHER && last) ? aon[h][i] : aoc[h][i];
            PG8_LDB(B0, 0, 0); PG8_LDB(B1, 0, 1); PG8_SCHED; PG8_LDA(At, 0, 0); PG8_STAGE_A(PG8_SA(1, 1), a1, 1, aoc);
            PG8_WAIT_V(8); PG8_WAIT_L(0); PG8_BAR; PG8_MMA(0, 0, At, B0); PG8_MMA(0, 1, At, B1); PG8_BAR; PG8_SCHED;
            PG8_LDA(At, 0, 1); PG8_STAGE(PG8_SB(0, 0), b2, voffB); PG8_STAGE(PG8_SB(0, 1), b2 + hstep, voffB); PG8_STAGE_A(PG8_SA(0, 0), a2, 0, ao2);
            PG8_WAIT_V(8); PG8_WAIT_L(0); PG8_BAR; PG8_MMA(1, 0, At, B0); PG8_MMA(1, 1, At, B1); PG8_BAR; PG8_SCHED;
            PG8_LDB(B0, 1, 0); PG8_LDB(B1, 1, 1); PG8_SCHED; PG8_LDA(At, 1, 0); PG8_STAGE_A(PG8_SA(0, 1), a2, 1, ao2);
            PG8_WAIT_V(8); PG8_WAIT_L(0); PG8_BAR; PG8_MMA(0, 0, At, B0); PG8_MMA(0, 1, At, B1); PG8_BAR; PG8_SCHED;
            PG8_LDA(At, 1, 1); PG8_STAGE(PG8_SB(1, 0), b3, voffB); PG8_STAGE(PG8_SB(1, 1), b3 + hstep, voffB); PG8_STAGE_A(PG8_SA(1, 0), a3, 0, ao2);
            PG8_WAIT_V(8); PG8_WAIT_L(0); PG8_BAR; PG8_MMA(1, 0, At, B0); PG8_MMA(1, 1, At, B1); PG8_BAR; PG8_SCHED;
        }
        if (wr == 0) PG8_BAR;
        asm volatile("s_nop 15\n\ts_nop 15\n\ts_nop 15" ::: "memory");
        { const int t2 = opaque_tid(), w2 = __builtin_amdgcn_readfirstlane(t2 >> 6), l2 = t2 & 63;
          E(acc, cur, w2 >> 2, w2 & 3, l2 & 15, l2 >> 4); }
        if (!has_next) break;
#pragma unroll
        for (int a = 0; a < 2; ++a)
#pragma unroll
            for (int b = 0; b < 2; ++b)
#pragma unroll
                for (int m = 0; m < 4; ++m)
#pragma unroll
                    for (int n = 0; n < 2; ++n) acc[a][b][m][n] = (f32x4){0.f, 0.f, 0.f, 0.f};
        cur = nxt; cA = nA; cB = nB; ++ui;
#pragma unroll
        for (int h = 0; h < 2; ++h)
#pragma unroll
            for (int i = 0; i < 2; ++i) aoc[h][i] = aon[h][i];
        if (wr == 1) PG8_BAR;
    }
    PG8_WAIT_V(0);
    PG8_BAR;
#undef PG8_SA
#undef PG8_SB
#undef PG8_STAGE
#undef PG8_STAGE_A
#undef PG8_LDA
#undef PG8_LD32
#undef PG8_LDB
#undef PG8_MMA
#undef PG8_WAIT_V
#undef PG8_WAIT_L
#undef PG8_BAR
#undef PG8_SCHED
}

struct EpiBf16Skip {
    static constexpr bool PERM = true;
    bf16* O; int ldc, pn_skip, skip;
    __device__ __forceinline__ void operator()(const f32x4 (&acc)[2][2][4][2], const Unit& u, int wr, int wc, int fr, int fq) const {
        const int row0 = u.pm * BM + wr * 64 + fr, col0 = u.pn * BM + wc * 32 + 8 * fq + (u.pn >= pn_skip ? skip : 0);
#pragma unroll
        for (int ai = 0; ai < 2; ++ai)
#pragma unroll
            for (int m = 0; m < 4; ++m) { bf16* rowp = O + (size_t)(row0 + ai * HALF + m * 16) * ldc + col0;
#pragma unroll
                for (int bj = 0; bj < 2; ++bj) { const f32x4 v0 = acc[ai][bj][m][0], v1 = acc[ai][bj][m][1];
                    v4u w; w.x = cvt_pk_bf16(v0[0], v0[1]); w.y = cvt_pk_bf16(v0[2], v0[3]); w.z = cvt_pk_bf16(v1[0], v1[1]); w.w = cvt_pk_bf16(v1[2], v1[3]);
                    *(v4u*)(rowp + bj * HALF) = w; } }
    }
};
struct EpiFp8 {
    static constexpr bool PERM = true;
    unsigned char* O; int ldc;
    __device__ __forceinline__ void operator()(const f32x4 (&acc)[2][2][4][2], const Unit& u, int wr, int wc, int fr, int fq) const {
        const int row0 = u.pm * BM + wr * 64 + fr, col0 = u.pn * BM + wc * 32 + 8 * fq;
#pragma unroll
        for (int ai = 0; ai < 2; ++ai)
#pragma unroll
            for (int m = 0; m < 4; ++m) { unsigned char* rowp = O + (size_t)(row0 + ai * HALF + m * 16) * ldc + col0;
#pragma unroll
                for (int bj = 0; bj < 2; ++bj) { const f32x4 v0 = acc[ai][bj][m][0] * 8.0f, v1 = acc[ai][bj][m][1] * 8.0f;
                    v2u w; w.x = pk4_fp8(v0[0], v0[1], v0[2], v0[3]); w.y = pk4_fp8(v1[0], v1[1], v1[2], v1[3]);
                    *(v2u*)(rowp + bj * HALF) = w; } }
    }
};
struct EpiBf16 {
    static constexpr bool PERM = true;
    bf16* O; int ldc;
    __device__ __forceinline__ void operator()(const f32x4 (&acc)[2][2][4][2], const Unit& u, int wr, int wc, int fr, int fq) const {
        const int row0 = u.pm * BM + wr * 64 + fr, col0 = u.pn * BM + wc * 32 + 8 * fq;
#pragma unroll
        for (int ai = 0; ai < 2; ++ai)
#pragma unroll
            for (int m = 0; m < 4; ++m) { bf16* rowp = O + (size_t)(row0 + ai * HALF + m * 16) * ldc + col0;
#pragma unroll
                for (int bj = 0; bj < 2; ++bj) { const f32x4 v0 = acc[ai][bj][m][0], v1 = acc[ai][bj][m][1];
                    v4u w; w.x = cvt_pk_bf16(v0[0], v0[1]); w.y = cvt_pk_bf16(v0[2], v0[3]); w.z = cvt_pk_bf16(v1[0], v1[1]); w.w = cvt_pk_bf16(v1[2], v1[3]);
                    *(v4u*)(rowp + bj * HALF) = w; } }
    }
};
struct EpiF32 {
    static constexpr bool PERM = false;
    float* C; int ldc;
    __device__ __forceinline__ void operator()(const f32x4 (&acc)[2][2][4][2], const Unit& u, int wr, int wc, int fr, int fq) const {
        const int row0 = u.pm * BM + wr * 64 + fr, col0 = u.pn * BM + wc * 32 + 4 * fq;
#pragma unroll
        for (int ai = 0; ai < 2; ++ai)
#pragma unroll
            for (int m = 0; m < 4; ++m) { float* rowp = C + (size_t)(row0 + ai * HALF + m * 16) * ldc + col0;
#pragma unroll
                for (int bj = 0; bj < 2; ++bj)
#pragma unroll
                    for (int n = 0; n < 2; ++n) *(f32x4*)(rowp + bj * HALF + n * 16) = acc[ai][bj][m][n]; }
    }
};
struct EpiResF32 {
    static constexpr bool PERM = false;
    const float* base; float* out; int ldc;
    __device__ __forceinline__ void operator()(const f32x4 (&acc)[2][2][4][2], const Unit& u, int wr, int wc, int fr, int fq) const {
        const int row0 = u.pm * BM + wr * 64 + fr, col0 = u.pn * BM + wc * 32 + 4 * fq;
#pragma unroll
        for (int ai = 0; ai < 2; ++ai)
#pragma unroll
            for (int m = 0; m < 4; ++m) { const size_t off = (size_t)(row0 + ai * HALF + m * 16) * ldc + col0;
#pragma unroll
                for (int bj = 0; bj < 2; ++bj)
#pragma unroll
                    for (int n = 0; n < 2; ++n) { const f32x4 b = *(const f32x4*)(base + off + bj * HALF + n * 16); *(f32x4*)(out + off + bj * HALF + n * 16) = b + acc[ai][bj][m][n]; } }
    }
};
struct EpiResBf16P {
    static constexpr bool PERM = true;
    const float* base; bf16* out; int ldc;
    __device__ __forceinline__ void operator()(const f32x4 (&acc)[2][2][4][2], const Unit& u, int wr, int wc, int fr, int fq) const {
        const int row0 = u.pm * BM + wr * 64 + fr, col0 = u.pn * BM + wc * 32 + 8 * fq;
#pragma unroll
        for (int ai = 0; ai < 2; ++ai)
#pragma unroll
            for (int m = 0; m < 4; ++m) { const size_t off = (size_t)(row0 + ai * HALF + m * 16) * ldc + col0;
#pragma unroll
                for (int bj = 0; bj < 2; ++bj) { const f32x4 v0 = *(const f32x4*)(base + off + bj * HALF) + acc[ai][bj][m][0], v1 = *(const f32x4*)(base + off + bj * HALF + 4) + acc[ai][bj][m][1];
                    v4u w; w.x = cvt_pk_bf16(v0[0], v0[1]); w.y = cvt_pk_bf16(v0[2], v0[3]); w.z = cvt_pk_bf16(v1[0], v1[1]); w.w = cvt_pk_bf16(v1[2], v1[3]);
                    *(v4u*)(out + off + bj * HALF) = w; } }
    }
};
struct EpiResF32P {
    static constexpr bool PERM = true;
    const float* base; float* out; int ldc;
    __device__ __forceinline__ void operator()(const f32x4 (&acc)[2][2][4][2], const Unit& u, int wr, int wc, int fr, int fq) const {
        const int row0 = u.pm * BM + wr * 64 + fr, col0 = u.pn * BM + wc * 32 + 8 * fq;
#pragma unroll
        for (int ai = 0; ai < 2; ++ai)
#pragma unroll
            for (int m = 0; m < 4; ++m) { const size_t off = (size_t)(row0 + ai * HALF + m * 16) * ldc + col0;
#pragma unroll
                for (int bj = 0; bj < 2; ++bj)
#pragma unroll
                    for (int n = 0; n < 2; ++n) { const f32x4 b = *(const f32x4*)(base + off + bj * HALF + n * 4); *(f32x4*)(out + off + bj * HALF + n * 4) = b + acc[ai][bj][m][n]; } }
    }
};
struct EpiGateMix {
    static constexpr bool PERM = true;
    const unsigned char* YA; const unsigned char* YB; unsigned char* U; const float* bias;
    __device__ __forceinline__ void operator()(const f32x4 (&acc)[2][2][4][2], const Unit& u, int wr, int wc, int fr, int fq) const {
        const int row0 = u.pm * BM + wr * 64 + fr, col0 = u.pn * HALF + wc * 32 + 8 * fq;
        const f32x4 ba0 = *(const f32x4*)(bias + col0), ba1 = *(const f32x4*)(bias + col0 + 4), bb0 = *(const f32x4*)(bias + D + col0), bb1 = *(const f32x4*)(bias + D + col0 + 4);
#pragma unroll
        for (int ai = 0; ai < 2; ++ai)
#pragma unroll
            for (int m = 0; m < 4; ++m) { const size_t off = (size_t)(row0 + ai * HALF + m * 16) * D + col0;
                const v2u ya = *(const v2u*)(YA + off), yb = *(const v2u*)(YB + off);
                const f32x4 a0 = acc[ai][0][m][0] + ba0, a1 = acc[ai][0][m][1] + ba1, b0 = acc[ai][1][m][0] + bb0, b1 = acc[ai][1][m][1] + bb1;
                float o[8];
                float va[8], vb[8];
                { const auto p0 = __builtin_amdgcn_cvt_pk_f32_fp8((int)ya.x, false), p1 = __builtin_amdgcn_cvt_pk_f32_fp8((int)ya.x, true), p2 = __builtin_amdgcn_cvt_pk_f32_fp8((int)ya.y, false), p3 = __builtin_amdgcn_cvt_pk_f32_fp8((int)ya.y, true);
                  va[0] = p0[0]; va[1] = p0[1]; va[2] = p1[0]; va[3] = p1[1]; va[4] = p2[0]; va[5] = p2[1]; va[6] = p3[0]; va[7] = p3[1]; }
                { const auto p0 = __builtin_amdgcn_cvt_pk_f32_fp8((int)yb.x, false), p1 = __builtin_amdgcn_cvt_pk_f32_fp8((int)yb.x, true), p2 = __builtin_amdgcn_cvt_pk_f32_fp8((int)yb.y, false), p3 = __builtin_amdgcn_cvt_pk_f32_fp8((int)yb.y, true);
                  vb[0] = p0[0]; vb[1] = p0[1]; vb[2] = p1[0]; vb[3] = p1[1]; vb[4] = p2[0]; vb[5] = p2[1]; vb[6] = p3[0]; vb[7] = p3[1]; }
#pragma unroll
                for (int j = 0; j < 8; ++j) { const float ga = sigmoidf_(j < 4 ? a0[j & 3] : a1[j & 3]), gb = sigmoidf_(j < 4 ? b0[j & 3] : b1[j & 3]);
                    o[j] = ga * va[j] + gb * vb[j]; }
                v2u w; w.x = pk4_fp8(o[0], o[1], o[2], o[3]); w.y = pk4_fp8(o[4], o[5], o[6], o[7]);
                *(v2u*)(U + off) = w;
                asm volatile("" ::: "memory"); }
    }
};
struct EpiPleFinal {
    static constexpr bool PERM = true;
    const bf16* x2; const bf16* P; float* out; const float* bias;
    __device__ __forceinline__ void operator()(const f32x4 (&acc)[2][2][4][2], const Unit& u, int wr, int wc, int fr, int fq) const {
        const int row0 = u.pm * BM + wr * 64 + fr, col0 = u.pn * BM + wc * 32 + 8 * fq;
#pragma unroll
        for (int bj = 0; bj < 2; ++bj) { const f32x4 bv0 = *(const f32x4*)(bias + col0 + bj * HALF), bv1 = *(const f32x4*)(bias + col0 + bj * HALF + 4);
#pragma unroll
            for (int ai = 0; ai < 2; ++ai)
#pragma unroll
                for (int m = 0; m < 4; ++m) { const size_t off = (size_t)(row0 + ai * HALF + m * 16) * D + col0 + bj * HALF;
                    const v4u pw = *(const v4u*)(P + off), xw = *(const v4u*)(x2 + off);
                    const f32x4 x0 = {bflo(xw.x), bfhi(xw.x), bflo(xw.y), bfhi(xw.y)}, x1 = {bflo(xw.z), bfhi(xw.z), bflo(xw.w), bfhi(xw.w)};
                    const f32x4 a0 = acc[ai][bj][m][0] + bv0, a1 = acc[ai][bj][m][1] + bv1;
                    f32x4 o0, o1;
                    o0[0] = x0[0] + sigmoidf_(a0[0]) * bflo(pw.x); o0[1] = x0[1] + sigmoidf_(a0[1]) * bfhi(pw.x); o0[2] = x0[2] + sigmoidf_(a0[2]) * bflo(pw.y); o0[3] = x0[3] + sigmoidf_(a0[3]) * bfhi(pw.y);
                    o1[0] = x1[0] + sigmoidf_(a1[0]) * bflo(pw.z); o1[1] = x1[1] + sigmoidf_(a1[1]) * bfhi(pw.z); o1[2] = x1[2] + sigmoidf_(a1[2]) * bflo(pw.w); o1[3] = x1[3] + sigmoidf_(a1[3]) * bfhi(pw.w);
                    *(f32x4*)(out + off) = o0; *(f32x4*)(out + off + 4) = o1; } }
    }
};

struct PleOrder {
    int G, c;
    __device__ __forceinline__ bool next(int i, Unit& u) const {
        int L;
        if (G == 256) { if (c >= 128) { if (i >= 7) return false; L = (c - 128) * 7 + i; } else { if (i >= 1) return false; L = 896 + c; } }
        else { L = i * G + c; if (L >= 1024) return false; }
        u.pm = L >> 3; u.pn = L & 7; u.e = 0; u.mt = 0; return true;
    }
    __device__ __forceinline__ void rows(const Unit&, int, int, unsigned (&)[2][2]) const {}
};
struct MoeOrder {
    const LAS int* pref;
    const LAS int* cntl;
    const int* tokrow; int NT, G, c, K;
    __device__ __forceinline__ bool next(int i, Unit& u) const {
        const int L = i * G + c; if (L >= pref[64] * NT) return false;
        const int tt = L / NT, pnl = L - tt * NT; int lo = 0, hi = 64;
        while (hi - lo > 1) { const int mid = (lo + hi) >> 1; if (pref[mid] <= tt) lo = mid; else hi = mid; }
        u.e = lo; u.mt = tt - pref[lo]; u.pm = tt; u.pn = lo * NT + pnl; return true;
    }
    __device__ __forceinline__ void rows(const Unit& u, int R0, int R1, unsigned (&off)[2][2]) const {
        const int n = cntl[u.e];
#pragma unroll
        for (int h = 0; h < 2; ++h)
#pragma unroll
            for (int i = 0; i < 2; ++i) { const int j = u.mt * 256 + h * 128 + (i ? R1 : R0);
                const int tk = (j < n) ? (tokrow[(size_t)u.e * ECAP + j] >> 1) : 0; off[h][i] = (unsigned)tk * (unsigned)(K * 2); }
    }
};
struct EpiMoe1 {
    static constexpr bool PERM = true;
    unsigned char* ACT;
    __device__ __forceinline__ void operator()(const f32x4 (&acc)[2][2][4][2], const Unit& u, int wr, int wc, int fr, int fq) const {
        const int row0 = u.pm * BM + wr * 64 + fr, col0 = (u.pn & 3) * HALF + wc * 32 + 8 * fq;
#pragma unroll
        for (int ai = 0; ai < 2; ++ai)
#pragma unroll
            for (int m = 0; m < 4; ++m) { float o[8];
#pragma unroll
                for (int j = 0; j < 8; ++j) { const float g = acc[ai][0][m][j >> 2][j & 3], up = acc[ai][1][m][j >> 2][j & 3]; o[j] = 4.0f * g * sigmoidf_(g) * up; }
                v2u w; w.x = pk4_fp8(o[0], o[1], o[2], o[3]); w.y = pk4_fp8(o[4], o[5], o[6], o[7]);
                *(v2u*)(ACT + (size_t)(row0 + ai * HALF + m * 16) * EFF + col0) = w; }
    }
};
struct EpiMoe2 {
    static constexpr bool PERM = true;
    bf16* Y0; long long ydelta; const int* tokrow; const float* tokw; const LAS int* cntl;
    __device__ __forceinline__ void operator()(const f32x4 (&acc)[2][2][4][2], const Unit& u, int wr, int wc, int fr, int fq) const {
        const int n = cntl[u.e], col0 = (u.pn & 7) * BM + wc * 32 + 8 * fq;
        int infos[2][4]; float wts[2][4];
#pragma unroll
        for (int ai = 0; ai < 2; ++ai)
#pragma unroll
            for (int m = 0; m < 4; ++m) { const int j = u.mt * 256 + ai * HALF + wr * 64 + m * 16 + fr, jj = j < n ? j : 0;
                infos[ai][m] = tokrow[(size_t)u.e * ECAP + jj]; wts[ai][m] = tokw[(size_t)u.e * ECAP + jj]; }
#pragma unroll
        for (int ai = 0; ai < 2; ++ai)
#pragma unroll
            for (int m = 0; m < 4; ++m) { const int j = u.mt * 256 + ai * HALF + wr * 64 + m * 16 + fr;
                if (j < n) { const int info = infos[ai][m]; const float wt = wts[ai][m];
                    bf16* rowp = Y0 + (long long)(info & 1) * ydelta + (size_t)(info >> 1) * D + col0;
#pragma unroll
                    for (int bj = 0; bj < 2; ++bj) { const f32x4 v0 = acc[ai][bj][m][0] * wt, v1 = acc[ai][bj][m][1] * wt;
                        v4u w; w.x = cvt_pk_bf16(v0[0], v0[1]); w.y = cvt_pk_bf16(v0[2], v0[3]); w.z = cvt_pk_bf16(v1[0], v1[1]); w.w = cvt_pk_bf16(v1[2], v1[3]);
                        *(v4u*)(rowp + bj * HALF) = w; } } }
    }
};
}


#define MFMA32(a, b, c) __builtin_amdgcn_mfma_f32_32x32x16_bf16((a), (b), (c), 0, 0, 0)
__device__ __forceinline__ int crow(int r, int hi) { return (r & 3) + 8 * (r >> 2) + 4 * hi; }

constexpr int GLA_Q_OFF = 0, GLA_K_OFF = 65536, GLA_GLR_OFF = 132096;
__device__ __forceinline__ void gla_prep_task(LAS unsigned char* lds, bf16* Z, const float* w_alpha, const float* b_alpha, float* DEC, int task) {
    const int tid = opaque_tid(); const size_t t0 = (size_t)task * 64;
    LAS float* glr = (LAS float*)(lds + GLA_GLR_OFF);
    LAS unsigned short* qt = (LAS unsigned short*)(lds + GLA_Q_OFF); LAS unsigned short* kt = (LAS unsigned short*)(lds + GLA_K_OFF);
    __syncthreads();
#pragma unroll
    for (int i = 0; i < 8; ++i) { const int ch = tid + 512 * i, row = ch >> 6, c8 = (ch & 63) * 8;
        *(LAS v4u*)(qt + row * 512 + c8) = *(const GAS v4u*)(Z + (t0 + row) * ZP + ZC_GQ + c8);
        *(LAS v4u*)(kt + row * 512 + c8) = *(const GAS v4u*)(Z + (t0 + row) * ZP + ZC_GK + c8); }
    for (int i = tid; i < 1024; i += 512) glr[i] = bf2f(Z[(t0 + (i >> 4)) * ZP + ZC_GLR + (i & 15)]);
    float w[16];
#pragma unroll
    for (int i = 0; i < 16; ++i) w[i] = w_alpha[i * 512 + tid];
    const float bb = b_alpha[tid];
    __syncthreads();
    float G = 0.f;
#pragma unroll 4
    for (int r = 0; r < 64; ++r) {
        float pre = bb;
#pragma unroll
        for (int i = 0; i < 16; ++i) pre = fmaf(glr[r * 16 + i], w[i], pre);
        const float ls = fminf(pre, 0.f) - log1pf(__expf(-fabsf(pre)));
        G += ls * (1.0f / 16.0f);
        const float Gc = fmaxf(G, -80.f);
        const float eq = __expf(Gc), ek = __expf(-Gc);
        const float qv = bf2f(qt[r * 512 + tid]), kv = bf2f(kt[r * 512 + tid]);
        qt[r * 512 + tid] = (unsigned short)f2bf(qv * 0.125f * eq);
        kt[r * 512 + tid] = (unsigned short)f2bf(kv * ek);
    }
    DEC[(size_t)task * 512 + tid] = __expf(fmaxf(G, -80.f));
    __syncthreads();
#pragma unroll
    for (int i = 0; i < 8; ++i) { const int ch = tid + 512 * i, row = ch >> 6, c8 = (ch & 63) * 8;
        *(GAS v4u*)(Z + (t0 + row) * ZP + ZC_GQ + c8) = *(const LAS v4u*)(qt + row * 512 + c8);
        *(GAS v4u*)(Z + (t0 + row) * ZP + ZC_GK + c8) = *(const LAS v4u*)(kt + row * 512 + c8); }
    LDS_WAIT(); VM_WAIT(); __syncthreads();
}
__device__ __forceinline__ void dsa_prep_row(int lane, bf16* Z, size_t m, const float* qg, const float* kg, bf16* IKC, float* UW) {
#pragma unroll
    for (int which = 0; which < 2; ++which) {
        bf16* p = Z + m * ZP + (which ? ZC_DK : ZC_DQ) + lane * 16;
        const v4u a = *(const v4u*)p, b = *(const v4u*)(p + 8);
        float v[16]; const unsigned ww[8] = {a.x, a.y, a.z, a.w, b.x, b.y, b.z, b.w};
        float ss = 0.f;
#pragma unroll
        for (int i = 0; i < 8; ++i) { v[2 * i] = bflo(ww[i]); v[2 * i + 1] = bfhi(ww[i]); ss += v[2 * i] * v[2 * i] + v[2 * i + 1] * v[2 * i + 1]; }
        ss = sum8(ss);
        const float rstd = (1.0f / sqrtf(ss * (1.0f / 128.f) + EPS)) * (which ? 1.0f : 0.08838834764831845f * 1.4426950408889634f);
        const float* g = (which ? kg : qg) + (lane & 7) * 16;
        v4u o0, o1;
        o0.x = pk2(v[0] * rstd * g[0], v[1] * rstd * g[1]); o0.y = pk2(v[2] * rstd * g[2], v[3] * rstd * g[3]); o0.z = pk2(v[4] * rstd * g[4], v[5] * rstd * g[5]); o0.w = pk2(v[6] * rstd * g[6], v[7] * rstd * g[7]);
        o1.x = pk2(v[8] * rstd * g[8], v[9] * rstd * g[9]); o1.y = pk2(v[10] * rstd * g[10], v[11] * rstd * g[11]); o1.z = pk2(v[12] * rstd * g[12], v[13] * rstd * g[13]); o1.w = pk2(v[14] * rstd * g[14], v[15] * rstd * g[15]);
        *(v4u*)p = o0; *(v4u*)(p + 8) = o1;
    }
    if (lane < 8) *(v4u*)(IKC + m * 64 + lane * 8) = *(const v4u*)(Z + m * ZP + ZC_IK + lane * 8);
    if (lane < 16) UW[m * 16 + lane] = bf2f(Z[m * ZP + ZC_IW + lane]) * (0.5f / 32.0f);
}
#define FRAG_NAT(dst, tile, s, hg, col) do { _Pragma("unroll") for (int j_ = 0; j_ < 8; ++j_) dst[j_] = (short)(tile)[(16 * (s) + 8 * (hg) + j_) * 64 + (col)]; } while (0)
__device__ __forceinline__ void gla_local_unit(LAS unsigned char* lds, int wave, int lane, const bf16* Z, const float* DEC, float* SLOC, int u) {
    const int h = u & 7; const size_t t0 = (size_t)(u >> 3) * 64; const int r = lane & 31, hg = lane >> 5;
    const LAS unsigned short* kt = (const LAS unsigned short*)(lds + GLA_K_OFF) + h * 64;
    LAS unsigned short* vt = (LAS unsigned short*)(lds + GLA_Q_OFF + wave * 8192);
    const float d0 = DEC[(size_t)u * 64 + r], d1 = DEC[(size_t)u * 64 + 32 + r];
    bf16x8 Bk[2][4];
#pragma unroll
    for (int nt = 0; nt < 2; ++nt)
#pragma unroll
        for (int s = 0; s < 4; ++s) {
#pragma unroll
            for (int j = 0; j < 8; ++j) Bk[nt][s][j] = (short)kt[(16 * s + 8 * hg + j) * 512 + 32 * nt + r]; }
#pragma unroll 1
    for (int half = 0; half < 2; ++half) {
        LDS_WAIT();
#pragma unroll
        for (int i = 0; i < 8; ++i) { const int row = i * 8 + (lane >> 3), ch = lane & 7;
            *(LAS v4u*)(vt + row * 64 + ch * 8) = *(const v4u*)(Z + (t0 + row) * ZP + ZC_GV + h * 128 + half * 64 + ch * 8); }
        LDS_WAIT();
        f32x16 acc[2][2];
#pragma unroll
        for (int a = 0; a < 2; ++a)
#pragma unroll
            for (int b = 0; b < 2; ++b)
#pragma unroll
                for (int i = 0; i < 16; ++i) acc[a][b][i] = 0.f;
#pragma unroll
        for (int mt = 0; mt < 2; ++mt)
#pragma unroll
            for (int s = 0; s < 4; ++s) { bf16x8 Av; FRAG_NAT(Av, vt, s, hg, 32 * mt + r);
                acc[mt][0] = MFMA32(Av, Bk[0][s], acc[mt][0]); acc[mt][1] = MFMA32(Av, Bk[1][s], acc[mt][1]); }
        unsigned short* out = (unsigned short*)SLOC + (size_t)u * 8192;
#pragma unroll
        for (int mt = 0; mt < 2; ++mt)
#pragma unroll
            for (int i = 0; i < 16; ++i) { const int dv = half * 64 + 32 * mt + crow(i, hg);
                out[dv * 64 + r] = (unsigned short)f2bf(acc[mt][0][i] * d0); out[dv * 64 + 32 + r] = (unsigned short)f2bf(acc[mt][1][i] * d1); }
    }
}
__device__ __forceinline__ void gla_scan(const float* SLOC, const float* DEC, bf16* STT, int gt, int ngt) {
    for (int p = gt; p < 32 * 4096; p += ngt) {
        const int bh = p >> 12, ev = (p & 4095) * 2, b = bh >> 3, h = bh & 7, k = ev & 63;
        float s0 = 0.f, s1 = 0.f;
#pragma unroll 8
        for (int c = 0; c < 128; ++c) {
            const size_t u = ((size_t)(b * 128 + c) * 8 + h);
            const unsigned slw = *(const unsigned*)((const unsigned short*)SLOC + u * 8192 + ev); float2 sl; sl.x = bflo(slw); sl.y = bfhi(slw); const float2 dc = *(const float2*)(DEC + u * 64 + k);
            *(unsigned*)(STT + u * 8192 + ev) = pk2(s0, s1);
            s0 = fmaf(s0, dc.x, sl.x); s1 = fmaf(s1, dc.y, sl.y);
        }
    }
}
__device__ __forceinline__ void gla_out_unit(LAS unsigned char* wl, int lane, const bf16* Z, const bf16* STT, const float* gn, bf16* OA, int u) {
    const int h = u & 7; const size_t t0 = (size_t)(u >> 3) * 64; const int r = lane & 31, hg = lane >> 5;
    LAS unsigned short* vt = (LAS unsigned short*)wl;
    LDS_WAIT();
#pragma unroll
    for (int i = 0; i < 16; ++i) { const int row = i * 4 + (lane >> 4), ch = lane & 15;
        *(LAS v4u*)(vt + row * 128 + ch * 8) = *(const v4u*)(Z + (t0 + row) * ZP + ZC_GV + h * 128 + ch * 8); }
    bf16x8 Fq[2][4], Fk[2][4];
#pragma unroll
    for (int t = 0; t < 2; ++t)
#pragma unroll
        for (int s = 0; s < 4; ++s) {
            Fq[t][s] = *(const bf16x8*)(Z + (t0 + 32 * t + r) * ZP + ZC_GQ + h * 64 + 16 * s + 8 * hg);
            Fk[t][s] = *(const bf16x8*)(Z + (t0 + 32 * t + r) * ZP + ZC_GK + h * 64 + 16 * s + 8 * hg); }
    const bf16* st = STT + (size_t)u * 8192;
    LDS_WAIT();
#pragma unroll 1
    for (int it = 0; it < 2; ++it) {
        f32x16 o[4];
#pragma unroll
        for (int d = 0; d < 4; ++d)
#pragma unroll
            for (int i = 0; i < 16; ++i) o[d][i] = 0.f;
#pragma unroll
        for (int d = 0; d < 4; ++d)
#pragma unroll
            for (int s = 0; s < 4; ++s) { const bf16x8 Bs = *(const bf16x8*)(st + (32 * d + r) * 64 + 16 * s + 8 * hg); o[d] = MFMA32(Fq[it][s], Bs, o[d]); }
#pragma unroll
        for (int jt = 0; jt < 2; ++jt) {
            if (jt <= it) {
                f32x16 X;
#pragma unroll
                for (int i = 0; i < 16; ++i) X[i] = 0.f;
#pragma unroll
                for (int s = 0; s < 4; ++s) X = MFMA32(Fk[jt][s], Fq[it][s], X);
                asm volatile("s_nop 15\n\ts_nop 7" : "+v"(X));
                if (jt == it) {
#pragma unroll
                    for (int i = 0; i < 16; ++i) if (crow(i, hg) > r) X[i] = 0.f;
                }
#pragma unroll
                for (int s2 = 0; s2 < 2; ++s2) {
                    v4u pw; pw.x = cvt_pk_bf16(X[8 * s2 + 0], X[8 * s2 + 1]); pw.y = cvt_pk_bf16(X[8 * s2 + 2], X[8 * s2 + 3]); pw.z = cvt_pk_bf16(X[8 * s2 + 4], X[8 * s2 + 5]); pw.w = cvt_pk_bf16(X[8 * s2 + 6], X[8 * s2 + 7]);
                    const bf16x8 pa = __builtin_bit_cast(bf16x8, pw);
#pragma unroll
                    for (int d = 0; d < 4; ++d) { bf16x8 Bv;
#pragma unroll
                        for (int j = 0; j < 8; ++j) Bv[j] = (short)vt[(32 * jt + 16 * s2 + 8 * (j >> 2) + 4 * hg + (j & 3)) * 128 + 32 * d + r];
                        o[d] = MFMA32(pa, Bv, o[d]); }
                }
            }
        }
        float g4[4];
#pragma unroll
        for (int d = 0; d < 4; ++d) g4[d] = gn[32 * d + r];
#pragma unroll
        for (int i = 0; i < 16; ++i) {
            float ss = o[0][i] * o[0][i] + o[1][i] * o[1][i] + o[2][i] * o[2][i] + o[3][i] * o[3][i];
            ss = sum32(ss);
            const float rstd = 1.0f / sqrtf(ss * (1.0f / 128.f) + EPS);
            const size_t tok = t0 + 32 * it + crow(i, hg);
#pragma unroll
            for (int d = 0; d < 4; ++d) { const float gr = bf2f(Z[tok * ZP + ZC_GR + h * 128 + 32 * d + r]);
                const float val = o[d][i] * rstd * g4[d] * (gr * sigmoidf_(gr));
                OA[tok * 1024 + h * 128 + 32 * d + r] = (bf16)f2bf(val); }
        }
    }
}


__device__ __forceinline__ size_t sc_off(int b, int c) { return (size_t)b * SC_PER_BATCH + (size_t)4096 * ((size_t)c * (c + 1) / 2); }
__device__ __forceinline__ unsigned score_code(float sc) {
    const _Float16 hf = (_Float16)sc; const unsigned bits = (unsigned)__builtin_bit_cast(unsigned short, hf);
    return (bits & 0x8000u) ? (~bits & 0xffffu) : (bits | 0x8000u);
}
__device__ __forceinline__ void idx_scores_oct(LAS unsigned char* wl, int lane, const bf16* Z, const bf16* IKC, const float* UW, unsigned short* SC, int b, int c, int oct) {
    const int r = lane & 31, hg = lane >> 5, n = 64 * (c + 1);
    const size_t t0 = (size_t)b * SEQ + (size_t)c * 64 + 8 * oct;
    bf16x8 A[4][4];
    { const int q = (r >> 2) & 1, head = (r & 3) + 4 * (r >> 3);
#pragma unroll
      for (int a = 0; a < 4; ++a)
#pragma unroll
        for (int s = 0; s < 4; ++s) A[a][s] = *(const bf16x8*)(Z + (t0 + 2 * a + q) * ZP + ZC_IQ + head * 64 + 16 * s + 8 * hg); }
    LAS float* ul = (LAS float*)wl;
    LDS_WAIT();
    ul[lane] = UW[t0 * 16 + lane]; ul[64 + lane] = UW[t0 * 16 + 64 + lane];
    LDS_WAIT();
    GAS unsigned short* row0 = (GAS unsigned short*)SC + sc_off(b, c) + (size_t)(8 * oct + hg) * n;
    const GAS bf16* kb = (const GAS bf16*)IKC + ((size_t)b * SEQ + r) * 64 + 8 * hg;
    const int npair = n / 64;
#define IDX_LOADB(dst, kt_) do { _Pragma("unroll") for (int t = 0; t < 2; ++t) _Pragma("unroll") for (int s = 0; s < 4; ++s) dst[t][s] = *(const GAS bf16x8*)(kb + (size_t)((kt_) + t) * 32 * 64 + 16 * s); } while (0)
#define IDX_STEP(Bc, kt_) do { _Pragma("unroll") for (int a = 0; a < 4; ++a) { \
            f32x2 u2[8]; \
            _Pragma("unroll") for (int i = 0; i < 4; ++i) { const f32x4 t4 = *(const LAS f32x4*)(ul + (2 * a + hg) * 16 + 4 * i); u2[2 * i] = (f32x2){t4.x, t4.y}; u2[2 * i + 1] = (f32x2){t4.z, t4.w}; } \
            f32x16 acc0, acc1; \
            _Pragma("unroll") for (int i = 0; i < 16; ++i) { acc0[i] = 0.f; acc1[i] = 0.f; } \
            _Pragma("unroll") for (int s = 0; s < 4; ++s) { acc0 = MFMA32(A[a][s], Bc[0][s], acc0); acc1 = MFMA32(A[a][s], Bc[1][s], acc1); } \
            f32x2 l0 = {0.f, 0.f}, l1 = {0.f, 0.f}; \
            _Pragma("unroll") for (int j = 0; j < 8; ++j) { l0 = (f32x2){acc0[2 * j], acc0[2 * j + 1]} * u2[j] + l0; l1 = (f32x2){acc1[2 * j], acc1[2 * j + 1]} * u2[j] + l1; } \
            float s0 = l0.x + l0.y, s1 = l1.x + l1.y; \
            _Pragma("unroll") for (int j = 0; j < 8; ++j) { \
                asm("v_fma_f32 %0, |%1|, %2, %0" : "+v"(s0) : "v"(acc0[2 * j]), "v"(u2[j].x)); asm("v_fma_f32 %0, |%1|, %2, %0" : "+v"(s1) : "v"(acc1[2 * j]), "v"(u2[j].x)); \
                asm("v_fma_f32 %0, |%1|, %2, %0" : "+v"(s0) : "v"(acc0[2 * j + 1]), "v"(u2[j].y)); asm("v_fma_f32 %0, |%1|, %2, %0" : "+v"(s1) : "v"(acc1[2 * j + 1]), "v"(u2[j].y)); } \
            const unsigned c0 = score_code(s0), c1 = score_code(s1); \
            const unsigned pa = (unsigned)DPP_I(c0, DPP_X1), pb = (unsigned)DPP_I(c1, DPP_X1); \
            GAS unsigned short* row = row0 + (size_t)(2 * a) * n; \
            if ((r & 1) == 0) *(GAS unsigned*)(row + (kt_) * 32 + r) = c0 | (pa << 16); \
            else *(GAS unsigned*)(row + ((kt_) + 1) * 32 + r - 1) = pb | (c1 << 16); \
            } } while (0)
    bf16x8 B0[2][4], B1[2][4];
    IDX_LOADB(B0, 0);
#pragma unroll 1
    for (int p = 0; p < npair; p += 2) {
        if (p + 1 < npair) IDX_LOADB(B1, 2 * (p + 1));
        IDX_STEP(B0, 2 * p);
        if (p + 1 < npair) {
            if (p + 2 < npair) IDX_LOADB(B0, 2 * (p + 2));
            IDX_STEP(B1, 2 * (p + 1));
        }
    }
#undef IDX_LOADB
#undef IDX_STEP
}
__device__ __forceinline__ void idx_select_row(int lane, const unsigned short* row, int n, LAS unsigned char* bmrow, LAS unsigned* bins  ) {
    const int nch = n / 8;
    if (n <= 256) {
#pragma unroll
        for (int s = 0; s < 16; ++s) { const int j = lane + 64 * s; bmrow[j] = (j < nch) ? 0xffu : 0u; }
        return;
    }
    v4u cw[16];
#pragma unroll
    for (int s = 0; s < 16; ++s) { const int j = lane + 64 * s; const unsigned m = (unsigned)((j - nch) >> 31);
        const int jc = j < nch ? j : nch - 1; const v4u t = *(const v4u*)(row + (size_t)jc * 8); cw[s] = (v4u){t.x & m, t.y & m, t.z & m, t.w & m}; }
    const int ns = (nch + 63) / 64;
#define WSCAN(v) do { _Pragma("unroll") for (int o_ = 1; o_ < 64; o_ <<= 1) { const int t_ = __builtin_amdgcn_ds_bpermute((lane - o_) << 2, (v)); if (lane >= o_) (v) += t_; } } while (0)
#pragma unroll
    for (int i = 0; i < 8; ++i) *(LAS v4u*)(bins + (i * 64 + lane) * 4) = (v4u){0u, 0u, 0u, 0u};
    LDS_WAIT();
#pragma unroll
    for (int s = 0; s < 16; ++s) if (s < ns) {
#pragma unroll
        for (int e = 0; e < 4; ++e) { const unsigned w = cw[s][e];
            __hip_atomic_fetch_add(bins + ((w & 0xffffu) >> 5), 1u, __ATOMIC_RELAXED, __HIP_MEMORY_SCOPE_WORKGROUP);
            __hip_atomic_fetch_add(bins + (w >> 21), 1u, __ATOMIC_RELAXED, __HIP_MEMORY_SCOPE_WORKGROUP); } }
    LDS_WAIT();
    int B, above;
    { unsigned bv[32]; int sl = 0;
#pragma unroll
      for (int i = 0; i < 8; ++i) { const v4u t = *(const LAS v4u*)(bins + lane * 32 + 4 * i); bv[4 * i] = t.x; bv[4 * i + 1] = t.y; bv[4 * i + 2] = t.z; bv[4 * i + 3] = t.w; sl += (int)(t.x + t.y + t.z + t.w); }
      int incl = sl; WSCAN(incl);
      const int tot = __builtin_amdgcn_readlane(incl, 63);
      int run = tot - incl;
      const bool mine = run < 256 && run + sl >= 256;
      int bl = 0, al = 0; bool found = false;
#pragma unroll
      for (int k = 31; k >= 0; --k) { const int cbin = (int)bv[k]; if (!found && run + cbin >= 256) { bl = 32 * lane + k; al = run; found = true; } run += cbin; }
      const unsigned long long mk = __builtin_amdgcn_ballot_w64(mine); const int src = (int)__builtin_ctzll(mk);
      B = __builtin_amdgcn_readlane(bl, src); above = __builtin_amdgcn_readlane(al, src); }
    LDS_WAIT();
    if (lane < 8) *(LAS v4u*)(bins + lane * 4) = (v4u){0u, 0u, 0u, 0u};
    LDS_WAIT();
#pragma unroll
    for (int s = 0; s < 16; ++s) if (s < ns) {
#pragma unroll
        for (int e = 0; e < 4; ++e) { const unsigned w = cw[s][e]; const unsigned lo = w & 0xffffu, hi = w >> 16;
            if ((int)(lo >> 5) == B) __hip_atomic_fetch_add(bins + (lo & 31u), 1u, __ATOMIC_RELAXED, __HIP_MEMORY_SCOPE_WORKGROUP);
            if ((int)(hi >> 5) == B) __hip_atomic_fetch_add(bins + (hi & 31u), 1u, __ATOMIC_RELAXED, __HIP_MEMORY_SCOPE_WORKGROUP); } }
    LDS_WAIT();
    unsigned thr; int cgt, ceq;
    { const int cl = lane < 32 ? (int)bins[lane] : 0; int incl = cl; WSCAN(incl);
      const int tot = __builtin_amdgcn_readlane(incl, 63);
      const int run = above + tot - incl;
      const bool mine = lane < 32 && run < 256 && run + cl >= 256;
      const unsigned long long mk = __builtin_amdgcn_ballot_w64(mine); const int src = (int)__builtin_ctzll(mk);
      thr = ((unsigned)B << 5) | (unsigned)src; cgt = __builtin_amdgcn_readlane(run, src); ceq = __builtin_amdgcn_readlane(cl, src); }
    LDS_WAIT();
#undef WSCAN
    const int need = 256 - cgt;
    const bool fast = (ceq == need);
    int run = 0;
#pragma unroll
    for (int s = 0; s < 16; ++s) {
        const int j = lane + 64 * s;
        unsigned gm = 0u, tm = 0u;
        if (s < ns) {
#pragma unroll
            for (int e = 0; e < 4; ++e) { const unsigned w = cw[s][e]; const unsigned lo = w & 0xffffu, hi = w >> 16;
                gm |= ((thr - lo) >> 31) << (2 * e); gm |= ((thr - hi) >> 31) << (2 * e + 1);
                tm |= (((lo ^ thr) - 1u) >> 31) << (2 * e); tm |= (((hi ^ thr) - 1u) >> 31) << (2 * e + 1); }
            if (fast) gm |= tm;
            else {
                const int tc = __builtin_popcount(tm); int incl = tc;
#pragma unroll
                for (int o = 1; o < 64; o <<= 1) { const int t = __builtin_amdgcn_ds_bpermute((lane - o) << 2, incl); if (lane >= o) incl += t; }
                int rank = run + incl - tc;
#pragma unroll
                for (int e = 0; e < 8; ++e) if ((tm >> e) & 1u) { if (rank < need) gm |= 1u << e; ++rank; }
                run += __builtin_amdgcn_readlane(incl, 63);
            }
        }
        bmrow[j] = (unsigned char)gm;
    }
}


__device__ __forceinline__ void bt_emit_tile(int lane, const LAS unsigned char* rows, unsigned* BT, int b, int c, int tile, bool zero) {
    unsigned long long w = 0ull;
    if (!zero) w = *(const LAS unsigned long long*)(rows + lane * 1024 + tile * 8);
    unsigned va = 0u, vb = 0u;
#pragma unroll
    for (int pos = 0; pos < 64; ++pos) { const int rr = (pos >> 1) & 15, p = pos >> 5, h = pos & 1, key = 32 * p + (rr & 3) + 8 * (rr >> 2) + 4 * h;
        const unsigned long long m = __builtin_amdgcn_ballot_w64(((w >> key) & 1ull) != 0ull);
        asm volatile("s_nop 1\n\tv_writelane_b32 %0, %1, %2" : "+v"(va) : "s"((unsigned)m), "n"(pos)); asm volatile("v_writelane_b32 %0, %1, %2" : "+v"(vb) : "s"((unsigned)(m >> 32)), "n"(pos)); }
    const size_t g0 = ((size_t)(b * 256 + 2 * c) * 128 + tile) * 64;
    BT[g0 + lane] = va; BT[g0 + 128 * 64 + lane] = vb;
}

namespace att {
constexpr int AD = 128, NW = 8, QBLK = 32, KVBLK = 64, QB = NW * QBLK;
constexpr int SHM_V = KVBLK * AD * 2, SHM_K = KVBLK * AD * 2;
constexpr int LI_OFF = 2 * SHM_V + 2 * SHM_K;
constexpr int LUT_OFF = LI_OFF + NW * 64 * 4;
constexpr int NM_OFF = LUT_OFF + 8 * 256 * 4;
constexpr int QI_OFF = NM_OFF + 32;
constexpr int ATT_LDS = NM_OFF + 64;
typedef unsigned u32x16 __attribute__((ext_vector_type(16)));
#define AS4C __attribute__((address_space(4)))
#define KSWZ(row, colB) ((row) * 256 + ((colB) ^ (((row) & 7) << 4)))
#define SBAR() __builtin_amdgcn_sched_barrier(0)
__device__ __forceinline__ int v_st(int k, int c) { const int kk = (k & ~0xC) | ((k & 4) << 1) | ((k & 8) >> 1); return ((kk >> 3) * 4 + (c >> 5)) * 512 + ((kk & 7) * 32 + (c & 31)) * 2; }
__device__ __forceinline__ int v_rd_base(int lane) { return ((lane & 3) << 3) | (((lane >> 2) & 3) << 6) | (((lane >> 4) & 1) << 5) | (((lane >> 5) & 1) << 8); }
constexpr int v_rd_off(int d0, int ks, int half) { return d0 * 512 + ks * 4096 + half * 2048; }
__device__ __forceinline__ unsigned cvtpk(float lo, float hi) { unsigned r; asm volatile("v_cvt_pk_bf16_f32 %0, %1, %2" : "=v"(r) : "v"(lo), "v"(hi)); return r; }
__device__ __forceinline__ bf16x8 load8(const bf16* p) { return *reinterpret_cast<const bf16x8*>(p); }
__device__ __forceinline__ void mask16(f32x16& p, const u32x16& ma, const u32x16& mb, float neg) {
#pragma unroll
    for (int r = 0; r < 16; ++r) { const unsigned lo = r < 8 ? ma[2 * r] : mb[2 * r - 16], hi = r < 8 ? ma[2 * r + 1] : mb[2 * r - 15];
        const unsigned long long mm = ((unsigned long long)hi << 32) | lo; float o;
        asm volatile("v_cndmask_b32_e64 %0, %1, %2, %3" : "=v"(o) : "v"(neg), "v"(p[r]), "s"(mm)); p[r] = o; }
}
#define MFMA_PAD(a, b) asm volatile("s_nop 15\n\ts_nop 7" : "+v"(a), "+v"(b))
__device__ __forceinline__ void bias_tile(f32x16& p0, f32x16& p1, const LAS float* lut) {
#pragma unroll
    for (int r = 0; r < 16; ++r) { const int c = (r & 3) + 8 * (r >> 2); p0[r] += lut[c]; p1[r] += lut[c + 32]; }
}
__device__ __forceinline__ void exp16(f32x16& p) {
#pragma unroll
    for (int r = 0; r < 16; ++r) p[r] = __builtin_amdgcn_exp2f(p[r]);
}
__device__ __forceinline__ void finishSM(f32x16& p0, f32x16& p1, float& l_reg, bf16x8& pa0, bf16x8& pa1, bf16x8& pa2, bf16x8& pa3) {
    exp16(p1);
    float ps = 0;
#pragma unroll
    for (int r = 0; r < 16; ++r) ps += p0[r];
#pragma unroll
    for (int r = 0; r < 16; ++r) ps += p1[r];
    l_reg += ps;
#define PK4(P, B_, OUT) do { unsigned a0 = cvtpk(P[B_+0], P[B_+1]), a1 = cvtpk(P[B_+2], P[B_+3]);                          \
        unsigned b0 = cvtpk(P[B_+4], P[B_+5]), b1 = cvtpk(P[B_+6], P[B_+7]);                                             \
        auto r0 = __builtin_amdgcn_permlane32_swap(a0, b0, false, false); auto r1 = __builtin_amdgcn_permlane32_swap(a1, b1, false, false); \
        v4u w = {r0[0], r1[0], r0[1], r1[1]}; OUT = *reinterpret_cast<bf16x8*>(&w); } while (0)
    PK4(p0, 0, pa0); PK4(p0, 8, pa1); PK4(p1, 0, pa2); PK4(p1, 8, pa3);
#undef PK4
}
template <int KB>
__device__ __forceinline__ void qkt(f32x16& p0, f32x16& p1, const char* K_lds, int r32, int hi, const bf16x8* qr, float init) {
#pragma unroll
    for (int r = 0; r < 16; ++r) { float i0 = init, i1 = init; asm volatile("" : "+v"(i0), "+v"(i1)); p0[r] = i0; p1[r] = i1; }
    const char* kb[4];
#pragma unroll
    for (int dd = 0; dd < 4; ++dd) kb[dd] = K_lds + KB * SHM_K + KSWZ(r32, (dd * 16 + hi * 8) * 2);
#pragma unroll
    for (int d0 = 0; d0 < 8; ++d0) { const char* a = kb[d0 & 3] + (d0 >> 2) * 128;
        bf16x8 b0 = *reinterpret_cast<const bf16x8*>(a);
        bf16x8 b1 = *reinterpret_cast<const bf16x8*>(a + 32 * 256);
        p0 = __builtin_amdgcn_mfma_f32_32x32x16_bf16(b0, qr[d0], p0, 0, 0, 0);
        p1 = __builtin_amdgcn_mfma_f32_32x32x16_bf16(b1, qr[d0], p1, 0, 0, 0); }
}
template <int VB>
__device__ __forceinline__ void pv_tile(f32x16* o, int vb0, bf16x8 pa0, bf16x8 pa1, bf16x8 pa2, bf16x8 pa3) {
#define TRRD(dst, off) asm volatile("ds_read_b64_tr_b16 %0, %1 offset:%2" : "=&v"(dst) : "v"(vb0), "i"(off) : "memory")
#define PV_D0(d0) do { s16x4 l0, l1, l2, l3, h0, h1, h2, h3; constexpr int b_ = VB * SHM_V + v_rd_off(d0, 0, 0); \
        TRRD(l0, b_); TRRD(h0, b_ + 2048); TRRD(l1, b_ + 4096); TRRD(h1, b_ + 6144); TRRD(l2, b_ + 8192); TRRD(h2, b_ + 10240); TRRD(l3, b_ + 12288); TRRD(h3, b_ + 14336); \
        asm volatile("s_waitcnt lgkmcnt(0)" ::: "memory"); SBAR();   \
        o[d0] = __builtin_amdgcn_mfma_f32_32x32x16_bf16(pa0, (bf16x8){l0[0], l0[1], l0[2], l0[3], h0[0], h0[1], h0[2], h0[3]}, o[d0], 0, 0, 0);   \
        o[d0] = __builtin_amdgcn_mfma_f32_32x32x16_bf16(pa1, (bf16x8){l1[0], l1[1], l1[2], l1[3], h1[0], h1[1], h1[2], h1[3]}, o[d0], 0, 0, 0);   \
        o[d0] = __builtin_amdgcn_mfma_f32_32x32x16_bf16(pa2, (bf16x8){l2[0], l2[1], l2[2], l2[3], h2[0], h2[1], h2[2], h2[3]}, o[d0], 0, 0, 0);   \
        o[d0] = __builtin_amdgcn_mfma_f32_32x32x16_bf16(pa3, (bf16x8){l3[0], l3[1], l3[2], l3[3], h3[0], h3[1], h3[2], h3[3]}, o[d0], 0, 0, 0); } while (0)
    PV_D0(0); PV_D0(1); PV_D0(2); PV_D0(3);
#undef PV_D0
#undef TRRD
}
struct BlockRef { const bf16* Q; const bf16* K; unsigned char* O; const unsigned* bt; int P0; int h; };
struct Seam { bf16x8 qr[8]; bf16x8 st_v0, st_v1, st_k0, st_k1; };
#define ROW(p, k0, rr) ((p) + (size_t)((k0) + (rr)) * ZP + sc)
#define VMW() asm volatile("s_waitcnt vmcnt(0)" ::: "memory")
#define VMWN(n) asm volatile("s_waitcnt vmcnt(%0)" :: "i"(n) : "memory")
#define SLOAD_H(Kp, k0) do { const bf16* r0_ = ROW(Kp, k0, sr); const bf16* r1_ = ROW(Kp, k0, 32 + sr);   \
                         S.st_v0 = load8(r0_ + (ZC_DV - ZC_DK)); S.st_v1 = load8(r1_ + (ZC_DV - ZC_DK)); S.st_k0 = load8(r0_); S.st_k1 = load8(r1_); } while (0)
#define SWRITE_HK(bf) do { *(bf16x8*)(K_lds + (bf) * SHM_K + kws) = S.st_k0; *(bf16x8*)(K_lds + (bf) * SHM_K + kws + 32 * 256) = S.st_k1; } while (0)
#define SWRITE_HV(bf) do { *(bf16x8*)(V_lds + (bf) * SHM_V + vst0) = S.st_v0; *(bf16x8*)(V_lds + (bf) * SHM_V + vst1) = S.st_v1; } while (0)
#define SWRITE_H(bf) do { SWRITE_HV(bf); SWRITE_HK(bf); } while (0)
#define MLOAD(dst0, dst1, ptr, byteoff) do { const AS4C u32x16* q_ = (const AS4C u32x16*)(const AS4C void*)(ptr); dst0 = q_[(byteoff) / 64]; dst1 = q_[(byteoff) / 64 + 1]; } while (0)
__device__ __forceinline__ void prime(const BlockRef& cur, char* lds, Seam& S) {
    const int tid = opaque_tid(), wid = __builtin_amdgcn_readfirstlane(tid >> 6), lane = tid & 63, r32 = lane & 31, hi = lane >> 5;
    const int sr = tid >> 4, sc = (tid & 15) * 8, kws = KSWZ(sr, sc * 2); char* K_lds = lds + 2 * SHM_V;
#pragma unroll
    for (int d0 = 0; d0 < 8; ++d0) S.qr[d0] = load8(cur.Q + (size_t)(wid * QBLK + r32) * ZP + d0 * 16 + hi * 8);
    SLOAD_H(cur.K, 0); VMW(); SWRITE_HK(0);
    __syncthreads();
}
__device__ __forceinline__ void block(const BlockRef& cur, const BlockRef& nxt, char* lds, Seam& S) {
    const int tid = opaque_tid(), wid = __builtin_amdgcn_readfirstlane(tid >> 6), lane = tid & 63, r32 = lane & 31, hi = lane >> 5;
    const int NT = cur.P0 / KVBLK + 4;
    const int qlo = cur.P0 + wid * QBLK, qch = qlo >> 6;
    char* V_lds = lds; char* K_lds = lds + 2 * SHM_V;
    float* li_l = (float*)(lds + LI_OFF) + wid * 64;
    const float ninit = *(const float*)(lds + NM_OFF + 4 * cur.h);
    const float NEG = -__builtin_inff();
    const unsigned* btw = cur.bt + (size_t)wid * (128 * 64);
    float l_reg = 0; f32x16 o[4];
#pragma unroll
    for (int d = 0; d < 4; ++d)
#pragma unroll
        for (int r = 0; r < 16; ++r) o[d][r] = 0.f;
    const int sr = tid >> 4, sc = (tid & 15) * 8, vst0 = v_st(sr, sc), vst1 = v_st(32 + sr, sc), kws = KSWZ(sr, sc * 2);
    const int vb0 = (int)(uintptr_t)V_lds + v_rd_base(lane);
    const bf16* Kh = cur.K;
#define KBASE(t) ((t) * KVBLK)
#define LUTB(t) (LUT_OFF + 4 * (cur.h * 256 + 191 + 4 * hi - qlo - r32 + (t) * KVBLK))
#define MASKT(P0_, P1_, t) do { if ((t) >= qch - 2 && (t) <= qch) bias_tile(P0_, P1_, (const LAS float*)(unsigned)LUTB(t)); \
        mask16(P0_, m0, m1, NEG); { const unsigned* mp_ = btw + (size_t)(t) * 64; MLOAD(m0, m1, mp_, 128); } \
        if (__builtin_expect(__all(ninit <= 0.f), 1)) { exp16(P0_); } else { l_reg = 0.f; }     \
        mask16(P1_, m0, m1, NEG); } while (0)
#define MREQ(t) do { const unsigned* mp_ = btw + (size_t)(t) * 64; MLOAD(m0, m1, mp_, 0); } while (0)
    constexpr int NQL = 8;
#define SEAM_K0() do { VMWN(NQL); SWRITE_HK(0); SBAR(); } while (0)
    f32x16 pA0, pA1, pB0, pB1; bf16x8 pa0, pa1, pa2, pa3; u32x16 m0, m1;
    SWRITE_HV(0); SBAR();
    MREQ(0);
    if (NT > 1) SLOAD_H(Kh, KBASE(1));
    SBAR(); qkt<0>(pA0, pA1, K_lds, r32, hi, S.qr, ninit);
    MFMA_PAD(pA0, pA1); MASKT(pA0, pA1, 0);
    if (NT > 1) { VMW(); SWRITE_H(1); }
    __syncthreads();
#define HALF_STEP(PX0, PX1, PY0, PY1, t, KB, VB, SB) do {                                                      \
        SBAR(); MREQ(t); qkt<KB>(PX0, PX1, K_lds, r32, hi, S.qr, ninit);                                             \
        finishSM(PY0, PY1, l_reg, pa0, pa1, pa2, pa3); SBAR();                                                           \
        if ((t) + 1 < NT) { SLOAD_H(Kh, KBASE((t) + 1)); SBAR(); }                                               \
        pv_tile<VB>(o, vb0, pa0, pa1, pa2, pa3); MASKT(PX0, PX1, (t));                                        \
        __syncthreads();                                                                                                      \
        if ((t) + 1 < NT) { VMW(); SWRITE_H(SB); }                                                                          \
        __syncthreads(); } while (0)
    for (int t = 1; t + 1 < NT; t += 2) {
        HALF_STEP(pB0, pB1, pA0, pA1, t, 1, 0, 0);
        HALF_STEP(pA0, pA1, pB0, pB1, t + 1, 0, 1, 1);
    }
    MREQ(NT - 1);
    SBAR(); qkt<1>(pB0, pB1, K_lds, r32, hi, S.qr, ninit); SBAR();
    SLOAD_H(nxt.K, 0); SBAR();
#pragma unroll
    for (int d0 = 0; d0 < 8; ++d0) S.qr[d0] = load8(nxt.Q + (size_t)(wid * QBLK + r32) * ZP + d0 * 16 + hi * 8);
    SBAR();
    finishSM(pA0, pA1, l_reg, pa0, pa1, pa2, pa3); SBAR();
    pv_tile<0>(o, vb0, pa0, pa1, pa2, pa3);
    MASKT(pB0, pB1, NT - 1); __syncthreads();
    finishSM(pB0, pB1, l_reg, pa0, pa1, pa2, pa3); SBAR(); pv_tile<1>(o, vb0, pa0, pa1, pa2, pa3);
    SBAR(); SEAM_K0();
    { auto rr = __builtin_amdgcn_permlane32_swap(__float_as_uint(l_reg), __float_as_uint(l_reg), false, false); l_reg = __uint_as_float(rr[0]) + __uint_as_float(rr[1]); }
    if (hi == 0) li_l[r32] = l_reg; asm volatile("s_waitcnt lgkmcnt(0)" ::: "memory");
    float rli[16];
#pragma unroll
    for (int r = 0; r < 16; ++r) rli[r] = __builtin_amdgcn_rcpf(fmaxf(li_l[crow(r, hi)], 1e-37f));
    unsigned char* Ow = cur.O + (size_t)(wid * QBLK) * 1024;
#pragma unroll
    for (int r = 0; r < 16; ++r) { const int orow = crow(r, hi);
#pragma unroll
        for (int d0 = 0; d0 < 4; ++d0) { const float v = o[d0][r] * rli[r] * 16.0f;
            const float v1 = DPP_F(v, 0x55), v2 = DPP_F(v, 0xAA), v3 = DPP_F(v, 0xFF);
            if ((r32 & 3) == 0) *(unsigned*)(Ow + (size_t)orow * 1024 + d0 * 32 + r32) = pk4_fp8(v, v1, v2, v3); } }
    __syncthreads();
#undef KBASE
#undef LUTB
#undef MASKT
#undef MREQ
#undef SEAM_K0
#undef HALF_STEP
}
#undef ROW
#undef VMW
#undef VMWN
#undef SLOAD_H
#undef SWRITE_HK
#undef SWRITE_HV
#undef SWRITE_H
#undef MLOAD
__device__ __forceinline__ BlockRef make_ref(int L, int pass, const bf16* Z, unsigned char* OB, const unsigned* BT) {
    const int bh = L >> 4, x = L & 15, b = bh >> 3, h = bh & 7, qb = pass ? 31 - x : x;
    BlockRef r; const size_t row0 = (size_t)b * SEQ + (size_t)qb * QB;
    r.Q = Z + row0 * ZP + ZC_DQ + h * AD; r.K = Z + (size_t)b * SEQ * ZP + ZC_DK + h * AD;
    r.O = OB + row0 * 1024 + h * AD; r.bt = BT + (size_t)(b * 256 + qb * 8) * (128 * 64); r.P0 = qb * QB; r.h = h; return r;
}
__device__ __forceinline__ int t5_bucket(int rel) {
    const int n = rel < 0 ? -rel : rel; int bk;
    if (n < 8) bk = n; else if (n < 12) bk = 8; else if (n < 16) bk = 9; else if (n < 23) bk = 10; else if (n < 32) bk = 11; else if (n < 46) bk = 12; else if (n < 64) bk = 13; else if (n < 91) bk = 14; else bk = 15;
    return (rel > 0 ? 16 : 0) + bk;
}
__device__ __forceinline__ BlockRef make_ref_blk(int i, const bf16* Z, unsigned char* OB, const unsigned* BT) {
    const int bh = i & 31, b = bh >> 3, h = bh & 7, qb = 31 - (i >> 5);
    BlockRef r; const size_t row0 = (size_t)b * SEQ + (size_t)qb * QB;
    r.Q = Z + row0 * ZP + ZC_DQ + h * AD; r.K = Z + (size_t)b * SEQ * ZP + ZC_DK + h * AD;
    r.O = OB + row0 * 1024 + h * AD; r.bt = BT + (size_t)(b * 256 + qb * 8) * (128 * 64); r.P0 = qb * QB; r.h = h; return r;
}
__device__ __forceinline__ int q_fetch(char* lds, gu32* qhead, int slot) {
    if (opaque_tid() == 0) { const unsigned v = __hip_atomic_fetch_add(qhead, 1u, RLX_AGENT); ((volatile unsigned*)(lds + QI_OFF))[slot] = v; }
    __syncthreads();
    return __builtin_amdgcn_readfirstlane((int)((volatile unsigned*)(lds + QI_OFF))[slot]);
}
__device__ __forceinline__ void attn_phase(char* lds, const bf16* Z, unsigned char* OB, const unsigned* BT, const float* rel_bias, const float* qg, const float* kg, gu32* qhead) {
    constexpr float L2E = 1.4426950408889634f;
    { float* lut = (float*)(lds + LUT_OFF);
      const int tid = opaque_tid();
      for (int i = tid; i < 8 * 256; i += 512) { const int h = i >> 8, rel = (i & 255) - 191; lut[i] = (rel_bias[t5_bucket(rel) * 8 + h] - rel_bias[15 * 8 + h]) * L2E; }
      if (tid < 64) { const int l = tid;
          float mq = fmaxf(fabsf(qg[l]), fabsf(qg[l + 64])), mk = fmaxf(fabsf(kg[l]), fabsf(kg[l + 64]));
          mq = wave_max(mq); mk = wave_max(mk);
          if (l < 8) { float mb = 0.f; for (int bk = 0; bk < 32; ++bk) mb = fmaxf(mb, rel_bias[bk * 8 + l] - rel_bias[15 * 8 + l]);
              ((float*)(lds + NM_OFF))[l] = -(11.313708498984761f * mq * mk + mb) * L2E; } } }
    asm volatile("" : "+s"(BT));
    __syncthreads();
    constexpr int total = NB * 8 * 32;
    const int i0 = q_fetch(lds, qhead, 0); if (i0 >= total) return;
    int i1 = q_fetch(lds, qhead, 1), slot = 0;
    BlockRef cur = make_ref_blk(i0, Z, OB, BT);
    Seam S;
    prime(cur, lds, S);
    for (;;) {
        const bool last = i1 >= total;
        const BlockRef nxt = last ? cur : make_ref_blk(i1, Z, OB, BT);
        block(cur, nxt, lds, S);
        if (last) break;
        cur = nxt; i1 = q_fetch(lds, qhead, slot); slot ^= 1;
    }
}
}

constexpr int RING_OFF = 0, RING_BYTES = 131072;
constexpr int LDSCTL_OFF = RING_BYTES, MISC_OFF = LDSCTL_OFF + 320;
constexpr int LDS_BYTES = 147456;

struct Frame {
    LAS unsigned char* lds;
    volatile LAS unsigned* MISC;
    gu32* ctl;
    int tid, lane, wave, vcu, G;
};

template <int MAP> __device__ __forceinline__ int rowmap(int n) {
    if (MAP == 0) return n;
    if (MAP == 1) {
        if (n < 1024) return n;
        if (n < 3072) return -1;
        if (n < 3088) return ZC_GLR - 2048 + (n - 3072);
        if (n < 6160) return -1;
        if (n < 7184) return ZC_IQ - 2048 + (n - 6160);
        if (n < 7248) return ZC_IK - 2048 + (n - 7184);
        return ZC_IW - 2048 + (n - 7248);
    }
    if (MAP == 4) return (n >= 1024 && n < 3072) ? n - 1024 : (n >= 3088 && n < 6160) ? n - 3088 + 2048 : -1;
    if (MAP == 2) { const int half = n >> 11, c = n & 2047; return (c >> 7) * 256 + half * 128 + (c & 127); }
    if (MAP == 3) return (n >> 7) * 256 + (n & 127);
    return n;
}
template <int MAP>
__device__ __forceinline__ void p0_transpose_item(const float* W, int K, int N, bf16* WT, int row_off, LAS float* scr, int item, int lane) {
    const int nblk = N / 32, kb = item / nblk, nb = item % nblk, k0 = 64 * kb, n0 = 32 * nb;
#pragma unroll 8
    for (int i = 0; i < 32; ++i) { const int kk = 2 * i + (lane >> 5); scr[kk * 33 + (lane & 31)] = W[(size_t)(k0 + kk) * N + n0 + (lane & 31)]; }
    LDS_WAIT(); asm volatile("" ::: "memory");
    const int c = lane & 7;
#pragma unroll
    for (int j = 0; j < 4; ++j) { const int n = (lane >> 3) + 8 * j; const LAS float* s = scr + (8 * c) * 33 + n;
        v4u o; o.x = pk2(s[0 * 33], s[1 * 33]); o.y = pk2(s[2 * 33], s[3 * 33]); o.z = pk2(s[4 * 33], s[5 * 33]); o.w = pk2(s[6 * 33], s[7 * 33]);
        const int rm = rowmap<MAP>(n0 + n); if (rm >= 0) *(GAS v4u*)(WT + (size_t)(row_off + rm) * K + k0 + 8 * c) = o; }
    LDS_WAIT(); asm volatile("" ::: "memory");
}
template <int MAP>
__device__ __forceinline__ void p0_transpose_item8(const float* W, int K, int N, unsigned char* WT, int row_off, LAS float* scr, int item, int lane, float scale) {
    const int nblk = N / 32, kb = item / nblk, nb = item % nblk, k0 = 64 * kb, n0 = 32 * nb;
#pragma unroll 8
    for (int i = 0; i < 32; ++i) { const int kk = 2 * i + (lane >> 5); scr[kk * 33 + (lane & 31)] = W[(size_t)(k0 + kk) * N + n0 + (lane & 31)] * scale; }
    LDS_WAIT(); asm volatile("" ::: "memory");
    const int c = lane & 3;
#pragma unroll
    for (int j = 0; j < 2; ++j) { const int n = (lane >> 2) + 16 * j; const LAS float* sp = scr + (16 * c) * 33 + n;
        v4u o; o.x = pk4_fp8(sp[0 * 33], sp[1 * 33], sp[2 * 33], sp[3 * 33]); o.y = pk4_fp8(sp[4 * 33], sp[5 * 33], sp[6 * 33], sp[7 * 33]);
        o.z = pk4_fp8(sp[8 * 33], sp[9 * 33], sp[10 * 33], sp[11 * 33]); o.w = pk4_fp8(sp[12 * 33], sp[13 * 33], sp[14 * 33], sp[15 * 33]);
        const int rm = rowmap<MAP>(n0 + n); if (rm >= 0) *(GAS v4u*)(WT + (size_t)(row_off + rm) * K + k0 + 16 * c) = o; }
    LDS_WAIT(); asm volatile("" ::: "memory");
}
constexpr int CONV_MOD = 6, CONV_DEPTH = 3;
template <int MAP>
__device__ __forceinline__ void conv_stream8(const float* W, int K, int N, unsigned char* WT, int erows, int row_add, LAS float* scr, int lane, int cw, int NCW) {
    const int nblk = N / 32, per_e = (K / 64) * nblk, total = NEXP * per_e;
    const int lr = lane >> 3, lc = (lane & 7) * 4;
    if (cw >= total) return;
    const int n_my = (total - cw + NCW - 1) / NCW, it_last = cw + (n_my - 1) * NCW;
    f32x4 v[CONV_DEPTH][8];
#define CONV_IT(j_) min(cw + (j_) * NCW, it_last)
#define CONV_LOAD(d_, it_) do { const int e_ = (it_) / per_e, r_ = (it_) - e_ * per_e, kb_ = r_ / nblk, nb_ = r_ - kb_ * nblk; \
        const float* s_ = W + (size_t)e_ * K * N + (size_t)(64 * kb_ + lr) * N + 32 * nb_ + lc; \
        _Pragma("unroll") for (int i = 0; i < 8; ++i) v[d_][i] = __builtin_nontemporal_load((const f32x4*)(s_ + (size_t)(8 * i) * N)); } while (0)
#pragma unroll
    for (int d = 0; d < CONV_DEPTH; ++d) { CONV_LOAD(d, CONV_IT(d)); asm volatile("" ::: "memory"); __builtin_amdgcn_sched_barrier(0); }
    for (int j0 = 0; j0 < n_my; j0 += CONV_DEPTH) {
#pragma unroll
        for (int d = 0; d < CONV_DEPTH; ++d) {
            const int it = CONV_IT(j0 + d);
            const int e = it / per_e, r = it - e * per_e, kb = r / nblk, nb = r - kb * nblk, k0 = 64 * kb, n0 = 32 * nb;
#pragma unroll
            for (int i = 0; i < 8; ++i) { LAS float* dd = scr + (8 * i + lr) * 33 + lc; dd[0] = v[d][i].x; dd[1] = v[d][i].y; dd[2] = v[d][i].z; dd[3] = v[d][i].w; }
            CONV_LOAD(d, CONV_IT(j0 + d + CONV_DEPTH));
            LDS_WAIT(); asm volatile("" ::: "memory");
            const int c = lane & 3;
#pragma unroll
            for (int j = 0; j < 2; ++j) { const int n = (lane >> 2) + 16 * j; const LAS float* sp = scr + (16 * c) * 33 + n;
                v4u o; o.x = pk4_fp8(32.f * sp[0 * 33], 32.f * sp[1 * 33], 32.f * sp[2 * 33], 32.f * sp[3 * 33]); o.y = pk4_fp8(32.f * sp[4 * 33], 32.f * sp[5 * 33], 32.f * sp[6 * 33], 32.f * sp[7 * 33]);
                o.z = pk4_fp8(32.f * sp[8 * 33], 32.f * sp[9 * 33], 32.f * sp[10 * 33], 32.f * sp[11 * 33]); o.w = pk4_fp8(32.f * sp[12 * 33], 32.f * sp[13 * 33], 32.f * sp[14 * 33], 32.f * sp[15 * 33]);
                __builtin_nontemporal_store(o, (GAS v4u*)(WT + (size_t)(e * erows + row_add + rowmap<MAP>(n0 + n)) * K + k0 + 16 * c)); }
            LDS_WAIT(); asm volatile("" ::: "memory");
        }
    }
#undef CONV_LOAD
#undef CONV_IT
}
__device__ __forceinline__ void p0_transpose_item_win(const float* W, bf16* WT, unsigned char* WT8, LAS float* scr, int item, int lane) {
    constexpr int K = D, N = 7264;
    const int nblk = N / 32, kb = item / nblk, nb = item % nblk, k0 = 64 * kb, n0 = 32 * nb;
#pragma unroll 8
    for (int i = 0; i < 32; ++i) { const int kk = 2 * i + (lane >> 5); scr[kk * 33 + (lane & 31)] = W[(size_t)(k0 + kk) * N + n0 + (lane & 31)]; }
    LDS_WAIT(); asm volatile("" ::: "memory");
    { const int c = lane & 7;
#pragma unroll
      for (int j = 0; j < 4; ++j) { const int n = (lane >> 3) + 8 * j; const LAS float* sp = scr + (8 * c) * 33 + n; const int rm = rowmap<1>(n0 + n);
        if (rm >= 0) { v4u o; o.x = pk2(sp[0 * 33], sp[1 * 33]); o.y = pk2(sp[2 * 33], sp[3 * 33]); o.z = pk2(sp[4 * 33], sp[5 * 33]); o.w = pk2(sp[6 * 33], sp[7 * 33]);
            *(GAS v4u*)(WT + (size_t)rm * K + k0 + 8 * c) = o; } } }
    { const int c = lane & 3;
#pragma unroll
      for (int j = 0; j < 2; ++j) { const int n = (lane >> 2) + 16 * j; const LAS float* sp = scr + (16 * c) * 33 + n; const int rm = rowmap<4>(n0 + n);
        if (rm >= 0) { v4u o; o.x = pk4_fp8(32.f * sp[0 * 33], 32.f * sp[1 * 33], 32.f * sp[2 * 33], 32.f * sp[3 * 33]); o.y = pk4_fp8(32.f * sp[4 * 33], 32.f * sp[5 * 33], 32.f * sp[6 * 33], 32.f * sp[7 * 33]);
            o.z = pk4_fp8(32.f * sp[8 * 33], 32.f * sp[9 * 33], 32.f * sp[10 * 33], 32.f * sp[11 * 33]); o.w = pk4_fp8(32.f * sp[12 * 33], 32.f * sp[13 * 33], 32.f * sp[14 * 33], 32.f * sp[15 * 33]);
            *(GAS v4u*)(WT8 + (size_t)rm * K + k0 + 16 * c) = o; } } }
    LDS_WAIT(); asm volatile("" ::: "memory");
}
__device__ __forceinline__ void rms_row_to_bf16(int lane, const float* xrow, const float* g, bf16* orow, unsigned char* orow8 = nullptr) {
    const GAS f32x4* xr = (const GAS f32x4*)xrow + lane;
    f32x4 v[8]; float s = 0.f;
#pragma unroll
    for (int j = 0; j < 8; ++j) { v[j] = xr[64 * j]; s += (v[j].x * v[j].x + v[j].y * v[j].y) + (v[j].z * v[j].z + v[j].w * v[j].w); }
    const float rstd = 1.0f / sqrtf(wave_sum(s) * (1.f / D) + EPS);
    GAS unsigned long long* o8 = (GAS unsigned long long*)orow + lane;
#pragma unroll
    for (int j = 0; j < 8; ++j) { const f32x4 gg = ((const GAS f32x4*)g)[64 * j + lane];
        o8[64 * j] = (unsigned long long)pk2(v[j].x * rstd * gg.x, v[j].y * rstd * gg.y) | ((unsigned long long)pk2(v[j].z * rstd * gg.z, v[j].w * rstd * gg.w) << 32);
        if (orow8) ((GAS unsigned*)orow8)[64 * j + lane] = pk4_fp8(v[j].x * rstd * gg.x, v[j].y * rstd * gg.y, v[j].z * rstd * gg.z, v[j].w * rstd * gg.w); }
}

#ifndef MK_DSA
#define MK_DSA 1
#endif
#ifndef MK_MOE
#define MK_MOE 1
#endif
#ifndef MK_GLA
#define MK_GLA 1
#endif
constexpr int PREF_OFF = LDSCTL_OFF, CNTL_OFF = MISC_OFF + 128;
__device__ __forceinline__ void rms_row_bf(int lane, const bf16* xrow, const float* g, bf16* orow, unsigned char* orow8) {
    const GAS v4u* xr = (const GAS v4u*)xrow + lane;
    v4u w[4]; float s = 0.f;
#pragma unroll
    for (int j = 0; j < 4; ++j) { w[j] = xr[64 * j];
        const float a0 = bflo(w[j].x), a1 = bfhi(w[j].x), a2 = bflo(w[j].y), a3 = bfhi(w[j].y), a4 = bflo(w[j].z), a5 = bfhi(w[j].z), a6 = bflo(w[j].w), a7 = bfhi(w[j].w);
        s += ((a0 * a0 + a1 * a1) + (a2 * a2 + a3 * a3)) + ((a4 * a4 + a5 * a5) + (a6 * a6 + a7 * a7)); }
    const float rstd = 1.0f / sqrtf(wave_sum(s) * (1.f / D) + EPS);
#pragma unroll
    for (int j = 0; j < 4; ++j) { const f32x4 g0 = ((const GAS f32x4*)g)[2 * (64 * j + lane)], g1 = ((const GAS f32x4*)g)[2 * (64 * j + lane) + 1];
        const float a0 = bflo(w[j].x) * rstd * g0.x, a1 = bfhi(w[j].x) * rstd * g0.y, a2 = bflo(w[j].y) * rstd * g0.z, a3 = bfhi(w[j].y) * rstd * g0.w;
        const float a4 = bflo(w[j].z) * rstd * g1.x, a5 = bfhi(w[j].z) * rstd * g1.y, a6 = bflo(w[j].w) * rstd * g1.z, a7 = bfhi(w[j].w) * rstd * g1.w;
        v4u o; o.x = pk2(a0, a1); o.y = pk2(a2, a3); o.z = pk2(a4, a5); o.w = pk2(a6, a7);
        ((GAS v4u*)orow)[64 * j + lane] = o;
        v2u o8; o8.x = pk4_fp8(a0, a1, a2, a3); o8.y = pk4_fp8(a4, a5, a6, a7);
        ((GAS v2u*)orow8)[64 * j + lane] = o8; }
}
__device__ __forceinline__ void combine_row_bf(int lane, const bf16* x1, const bf16* y0, const bf16* y1, const float* g, bf16* x2, unsigned char* orow8) {
    float v[4][8]; float s = 0.f;
#pragma unroll
    for (int j = 0; j < 4; ++j) { const v4u w = ((const GAS v4u*)x1)[64 * j + lane];
        v[j][0] = bflo(w.x); v[j][1] = bfhi(w.x); v[j][2] = bflo(w.y); v[j][3] = bfhi(w.y); v[j][4] = bflo(w.z); v[j][5] = bfhi(w.z); v[j][6] = bflo(w.w); v[j][7] = bfhi(w.w);
#if MK_MOE
        const v4u a = ((const GAS v4u*)y0)[64 * j + lane], b = ((const GAS v4u*)y1)[64 * j + lane];
        v[j][0] += bflo(a.x) + bflo(b.x); v[j][1] += bfhi(a.x) + bfhi(b.x); v[j][2] += bflo(a.y) + bflo(b.y); v[j][3] += bfhi(a.y) + bfhi(b.y);
        v[j][4] += bflo(a.z) + bflo(b.z); v[j][5] += bfhi(a.z) + bfhi(b.z); v[j][6] += bflo(a.w) + bflo(b.w); v[j][7] += bfhi(a.w) + bfhi(b.w);
#endif
        v4u o; o.x = pk2(v[j][0], v[j][1]); o.y = pk2(v[j][2], v[j][3]); o.z = pk2(v[j][4], v[j][5]); o.w = pk2(v[j][6], v[j][7]);
        ((GAS v4u*)x2)[64 * j + lane] = o;
        v[j][0] = bflo(o.x); v[j][1] = bfhi(o.x); v[j][2] = bflo(o.y); v[j][3] = bfhi(o.y); v[j][4] = bflo(o.z); v[j][5] = bfhi(o.z); v[j][6] = bflo(o.w); v[j][7] = bfhi(o.w);
#pragma unroll
        for (int q = 0; q < 8; ++q) s += v[j][q] * v[j][q]; }
    const float rstd = 1.0f / sqrtf(wave_sum(s) * (1.f / D) + EPS);
#pragma unroll
    for (int j = 0; j < 4; ++j) { const f32x4 g0 = ((const GAS f32x4*)g)[2 * (64 * j + lane)], g1 = ((const GAS f32x4*)g)[2 * (64 * j + lane) + 1];
        v2u o8; o8.x = pk4_fp8(v[j][0] * rstd * g0.x, v[j][1] * rstd * g0.y, v[j][2] * rstd * g0.z, v[j][3] * rstd * g0.w);
        o8.y = pk4_fp8(v[j][4] * rstd * g1.x, v[j][5] * rstd * g1.y, v[j][6] * rstd * g1.z, v[j][7] * rstd * g1.w);
        ((GAS v2u*)orow8)[64 * j + lane] = o8; }
}
__device__ __forceinline__ void combine_row(int lane, float* xio, const bf16* y0, const bf16* y1, const float* g, unsigned char* orow8) {
    GAS f32x4* xr = (GAS f32x4*)xio + lane;
    f32x4 v[8]; float s = 0.f;
#pragma unroll
    for (int j = 0; j < 8; ++j) { v[j] = xr[64 * j];
#if MK_MOE
        const v2u a = ((const GAS v2u*)y0)[64 * j + lane], b = ((const GAS v2u*)y1)[64 * j + lane];
        v[j].x += bflo(a.x) + bflo(b.x); v[j].y += bfhi(a.x) + bfhi(b.x); v[j].z += bflo(a.y) + bflo(b.y); v[j].w += bfhi(a.y) + bfhi(b.y);
#endif
        s += (v[j].x * v[j].x + v[j].y * v[j].y) + (v[j].z * v[j].z + v[j].w * v[j].w); }
    const float rstd = 1.0f / sqrtf(wave_sum(s) * (1.f / D) + EPS);
#pragma unroll
    for (int j = 0; j < 8; ++j) { const f32x4 gg = ((const GAS f32x4*)g)[64 * j + lane];
        xr[64 * j] = v[j];
        ((GAS unsigned*)orow8)[64 * j + lane] = pk4_fp8(v[j].x * rstd * gg.x, v[j].y * rstd * gg.y, v[j].z * rstd * gg.z, v[j].w * rstd * gg.w); }
}

struct Args { const float* in[27]; float* out; unsigned char* ws; int ph_lo, ph_hi; };
#define AS4 __attribute__((address_space(4)))

constexpr int P0_I_IN = (D / 64) * (7264 / 32), P0_I_BG = (D / 64) * (4096 / 32), P0_I_OG = (1024 / 64) * (D / 32), P0_I_O = (D / 64) * (D / 32), P0_I_PP = (PLE / 64) * (D / 32);
constexpr int P0_NITEMS = P0_I_IN + P0_I_BG + 2 * P0_I_OG + 2 * P0_I_O + P0_I_PP, P0_DEPTH = 3;
struct P0Item { const float* src; int N, kind, K, k0, n0; unsigned char* dst; };
__device__ __forceinline__ P0Item p0_decode(int r, const AS4 Args* ap, unsigned char* ws) {
    P0Item t; const float* W; int nblk;
    if (r < P0_I_IN) { W = ap->in[3]; t.N = 7264; t.K = D; t.kind = 0; t.dst = ws + WS_WIN; }
    else if ((r -= P0_I_IN) < P0_I_BG) { W = ap->in[12]; t.N = 4096; t.K = D; t.kind = 3; t.dst = ws + WS_WBG8; }
    else if ((r -= P0_I_BG) < P0_I_OG) { W = ap->in[7]; t.N = D; t.K = 1024; t.kind = 1; t.dst = ws + WS_WOG; }
    else if ((r -= P0_I_OG) < P0_I_OG) { W = ap->in[11]; t.N = D; t.K = 1024; t.kind = 2; t.dst = ws + WS_WOD8; }
    else if ((r -= P0_I_OG) < P0_I_O) { W = ap->in[14]; t.N = D; t.K = D; t.kind = 2; t.dst = ws + WS_WO8; }
    else if ((r -= P0_I_O) < P0_I_O) { W = ap->in[24]; t.N = D; t.K = D; t.kind = 2; t.dst = ws + WS_WPG8; }
    else { r -= P0_I_O; W = ap->in[26]; t.N = D; t.K = PLE; t.kind = 1; t.dst = ws + WS_WPP; }
    nblk = t.N / 32; const int kb = r / nblk, nb = r - kb * nblk; t.k0 = 64 * kb; t.n0 = 32 * nb;
    t.src = W + (size_t)t.k0 * t.N + t.n0; return t;
}
__device__ __forceinline__ void p0_emit(const P0Item& t, LAS float* scr, int lane) {
    if (t.kind == 1 || t.kind == 0) { const int c = lane & 7; bf16* WT = (bf16*)t.dst;
#pragma unroll
        for (int j = 0; j < 4; ++j) { const int n = (lane >> 3) + 8 * j; const LAS float* sp = scr + (8 * c) * 33 + n; const int rm = t.kind == 0 ? rowmap<1>(t.n0 + n) : t.n0 + n;
            if (rm >= 0) { v4u o; o.x = pk2(sp[0 * 33], sp[1 * 33]); o.y = pk2(sp[2 * 33], sp[3 * 33]); o.z = pk2(sp[4 * 33], sp[5 * 33]); o.w = pk2(sp[6 * 33], sp[7 * 33]);
                *(GAS v4u*)(WT + (size_t)rm * t.K + t.k0 + 8 * c) = o; } } }
    if (t.kind != 1) { const int c = lane & 3; unsigned char* WT8 = t.kind == 0 ? t.dst + (WS_WIN8 - WS_WIN) : t.dst;
#pragma unroll
        for (int j = 0; j < 2; ++j) { const int n = (lane >> 2) + 16 * j; const LAS float* sp = scr + (16 * c) * 33 + n;
            const int rm = t.kind == 0 ? rowmap<4>(t.n0 + n) : t.kind == 3 ? rowmap<2>(t.n0 + n) : t.n0 + n;
            if (rm >= 0) { v4u o; o.x = pk4_fp8(32.f * sp[0 * 33], 32.f * sp[1 * 33], 32.f * sp[2 * 33], 32.f * sp[3 * 33]); o.y = pk4_fp8(32.f * sp[4 * 33], 32.f * sp[5 * 33], 32.f * sp[6 * 33], 32.f * sp[7 * 33]);
                o.z = pk4_fp8(32.f * sp[8 * 33], 32.f * sp[9 * 33], 32.f * sp[10 * 33], 32.f * sp[11 * 33]); o.w = pk4_fp8(32.f * sp[12 * 33], 32.f * sp[13 * 33], 32.f * sp[14 * 33], 32.f * sp[15 * 33]);
                *(GAS v4u*)(WT8 + (size_t)rm * t.K + t.k0 + 16 * c) = o; } } }
}
__device__ __forceinline__ void p0_weight_stream(const AS4 Args* ap, unsigned char* ws, LAS float* scr, int lane, int gw, int NGW) {
    if (gw >= P0_NITEMS) return;
    const int n_my = (P0_NITEMS - gw + NGW - 1) / NGW, it_last = gw + (n_my - 1) * NGW;
    const int lr = lane >> 3, lc = (lane & 7) * 4;
    f32x4 v[P0_DEPTH][8];
#define P0_IT(j_) min(gw + (j_) * NGW, it_last)
#define P0_LOAD(d_, it_) do { const P0Item q_ = p0_decode((it_), ap, ws); const float* s_ = q_.src + (size_t)lr * q_.N + lc; \
        _Pragma("unroll") for (int i = 0; i < 8; ++i) v[d_][i] = *(const f32x4*)(s_ + (size_t)(8 * i) * q_.N); } while (0)
#pragma unroll
    for (int d = 0; d < P0_DEPTH; ++d) { P0_LOAD(d, P0_IT(d)); asm volatile("" ::: "memory"); __builtin_amdgcn_sched_barrier(0); }
    for (int j0 = 0; j0 < n_my; j0 += P0_DEPTH) {
#pragma unroll
        for (int d = 0; d < P0_DEPTH; ++d) {
            const P0Item t = p0_decode(P0_IT(j0 + d), ap, ws);
#pragma unroll
            for (int i = 0; i < 8; ++i) { LAS float* dd = scr + (8 * i + lr) * 33 + lc; dd[0] = v[d][i].x; dd[1] = v[d][i].y; dd[2] = v[d][i].z; dd[3] = v[d][i].w; }
            P0_LOAD(d, P0_IT(j0 + d + P0_DEPTH));
            LDS_WAIT(); asm volatile("" ::: "memory");
            p0_emit(t, scr, lane);
            LDS_WAIT(); asm volatile("" ::: "memory");
        }
    }
#undef P0_LOAD
#undef P0_IT
}

#define PHASE_LOCALS \
    const AS4 Args* ap = (const AS4 Args*)__builtin_amdgcn_kernarg_segment_ptr(); asm volatile("" : "+s"(ap)); \
    unsigned char* const ws = ap->ws; int tid_o = threadIdx.x; asm volatile("" : "+v"(tid_o)); \
    Frame F; F.lds = (LAS unsigned char*)lds_raw; F.MISC = (volatile LAS unsigned*)(F.lds + MISC_OFF); F.ctl = (gu32*)(ws + WS_CTL); \
    F.tid = tid_o; F.lane = tid_o & 63; F.wave = __builtin_amdgcn_readfirstlane(tid_o >> 6); F.G = gridDim.x; \
    { const int bx = blockIdx.x; F.vcu = (F.G % 8 == 0) ? (bx % 8) * (F.G / 8) + bx / 8 : bx; } \
    const int gw = F.vcu * NWAVES + F.wave, NGW = F.G * NWAVES; const int gt = blockIdx.x * 512 + F.tid, NGT = F.G * 512; \
    bf16* const HB = (bf16*)(ws + WS_HB); bf16* const ZB = (bf16*)(ws + WS_ZB); \
    LAS unsigned char* const wl = F.lds + RING_OFF + F.wave * 16384; \
    (void)gw; (void)NGW; (void)gt; (void)NGT; (void)HB; (void)ZB; (void)wl;
#ifndef MK_DBL
#define MK_DBL 0
#endif
#define REP2 for (int rep_ = 0; rep_ < 2; ++rep_)
#if (MK_DBL >> 0) & 1
#define REP_0 REP2
#else
#define REP_0
#endif
#if (MK_DBL >> 1) & 1
#define REP_1 REP2
#else
#define REP_1
#endif
#if (MK_DBL >> 2) & 1
#define REP_2 REP2
#else
#define REP_2
#endif
#if (MK_DBL >> 3) & 1
#define REP_3 REP2
#else
#define REP_3
#endif
#if (MK_DBL >> 4) & 1
#define REP_4 REP2
#else
#define REP_4
#endif
#if (MK_DBL >> 5) & 1
#define REP_5 REP2
#else
#define REP_5
#endif
#if (MK_DBL >> 6) & 1
#define REP_6 REP2
#else
#define REP_6
#endif
#if (MK_DBL >> 7) & 1
#define REP_7 REP2
#else
#define REP_7
#endif
#if (MK_DBL >> 8) & 1
#define REP_8 REP2
#else
#define REP_8
#endif
#if (MK_DBL >> 9) & 1
#define REP_9 REP2
#else
#define REP_9
#endif
#if (MK_DBL >> 10) & 1
#define REP_10 REP2
#else
#define REP_10
#endif
#if (MK_DBL >> 11) & 1
#define REP_11 REP2
#else
#define REP_11
#endif
#if (MK_DBL >> 12) & 1
#define REP_12 REP2
#else
#define REP_12
#endif
#if (MK_DBL >> 13) & 1
#define REP_13 REP2
#else
#define REP_13
#endif
#if (MK_DBL >> 14) & 1
#define REP_14 REP2
#else
#define REP_14
#endif
#define REP(k) REP_##k
#define IN(k) (ap->in[k])
#define GRID_BAR() do { XcdBarrier bb_; bb_.bar = (unsigned*)(F.ctl + CW_BAR); bb_.x = xb_xcc_id(); bb_.st = F.MISC + 8; xcd_barrier(bb_); } while (0)

__global__ void __launch_bounds__(NWAVES * 64, 2) mk_fwd(Args args) {
    extern __shared__ __attribute__((aligned(16))) unsigned char lds_raw[];
    (void)args;
    {
        PHASE_LOCALS
        for (int u = F.tid; u < (LDS_BYTES - LDSCTL_OFF) / 4; u += NWAVES * 64) ((LAS unsigned*)(F.lds + LDSCTL_OFF))[u] = 0u;
        __syncthreads();
        (void)xcd_barrier_post((unsigned*)(F.ctl + CW_BAR), F.MISC + 8);
    }
    REP(0)
    {
        PHASE_LOCALS
        LAS float* scr = (LAS float*)wl;
        constexpr int I_IN = (D / 64) * (7264 / 32), I_BG = (D / 64) * (4096 / 32), I_OG = (1024 / 64) * (D / 32), I_O = (D / 64) * (D / 32), I_PP = (PLE / 64) * (D / 32);
        constexpr int NITEMS = I_IN + I_BG + 2 * I_OG + 2 * I_O + I_PP;
        for (int it = gw; it < I_IN; it += NGW) p0_transpose_item_win(IN(3), (bf16*)(ws + WS_WIN), ws + WS_WIN8, scr, it, F.lane);
        { GAS v4u* z = (GAS v4u*)((bf16*)(ws + WS_WIN) + (size_t)(ZC_IW + 16 - 2048) * D);
          for (int i = gt; i < 160 * D * 2 / 16; i += NGT) z[i] = (v4u){0u, 0u, 0u, 0u}; }
        { bf16* wr = (bf16*)(ws + WS_WR); const float* wg = IN(16); const float* we = IN(18);
          for (int i = gt; i < 256 * D; i += NGT) { const int n = i >> 11, k = i & 2047; const float v = n < 8 ? wg[k * 8 + n] : (n < 72 ? we[k * 64 + (n - 8)] : 0.f); wr[i] = (bf16)f2bf(v); } }
        for (int m = gw; m < T; m += NGW) rms_row_to_bf16(F.lane, IN(0) + (size_t)m * D, IN(2), HB + (size_t)m * D, (unsigned char*)ap->out + (size_t)m * D);
        GRID_BAR();
    }
    REP(1)
    {
        PHASE_LOCALS
        { pg8::StaticOrder S; S.init(T, ZN_A - 2048, F.G, (int)blockIdx.x);
          pg8::Gemm g{HB, (const bf16*)(ws + WS_WIN), D};
          pg8::EpiBf16Skip E{ZB, ZP, 4, 2048};
          pg8::gemm_phase<pg8::EpiBf16Skip, pg8::StaticOrder>(F.lds + RING_OFF, g, S, E); }
        { pg8::StaticOrder S; S.init(T, 5120, F.G, (int)blockIdx.x);
          pg8::Gemm8 g{(const unsigned char*)ap->out, ws + WS_WIN8, D / 2, 0x7f7f7f7f, 0x7a7a7a7a};
          pg8::EpiBf16Skip E{ZB + 1024, ZP, 8, ZN_A - 3072};
          pg8::gemm_phase8<pg8::EpiBf16Skip, pg8::StaticOrder>(F.lds + RING_OFF, g, S, E); }
        GRID_BAR();
    }
    REP(2)
    {
        PHASE_LOCALS
#if MK_GLA
        for (int task = blockIdx.x; task < NB * 128; task += F.G) {
            gla_prep_task(F.lds, ZB, IN(4), IN(5), (float*)(ws + WS_DEC), task);
            gla_local_unit(F.lds, F.wave, F.lane, ZB, (const float*)(ws + WS_DEC), (float*)(ws + WS_SLOC), task * 8 + F.wave);
            __syncthreads();
        }
#endif
        for (int m = gw; m < T; m += NGW) dsa_prep_row(F.lane, ZB, (size_t)m, IN(8), IN(9), (bf16*)(ws + WS_IKC), (float*)(ws + WS_UW));
        GRID_BAR();
    }
    REP(3)
    {
        PHASE_LOCALS
#if MK_GLA
        gla_scan((const float*)(ws + WS_SLOC), (const float*)(ws + WS_DEC), (bf16*)(ws + WS_STT), gt, NGT);
#endif
#if MK_DSA
        for (int task = blockIdx.x; task < NB * 64; task += F.G) {
            const int b = task >> 6, xq = task & 63;
#pragma unroll 1
            for (int half = 0; half < 2; ++half) {
                const int c = half ? 127 - xq : xq, n = 64 * (c + 1);
                unsigned char* wsl = ws; int lane_l = F.lane; asm volatile("" : "+s"(wsl), "+v"(lane_l));
                idx_scores_oct(wl, lane_l, (const bf16*)(wsl + WS_ZB), (const bf16*)(wsl + WS_IKC), (const float*)(wsl + WS_UW), (unsigned short*)(wsl + WS_SC), b, c, F.wave);
                VM_WAIT(); __syncthreads();
                asm volatile("" : "+s"(wsl), "+v"(lane_l));
#pragma unroll 1
                for (int q = 0; q < 8; ++q) { const int ql = F.wave * 8 + q;
                    idx_select_row(lane_l, (const unsigned short*)(wsl + WS_SC) + sc_off(b, c) + (size_t)ql * n, n, F.lds + RING_OFF + ql * 1024, (LAS unsigned*)(F.lds + RING_OFF + 65536 + F.wave * 8192)); }
                LDS_WAIT(); __syncthreads();
                asm volatile("" : "+s"(wsl), "+v"(lane_l));
                const int tend = (c | 3) + 1;
#pragma unroll 1
                for (int tile = F.wave; tile < tend; tile += NWAVES) bt_emit_tile(lane_l, F.lds + RING_OFF, (unsigned*)(wsl + WS_BM), b, c, tile, tile > c);
                __syncthreads();
            }
        }
#endif
        GRID_BAR();
    }
    REP(4)
    {
        PHASE_LOCALS
#if MK_GLA
        for (int u = gw; u < 4096; u += NGW) gla_out_unit(wl, F.lane, ZB, (const bf16*)(ws + WS_STT), IN(6), (bf16*)(ws + WS_OA), u);
        __syncthreads();
#endif
#if MK_MOE
        if (F.vcu % CONV_MOD == 0) {
            const int cw = (F.vcu / CONV_MOD) * NWAVES + F.wave, NCW = ((F.G + CONV_MOD - 1) / CONV_MOD) * NWAVES;
            LAS float* scr = (LAS float*)wl; const int lane_c = opaque_tid() & 63;
            conv_stream8<3>(IN(20), D, EFF, ws + WS_WGU8, 1024, 0, scr, lane_c, cw, NCW);
            conv_stream8<3>(IN(21), D, EFF, ws + WS_WGU8, 1024, 128, scr, lane_c, cw, NCW);
            conv_stream8<0>(IN(22), EFF, D, ws + WS_WDN8, D, 0, scr, lane_c, cw, NCW);
            p0_weight_stream(ap, ws, scr, lane_c, P0_I_IN + cw, NCW);
            __syncthreads();
        }
#endif
#if MK_DSA
        att::attn_phase((char*)lds_raw, ZB, ws + WS_OB, (const unsigned*)(ws + WS_BM), IN(10), IN(8), IN(9), F.ctl + CW_ATTQ);
#endif
        GRID_BAR();
    }
    REP(5)
    {
        PHASE_LOCALS
        pg8::StaticOrder S; S.init(T, D, F.G, (int)blockIdx.x);
        { pg8::Gemm g{(const bf16*)(ws + WS_OA), (const bf16*)(ws + WS_WOG), 1024}; pg8::EpiFp8 E{ws + WS_YA, D};
          pg8::gemm_phase<pg8::EpiFp8, pg8::StaticOrder>(F.lds + RING_OFF, g, S, E); }
        { pg8::Gemm8 g{ws + WS_OB, ws + WS_WOD8, 1024 / 2, 0x7b7b7b7b, 0x7a7a7a7a}; pg8::EpiFp8 E{ws + WS_YB, D};
          pg8::gemm_phase8<pg8::EpiFp8, pg8::StaticOrder>(F.lds + RING_OFF, g, S, E); }
        GRID_BAR();
    }
    REP(6)
    {
        PHASE_LOCALS
        pg8::StaticOrder S; S.init(T, 4096, F.G, (int)blockIdx.x);
        pg8::Gemm8 g{(const unsigned char*)ap->out, ws + WS_WBG8, D / 2, 0x7f7f7f7f, 0x7a7a7a7a};
        pg8::EpiGateMix E{ws + WS_YA, ws + WS_YB, ws + WS_U, IN(13)};
        pg8::gemm_phase8<pg8::EpiGateMix, pg8::StaticOrder>(F.lds + RING_OFF, g, S, E);
        GRID_BAR();
    }
    REP(7)
    {
        PHASE_LOCALS
        pg8::StaticOrder S; S.init(T, D, F.G, (int)blockIdx.x);
        pg8::Gemm8 g{ws + WS_U, ws + WS_WO8, D / 2, 0x7c7c7c7c, 0x7a7a7a7a};
        pg8::EpiResBf16P E{IN(0), (bf16*)ap->out, D};
        pg8::gemm_phase8<pg8::EpiResBf16P, pg8::StaticOrder>(F.lds + RING_OFF, g, S, E);
        GRID_BAR();
    }
    REP(8)
    {
        PHASE_LOCALS
        for (int m = gw; m < T; m += NGW) rms_row_bf(F.lane, (const bf16*)ap->out + (size_t)m * D, IN(15), (bf16*)(ws + WS_H2B) + (size_t)m * D, ws + WS_H8 + (size_t)m * D);
        { const GAS f32x4* p4 = (const GAS f32x4*)IN(1); GAS v2u* o = (GAS v2u*)(ws + WS_PBF);
          for (size_t i = (size_t)gt; i < (size_t)T * PLE / 4; i += (size_t)NGT) { const f32x4 v = p4[i]; v2u w; w.x = pk2(v.x, v.y); w.y = pk2(v.z, v.w); o[i] = w; } }
        GRID_BAR();
    }
#if MK_MOE
    REP(9)
    {
        PHASE_LOCALS
        pg8::StaticOrder S; S.init(T, 256, F.G, (int)blockIdx.x);
        pg8::Gemm g{(const bf16*)(ws + WS_H2B), (const bf16*)(ws + WS_WR), D};
        pg8::EpiF32 E{(float*)(ws + WS_LOGIT), 256};
        pg8::gemm_phase<pg8::EpiF32, pg8::StaticOrder>(F.lds + RING_OFF, g, S, E);
        VM_WAIT(); __syncthreads();
        { pg8::Unit ur;
          const int nu = (128 - (int)blockIdx.x + F.G - 1) / F.G;
#pragma unroll 1
          for (int iu = 0; iu < nu; ++iu) { S.next(iu, ur); const int t_lo = ur.pm * 256, t_hi = t_lo + 256;
        const float* LG = (const float*)(ws + WS_LOGIT); const float* bg = IN(17); const float* be = IN(19);
          unsigned* cnt = (unsigned*)(F.ctl + CW_CNT); int* tokrow = (int*)(ws + WS_TOKROW); float* tokw = (float*)(ws + WS_TOKW);
          LAS unsigned* cl = (LAS unsigned*)(F.lds + RING_OFF);
          if (F.tid < 64) cl[F.tid] = 0u;
          __syncthreads();
          const bool act_t = F.tid < 256; const int t = t_lo + F.tid; (void)t_hi;
          int e0 = 0, e1 = 0; unsigned r0 = 0u, r1 = 0u; float wa = 0.f, wb = 0.f;
          if (act_t) {
              const f32x4 a = *(const f32x4*)(LG + (size_t)t * 256), b2 = *(const f32x4*)(LG + (size_t)t * 256 + 4);
              float l[8] = {a.x + bg[0], a.y + bg[1], a.z + bg[2], a.w + bg[3], b2.x + bg[4], b2.y + bg[5], b2.z + bg[6], b2.w + bg[7]};
              int gi = 0; float gm = l[0];
#pragma unroll
              for (int i = 1; i < 8; ++i) if (l[i] > gm) { gm = l[i]; gi = i; }
              float se = 0.f;
#pragma unroll
              for (int i = 0; i < 8; ++i) se += __expf(l[i] - gm);
              const float grp_w = 1.0f / se;
              const f32x4 c0 = *(const f32x4*)(LG + (size_t)t * 256 + 8 + gi * 8), c1 = *(const f32x4*)(LG + (size_t)t * 256 + 12 + gi * 8);
              const float* bb = be + gi * 8;
              float ev[8] = {c0.x + bb[0], c0.y + bb[1], c0.z + bb[2], c0.w + bb[3], c1.x + bb[4], c1.y + bb[5], c1.z + bb[6], c1.w + bb[7]};
              int i0 = 0; float v0 = ev[0];
#pragma unroll
              for (int i = 1; i < 8; ++i) if (ev[i] > v0) { v0 = ev[i]; i0 = i; }
              int i1 = -1; float v1 = -__builtin_inff();
#pragma unroll
              for (int i = 0; i < 8; ++i) if (i != i0 && ev[i] > v1) { v1 = ev[i]; i1 = i; }
              const float w0 = 1.0f / (1.0f + __expf(v1 - v0)), w1 = 1.0f - w0;
              e0 = gi * 8 + i0; e1 = gi * 8 + i1; wa = grp_w * w0; wb = grp_w * w1;
              r0 = __hip_atomic_fetch_add(cl + e0, 1u, __ATOMIC_RELAXED, __HIP_MEMORY_SCOPE_WORKGROUP); r1 = __hip_atomic_fetch_add(cl + e1, 1u, __ATOMIC_RELAXED, __HIP_MEMORY_SCOPE_WORKGROUP);
          }
          __syncthreads();
          if (F.tid < 64) { const unsigned c = cl[F.tid]; cl[64 + F.tid] = c ? atomicAdd(&cnt[F.tid], c) : 0u; }
          __syncthreads();
          if (act_t) { const unsigned p0 = cl[64 + e0] + r0, p1 = cl[64 + e1] + r1;
              tokrow[(size_t)e0 * ECAP + p0] = t * 2; tokw[(size_t)e0 * ECAP + p0] = wa;
              tokrow[(size_t)e1 * ECAP + p1] = t * 2 + 1; tokw[(size_t)e1 * ECAP + p1] = wb; }
          __syncthreads();
          } }
        { pg8::PleOrder SP{F.G, (int)blockIdx.x};
          pg8::Gemm gp{(const bf16*)(ws + WS_PBF), (const bf16*)(ws + WS_WPP), PLE};
          pg8::EpiBf16 EP{(bf16*)(ws + WS_PLEB), D};
          pg8::gemm_phase<pg8::EpiBf16, pg8::PleOrder>(F.lds + RING_OFF, gp, SP, EP); }
        GRID_BAR();
    }
    REP(11)
    {
        PHASE_LOCALS
        LAS int* pref = (LAS int*)(F.lds + PREF_OFF); LAS int* cntl = (LAS int*)(F.lds + CNTL_OFF);
        if (F.tid < 64) cntl[F.tid] = (int)__hip_atomic_load((unsigned*)(F.ctl + CW_CNT) + F.tid, RLX_AGENT);
        __syncthreads();
        if (F.tid == 0) { int acc = 0; for (int e = 0; e < 64; ++e) { pref[e] = acc; acc += (cntl[e] + 255) >> 8; } pref[64] = acc; }
        __syncthreads();
        pg8::MoeOrder S{pref, cntl, (const int*)(ws + WS_TOKROW), 4, F.G, F.vcu, D / 2};
        pg8::Gemm8 g{ws + WS_H8, ws + WS_WGU8, D / 2, 0x7f7f7f7f, 0x7a7a7a7a};
        pg8::EpiMoe1 E{ws + WS_ACT};
        pg8::gemm_phase8<pg8::EpiMoe1, pg8::MoeOrder, true>(F.lds + RING_OFF, g, S, E);
        GRID_BAR();
    }
    REP(12)
    {
        PHASE_LOCALS
        LAS int* pref = (LAS int*)(F.lds + PREF_OFF); LAS int* cntl = (LAS int*)(F.lds + CNTL_OFF);
        pg8::MoeOrder S{pref, cntl, (const int*)(ws + WS_TOKROW), 8, F.G, F.vcu, EFF / 2};
        pg8::Gemm8 g{ws + WS_ACT, ws + WS_WDN8, EFF / 2, 0x7d7d7d7d, 0x7a7a7a7a};
        pg8::EpiMoe2 E{(bf16*)(ws + WS_Y0), (long long)(HB - (bf16*)(ws + WS_Y0)), (const int*)(ws + WS_TOKROW), (const float*)(ws + WS_TOKW), cntl};
        pg8::gemm_phase8<pg8::EpiMoe2, pg8::MoeOrder, false>(F.lds + RING_OFF, g, S, E);
        GRID_BAR();
    }
#endif
    REP(13)
    {
        PHASE_LOCALS
        for (int m = gw; m < T; m += NGW) combine_row_bf(F.lane, (const bf16*)ap->out + (size_t)m * D, (const bf16*)(ws + WS_Y0) + (size_t)m * D, HB + (size_t)m * D, IN(23), (bf16*)(ws + WS_X2B) + (size_t)m * D, ws + WS_H8 + (size_t)m * D);
        GRID_BAR();
    }
    REP(14)
    {
        PHASE_LOCALS
        pg8::StaticOrder S; S.init(T, D, F.G, (int)blockIdx.x);
        { pg8::Gemm8 g{ws + WS_H8, ws + WS_WPG8, D / 2, 0x7f7f7f7f, 0x7a7a7a7a};
          pg8::EpiPleFinal E{(const bf16*)(ws + WS_X2B), (const bf16*)(ws + WS_PLEB), ap->out, IN(25)};
          pg8::gemm_phase8<pg8::EpiPleFinal, pg8::StaticOrder>(F.lds + RING_OFF, g, S, E); }
    }
}

extern "C" void kernel_launch(void* const* d_in, const int* in_sizes, int n_in, void* d_out, int out_size, void* d_ws, size_t ws_size, hipStream_t stream) {
    static int grid = 0;
    if (grid == 0) {
        if (n_in != 27 || out_size != T * D || ws_size < WS_END) { fprintf(stderr, "kernel_launch: unexpected shapes (n_in %d out %d ws %zu, need %zu)\n", n_in, out_size, ws_size, (size_t)WS_END); grid = -1; return; }
        int dev = 0, cus = 0, per_cu = 0;
        if (hipGetDevice(&dev) != hipSuccess || hipDeviceGetAttribute(&cus, hipDeviceAttributeMultiprocessorCount, dev) != hipSuccess) { grid = -1; return; }
        if (hipFuncSetAttribute((const void*)mk_fwd, hipFuncAttributeMaxDynamicSharedMemorySize, LDS_BYTES) != hipSuccess) { fprintf(stderr, "kernel_launch: hipFuncSetAttribute failed\n"); grid = -1; return; }
        if (hipOccupancyMaxActiveBlocksPerMultiprocessor(&per_cu, (const void*)mk_fwd, NWAVES * 64, LDS_BYTES) != hipSuccess || per_cu < 1) { fprintf(stderr, "kernel_launch: occupancy query says %d\n", per_cu); }
        (void)hipGetLastError();
        grid = cus;
    }
    if (grid < 0) return;
    if (hipMemsetAsync((char*)d_ws + WS_CTL, 0, CTL_ZERO_BYTES, stream) != hipSuccess) return;
    Args a{};
    for (int i = 0; i < 27; ++i) a.in[i] = (const float*)d_in[i];
    a.out = (float*)d_out; a.ws = (unsigned char*)d_ws; a.ph_lo = 0; a.ph_hi = 99;
    hipLaunchKernelGGL(mk_fwd, dim3(grid), dim3(NWAVES * 64), LDS_BYTES, stream, a);
}
```
